# Optimizing an MI355X kernel written in HIP

```python
import jax, jax.numpy as jnp
from jax import lax
import numpy as np

D_MODEL = 2048
BATCH = 1
SEQ = 16384
DEPTH = 1

CHUNK = 64
EPS = 1e-6
MIX_WIDTH = D_MODEL

SSD_HEAD_DIM = 64
SSD_INNER = MIX_WIDTH // 2
SSD_HEADS = SSD_INNER // SSD_HEAD_DIM
SSD_GROUPS = 2
SSD_STATE = 128
SSD_CONV = 4
SSD_CONV_DIM = SSD_INNER + 2 * SSD_GROUPS * SSD_STATE

FOX_HEAD_DIM = 64
FOX_INNER = MIX_WIDTH - SSD_INNER
FOX_HEADS = FOX_INNER // FOX_HEAD_DIM
Q_BLOCK = 128

PEER_HEADS = 8
PEER_N_KEYS = 128
PEER_N_EXPERTS = PEER_N_KEYS * PEER_N_KEYS
PEER_KEY_DIM = 256
PEER_TOPK = 16
PEER_TOKEN_BLOCK = 128

IN_SPLITS = (SSD_INNER, SSD_CONV_DIM, SSD_HEADS, FOX_INNER, FOX_INNER, FOX_INNER, FOX_HEADS)
IN_PROJ_DIM = sum(IN_SPLITS)

kernel_name = "hymba_ssd_fox_peer_block"


def rmsnorm(x, w):
    xf = x.astype(jnp.float32)
    xf = xf * lax.rsqrt(jnp.mean(xf * xf, axis=-1, keepdims=True) + EPS)
    return (xf * w.astype(jnp.float32)).astype(x.dtype)


def ssd_chunked(xs, dt, A, Bm, Cm):
    b, l = xs.shape[:2]
    nc = l // CHUNK
    R = SSD_HEADS // SSD_GROUPS
    x = xs.astype(jnp.float32).reshape(b, nc, CHUNK, SSD_GROUPS, R, SSD_HEAD_DIM)
    dtc = dt.reshape(b, nc, CHUNK, SSD_GROUPS, R)
    Bc = Bm.astype(jnp.float32).reshape(b, nc, CHUNK, SSD_GROUPS, SSD_STATE)
    Cc = Cm.astype(jnp.float32).reshape(b, nc, CHUNK, SSD_GROUPS, SSD_STATE)
    a = dtc * A.reshape(SSD_GROUPS, R)
    a_cum = jnp.cumsum(a, axis=2)
    xdt = x * dtc[..., None]
    seg = a_cum[:, :, :, None] - a_cum[:, :, None]
    tri = jnp.tril(jnp.ones((CHUNK, CHUNK), dtype=bool))[None, None, :, :, None, None]
    L = jnp.exp(jnp.where(tri, seg, -jnp.inf))
    cb = jnp.einsum('bctgn,bcsgn->bctsg', Cc, Bc)
    y_diag = jnp.einsum('bctsg,bctsgr,bcsgrp->bctgrp', cb, L, xdt)
    decay_states = jnp.exp(a_cum[:, :, -1:] - a_cum)
    states = jnp.einsum('bcsgn,bcsgr,bcsgrp->bcgrpn', Bc, decay_states, xdt)
    chunk_decay = jnp.exp(a_cum[:, :, -1])

    def step(h, inp):
        s_c, d_c = inp
        return h * d_c[..., None, None] + s_c, h

    h0 = jnp.zeros((b, SSD_GROUPS, R, SSD_HEAD_DIM, SSD_STATE), jnp.float32)
    _, prev = lax.scan(step, h0, (jnp.moveaxis(states, 1, 0), jnp.moveaxis(chunk_decay, 1, 0)))
    prev = jnp.moveaxis(prev, 0, 1)
    y_off = jnp.einsum('bctgn,bcgrpn,bctgr->bctgrp', Cc, prev, jnp.exp(a_cum))
    return (y_diag + y_off).reshape(b, l, SSD_HEADS, SSD_HEAD_DIM)


def ssd_group(z, xbc, dt_raw, conv_w, conv_b, dt_bias, a_log, d_skip, ssd_norm_w):
    b, l = z.shape[:2]
    xbc = lax.conv_general_dilated(
        xbc, conv_w[:, None, :], window_strides=(1,), padding=[(SSD_CONV - 1, 0)],
        dimension_numbers=('NWC', 'WIO', 'NWC'), feature_group_count=SSD_CONV_DIM) + conv_b
    xbc = jax.nn.silu(xbc)
    xs, Bm, Cm = jnp.split(xbc, [SSD_INNER, SSD_INNER + SSD_GROUPS * SSD_STATE], axis=-1)
    xs = xs.reshape(b, l, SSD_HEADS, SSD_HEAD_DIM)
    Bm = Bm.reshape(b, l, SSD_GROUPS, SSD_STATE)
    Cm = Cm.reshape(b, l, SSD_GROUPS, SSD_STATE)
    dt = jax.nn.softplus(dt_raw.astype(jnp.float32) + dt_bias.astype(jnp.float32))
    A = -jnp.exp(a_log.astype(jnp.float32))
    y = ssd_chunked(xs, dt, A, Bm, Cm)
    y = y + d_skip.astype(jnp.float32)[:, None] * xs.astype(jnp.float32)
    y = y.reshape(b, l, SSD_INNER) * jax.nn.silu(z.astype(jnp.float32))
    y = y.reshape(b, l, SSD_GROUPS, SSD_INNER // SSD_GROUPS)
    y = y * lax.rsqrt(jnp.mean(y * y, axis=-1, keepdims=True) + EPS)
    y = y.reshape(b, l, SSD_INNER) * ssd_norm_w.astype(jnp.float32)
    return y.astype(z.dtype)


def fox_group(q, k, v, f_raw, fox_f_bias):
    b, l = q.shape[:2]
    q = q.reshape(b, l, FOX_HEADS, FOX_HEAD_DIM) * (FOX_HEAD_DIM ** -0.5)
    k = k.reshape(b, l, FOX_HEADS, FOX_HEAD_DIM)
    v = v.reshape(b, l, FOX_HEADS, FOX_HEAD_DIM)
    log_f = jax.nn.log_sigmoid(f_raw.astype(jnp.float32) + fox_f_bias.astype(jnp.float32))
    cum = jnp.transpose(jnp.cumsum(log_f, axis=1), (0, 2, 1))
    outs = []
    for i in range(l // Q_BLOCK):
        qs, qe = i * Q_BLOCK, (i + 1) * Q_BLOCK
        s = jnp.einsum('bqhd,bkhd->bhqk', q[:, qs:qe], k[:, :qe]).astype(jnp.float32)
        s = s + cum[:, :, qs:qe, None] - cum[:, :, None, :qe]
        mask = (qs + jnp.arange(Q_BLOCK))[:, None] >= jnp.arange(qe)[None, :]
        p = jax.nn.softmax(jnp.where(mask, s, -jnp.inf), axis=-1)
        outs.append(jnp.einsum('bhqk,bkhd->bqhd', p.astype(v.dtype), v[:, :qe]))
    return jnp.concatenate(outs, axis=1).reshape(b, l, FOX_INNER)


def peer(h, wq, k1, k2, u, v):
    b, l, d = h.shape
    t = h.reshape(-1, d)
    T = t.shape[0]
    q = (t @ wq).reshape(T, PEER_HEADS, 2, PEER_KEY_DIM // 2)
    s1 = jnp.einsum('thd,hnd->thn', q[:, :, 0], k1).astype(jnp.float32)
    s2 = jnp.einsum('thd,hnd->thn', q[:, :, 1], k2).astype(jnp.float32)
    v1, i1 = lax.top_k(s1, PEER_TOPK)
    v2, i2 = lax.top_k(s2, PEER_TOPK)
    cand = (v1[..., :, None] + v2[..., None, :]).reshape(T, PEER_HEADS, PEER_TOPK * PEER_TOPK)
    cand_idx = (i1[..., :, None] * PEER_N_KEYS + i2[..., None, :]).reshape(T, PEER_HEADS, PEER_TOPK * PEER_TOPK)
    sc, pos = lax.top_k(cand, PEER_TOPK)
    idx = jnp.take_along_axis(cand_idx, pos, axis=-1)
    g = jax.nn.softmax(sc, axis=-1).astype(t.dtype)

    def block(args):
        tb, ib, gb = args
        act = jax.nn.gelu(jnp.einsum('thkd,td->thk', u[ib], tb), approximate=False)
        return jnp.einsum('thk,thkd->td', gb * act, v[ib])

    nb = T // PEER_TOKEN_BLOCK
    out = lax.map(block, (t.reshape(nb, PEER_TOKEN_BLOCK, d),
                          idx.reshape(nb, PEER_TOKEN_BLOCK, PEER_HEADS, PEER_TOPK),
                          g.reshape(nb, PEER_TOKEN_BLOCK, PEER_HEADS, PEER_TOPK)))
    return out.reshape(b, l, d)


def setup_inputs(seed: int = 0) -> dict:
    key = jax.random.key(seed)
    ks = jax.random.split(key, 20)
    f32 = jnp.float32
    nrm = lambda k, shape: jax.random.normal(k, shape, f32)
    dt0 = jnp.exp(jax.random.uniform(ks[5], (SSD_HEADS,), f32, np.log(1e-3), np.log(1e-1)))
    return {
        "x": nrm(ks[0], (BATCH, SEQ, D_MODEL)),
        "ln1_w": 1.0 + 0.02 * nrm(ks[1], (D_MODEL,)),
        "w_in": nrm(ks[2], (D_MODEL, IN_PROJ_DIM)) * D_MODEL ** -0.5,
        "conv_w": nrm(ks[3], (SSD_CONV, SSD_CONV_DIM)) * SSD_CONV ** -0.5,
        "conv_b": 0.02 * nrm(ks[4], (SSD_CONV_DIM,)),
        "dt_bias": dt0 + jnp.log(-jnp.expm1(-dt0)),
        "a_log": jnp.log(jax.random.uniform(ks[6], (SSD_HEADS,), f32, 1.0, 16.0)),
        "d_skip": 1.0 + 0.1 * nrm(ks[7], (SSD_HEADS,)),
        "ssd_norm_w": 1.0 + 0.02 * nrm(ks[8], (SSD_INNER,)),
        "fox_f_bias": jnp.linspace(1.0, 6.0, FOX_HEADS, dtype=f32) + 0.1 * nrm(ks[9], (FOX_HEADS,)),
        "w_out": nrm(ks[10], (MIX_WIDTH, D_MODEL)) * MIX_WIDTH ** -0.5,
        "ln2_w": 1.0 + 0.02 * nrm(ks[11], (D_MODEL,)),
        "peer_wq": nrm(ks[12], (D_MODEL, PEER_HEADS * PEER_KEY_DIM)) * D_MODEL ** -0.5,
        "peer_k1": nrm(ks[13], (PEER_HEADS, PEER_N_KEYS, PEER_KEY_DIM // 2)) * (PEER_KEY_DIM // 2) ** -0.5,
        "peer_k2": nrm(ks[14], (PEER_HEADS, PEER_N_KEYS, PEER_KEY_DIM // 2)) * (PEER_KEY_DIM // 2) ** -0.5,
        "peer_u": nrm(ks[15], (PEER_N_EXPERTS, D_MODEL)) * D_MODEL ** -0.5,
        "peer_v": nrm(ks[16], (PEER_N_EXPERTS, D_MODEL)) * PEER_HEADS ** -0.5,
        "lnf_w": 1.0 + 0.02 * nrm(ks[17], (D_MODEL,)),
    }


def reference(x, ln1_w, w_in, conv_w, conv_b, dt_bias, a_log, d_skip, ssd_norm_w,
              fox_f_bias, w_out, ln2_w, peer_wq, peer_k1, peer_k2, peer_u, peer_v, lnf_w):
    split_at = [int(s) for s in np.cumsum(IN_SPLITS)[:-1]]
    for _ in range(DEPTH):
        h = rmsnorm(x, ln1_w)
        proj = h @ w_in
        z, xbc, dt_raw, q, k, v, f_raw = jnp.split(proj, split_at, axis=-1)
        y_ssd = ssd_group(z, xbc, dt_raw, conv_w, conv_b, dt_bias, a_log, d_skip, ssd_norm_w)
        y_fox = fox_group(q, k, v, f_raw, fox_f_bias)
        x = x + jnp.concatenate([y_ssd, y_fox], axis=-1) @ w_out
        x = x + peer(rmsnorm(x, ln2_w), peer_wq, peer_k1, peer_k2, peer_u, peer_v)
    return rmsnorm(x, lnf_w)
```

```cpp
#include <hip/hip_runtime.h>
#include <cstdio>
#include <cstdint>
#include <cmath>
#ifndef SELFCHECK
#define SELFCHECK 0
#endif
namespace pg8 {
#define PG8_LAS __attribute__((address_space(3)))
typedef unsigned short bf16_t;
typedef short bf16x8 __attribute__((ext_vector_type(8)));
typedef float f32x4 __attribute__((ext_vector_type(4)));
typedef unsigned u32x4 __attribute__((ext_vector_type(4)));
constexpr int BM = 256, BK = 64, HALF = 128, HTB = HALF * BK * 2  , STAGE_BYTES = 8 * HTB, NXCD = 8, WGM = 4;

__host__ __device__ __forceinline__ int lds_byte(int r, int c) { const int st = (r >> 4) * 2 + (c >> 5), rr = r & 15, cc = c & 31, ob = rr * 64 + cc * 2; return st * 1024 + (ob ^ (((ob >> 9) & 1) << 5)); }
__host__ __device__ __forceinline__ void stage_rc(int b, int& R, int& C) { const int st = b / 1024, sb = b % 1024, swz = sb ^ (((sb >> 9) & 1) << 5); R = (st >> 1) * 16 + swz / 64; C = (st & 1) * 32 + (swz % 64) / 2; }
__host__ __device__ __forceinline__ int perm32(int rho) { const int n = rho >> 4, i = rho & 15; return 8 * (i >> 2) + 4 * n + (i & 3); }

struct Unit { int pm, pn; };
struct Gemm { const bf16_t* A; const bf16_t* Bt; int M, N, K; };

struct StaticOrder {
    int nM, nN, nwg, G, c;
    __host__ __device__ void init(int M, int N, int G_, int c_) { nM = M / BM; nN = N / BM; nwg = nM * nN; G = G_; c = c_; }
    __host__ __device__ bool next(int i, Unit& u) const {
        const long L = (long)i * G + c; if (L >= nwg) return false;
        int wgid = (int)L; { const int q = nwg / NXCD, r = nwg % NXCD, xcd = wgid % NXCD, off = wgid / NXCD; wgid = (xcd < r ? xcd * (q + 1) : r * (q + 1) + (xcd - r) * q) + off; }
        const int nig = WGM * nN, gid = wgid / nig, fm = gid * WGM, gsz = (nM - fm) < WGM ? (nM - fm) : WGM;
        u.pm = fm + ((wgid % nig) % gsz); u.pn = (wgid % nig) / gsz; return true;
    }
    __device__ __forceinline__ void a_ready(const Unit&) const {}
    __device__ __forceinline__ void done(const Unit&) const {}
};

__device__ __forceinline__ unsigned cvt_pk_bf16(float lo, float hi) { unsigned r; asm volatile("v_cvt_pk_bf16_f32 %0, %1, %2" : "=v"(r) : "v"(lo), "v"(hi)); return r; }
typedef float f32x2 __attribute__((ext_vector_type(2)));
__device__ __forceinline__ f32x2 gelu_pk(f32x2 v) {
    const f32x2 av = __builtin_elementwise_abs(v), d = av * 0.2316418882f + 1.0f;
    f32x2 t; t.x = __builtin_amdgcn_rcpf(d.x); t.y = __builtin_amdgcn_rcpf(d.y);
    f32x2 q = t * 0.5307027145f + (-0.7265760135f); q = q * t + 0.7107068705f; q = q * t + (-0.142248368f); q = q * t + 0.127414796f; q = q * t;
    const f32x2 s = (v * v) * (-0.72134752044f);
    f32x2 e; e.x = __builtin_amdgcn_exp2f(s.x); e.y = __builtin_amdgcn_exp2f(s.y);
    const f32x2 m = v * (q * e), r = v - m;
    f32x2 o; o.x = v.x < 0.f ? m.x : r.x; o.y = v.y < 0.f ? m.y : r.y; return o;
}

template <int ACT  > struct EpiBf16 {
    static constexpr bool PERM = true, AFTER_DRAIN = false; static_assert(ACT == 0 || ACT == 1, "EpiBf16: ACT is 0 (none) or 1 (gelu_pk)");
    bf16_t* O; int ldc; const float* bias; int split_cols; size_t split_stride; float scale0;
    __device__ __forceinline__ void operator()(const f32x4 (&acc)[2][2][4][2], const Unit& u, int wr, int wc, int fr, int fq) const {
        const int row0 = u.pm * BM + wr * 64 + fr; int colt = u.pn * BM; bf16_t* base = O;
        float sc = 1.f; if (split_cols) { const int t = colt / split_cols; base += (size_t)t * split_stride; colt -= t * split_cols; if (t == 0) sc = scale0; }
        const int col0 = colt + wc * 32 + 8 * fq, bcol0 = u.pn * BM + wc * 32 + 8 * fq;
        f32x4 bv[2][2];
#pragma unroll
        for (int bj = 0; bj < 2; ++bj)
#pragma unroll
            for (int n = 0; n < 2; ++n) bv[bj][n] = bias ? *(const f32x4*)(bias + bcol0 + bj * HALF + 4 * n) : (f32x4){0.f, 0.f, 0.f, 0.f};
#pragma unroll
        for (int ai = 0; ai < 2; ++ai)
#pragma unroll
            for (int m = 0; m < 4; ++m) { bf16_t* rowp = base + (size_t)(row0 + ai * HALF + m * 16) * ldc + col0;
#pragma unroll
                for (int bj = 0; bj < 2; ++bj) { f32x4 v0 = acc[ai][bj][m][0] + bv[bj][0], v1 = acc[ai][bj][m][1] + bv[bj][1];
                    if (ACT == 1) { f32x2 a = gelu_pk((f32x2){v0[0], v0[1]}), b = gelu_pk((f32x2){v0[2], v0[3]}), c = gelu_pk((f32x2){v1[0], v1[1]}), d = gelu_pk((f32x2){v1[2], v1[3]});
                        v0 = (f32x4){a.x, a.y, b.x, b.y}; v1 = (f32x4){c.x, c.y, d.x, d.y}; }
                    v0 = v0 * sc; v1 = v1 * sc; u32x4 w; w.x = cvt_pk_bf16(v0[0], v0[1]); w.y = cvt_pk_bf16(v0[2], v0[3]); w.z = cvt_pk_bf16(v1[0], v1[1]); w.w = cvt_pk_bf16(v1[2], v1[3]);
                    *(u32x4*)(rowp + bj * HALF) = w; } }
    }
};
template <class Epi, class Sched, bool ALIGN_EPI = false, bool SP2 = false>
__device__ __forceinline__ void gemm_phase(PG8_LAS unsigned char* lds, const Gemm g, const Sched& S, const Epi& E, const int tid_in) {
    const int tid = tid_in, wid = __builtin_amdgcn_readfirstlane(tid >> 6), lane = tid & 63, wr = wid >> 2, wc = wid & 3, fr = lane & 15, fq = lane >> 4;
    const int K = g.K, nt = K / BK;
    unsigned voffA[2], voffB[2];
#pragma unroll
    for (int i = 0; i < 2; ++i) { int R, C; stage_rc(tid * 16 + i * 8192, R, C); const int Rb = Epi::PERM ? ((R & ~31) + perm32(R & 31)) : R;
        voffA[i] = (unsigned)(R * K + C) * 2u; voffB[i] = (unsigned)(Rb * K + C) * 2u; }
    const size_t kstep = (size_t)(BK * 2);
    const size_t hstep = (size_t)HALF * K * 2;
    const size_t tstep = 2 * hstep;
    const unsigned ldsw = (unsigned)wid * 1024u;
    const int aoff = lds_byte(wr * 64 + fr, fq * 8), boff = lds_byte(wc * 32 + fr, fq * 8);
#define PG8_SA(b, h) (((b) * 2 + (h)) * HTB)
#define PG8_SB(b, h) ((4 + (b) * 2 + (h)) * HTB)
#define PG8_STAGE(bufoff, gbase, voff) do { _Pragma("unroll") for (int _i = 0; _i < 2; ++_i) \
        __builtin_amdgcn_global_load_lds((const unsigned*)((const char*)(gbase) + (voff)[_i]), (PG8_LAS unsigned*)(lds + (bufoff) + ldsw + _i * 8192), 16, 0, 0); } while (0)
#define PG8_LDA(dst, b, h) do { _Pragma("unroll") for (int m = 0; m < 4; ++m) _Pragma("unroll") for (int k = 0; k < 2; ++k) dst[m][k] = *(const PG8_LAS bf16x8*)(lds + PG8_SA(b, h) + aoff + m * 2048 + k * 1024); } while (0)
#define PG8_LDB(dst, b, h) do { _Pragma("unroll") for (int n = 0; n < 2; ++n) _Pragma("unroll") for (int k = 0; k < 2; ++k) dst[n][k] = *(const PG8_LAS bf16x8*)(lds + PG8_SB(b, h) + boff + n * 2048 + k * 1024); } while (0)
#define PG8_MMA(ai, bj, At, Bt) do { __builtin_amdgcn_s_setprio(1); _Pragma("unroll") for (int m = 0; m < 4; ++m) _Pragma("unroll") for (int n = 0; n < 2; ++n) _Pragma("unroll") for (int k = 0; k < 2; ++k) \
        acc[ai][bj][m][n] = __builtin_amdgcn_mfma_f32_16x16x32_bf16(Bt[n][k], At[m][k], acc[ai][bj][m][n], 0, 0, 0); __builtin_amdgcn_s_setprio(0); } while (0)
#define PG8_WAIT_V(n) asm volatile("s_waitcnt vmcnt(" #n ")" ::: "memory")
#define PG8_WAIT_L(n) asm volatile("s_waitcnt lgkmcnt(" #n ")" ::: "memory")
#define PG8_BAR __builtin_amdgcn_s_barrier()
#define PG8_SCHED __builtin_amdgcn_sched_barrier(0)
    Unit cur, nxt; int ui = 0;
    if (!S.next(0, cur)) return;
    f32x4 acc[2][2][4][2];
#pragma unroll
    for (int a = 0; a < 2; ++a)
#pragma unroll
        for (int b = 0; b < 2; ++b)
#pragma unroll
            for (int m = 0; m < 4; ++m)
#pragma unroll
                for (int n = 0; n < 2; ++n) acc[a][b][m][n] = (f32x4){0.f, 0.f, 0.f, 0.f};
    bf16x8 At[4][2], B0[2][2], B1[2][2];
    const char* cA = (const char*)g.A + (size_t)cur.pm * tstep; const char* cB = (const char*)g.Bt + (size_t)cur.pn * tstep;
    S.a_ready(cur);
    if constexpr (SP2) {
        PG8_STAGE(PG8_SB(0, 0), cB, voffB); PG8_STAGE(PG8_SB(0, 1), cB + hstep, voffB); PG8_STAGE(PG8_SA(0, 0), cA, voffA); PG8_STAGE(PG8_SA(0, 1), cA + hstep, voffA);
        if (wr == 1) PG8_BAR;
        PG8_WAIT_V(2); PG8_BAR;
        PG8_STAGE(PG8_SB(1, 0), cB + kstep, voffB); PG8_STAGE(PG8_SA(1, 0), cA + kstep, voffA); PG8_STAGE(PG8_SB(1, 1), cB + hstep + kstep, voffB);
        PG8_WAIT_V(6); PG8_BAR;
    } else {
        PG8_STAGE(PG8_SB(0, 0), cB, voffB); PG8_STAGE(PG8_SA(0, 0), cA, voffA); PG8_STAGE(PG8_SB(0, 1), cB + hstep, voffB); PG8_STAGE(PG8_SA(0, 1), cA + hstep, voffA);
        if (wr == 1) PG8_BAR;
        PG8_WAIT_V(4); PG8_BAR;
        PG8_STAGE(PG8_SB(1, 0), cB + kstep, voffB); PG8_STAGE(PG8_SA(1, 0), cA + kstep, voffA); PG8_STAGE(PG8_SB(1, 1), cB + hstep + kstep, voffB);
        PG8_WAIT_V(6); PG8_BAR;
    }
    for (;;) {
        const bool has_next = S.next(ui + 1, nxt);
        const char* nA = has_next ? (const char*)g.A + (size_t)nxt.pm * tstep : cA; const char* nB = has_next ? (const char*)g.Bt + (size_t)nxt.pn * tstep : cB;
        for (int t = 0; t < nt; t += 2) {
            const bool last = (t == nt - 2);
            const char* a1 = cA + (size_t)(t + 1) * kstep;
            const char* a2 = last ? nA : cA + (size_t)(t + 2) * kstep; const char* b2 = last ? nB : cB + (size_t)(t + 2) * kstep;
            const char* a3 = a2 + kstep; const char* b3 = b2 + kstep;
            if (last && has_next) S.a_ready(nxt);
            if constexpr (SP2) {
            PG8_LDB(B0, 0, 0); PG8_LDB(B1, 0, 1); PG8_SCHED; PG8_LDA(At, 0, 0); PG8_STAGE(PG8_SA(1, 1), a1 + hstep, voffA);
            PG8_WAIT_V(8); PG8_WAIT_L(0); PG8_BAR; PG8_MMA(0, 0, At, B0); PG8_MMA(0, 1, At, B1); PG8_BAR; PG8_SCHED;
            PG8_LDA(At, 0, 1); PG8_STAGE(PG8_SB(0, 0), b2, voffB); PG8_STAGE(PG8_SB(0, 1), b2 + hstep, voffB); PG8_STAGE(PG8_SA(0, 0), a2, voffA);
            PG8_WAIT_V(8); PG8_WAIT_L(0); PG8_BAR; PG8_MMA(1, 0, At, B0); PG8_MMA(1, 1, At, B1); PG8_BAR; PG8_SCHED;
            PG8_LDB(B0, 1, 0); PG8_LDB(B1, 1, 1); PG8_SCHED; PG8_LDA(At, 1, 0); PG8_STAGE(PG8_SA(0, 1), a2 + hstep, voffA);
            PG8_WAIT_V(8); PG8_WAIT_L(0); PG8_BAR; PG8_MMA(0, 0, At, B0); PG8_MMA(0, 1, At, B1); PG8_BAR; PG8_SCHED;
            PG8_LDA(At, 1, 1); PG8_STAGE(PG8_SB(1, 0), b3, voffB); PG8_STAGE(PG8_SB(1, 1), b3 + hstep, voffB); PG8_STAGE(PG8_SA(1, 0), a3, voffA);
            PG8_WAIT_V(8); PG8_WAIT_L(0); PG8_BAR; PG8_MMA(1, 0, At, B0); PG8_MMA(1, 1, At, B1); PG8_BAR; PG8_SCHED;
            } else {
            PG8_LDB(B0, 0, 0); PG8_SCHED; PG8_LDA(At, 0, 0); PG8_STAGE(PG8_SA(1, 1), a1 + hstep, voffA);
            PG8_WAIT_L(8); PG8_BAR; PG8_WAIT_L(0); PG8_MMA(0, 0, At, B0); PG8_BAR; PG8_SCHED;
            PG8_LDB(B1, 0, 1); PG8_STAGE(PG8_SB(0, 0), b2, voffB);
            PG8_BAR; PG8_WAIT_L(0); PG8_MMA(0, 1, At, B1); PG8_BAR;
            PG8_LDA(At, 0, 1); PG8_STAGE(PG8_SA(0, 0), a2, voffA);
            PG8_BAR; PG8_WAIT_L(0); PG8_MMA(1, 0, At, B0); PG8_BAR; PG8_SCHED;
            PG8_STAGE(PG8_SB(0, 1), b2 + hstep, voffB);
            PG8_WAIT_V(6); PG8_BAR; PG8_MMA(1, 1, At, B1); PG8_BAR;
            PG8_LDB(B0, 1, 0); PG8_SCHED; PG8_LDA(At, 1, 0); PG8_STAGE(PG8_SA(0, 1), a2 + hstep, voffA);
            PG8_WAIT_L(8); PG8_BAR; PG8_WAIT_L(0); PG8_MMA(0, 0, At, B0); PG8_BAR; PG8_SCHED;
            PG8_LDB(B1, 1, 1); PG8_STAGE(PG8_SB(1, 0), b3, voffB);
            PG8_BAR; PG8_WAIT_L(0); PG8_MMA(0, 1, At, B1); PG8_BAR;
            PG8_LDA(At, 1, 1); PG8_STAGE(PG8_SA(1, 0), a3, voffA);
            PG8_BAR; PG8_WAIT_L(0); PG8_MMA(1, 0, At, B0); PG8_BAR; PG8_SCHED;
            PG8_STAGE(PG8_SB(1, 1), b3 + hstep, voffB);
            PG8_WAIT_V(6); PG8_BAR; PG8_MMA(1, 1, At, B1); PG8_BAR;
            }
        }
        if constexpr (ALIGN_EPI) { if (wr == 0) PG8_BAR; }
        if constexpr (!Epi::AFTER_DRAIN) { E(acc, cur, wr, wc, fr, fq); S.done(cur); }
        if (!has_next) break;
#pragma unroll
        for (int a = 0; a < 2; ++a)
#pragma unroll
            for (int b = 0; b < 2; ++b)
#pragma unroll
                for (int m = 0; m < 4; ++m)
#pragma unroll
                    for (int n = 0; n < 2; ++n) acc[a][b][m][n] = (f32x4){0.f, 0.f, 0.f, 0.f};
        cur = nxt; cA = nA; cB = nB; ++ui;
        if constexpr (ALIGN_EPI) { if (wr == 1) PG8_BAR; }
    }
    PG8_WAIT_V(0);
    if constexpr (!ALIGN_EPI) { if (wr == 0) PG8_BAR; }
    PG8_BAR;
    if constexpr (Epi::AFTER_DRAIN) { E.fused(acc, cur, wr, wc, fr, fq, lds, wid, lane); S.done(cur); }
#undef PG8_SA
#undef PG8_SB
#undef PG8_STAGE
#undef PG8_LDA
#undef PG8_LDB
#undef PG8_MMA
#undef PG8_WAIT_V
#undef PG8_WAIT_L
#undef PG8_BAR
#undef PG8_SCHED
}
}
#define LAS __attribute__((address_space(3)))
typedef unsigned short bf16;
typedef short bf16x8 __attribute__((ext_vector_type(8)));
typedef float f32x4 __attribute__((ext_vector_type(4)));
typedef float f32x2 __attribute__((ext_vector_type(2)));
typedef unsigned u32x4 __attribute__((ext_vector_type(4)));
typedef unsigned u32x2 __attribute__((ext_vector_type(2)));
typedef __bf16 bf16x2_t __attribute__((ext_vector_type(2)));

constexpr int M = 16384, DM = 2048, NIN = 5888, NCHUNK = 256;
constexpr float EPS = 1e-6f, LOG2E = 1.4426950408889634f, QSCALE = 0.125f * LOG2E;
constexpr int NWAVES = 8, NTHR = 512;
constexpr size_t MiB = 1u << 20;
constexpr size_t WS_CTL = 0, WS_WOUT = 1 * MiB, WS_WQ = 9 * MiB, WS_K12 = 17 * MiB, WS_XN = 18 * MiB, WS_WIN = 82 * MiB, WS_Z = 105 * MiB, WS_XBC = 137 * MiB,
                 WS_Q = 185 * MiB, WS_K = 217 * MiB, WS_V = 249 * MiB, WS_DTF = 281 * MiB, WS_XS = 283 * MiB, WS_BC = 315 * MiB, WS_DT = 331 * MiB, WS_ACUM = 332 * MiB,
                 WS_CUMF = 333 * MiB, WS_MISC = 334 * MiB, WS_MIX = 335 * MiB, WS_END = 464 * MiB;
constexpr size_t WS_SLOC = WS_XN;
constexpr size_t WS_HN = WS_XN;
constexpr size_t WS_QP = 105 * MiB, WS_IDX = 169 * MiB, WS_GW = 177 * MiB, WS_U = 185 * MiB, WS_V2 = 249 * MiB;
constexpr size_t MISC_FTOT = 0, MISC_SUMSQ = 65536, MISC_QN2 = 196608, MISC_KN2 = 212992, MISC_CHK = 262144;
constexpr int LDS_BYTES = 155648;

__device__ __forceinline__ unsigned cvtpk(float lo, float hi) { f32x2 v = {lo, hi}; bf16x2_t b = __builtin_convertvector(v, bf16x2_t); return __builtin_bit_cast(unsigned, b); }
__device__ __forceinline__ bf16 f2bf(float f) { return (bf16)(cvtpk(f, 0.f) & 0xffffu); }
__device__ __forceinline__ float bf2f(bf16 h) { return __uint_as_float((unsigned)h << 16); }
__device__ __forceinline__ float bflo(unsigned w) { return __uint_as_float(w << 16); }
__device__ __forceinline__ float bfhi(unsigned w) { return __uint_as_float(w & 0xffff0000u); }
template <int CTRL, int RM> __device__ __forceinline__ float dpp_self(float v) { return __int_as_float(__builtin_amdgcn_update_dpp(__float_as_int(v), __float_as_int(v), CTRL, RM, 0xf, false)); }
template <int CTRL, int RM> __device__ __forceinline__ float dpp_zero(float v) { return __int_as_float(__builtin_amdgcn_update_dpp(0, __float_as_int(v), CTRL, RM, 0xf, false)); }
__device__ __forceinline__ float wave_max(float v) {
    v = fmaxf(v, dpp_self<0x111, 0xf>(v)); v = fmaxf(v, dpp_self<0x112, 0xf>(v)); v = fmaxf(v, dpp_self<0x114, 0xf>(v)); v = fmaxf(v, dpp_self<0x118, 0xf>(v));
    v = fmaxf(v, dpp_self<0x142, 0xa>(v)); v = fmaxf(v, dpp_self<0x143, 0xc>(v));
    return __int_as_float(__builtin_amdgcn_readlane(__float_as_int(v), 63));
}
__device__ __forceinline__ float wave_sum(float v) {
    v += dpp_zero<0x111, 0xf>(v); v += dpp_zero<0x112, 0xf>(v); v += dpp_zero<0x114, 0xf>(v); v += dpp_zero<0x118, 0xf>(v);
    v += dpp_zero<0x142, 0xa>(v); v += dpp_zero<0x143, 0xc>(v);
    return __int_as_float(__builtin_amdgcn_readlane(__float_as_int(v), 63));
}
__device__ __forceinline__ float wave_scan_incl(float v, int lane) {
#pragma unroll
    for (int o = 1; o < 64; o <<= 1) { const float t = __shfl_up(v, o); if (lane >= o) v += t; }
    return v;
}
__device__ __forceinline__ float siluf(float x) { return x / (1.f + __expf(-x)); }
__device__ __forceinline__ float softplusf(float x) { return fmaxf(x, 0.f) + log1pf(__expf(-fabsf(x))); }
__device__ __forceinline__ float logsigmoidf(float x) { return fminf(x, 0.f) - log1pf(__expf(-fabsf(x))); }
__device__ __forceinline__ float dot2bf(unsigned a, unsigned b, float c) { const unsigned aa = a, bb = b; return __builtin_amdgcn_fdot2_f32_bf16(__builtin_bit_cast(bf16x2_t, aa), __builtin_bit_cast(bf16x2_t, bb), c, false); }
__device__ __forceinline__ f32x4 mfma16(bf16x8 a, bf16x8 b, f32x4 c) { return __builtin_amdgcn_mfma_f32_16x16x32_bf16(a, b, c, 0, 0, 0); }

struct Args {
    const float *x, *ln1_w, *w_in, *conv_w, *conv_b, *dt_bias, *a_log, *d_skip, *ssd_norm_w, *fox_f_bias, *w_out, *ln2_w, *peer_wq, *peer_k1, *peer_k2, *peer_u, *peer_v, *lnf_w;
    float* out; unsigned char* ws; int ph_lo, ph_hi;
};
typedef const __attribute__((address_space(4))) Args* ArgsP;
__device__ __forceinline__ ArgsP get_args() { ArgsP p = (ArgsP)__builtin_amdgcn_kernarg_segment_ptr(); asm volatile("" : "+s"(p)); return p; }
__device__ __forceinline__ int lane_id() { int l; asm volatile("v_mbcnt_lo_u32_b32 %0, -1, 0\n\tv_mbcnt_hi_u32_b32 %0, -1, %0" : "=v"(l)); return l; }
__device__ __forceinline__ int opaque(int v) { asm volatile("" : "+v"(v)); return v; }
#define GAS __attribute__((address_space(1)))
#define XB_TMO      128
#define XB_XCNT(j)  (256  + 64 * (j))
#define XB_XSUB(j)  (1280 + 64 * (j))
#define XB_XGEN(j)  (2304 + 64 * (j))
#define XB_TOP      3328
#define XB_TOPGEN   3392
#define XCD_BAR_WORDS 3456
#define XB_SPIN_CAP (1u << 18)

__device__ __forceinline__ unsigned xb_ld(unsigned* p)              { return __hip_atomic_load(p, __ATOMIC_RELAXED, __HIP_MEMORY_SCOPE_AGENT); }
__device__ __forceinline__ unsigned xb_add(unsigned* p, unsigned v) { return __hip_atomic_fetch_add(p, v, __ATOMIC_RELAXED, __HIP_MEMORY_SCOPE_AGENT); }
__device__ __forceinline__ unsigned xb_xcc_id() { return (unsigned)__builtin_amdgcn_s_getreg((3 << 11) | 20) & 0xFu; }
#define XB_SPIN(cond, bar) do { unsigned _sp = 0; while (cond) { __builtin_amdgcn_s_sleep(1); \
    if ((++_sp & 255u) == 0u) { if (xb_ld(&(bar)[XB_TMO])) break; if (_sp > XB_SPIN_CAP) { atomicAdd(&(bar)[XB_TMO], 1u); break; } } } } while (0)
struct XcdBarrier { unsigned* bar; unsigned x; volatile LAS unsigned* st; };
__device__ __forceinline__ XcdBarrier xcd_barrier_post(unsigned* bar, volatile LAS unsigned* st, const int tid) {
    XcdBarrier b; b.bar = bar; b.x = xb_xcc_id(); b.st = st;
    if (tid == 0) (void)xb_add(&bar[XB_XCNT(b.x)], 1u);
    return b;
}
__device__ __forceinline__ void xcd_barrier_complete(unsigned* bar, unsigned x, unsigned& nloc, unsigned& nx) {
    const unsigned G = gridDim.x;
    unsigned sum, cnt, mine, sp = 0u;
    for (;;) {
        sum = 0u; cnt = 0u; mine = 0u;
#pragma unroll
        for (unsigned j = 0; j < 16; ++j) { const unsigned c = xb_ld(&bar[XB_XCNT(j)]); sum += c; cnt += (c > 0u) ? 1u : 0u; mine = (j == x) ? c : mine; }
        if (sum == G) break;
        __builtin_amdgcn_s_sleep(1);
        if ((++sp & 255u) == 0u) { if (xb_ld(&bar[XB_TMO])) break; if (sp > XB_SPIN_CAP) { atomicAdd(&bar[XB_TMO], 1u); break; } }
    }
    nloc = mine > 0u ? mine : 1u; nx = cnt > 0u ? cnt : 1u;
}
__device__ __forceinline__ void xcd_barrier(const XcdBarrier& b, const int tid) {
    asm volatile("s_waitcnt vmcnt(0)" ::: "memory");
    __syncthreads();
    if (tid == 0) {
        unsigned* bar = b.bar;
        __builtin_amdgcn_s_waitcnt(0);
        unsigned nloc = b.st[0], nx = b.st[1];
        if (nloc == 0u) { xcd_barrier_complete(bar, b.x, nloc, nx); b.st[0] = nloc; b.st[1] = nx; }
        const unsigned old = xb_add(&bar[XB_XSUB(b.x)], 1u);
        const unsigned gen = old / nloc;
        if (old + 1u == (gen + 1u) * nloc) {
            __builtin_amdgcn_fence(__ATOMIC_RELEASE, "agent");
            asm volatile("s_waitcnt vmcnt(0)" ::: "memory");
            const unsigned og = xb_add(&bar[XB_TOP], 1u);
            const unsigned tg = og / nx;
            if (og + 1u == (tg + 1u) * nx) xb_add(&bar[XB_TOPGEN], 1u);
            else XB_SPIN(xb_ld(&bar[XB_TOPGEN]) == tg, bar);
            __builtin_amdgcn_fence(__ATOMIC_ACQUIRE, "agent");
            xb_add(&bar[XB_XGEN(b.x)], 1u);
            asm volatile("s_waitcnt vmcnt(0)" ::: "memory");
        } else {
            XB_SPIN(xb_ld(&bar[XB_XGEN(b.x)]) == gen, bar);
            __builtin_amdgcn_fence(__ATOMIC_ACQUIRE, "agent");
            asm volatile("s_waitcnt vmcnt(0)" ::: "memory");
        }
    }
    __syncthreads();
}
__device__ __forceinline__ int peer_next_item(unsigned* heads, const int myx, int& probe, const unsigned nper, volatile LAS int* bc, const int tid) {
    if (tid == 0) { int r = -1;
        while (probe < 8) { const int q = (myx + probe) & 7; const unsigned v = __hip_atomic_fetch_add(&heads[64 * q], 1u, __ATOMIC_RELAXED, __HIP_MEMORY_SCOPE_AGENT); if (v < nper) { r = q * (int)nper + (int)v; break; } ++probe; }
        bc[0] = r; }
    __syncthreads(); const int r = bc[0]; __syncthreads(); return r;
}
constexpr int Q_A = 8192 + 2048;
__device__ __forceinline__ int win_dest_row(int j) { return j < 2560 ? j : (j < 2576 ? 5632 + (j - 2560) : (j < 5648 ? j - 16 : j)); }
template <bool MAPROW> __device__ __forceinline__ void p0_transpose_item(const float* W, int K, int N, bf16* WT, LAS float* scr, int item, int lane) {
    const int nblk = N / 32, kb = item / nblk, nb = item % nblk, k0 = 64 * kb, n0 = 32 * nb;
    float wv[32];
#pragma unroll
    for (int i = 0; i < 32; ++i) { const int kk = 2 * i + (lane >> 5); wv[i] = W[(size_t)(k0 + kk) * N + n0 + (lane & 31)]; }
#pragma unroll
    for (int i = 0; i < 32; ++i) { const int kk = 2 * i + (lane >> 5); scr[kk * 33 + (lane & 31)] = wv[i]; }
    asm volatile("s_waitcnt lgkmcnt(0)" ::: "memory");
    const int c = lane & 7;
#pragma unroll
    for (int j = 0; j < 4; ++j) { const int n = (lane >> 3) + 8 * j; const LAS float* s = scr + (8 * c) * 33 + n;
        u32x4 o; o.x = cvtpk(s[0 * 33], s[1 * 33]); o.y = cvtpk(s[2 * 33], s[3 * 33]); o.z = cvtpk(s[4 * 33], s[5 * 33]); o.w = cvtpk(s[6 * 33], s[7 * 33]);
        const int drow = MAPROW ? win_dest_row(n0 + n) : (n0 + n);
        *(u32x4*)(WT + (size_t)drow * K + k0 + 8 * c) = o; }
    asm volatile("s_waitcnt lgkmcnt(0)" ::: "memory");
}
__device__ __forceinline__ void rms_rows2_to_bf16(const float* xrow, const float* w, bf16* orow, int lane) {
    const f32x4* xr = (const f32x4*)xrow + lane; const f32x4* wr = (const f32x4*)w + lane;
    f32x4 v[2][8]; float s0 = 0.f, s1 = 0.f;
#pragma unroll
    for (int j = 0; j < 8; ++j) { v[0][j] = xr[64 * j]; v[1][j] = xr[512 + 64 * j]; }
#pragma unroll
    for (int j = 0; j < 8; ++j) { s0 += (v[0][j].x * v[0][j].x + v[0][j].y * v[0][j].y) + (v[0][j].z * v[0][j].z + v[0][j].w * v[0][j].w); s1 += (v[1][j].x * v[1][j].x + v[1][j].y * v[1][j].y) + (v[1][j].z * v[1][j].z + v[1][j].w * v[1][j].w); }
    const float r0 = 1.f / sqrtf(wave_sum(s0) * (1.f / DM) + EPS), r1 = 1.f / sqrtf(wave_sum(s1) * (1.f / DM) + EPS);
    u32x2* o8 = (u32x2*)orow + lane;
#pragma unroll
    for (int j = 0; j < 8; ++j) { const f32x4 ww = wr[64 * j]; u32x2 o; o.x = cvtpk(v[0][j].x * r0 * ww.x, v[0][j].y * r0 * ww.y); o.y = cvtpk(v[0][j].z * r0 * ww.z, v[0][j].w * r0 * ww.w); o8[64 * j] = o;
        u32x2 p; p.x = cvtpk(v[1][j].x * r1 * ww.x, v[1][j].y * r1 * ww.y); p.y = cvtpk(v[1][j].z * r1 * ww.z, v[1][j].w * r1 * ww.w); o8[512 + 64 * j] = p; }
}
__device__ __forceinline__ void transpose_filler_item(ArgsP a, LAS unsigned char* lds, const int tidx, const int f) {
    const int lane = tidx & 63, wave = __builtin_amdgcn_readfirstlane(tidx >> 6); LAS float* scr = (LAS float*)(lds + wave * 16384);
    const bool second = f >= 256; const int it = (f & 255) * 8 + wave;
    p0_transpose_item<false>(second ? a->peer_wq : a->w_out, DM, DM, (bf16*)(a->ws + (second ? WS_WQ : WS_WOUT)), scr, it, lane);
}
__device__ __forceinline__ void phase0(ArgsP a, LAS unsigned char* lds, const int tidx) {
    const int tid = tidx, lane = tid & 63, wave = __builtin_amdgcn_readfirstlane(tid >> 6);
    LAS float* scr = (LAS float*)(lds + wave * 16384);
    const int gw = blockIdx.x * NWAVES + wave, NGW = gridDim.x * NWAVES;
    bf16* WinT = (bf16*)(a->ws + WS_WIN); bf16* WoutT = (bf16*)(a->ws + WS_WOUT); bf16* WqT = (bf16*)(a->ws + WS_WQ);
    constexpr int I_IN = (DM / 64) * (5664 / 32), I_SQ = (DM / 64) * (DM / 32);
    for (int it = gw; it < I_IN; it += NGW) p0_transpose_item<true>(a->w_in, DM, 5664, WinT, scr, it, lane);
    (void)WoutT; (void)WqT;
    { const int gt = blockIdx.x * NTHR + tid, NGT = gridDim.x * NTHR; u32x4* z = (u32x4*)(WinT + (size_t)5664 * DM);
      for (int i = gt; i < 224 * 256; i += NGT) z[i] = (u32x4){0u, 0u, 0u, 0u};
      float* ss = (float*)(a->ws + WS_MISC + MISC_SUMSQ); for (int i = gt; i < M; i += NGT) { ss[i] = 0.f; ss[i + 16384] = 0.f; }
      if (gt < 16) ((int*)(a->ws + WS_MISC + MISC_CHK))[gt] = 0;
      bf16* k12 = (bf16*)(a->ws + WS_K12);
      for (int i = gt; i < 2 * 8 * 128 * 128 / 2; i += NGT) { const int half = i >= 65536; const float* src = half ? a->peer_k2 : a->peer_k1; const int e = (i - half * 65536) * 2;
          ((unsigned*)k12)[i] = cvtpk(src[e], src[e + 1]); } }
    bf16* XN = (bf16*)(a->ws + WS_XN);
    for (int m = 2 * gw; m < M; m += 2 * NGW) rms_rows2_to_bf16(a->x + (size_t)m * DM, a->ln1_w, XN + (size_t)m * DM, lane);
}

struct EpiInProj {
    static constexpr bool PERM = true, AFTER_DRAIN = false;
    bf16 *Z, *XBC, *Q, *K, *V; float* DTF;
    __device__ __forceinline__ void operator()(const f32x4 (&acc)[2][2][4][2], const pg8::Unit& u, int wr, int wc, int fr, int fq) const {
        const int pn = u.pn; bf16* base; int ldc, colt; float sc = 1.f;
        if (pn < 4) { base = Z; ldc = 1024; colt = pn * 256; }
        else if (pn < 10) { base = XBC; ldc = 1536; colt = (pn - 4) * 256; }
        else if (pn < 14) { base = Q; ldc = 1024; colt = (pn - 10) * 256; sc = QSCALE; }
        else if (pn < 18) { base = K; ldc = 1024; colt = (pn - 14) * 256; }
        else if (pn < 22) { base = V; ldc = 1024; colt = (pn - 18) * 256; }
        else {
            if (wc == 0) {
#pragma unroll
                for (int ai = 0; ai < 2; ++ai)
#pragma unroll
                    for (int m = 0; m < 4; ++m) { const int row = u.pm * 256 + ai * 128 + wr * 64 + m * 16 + fr;
#pragma unroll
                        for (int n = 0; n < 2; ++n) *(f32x4*)(DTF + (size_t)row * 32 + 8 * fq + 4 * n) = acc[ai][0][m][n]; }
            }
            return;
        }
        const int row0 = u.pm * 256 + wr * 64 + fr, col0 = colt + wc * 32 + 8 * fq;
#pragma unroll
        for (int ai = 0; ai < 2; ++ai)
#pragma unroll
            for (int m = 0; m < 4; ++m) { bf16* rowp = base + (size_t)(row0 + ai * 128 + m * 16) * ldc + col0;
#pragma unroll
                for (int bj = 0; bj < 2; ++bj) { const f32x4 v0 = acc[ai][bj][m][0] * sc, v1 = acc[ai][bj][m][1] * sc;
                    u32x4 w; w.x = cvtpk(v0[0], v0[1]); w.y = cvtpk(v0[2], v0[3]); w.z = cvtpk(v1[0], v1[1]); w.w = cvtpk(v1[2], v1[3]);
                    *(u32x4*)(rowp + bj * 128) = w; } }
    }
};
struct EpiPlainBf16 {
    static constexpr bool PERM = true, AFTER_DRAIN = false;
    bf16* O; int ldc;
    __device__ __forceinline__ void operator()(const f32x4 (&acc)[2][2][4][2], const pg8::Unit& u, int wr, int wc, int fr, int fq) const {
        const int row0 = u.pm * 256 + wr * 64 + fr, col0 = u.pn * 256 + wc * 32 + 8 * fq;
#pragma unroll
        for (int ai = 0; ai < 2; ++ai)
#pragma unroll
            for (int m = 0; m < 4; ++m) { bf16* rowp = O + (size_t)(row0 + ai * 128 + m * 16) * ldc + col0;
#pragma unroll
                for (int bj = 0; bj < 2; ++bj) { const f32x4 v0 = acc[ai][bj][m][0], v1 = acc[ai][bj][m][1];
                    u32x4 w; w.x = cvtpk(v0[0], v0[1]); w.y = cvtpk(v0[2], v0[3]); w.z = cvtpk(v1[0], v1[1]); w.w = cvtpk(v1[2], v1[3]);
                    *(u32x4*)(rowp + bj * 128) = w; } }
    }
};
struct EpiOutProj {
    static constexpr bool PERM = false, AFTER_DRAIN = false;
    const float* x; float* out; bf16* HN; const float* ln2w; float* sumsq;
    __device__ __forceinline__ void operator()(const f32x4 (&acc)[2][2][4][2], const pg8::Unit& u, int wr, int wc, int fr, int fq) const {
        const int col0 = u.pn * 256 + wc * 32 + 4 * fq;
#pragma unroll
        for (int ai = 0; ai < 2; ++ai)
#pragma unroll
            for (int m = 0; m < 4; ++m) { const int row = u.pm * 256 + ai * 128 + wr * 64 + m * 16 + fr; const size_t off = (size_t)row * DM + col0; float ss = 0.f;
#pragma unroll
                for (int bj = 0; bj < 2; ++bj)
#pragma unroll
                    for (int n = 0; n < 2; ++n) { const size_t o = off + bj * 128 + n * 16; const f32x4 xv = *(const f32x4*)(x + o); const f32x4 x1 = acc[ai][bj][m][n] + xv;
                        *(f32x4*)(out + o) = x1; const f32x4 w = *(const f32x4*)(ln2w + col0 + bj * 128 + n * 16);
                        u32x2 hw; hw.x = cvtpk(x1[0] * w[0], x1[1] * w[1]); hw.y = cvtpk(x1[2] * w[2], x1[3] * w[3]); *(u32x2*)(HN + o) = hw;
                        ss += (x1[0] * x1[0] + x1[1] * x1[1]) + (x1[2] * x1[2] + x1[3] * x1[3]); }
                ss += __shfl_xor(ss, 16); ss += __shfl_xor(ss, 32);
                if (fq == 0) atomicAdd(sumsq + row, ss); }
    }
};
__device__ __forceinline__ void phase2(ArgsP a, LAS unsigned char* lds, const int tidx) {
    const int tid0 = tidx, w = __builtin_amdgcn_readfirstlane(tid0 >> 6);
    const bf16* XBC = (const bf16*)(a->ws + WS_XBC); const float* DTF = (const float*)(a->ws + WS_DTF);
    bf16* XS = (bf16*)(a->ws + WS_XS); bf16* BC = (bf16*)(a->ws + WS_BC); float* DT = (float*)(a->ws + WS_DT); float* ACUM = (float*)(a->ws + WS_ACUM);
    float* CUMF = (float*)(a->ws + WS_CUMF); float* FTOT = (float*)(a->ws + WS_MISC + MISC_FTOT); bf16* SLOC = (bf16*)(a->ws + WS_SLOC);
    LAS bf16* BT = (LAS bf16*)lds; LAS bf16* XT = (LAS bf16*)(lds + 18432 + w * 9216);
    for (int u = blockIdx.x; u < 2 * NCHUNK; u += gridDim.x) {
        const int tid = opaque(tid0), lane = tid & 63;
        const int c = u >> 1, g = u & 1, t0 = c * 64, h = 8 * g + w;
        {
            const int n = tid & 127;
#pragma unroll
            for (int which = 0; which < 2; ++which) {
                const int ch = 1024 + which * 256 + 128 * g + n;
                const float w0 = a->conv_w[ch], w1 = a->conv_w[1536 + ch], w2 = a->conv_w[2 * 1536 + ch], w3 = a->conv_w[3 * 1536 + ch], cb = a->conv_b[ch];
#pragma unroll
                for (int rr = 0; rr < 2; ++rr) {
                    const int s0 = 8 * ((tid >> 7) + 4 * rr);
                    float in[11];
#pragma unroll
                    for (int j = 0; j < 11; ++j) { const int t = t0 + s0 - 3 + j; const float v = bf2f(XBC[(size_t)(t < 0 ? 0 : t) * 1536 + ch]); in[j] = t < 0 ? 0.f : v; }
                    unsigned pk[4];
#pragma unroll
                    for (int j = 0; j < 8; j += 2) {
                        const float v0 = siluf(cb + w0 * in[j] + w1 * in[j + 1] + w2 * in[j + 2] + w3 * in[j + 3]);
                        const float v1 = siluf(cb + w0 * in[j + 1] + w1 * in[j + 2] + w2 * in[j + 3] + w3 * in[j + 4]);
                        const unsigned p2 = cvtpk(v0, v1); pk[j >> 1] = p2;
                        BC[(size_t)(t0 + s0 + j) * 512 + which * 256 + 128 * g + n] = (bf16)(p2 & 0xffffu);
                        BC[(size_t)(t0 + s0 + j + 1) * 512 + which * 256 + 128 * g + n] = (bf16)(p2 >> 16);
                    }
                    if (which == 0) *(LAS u32x4*)(BT + n * 72 + s0) = (u32x4){pk[0], pk[1], pk[2], pk[3]};
                }
            }
        }
        float wgt;
        {
            const int t = t0 + lane;
            const float dt = softplusf(DTF[(size_t)t * 32 + h] + a->dt_bias[h]);
            const float A = -__expf(a->a_log[h]);
            const float acum = wave_scan_incl(dt * A, lane);
            DT[(size_t)t * 16 + h] = dt; ACUM[(size_t)t * 16 + h] = acum;
            const float alast = __shfl(acum, 63);
            wgt = dt * __expf(alast - acum);
            const float lf = logsigmoidf(DTF[(size_t)t * 32 + 16 + h] + a->fox_f_bias[h]);
            const float cl = wave_scan_incl(lf, lane);
            CUMF[(size_t)h * M + t] = cl;
            if (lane == 63) FTOT[h * NCHUNK + c] = cl;
            { const u32x4* qp = (const u32x4*)((const bf16*)(a->ws + WS_Q) + (size_t)t * 1024 + 64 * h); const u32x4* kp = (const u32x4*)((const bf16*)(a->ws + WS_K) + (size_t)t * 1024 + 64 * h); float qn = 0.f, kn = 0.f;
#pragma unroll
              for (int i = 0; i < 8; ++i) { const u32x4 qv = qp[i], kv = kp[i];
                  qn += bflo(qv.x) * bflo(qv.x) + bfhi(qv.x) * bfhi(qv.x) + bflo(qv.y) * bflo(qv.y) + bfhi(qv.y) * bfhi(qv.y) + bflo(qv.z) * bflo(qv.z) + bfhi(qv.z) * bfhi(qv.z) + bflo(qv.w) * bflo(qv.w) + bfhi(qv.w) * bfhi(qv.w);
                  kn += bflo(kv.x) * bflo(kv.x) + bfhi(kv.x) * bfhi(kv.x) + bflo(kv.y) * bflo(kv.y) + bfhi(kv.y) * bfhi(kv.y) + bflo(kv.z) * bflo(kv.z) + bfhi(kv.z) * bfhi(kv.z) + bflo(kv.w) * bflo(kv.w) + bfhi(kv.w) * bfhi(kv.w); }
              qn = wave_max(qn); kn = wave_max(kn);
              if (lane == 0) { ((float*)(a->ws + WS_MISC + MISC_QN2))[h * NCHUNK + c] = qn; ((float*)(a->ws + WS_MISC + MISC_KN2))[h * NCHUNK + c] = kn; } }
        }
        {
            const int ch = 64 * h + lane;
            const float w0 = a->conv_w[ch], w1 = a->conv_w[1536 + ch], w2 = a->conv_w[2 * 1536 + ch], w3 = a->conv_w[3 * 1536 + ch], cb = a->conv_b[ch];
            float in[67]; const int t0v = opaque(t0);
#pragma unroll
            for (int j = 0; j < 67; ++j) { const int t = t0 - 3 + j; const unsigned off = (unsigned)(j < 3 ? (t < 0 ? 0 : t) : t0v - 3 + j) * 1536u + (unsigned)ch; const float v = bf2f(XBC[off]); in[j] = (j < 3 && t < 0) ? 0.f : v; }
#pragma unroll
            for (int sb = 0; sb < 8; ++sb) {
                unsigned pk[4];
#pragma unroll
                for (int j = 0; j < 8; j += 2) {
                    const int s = 8 * sb + j;
                    const float v0 = siluf(cb + w0 * in[s] + w1 * in[s + 1] + w2 * in[s + 2] + w3 * in[s + 3]);
                    const float v1 = siluf(cb + w0 * in[s + 1] + w1 * in[s + 2] + w2 * in[s + 3] + w3 * in[s + 4]);
                    const unsigned p2 = cvtpk(v0, v1);
                    XS[(size_t)(t0 + s) * 1024 + ch] = (bf16)(p2 & 0xffffu); XS[(size_t)(t0 + s + 1) * 1024 + ch] = (bf16)(p2 >> 16);
                    const float g0 = __shfl(wgt, s), g1 = __shfl(wgt, s + 1);
                    pk[j >> 1] = cvtpk(bflo(p2) * g0, bfhi(p2) * g1);
                }
                *(LAS u32x4*)(XT + lane * 72 + 8 * sb) = (u32x4){pk[0], pk[1], pk[2], pk[3]};
            }
        }
        __syncthreads();
        {
            const int fr = lane & 15, fq = lane >> 4;
            bf16x8 bfr[4][2];
#pragma unroll
            for (int pt = 0; pt < 4; ++pt)
#pragma unroll
                for (int kk = 0; kk < 2; ++kk) bfr[pt][kk] = *(const LAS bf16x8*)(XT + (16 * pt + fr) * 72 + 8 * fq + 32 * kk);
            bf16* dst = SLOC + ((size_t)(c * 16 + h) * 64) * 128;
#pragma unroll
            for (int nt = 0; nt < 8; ++nt) {
                const bf16x8 a0 = *(const LAS bf16x8*)(BT + (16 * nt + fr) * 72 + 8 * fq), a1 = *(const LAS bf16x8*)(BT + (16 * nt + fr) * 72 + 8 * fq + 32);
#pragma unroll
                for (int pt = 0; pt < 4; ++pt) {
                    f32x4 acc = {0.f, 0.f, 0.f, 0.f};
                    acc = mfma16(a0, bfr[pt][0], acc); acc = mfma16(a1, bfr[pt][1], acc);
                    u32x2 o; o.x = cvtpk(acc[0], acc[1]); o.y = cvtpk(acc[2], acc[3]);
                    *(u32x2*)(dst + (size_t)(16 * pt + fr) * 128 + 16 * nt + 4 * fq) = o;
                }
            }
        }
        __syncthreads();
    }
}

template <bool DRY> __device__ __forceinline__ void phase3(ArgsP a, const int tidx) {
    const int tid = tidx, lane = tid & 63, w = __builtin_amdgcn_readfirstlane(tid >> 6);
    const float* ACUM = (const float*)(a->ws + WS_ACUM); unsigned* SL = (unsigned*)(a->ws + WS_SLOC);
    const int gt = blockIdx.x * NTHR + tid, NGT = gridDim.x * NTHR;
    for (int e2 = gt; e2 < 65536; e2 += NGT) {
        const int h = e2 >> 12;
        float s0 = 0.f, s1 = 0.f;
        for (int cb = 0; cb < NCHUNK; cb += 8) {
            unsigned v[8]; float d[8];
#pragma unroll
            for (int j = 0; j < 8; ++j) { v[j] = SL[(size_t)(cb + j) * 65536 + e2]; d[j] = __expf(ACUM[(size_t)((cb + j) * 64 + 63) * 16 + h]); }
#pragma unroll
            for (int j = 0; j < 8; ++j) { SL[(size_t)(cb + j) * 65536 + e2] = DRY ? v[j] : cvtpk(s0, s1); s0 = s0 * d[j] + bflo(v[j]); s1 = s1 * d[j] + bfhi(v[j]); }
        }
    }
    const int gwv = blockIdx.x * NWAVES + w, NGW = gridDim.x * NWAVES;
    for (int hh = gwv; hh < 16; hh += NGW) {
        const float* FTOT = (const float*)(a->ws + WS_MISC + MISC_FTOT) + hh * NCHUNK; float* CF = (float*)(a->ws + WS_CUMF) + (size_t)hh * M;
        const f32x4 tv = *(const f32x4*)(FTOT + 4 * lane);
        const float tot = (tv.x + tv.y) + (tv.z + tv.w);
        const float incl = wave_scan_incl(tot, lane); float pre = incl - tot;
#pragma unroll
        for (int k = 0; k < 4; ++k) {
            f32x4* p = (f32x4*)(CF + (size_t)(4 * lane + k) * 64);
#pragma unroll 4
            for (int j = 0; j < 16; ++j) { f32x4 v = p[j]; if (!DRY) v = (v + pre) * LOG2E; p[j] = v; }
            pre += tv[k];
        }
    }
}
__device__ __forceinline__ void phase4(ArgsP a, LAS unsigned char* lds, const int tidx) {
    const int tid0 = tidx, w = __builtin_amdgcn_readfirstlane(tid0 >> 6);
    const bf16* XS = (const bf16*)(a->ws + WS_XS); const bf16* BC = (const bf16*)(a->ws + WS_BC); const float* DT = (const float*)(a->ws + WS_DT); const float* ACUM = (const float*)(a->ws + WS_ACUM);
    const bf16* PREV = (const bf16*)(a->ws + WS_SLOC); const bf16* Z = (const bf16*)(a->ws + WS_Z); bf16* MIX = (bf16*)(a->ws + WS_MIX);
    LAS bf16* CS = (LAS bf16*)lds; LAS bf16* BS = (LAS bf16*)(lds + 17408); LAS float* CBm = (LAS float*)(lds + 34816);
    LAS bf16* XT = (LAS bf16*)(lds + 52224 + w * 9216); LAS float* AC = (LAS float*)(lds + 125952 + w * 256); LAS float* SSW = (LAS float*)(lds + 128000);
    for (int u = blockIdx.x; u < 2 * NCHUNK; u += gridDim.x) {
        const int tid = opaque(tid0), lane = tid & 63, fr = lane & 15, fq = lane >> 4;
        const int c = u >> 1, g = u & 1, t0 = c * 64, h = 8 * g + w;
#pragma unroll
        for (int i = 0; i < 2; ++i) { const int q = tid + 512 * i, row = q >> 4, c16 = q & 15;
            *(LAS u32x4*)(CS + row * 136 + c16 * 8) = *(const u32x4*)(BC + (size_t)(t0 + row) * 512 + 256 + 128 * g + c16 * 8);
            *(LAS u32x4*)(BS + row * 136 + c16 * 8) = *(const u32x4*)(BC + (size_t)(t0 + row) * 512 + 128 * g + c16 * 8); }
        const float dts = DT[(size_t)(t0 + lane) * 16 + h];
        AC[lane] = ACUM[(size_t)(t0 + lane) * 16 + h];
        {
            const int ch = 64 * h + lane;
            float xin[64];
#pragma unroll
            for (int s = 0; s < 64; ++s) xin[s] = bf2f(XS[(size_t)(t0 + s) * 1024 + ch]);
#pragma unroll
            for (int sb = 0; sb < 8; ++sb) {
                unsigned pk[4];
#pragma unroll
                for (int j = 0; j < 8; j += 2) { const int s = 8 * sb + j; pk[j >> 1] = cvtpk(xin[s] * __shfl(dts, s), xin[s + 1] * __shfl(dts, s + 1)); }
                *(LAS u32x4*)(XT + lane * 72 + 8 * sb) = (u32x4){pk[0], pk[1], pk[2], pk[3]};
            }
        }
        __syncthreads();
#pragma unroll
        for (int x = 0; x < 2; ++x) { const int id = 2 * w + x, ti = id >> 2, si = id & 3; f32x4 acc = {0.f, 0.f, 0.f, 0.f};
#pragma unroll
            for (int kk = 0; kk < 4; ++kk) acc = mfma16(*(const LAS bf16x8*)(CS + (16 * ti + fr) * 136 + 8 * fq + 32 * kk), *(const LAS bf16x8*)(BS + (16 * si + fr) * 136 + 8 * fq + 32 * kk), acc);
#pragma unroll
            for (int r = 0; r < 4; ++r) CBm[(16 * ti + 4 * fq + r) * 68 + 16 * si + fr] = acc[r]; }
        __syncthreads();
        f32x4 acc[4][4];
#pragma unroll
        for (int i = 0; i < 4; ++i)
#pragma unroll
            for (int j = 0; j < 4; ++j) acc[i][j] = (f32x4){0.f, 0.f, 0.f, 0.f};
        {
            const bf16* pv = PREV + ((size_t)(c * 16 + h) * 64) * 128;
#pragma unroll
            for (int kk = 0; kk < 4; ++kk) {
                bf16x8 af[4], bfv[4];
#pragma unroll
                for (int i = 0; i < 4; ++i) af[i] = *(const LAS bf16x8*)(CS + (16 * i + fr) * 136 + 8 * fq + 32 * kk);
#pragma unroll
                for (int j = 0; j < 4; ++j) bfv[j] = *(const bf16x8*)(pv + (size_t)(16 * j + fr) * 128 + 8 * fq + 32 * kk);
#pragma unroll
                for (int i = 0; i < 4; ++i)
#pragma unroll
                    for (int j = 0; j < 4; ++j) acc[i][j] = mfma16(af[i], bfv[j], acc[i][j]);
            }
#pragma unroll
            for (int i = 0; i < 4; ++i)
#pragma unroll
                for (int r = 0; r < 4; ++r) { const float e = __expf(AC[16 * i + 4 * fq + r]);
#pragma unroll
                    for (int j = 0; j < 4; ++j) acc[i][j][r] *= e; }
        }
#pragma unroll
        for (int kk = 0; kk < 2; ++kk) {
            bf16x8 bfv[4];
#pragma unroll
            for (int j = 0; j < 4; ++j) bfv[j] = *(const LAS bf16x8*)(XT + (16 * j + fr) * 72 + 8 * fq + 32 * kk);
            const int sbase = 8 * fq + 32 * kk;
            const f32x4 as0 = *(const LAS f32x4*)(AC + sbase), as1 = *(const LAS f32x4*)(AC + sbase + 4);
#pragma unroll
            for (int i = 0; i < 4; ++i) {
                const int t = 16 * i + fr; const float act = AC[t];
                const f32x4 c0 = *(const LAS f32x4*)(CBm + t * 68 + sbase), c1 = *(const LAS f32x4*)(CBm + t * 68 + sbase + 4);
                float m[8];
#pragma unroll
                for (int jj = 0; jj < 4; ++jj) { m[jj] = (sbase + jj <= t) ? c0[jj] * __expf(fminf(act - as0[jj], 0.f)) : 0.f; m[4 + jj] = (sbase + 4 + jj <= t) ? c1[jj] * __expf(fminf(act - as1[jj], 0.f)) : 0.f; }
                u32x4 mp; mp.x = cvtpk(m[0], m[1]); mp.y = cvtpk(m[2], m[3]); mp.z = cvtpk(m[4], m[5]); mp.w = cvtpk(m[6], m[7]);
                const bf16x8 af = __builtin_bit_cast(bf16x8, mp);
#pragma unroll
                for (int j = 0; j < 4; ++j) acc[i][j] = mfma16(af, bfv[j], acc[i][j]);
            }
        }
        const float Dh = a->d_skip[h];
#pragma unroll
        for (int i = 0; i < 4; ++i)
#pragma unroll
            for (int r = 0; r < 4; ++r) { const int t = 16 * i + 4 * fq + r; float ss = 0.f;
#pragma unroll
                for (int j = 0; j < 4; ++j) { const size_t o = (size_t)(t0 + t) * 1024 + 64 * h + 16 * j + fr;
#if SELFCHECK
                    if (t0 + t < 8192) ((float*)(a->ws + (size_t)464 * MiB))[o] = acc[i][j][r];
#endif
                    const float y = (acc[i][j][r] + Dh * bf2f(XS[o])) * siluf(bf2f(Z[o])); acc[i][j][r] = y; ss += y * y; }
                ss += __shfl_xor(ss, 1); ss += __shfl_xor(ss, 2); ss += __shfl_xor(ss, 4); ss += __shfl_xor(ss, 8);
                if (fr == 0) SSW[w * 64 + t] = ss; }
        __syncthreads();
#pragma unroll
        for (int i = 0; i < 4; ++i)
#pragma unroll
            for (int r = 0; r < 4; ++r) { const int t = 16 * i + 4 * fq + r; float ss = 0.f;
#pragma unroll
                for (int ww = 0; ww < 8; ++ww) ss += SSW[ww * 64 + t];
                const float rstd = 1.f / sqrtf(ss * (1.f / 512.f) + EPS);
#pragma unroll
                for (int j = 0; j < 4; ++j) { const int ch = 64 * h + 16 * j + fr; MIX[(size_t)(t0 + t) * DM + ch] = f2bf(acc[i][j][r] * rstd * a->ssd_norm_w[ch]); } }
        __syncthreads();
    }
}

__device__ __forceinline__ void phase_attn(ArgsP a, LAS unsigned char* lds, const int tidx) {
    const int tid0 = tidx, w = __builtin_amdgcn_readfirstlane(tid0 >> 6);
    const bf16* Q = (const bf16*)(a->ws + WS_Q); const bf16* K = (const bf16*)(a->ws + WS_K); const bf16* V = (const bf16*)(a->ws + WS_V); const float* CL = (const float*)(a->ws + WS_CUMF);
    bf16* MIX = (bf16*)(a->ws + WS_MIX);
    LAS bf16* KS = (LAS bf16*)lds; LAS bf16* VT = (LAS bf16*)(lds + 9216); LAS float* CK = (LAS float*)(lds + 18432); LAS bf16* PS = (LAS bf16*)(lds + 18688 + w * 2304);
    const int G = gridDim.x;
    for (int i = 0;; ++i) {
        const int uidx = i * G + (int)blockIdx.x; if (uidx >= 2048) break;
        const int tid = opaque(tid0), lane = tid & 63, fr = lane & 15, fq = lane >> 4;
        const int slot = uidx >> 8, pos = uidx & 255, grp = pos >> 4, h = pos & 15;
        const int rnk = 16 * slot + ((slot & 1) ? 15 - grp : grp);
        const int qb = 127 - rnk;
        const int q0 = qb * 128 + 16 * w;
        const bf16x8 qf0 = *(const bf16x8*)(Q + (size_t)(q0 + fr) * 1024 + 64 * h + 8 * fq), qf1 = *(const bf16x8*)(Q + (size_t)(q0 + fr) * 1024 + 64 * h + 8 * fq + 32);
        float cq[4], mrun[4], lrun[4]; f32x4 o[4];
#pragma unroll
        for (int r = 0; r < 4; ++r) { cq[r] = CL[(size_t)h * M + q0 + 4 * fq + r]; mrun[r] = -3.0e38f; lrun[r] = 0.f; }
#pragma unroll
        for (int d = 0; d < 4; ++d) o[d] = (f32x4){0.f, 0.f, 0.f, 0.f};
        const int ntile = 2 * qb + 2;
        for (int kt = 0; kt < ntile; ++kt) {
            const int k0 = kt * 64;
            { const int row = tid >> 3, c16 = tid & 7; *(LAS u32x4*)(KS + row * 72 + c16 * 8) = *(const u32x4*)(K + (size_t)(k0 + row) * 1024 + 64 * h + c16 * 8);
              const int d = tid & 63, kb = tid >> 6; unsigned pk[4];
#pragma unroll
              for (int j = 0; j < 8; j += 2) { const unsigned lo = V[(size_t)(k0 + 8 * kb + j) * 1024 + 64 * h + d], hi = V[(size_t)(k0 + 8 * kb + j + 1) * 1024 + 64 * h + d]; pk[j >> 1] = lo | (hi << 16); }
              *(LAS u32x4*)(VT + d * 72 + 8 * kb) = (u32x4){pk[0], pk[1], pk[2], pk[3]};
              if (tid < 64) CK[tid] = CL[(size_t)h * M + k0 + tid]; }
            __syncthreads();
            f32x4 s[4];
#pragma unroll
            for (int nt = 0; nt < 4; ++nt) { s[nt] = (f32x4){0.f, 0.f, 0.f, 0.f};
                s[nt] = mfma16(qf0, *(const LAS bf16x8*)(KS + (16 * nt + fr) * 72 + 8 * fq), s[nt]);
                s[nt] = mfma16(qf1, *(const LAS bf16x8*)(KS + (16 * nt + fr) * 72 + 8 * fq + 32), s[nt]); }
            float mx[4];
#pragma unroll
            for (int r = 0; r < 4; ++r) { const int qg = q0 + 4 * fq + r; float m = -INFINITY;
#pragma unroll
                for (int nt = 0; nt < 4; ++nt) { const int kg = k0 + 16 * nt + fr; float v = s[nt][r] + (cq[r] - CK[16 * nt + fr]); v = kg > qg ? -INFINITY : v; s[nt][r] = v; m = fmaxf(m, v); }
                m = fmaxf(m, __shfl_xor(m, 1)); m = fmaxf(m, __shfl_xor(m, 2)); m = fmaxf(m, __shfl_xor(m, 4)); m = fmaxf(m, __shfl_xor(m, 8)); mx[r] = m; }
#pragma unroll
            for (int r = 0; r < 4; ++r) { const float mn = fmaxf(mrun[r], mx[r]); const float al = exp2f(mrun[r] - mn); mrun[r] = mn; float ps = 0.f;
#pragma unroll
                for (int nt = 0; nt < 4; ++nt) { const float p = exp2f(s[nt][r] - mn); ps += p; PS[(4 * fq + r) * 72 + 16 * nt + fr] = f2bf(p); }
                lrun[r] = lrun[r] * al + ps;
#pragma unroll
                for (int d = 0; d < 4; ++d) o[d][r] *= al; }
            asm volatile("s_waitcnt lgkmcnt(0)" ::: "memory");
            const bf16x8 pf0 = *(const LAS bf16x8*)(PS + fr * 72 + 8 * fq), pf1 = *(const LAS bf16x8*)(PS + fr * 72 + 8 * fq + 32);
#pragma unroll
            for (int d = 0; d < 4; ++d) { o[d] = mfma16(pf0, *(const LAS bf16x8*)(VT + (16 * d + fr) * 72 + 8 * fq), o[d]); o[d] = mfma16(pf1, *(const LAS bf16x8*)(VT + (16 * d + fr) * 72 + 8 * fq + 32), o[d]); }
            __syncthreads();
        }
#pragma unroll
        for (int r = 0; r < 4; ++r) { float l = lrun[r]; l += __shfl_xor(l, 1); l += __shfl_xor(l, 2); l += __shfl_xor(l, 4); l += __shfl_xor(l, 8); const float il = 1.f / l;
#pragma unroll
            for (int d = 0; d < 4; ++d) MIX[(size_t)(q0 + 4 * fq + r) * DM + 1024 + 64 * h + 16 * d + fr] = f2bf(o[d][r] * il); }
    }
}
constexpr size_t WS_U8 = 400 * MiB, WS_V8 = 432 * MiB;
constexpr size_t WS_USC = WS_K12 + 512 * 1024, WS_VSC = WS_K12 + 576 * 1024;
__device__ __forceinline__ void convert_uv_fp8_item(ArgsP a, const int tidx, const int item) {
    const int lane = tidx & 63, w = tidx >> 6;
    unsigned char* U8 = (unsigned char*)(a->ws + WS_U8); unsigned char* V8 = (unsigned char*)(a->ws + WS_V8);
    for (int row0 = 32 * item + 4 * w; row0 < 32 * item + 4 * w + 4; row0 += 2) {
        f32x4 x[2][8]; float mx[2] = {0.f, 0.f};
#pragma unroll
        for (int q = 0; q < 2; ++q) { const int row = row0 + q; const bool second = row >= 16384; const int e = row & 16383; const f32x4* src = (const f32x4*)((second ? a->peer_v : a->peer_u) + (size_t)e * DM) + lane;
#pragma unroll
            for (int j = 0; j < 8; ++j) x[q][j] = src[64 * j]; }
#pragma unroll
        for (int q = 0; q < 2; ++q) { const int row = row0 + q; const bool second = row >= 16384; const int e = row & 16383; unsigned char* dst = second ? V8 : U8;
#pragma unroll
            for (int j = 0; j < 8; ++j) mx[q] = fmaxf(mx[q], fmaxf(fmaxf(fabsf(x[q][j][0]), fabsf(x[q][j][1])), fmaxf(fabsf(x[q][j][2]), fabsf(x[q][j][3]))));
            const float mxa = wave_max(mx[q]); const float sc = mxa > 0.f ? 440.f / mxa : 1.f;
            if (lane == 0) ((float*)(a->ws + (second ? WS_VSC : WS_USC)))[e] = 1.f / sc;
#pragma unroll
            for (int j = 0; j < 8; ++j) { const int s = 2 * j + (lane >> 5); int p = __builtin_amdgcn_cvt_pk_fp8_f32(x[q][j][0] * sc, x[q][j][1] * sc, 0, false); p = __builtin_amdgcn_cvt_pk_fp8_f32(x[q][j][2] * sc, x[q][j][3] * sc, p, true);
                *(int*)(dst + ((size_t)s * 16384 + e) * 128 + 4 * (lane & 31)) = p; } } }
}
namespace attn_body {
using bf16=unsigned short;
using bf16x8=__attribute__((ext_vector_type(8)))short;
using s16x4=__attribute__((ext_vector_type(4)))short;
using f32x16=__attribute__((ext_vector_type(16)))float;
using u32x4=__attribute__((ext_vector_type(4)))unsigned;
constexpr int BATCH=1,NHEAD=16,SEQ=16384,D=64,DM=NHEAD*D,OPITCH=2048,OCOL=1024;
constexpr int NW=8,QBLK=32,QB=QBLK*NW,KVBLK=64,NQB=SEQ/QB;
constexpr int ATTN_PITCH=DM, ATTN_UNIT_ROWS=QB;
__device__ __forceinline__ int crow(int r,int hi){return (r&3)+8*(r>>2)+4*hi;}
#define SBAR() __builtin_amdgcn_sched_barrier(0)
__device__ __forceinline__ void cmask(f32x16&p0,f32x16&p1,int jb,int qrel,int hi){
  const float NEG=-INFINITY; int kb=64*jb+4*hi;
  #pragma unroll
  for(int r=0;r<16;++r){int kv=kb+(r&3)+8*(r>>2); if(kv>qrel)p0[r]=NEG; if(kv+32>qrel)p1[r]=NEG;}
}

constexpr int NSLOT=3, SLOTB=8192;
constexpr int LDS_K=0, LDS_V=NSLOT*SLOTB, LDS_WS=2*NSLOT*SLOTB, LDS_OST=LDS_WS+NW*64*4, LDS_CL=LDS_OST+NW*4096, LDS_BYTES=LDS_CL+SEQ*4;
constexpr float C2=0.125f*1.4426950408889634f;
__device__ __forceinline__ void glds16(const void*gsrc,unsigned lds_dst){unsigned keep;
  asm volatile("s_mov_b32 %0, m0\n\ts_mov_b32 m0, %2\n\ts_nop 0\n\tglobal_load_lds_dwordx4 %1, off\n\ts_mov_b32 m0, %0":"=&s"(keep):"v"(gsrc),"s"(lds_dst):"memory");}
__device__ __forceinline__ float max3f(float a,float b,float c){float r;asm("v_max3_f32 %0, %1, %2, %3":"=v"(r):"v"(a),"v"(b),"v"(c));return r;}
__device__ __forceinline__ float max2f(float a,float b){float r;asm("v_max_f32_e32 %0, %1, %2":"=v"(r):"v"(a),"v"(b));return r;}
__device__ __forceinline__ float fadd_s(float a,float b){float r;asm("v_add_f32_e32 %0, %1, %2":"=v"(r):"v"(a),"v"(b));return r;}
__device__ __forceinline__ float fsub_s(float a,float b){float r;asm("v_sub_f32_e32 %0, %1, %2":"=v"(r):"v"(a),"v"(b));return r;}
typedef float f32x2_t __attribute__((ext_vector_type(2))); typedef float f32x4_t __attribute__((ext_vector_type(4))); typedef __bf16 bf16x2_t __attribute__((ext_vector_type(2)));
__device__ __forceinline__ unsigned cvtpk_s(float lo,float hi){f32x2_t v={lo,hi};bf16x2_t b=__builtin_convertvector(v,bf16x2_t);return __builtin_bit_cast(unsigned,b);}
#define WAIT_BAR(N) asm volatile("s_waitcnt vmcnt(" #N ") lgkmcnt(0)\n\ts_barrier":::"memory")

__device__ __forceinline__ void qkt(f32x16&p0,f32x16&p1,const char*Kslot,const bf16x8*qr,const f32x16&i0,const f32x16&i1,int r32,int hi){
  const char*kb=Kslot+hi*1024+r32*16;
  #pragma unroll
  for(int d0=0;d0<4;++d0){
    const bf16x8 b0=*reinterpret_cast<const bf16x8*>(kb+d0*2048);
    const bf16x8 b1=*reinterpret_cast<const bf16x8*>(kb+d0*2048+512);
    if(d0==0){p0=__builtin_amdgcn_mfma_f32_32x32x16_bf16(b0,qr[0],i0,0,0,0);p1=__builtin_amdgcn_mfma_f32_32x32x16_bf16(b1,qr[0],i1,0,0,0);}
    else{p0=__builtin_amdgcn_mfma_f32_32x32x16_bf16(b0,qr[d0],p0,0,0,0);p1=__builtin_amdgcn_mfma_f32_32x32x16_bf16(b1,qr[d0],p1,0,0,0);}}
}
typedef __attribute__((address_space(3))) const char* lds_cptr;
typedef short v4i16_t __attribute__((ext_vector_type(4)));
__device__ __forceinline__ void kload8(bf16x8*kf,lds_cptr kp){
  kf[0]=*(const __attribute__((address_space(3))) bf16x8*)(kp);      kf[1]=*(const __attribute__((address_space(3))) bf16x8*)(kp+512);
  kf[2]=*(const __attribute__((address_space(3))) bf16x8*)(kp+2048); kf[3]=*(const __attribute__((address_space(3))) bf16x8*)(kp+2560);
  kf[4]=*(const __attribute__((address_space(3))) bf16x8*)(kp+4096); kf[5]=*(const __attribute__((address_space(3))) bf16x8*)(kp+4608);
  kf[6]=*(const __attribute__((address_space(3))) bf16x8*)(kp+6144); kf[7]=*(const __attribute__((address_space(3))) bf16x8*)(kp+6656);
}
__device__ __forceinline__ void kload2(bf16x8*kf,lds_cptr kp,int j){ kf[2*j]=*(const __attribute__((address_space(3))) bf16x8*)(kp+j*2048); kf[2*j+1]=*(const __attribute__((address_space(3))) bf16x8*)(kp+j*2048+512); }
__device__ __forceinline__ s16x4 vtr(lds_cptr p){ return __builtin_bit_cast(s16x4,__builtin_amdgcn_ds_read_tr16_b64_v4i16((__attribute__((address_space(3))) v4i16_t*)p)); }
__device__ __forceinline__ float rowmax(const f32x16&p0,const f32x16&p1){
  float a=max3f(p0[0],p0[1],p1[0]),b=max3f(p0[2],p0[3],p1[1]);a=max3f(a,p1[2],p1[3]);
  #pragma unroll
  for(int r=4;r<16;r+=4){a=max3f(a,p0[r],p0[r+1]);b=max3f(b,p0[r+2],p0[r+3]);a=max3f(a,p1[r],p1[r+1]);b=max3f(b,p1[r+2],p1[r+3]);}
  const float m=max2f(a,b);
  auto rr=__builtin_amdgcn_permlane32_swap(__float_as_uint(m),__float_as_uint(m),false,false);
  return max2f(__uint_as_float(rr[0]),__uint_as_float(rr[1]));
}
__device__ __forceinline__ void pv(f32x16*o,int vb,bf16x8 pa0,bf16x8 pa1,bf16x8 pa2,bf16x8 pa3){
  #pragma unroll
  for(int d0=0;d0<2;++d0){s16x4 lo[4],hi[4];
    #pragma unroll
    for(int ks=0;ks<4;++ks){
      asm volatile("ds_read_b64_tr_b16 %0,%1 offset:%c2":"=&v"(lo[ks]):"v"(vb),"i"(d0*4096+ks*1024):"memory");
      asm volatile("ds_read_b64_tr_b16 %0,%1 offset:%c2":"=&v"(hi[ks]):"v"(vb),"i"(d0*4096+ks*1024+512):"memory");}
    asm volatile("s_waitcnt lgkmcnt(0)":::"memory");SBAR();
    #define PK(k) (bf16x8){lo[k][0],lo[k][1],lo[k][2],lo[k][3],hi[k][0],hi[k][1],hi[k][2],hi[k][3]}
    o[d0]=__builtin_amdgcn_mfma_f32_32x32x16_bf16(pa0,PK(0),o[d0],0,0,0);
    o[d0]=__builtin_amdgcn_mfma_f32_32x32x16_bf16(pa1,PK(1),o[d0],0,0,0);
    o[d0]=__builtin_amdgcn_mfma_f32_32x32x16_bf16(pa2,PK(2),o[d0],0,0,0);
    o[d0]=__builtin_amdgcn_mfma_f32_32x32x16_bf16(pa3,PK(3),o[d0],0,0,0);
    #undef PK
  }
}

#ifndef ATTN_STORE16
#define ATTN_STORE16(p,v) (*(u32x4*)(p)=(v))
#endif
template<int THRL> __device__ __forceinline__ void attn_unit(int b,int h,int qb,const bf16*Q,const bf16*__restrict__ K,const bf16*__restrict__ V,bf16*O,const float*__restrict__ CLh,const float*__restrict__ QN2h,const float*__restrict__ KN2h,char*shm,const int tid_in){
  const int tid=tid_in,lane=tid&63,r32=lane&31,hi=lane>>5; const int wid=__builtin_amdgcn_readfirstlane(tid>>6);
  const long rowbase=(long)b*SEQ; const int q0=qb*QB;
  const bf16*Qw=Q+(rowbase+q0+wid*QBLK)*DM+h*D;
  int Ts;
  { const int NT0=(q0+QB)/KVBLK; float kn=0.f;
    _Pragma("unroll") for(int j=0;j<4;++j){ const int c=lane+64*j; if(c<NT0)kn=__builtin_fmaxf(kn,KN2h[c]); }
    kn=wave_max(kn);
    const float qn=__builtin_fmaxf(__builtin_fmaxf(QN2h[4*qb],QN2h[4*qb+1]),__builtin_fmaxf(QN2h[4*qb+2],QN2h[4*qb+3]));
    const float b2=2.f*__builtin_sqrtf(qn*kn), clq0=CLh[q0]; int cnt=0;
    _Pragma("unroll") for(int j=0;j<4;++j){ const int Tt=lane+64*j; const bool sk=(Tt<NT0)&&(clq0-CLh[Tt<NT0?64*Tt+63:0]+b2<-160.f); cnt+=__builtin_popcountll(__ballot(sk)); }
    Ts=cnt&~1; if(Ts>NT0-4)Ts=NT0-4; Ts=__builtin_amdgcn_readfirstlane(Ts); }
  const bf16*Kh=K+(rowbase+(long)Ts*KVBLK)*DM+h*D,*Vh=V+(rowbase+(long)Ts*KVBLK)*DM+h*D;
  const lds_cptr shm3=(lds_cptr)shm;
  const unsigned lds0=(unsigned)(uintptr_t)shm;
  float*wsf=(float*)(shm+LDS_WS)+wid*64;
  const bf16*ksrc=Kh+(long)lane*DM+wid*8;
  const bf16*vsrc=Vh+(long)(16*(wid&3)+(lane>>2))*DM+(wid>>2)*32+(lane&3)*8;
  const unsigned kdst=lds0+LDS_K+wid*1024, vdst=lds0+LDS_V+wid*1024;
  #define DMA_K(t,slot) glds16(ksrc+(long)(t)*KVBLK*DM,(unsigned)__builtin_amdgcn_readfirstlane(kdst+(slot)))
  #define DMA_V(t,slot) glds16(vsrc+(long)(t)*KVBLK*DM,(unsigned)__builtin_amdgcn_readfirstlane(vdst+(slot)))
  const int vb0=(int)(lds0+LDS_V)+((lane>>4)&1)*32+(lane&3)*8+(4*hi+((lane&15)>>2))*64;
  const char*Kbase=shm+LDS_K; bf16x8 kf[8];
  const lds_cptr kp0=shm3+LDS_K+hi*1024+r32*16; const lds_cptr vp0=shm3+LDS_V+((lane>>4)&1)*32+(lane&3)*8+(4*hi+((lane&15)>>2))*64;
  const int NT=(q0+QB)/KVBLK-Ts;
  typedef __attribute__((address_space(3))) float* lds_fptr; typedef __attribute__((address_space(3))) const f32x4_t* lds_f4ptr;
  { typedef __attribute__((address_space(3))) f32x4_t* lds_f4w; lds_f4w clw=(lds_f4w)(shm3+LDS_CL); const f32x4_t*cls=(const f32x4_t*)(CLh+Ts*KVBLK); const int ncl4=(q0+QB-Ts*KVBLK)>>2; _Pragma("nounroll") for(int i=tid;i<ncl4;i+=NW*64)clw[i]=cls[i]; }
  const lds_f4ptr clp=(lds_f4ptr)(shm3+LDS_CL+16*hi);
  float nb=CLh[q0+wid*QBLK+r32];
  #define CKLOAD(X0,X1,t) do{ const lds_f4ptr cb_=clp+(t)*16; \
    _Pragma("unroll") for(int g_=0;g_<4;++g_){ const f32x4_t a_=cb_[2*g_], b_=cb_[8+2*g_]; \
      _Pragma("unroll") for(int i_=0;i_<4;++i_){ X0[4*g_+i_]=a_[i_]; X1[4*g_+i_]=b_[i_]; } } }while(0)
  #define BIASSUB(C0,C1) do{ _Pragma("unroll") for(int r_=0;r_<16;++r_){ C0[r_]=nb-C0[r_]; C1[r_]=nb-C1[r_]; } }while(0)
  DMA_K(0,0);DMA_V(0,0);DMA_K(1,SLOTB);
  bf16x8 qr[4];
  #pragma unroll
  for(int d0=0;d0<4;++d0)qr[d0]=*reinterpret_cast<const bf16x8*>(&Qw[(long)r32*DM+d0*16+hi*8]);
  float l_reg=0.f;f32x16 o[2];o[0]=f32x16{};o[1]=f32x16{};
  const int qrel=wid*QBLK+r32;
  #define CMASK(P0,P1,t) do{int jb_=(t)-(NT-4); if(jb_>=0)cmask(P0,P1,jb_,qrel,hi);}while(0)
  bool resc=false;
  #define START(P0,P1) do{ const float rm=rowmax(P0,P1); resc=false; \
    { const float dl=rm; nb=fsub_s(nb,dl); \
      _Pragma("unroll") for(int r=0;r<16;++r){P0[r]=fsub_s(P0[r],dl);P1[r]=fsub_s(P1[r],dl);} } \
    _Pragma("unroll") for(int r=0;r<16;++r)P0[r]=__builtin_amdgcn_exp2f(P0[r]); }while(0)
  #define RESC() do{ if(resc){ asm volatile("s_waitcnt lgkmcnt(0)":::"memory"); \
      _Pragma("unroll") for(int d_=0;d_<2;++d_) _Pragma("unroll") for(int r=0;r<16;++r)o[d_][r]*=wsf[crow(r,hi)]; } }while(0)
  f32x16 pA0,pA1,pB0,pB1;
  int sl_prev=0,sl_cur=0,sl_next=SLOTB;
  #define ROT() do{sl_prev=sl_cur;sl_cur=sl_next;sl_next=(sl_next==(NSLOT-1)*SLOTB)?0:sl_next+SLOTB;}while(0)
  DMA_K(2,2*SLOTB);
  WAIT_BAR(3);
  CKLOAD(pA0,pA1,0); BIASSUB(pA0,pA1);
  qkt(pA0,pA1,Kbase,qr,pA0,pA1,r32,hi);asm volatile("s_nop 15\n\ts_nop 7":"+v"(pA0),"+v"(pA1));CMASK(pA0,pA1,0);
  START(pA0,pA1);
  _Pragma("unroll") for(int r=0;r<16;++r)pA1[r]=__builtin_amdgcn_exp2f(pA1[r]);
  WAIT_BAR(0);
  DMA_K(3,0);DMA_V(1,SLOTB);
  ROT();
  kload8(kf,kp0+sl_cur);
  WAIT_BAR(2);
  s16x4 vlo[8],vhi[8]; u32x4 pw0,pw1,pw2,pw3;
  #define PKW(P,B) cvtpk_s(P[B],P[B+1])
  #define PAF(k) __builtin_bit_cast(bf16x8,pw##k)
  #define VFR(i) (bf16x8){vlo[i][0],vlo[i][1],vlo[i][2],vlo[i][3],vhi[i][0],vhi[i][1],vhi[i][2],vhi[i][3]}
  #define PIN(x) asm volatile("":"+v"(x))
  #define MX3(a,b,c) __builtin_fmaxf(__builtin_fmaxf((a),(b)),(c))
  #define GAPA(MF,A0,A1,A2,A3,W0,W1,PW) do{ MF; sacc+=A0; sacc+=A1; sacc+=A2; sacc+=A3; PIN(sacc); W0; W1; PIN(PW); SBAR(); }while(0)
  #define EX(v) __builtin_amdgcn_exp2f(v)
  #define GAPB(MF,X,B) do{ MF; X[B]=EX(X[B]); X[B+1]=EX(X[B+1]); X[B+2]=EX(X[B+2]); X[B+3]=EX(X[B+3]); PIN(X); SBAR(); }while(0)
  #define VRD(i) do{ vlo[i]=vtr(vp_+(((i)>>2)*4096+((i)&3)*1024)); vhi[i]=vtr(vp_+(((i)>>2)*4096+((i)&3)*1024+512)); }while(0)
  #define KRD(G,j) do{ if(G){ kload2(kf,kp0+sl_next,j); SBAR(); } }while(0)
  #define STEP(C0,C1,P0,P1,t,GK,GV,GL) do{ CKLOAD(C0,C1,t); asm volatile("":"+v"(C0),"+v"(C1)); BIASSUB(C0,C1); SBAR(); \
    const lds_cptr vp_=vp0+sl_prev; \
    VRD(0); SBAR(); float sacc=(P0[0]+P0[1]); \
    GAPA(C0=__builtin_amdgcn_mfma_f32_32x32x16_bf16(kf[0],qr[0],C0,0,0,0), P0[2],P0[3],P0[4],P0[5],     pw0[0]=PKW(P0,0), pw0[1]=PKW(P0,2), pw0); \
    VRD(4); SBAR(); GAPA(C1=__builtin_amdgcn_mfma_f32_32x32x16_bf16(kf[1],qr[0],C1,0,0,0), P0[6],P0[7],P0[8],P0[9],     pw0[2]=PKW(P0,4), pw0[3]=PKW(P0,6), pw0); \
    VRD(1); SBAR(); GAPA(C0=__builtin_amdgcn_mfma_f32_32x32x16_bf16(kf[2],qr[1],C0,0,0,0),   P0[10],P0[11],P0[12],P0[13], pw1[0]=PKW(P0,8), pw1[1]=PKW(P0,10), pw1); \
    VRD(5); SBAR(); GAPA(C1=__builtin_amdgcn_mfma_f32_32x32x16_bf16(kf[3],qr[1],C1,0,0,0),   P0[14],P0[15],P1[0],P1[1],   pw1[2]=PKW(P0,12),pw1[3]=PKW(P0,14), pw1); \
    VRD(2); SBAR(); GAPA(C0=__builtin_amdgcn_mfma_f32_32x32x16_bf16(kf[4],qr[2],C0,0,0,0),   P1[2],P1[3],P1[4],P1[5],     pw2[0]=PKW(P1,0), pw2[1]=PKW(P1,2), pw2); \
    VRD(6); SBAR(); GAPA(C1=__builtin_amdgcn_mfma_f32_32x32x16_bf16(kf[5],qr[2],C1,0,0,0),   P1[6],P1[7],P1[8],P1[9],     pw2[2]=PKW(P1,4), pw2[3]=PKW(P1,6), pw2); \
    VRD(3); SBAR(); GAPA(C0=__builtin_amdgcn_mfma_f32_32x32x16_bf16(kf[6],qr[3],C0,0,0,0),   P1[10],P1[11],P1[12],P1[13], pw3[0]=PKW(P1,8), pw3[1]=PKW(P1,10), pw3); \
    VRD(7); SBAR(); GAPA(C1=__builtin_amdgcn_mfma_f32_32x32x16_bf16(kf[7],qr[3],C1,0,0,0),   P1[14],P1[15],0.f,0.f,       pw3[2]=PKW(P1,12),pw3[3]=PKW(P1,14), pw3); \
    l_reg+=sacc; \
    if(GK){DMA_K((t)+3,sl_cur);} if(GV){DMA_V((t)+1,sl_next);} \
    CMASK(C0,C1,t); \
    { float a=MX3(C0[0],C0[1],C1[0]),b=MX3(C0[2],C0[3],C1[1]); a=MX3(a,C1[2],C1[3]); \
      _Pragma("unroll") for(int r=4;r<16;r+=4){a=MX3(a,C0[r],C0[r+1]);b=MX3(b,C0[r+2],C0[r+3]);a=MX3(a,C1[r],C1[r+1]);b=MX3(b,C1[r+2],C1[r+3]);} \
      float rm=__builtin_fmaxf(a,b); { auto rr=__builtin_amdgcn_permlane32_swap(__float_as_uint(rm),__float_as_uint(rm),false,false); rm=__builtin_fmaxf(__uint_as_float(rr[0]),__uint_as_float(rr[1])); } \
      resc=false; \
      if(__builtin_expect(__any(rm>(float)THRL),0)){ const float dl=__builtin_fmaxf(rm,0.f); nb-=dl; \
        _Pragma("unroll") for(int r=0;r<16;++r){C0[r]-=dl;C1[r]-=dl;} \
        const float f=__builtin_amdgcn_exp2f(-dl); l_reg*=f; if(hi==0)wsf[r32]=f; resc=true; } } \
    SBAR(); \
    GAPB(o[0]=__builtin_amdgcn_mfma_f32_32x32x16_bf16(PAF(0),VFR(0),o[0],0,0,0), C0,0); \
    GAPB(o[1]=__builtin_amdgcn_mfma_f32_32x32x16_bf16(PAF(0),VFR(4),o[1],0,0,0), C0,4); \
    KRD(GL,0); GAPB(o[0]=__builtin_amdgcn_mfma_f32_32x32x16_bf16(PAF(1),VFR(1),o[0],0,0,0), C0,8); \
    KRD(GL,1); GAPB(o[1]=__builtin_amdgcn_mfma_f32_32x32x16_bf16(PAF(1),VFR(5),o[1],0,0,0), C0,12); \
    KRD(GL,2); GAPB(o[0]=__builtin_amdgcn_mfma_f32_32x32x16_bf16(PAF(2),VFR(2),o[0],0,0,0), C1,0); \
    KRD(GL,3); GAPB(o[1]=__builtin_amdgcn_mfma_f32_32x32x16_bf16(PAF(2),VFR(6),o[1],0,0,0), C1,4); \
    GAPB(o[0]=__builtin_amdgcn_mfma_f32_32x32x16_bf16(PAF(3),VFR(3),o[0],0,0,0), C1,8); \
    GAPB(o[1]=__builtin_amdgcn_mfma_f32_32x32x16_bf16(PAF(3),VFR(7),o[1],0,0,0), C1,12); \
    }while(0)
  int t=1;
  #undef CMASK
  #define CMASK(P0,P1,t) do{}while(0)
  for(;t+5<NT;t+=2){
    STEP(pB0,pB1,pA0,pA1,t,true,true,true);     WAIT_BAR(2); RESC(); ROT();
    STEP(pA0,pA1,pB0,pB1,t+1,true,true,true);   WAIT_BAR(2); RESC(); ROT();
  }
  #undef CMASK
  #define CMASK(P0,P1,t) do{int jb_=(t)-(NT-4); if(jb_>=0)cmask(P0,P1,jb_,qrel,hi);}while(0)
  #define ENDW(tt) do{ if((tt)+3<NT){WAIT_BAR(2);} else if((tt)+2<NT){WAIT_BAR(1);} else {WAIT_BAR(0);} }while(0)
  for(;t+1<NT;t+=2){
    STEP(pB0,pB1,pA0,pA1,t,(t+3<NT),(t+1<NT),(t+1<NT));       ENDW(t);   RESC(); ROT();
    STEP(pA0,pA1,pB0,pB1,t+1,(t+4<NT),(t+2<NT),(t+2<NT));     ENDW(t+1); RESC(); ROT();
  }
  STEP(pB0,pB1,pA0,pA1,NT-1,false,false,false); RESC();
  { float sacc=pB0[0]+pB0[1]; _Pragma("unroll") for(int r=2;r<16;++r)sacc+=pB0[r]; _Pragma("unroll") for(int r=0;r<16;++r)sacc+=pB1[r]; l_reg+=sacc;
    pw0=(u32x4){PKW(pB0,0),PKW(pB0,2),PKW(pB0,4),PKW(pB0,6)};pw1=(u32x4){PKW(pB0,8),PKW(pB0,10),PKW(pB0,12),PKW(pB0,14)};pw2=(u32x4){PKW(pB1,0),PKW(pB1,2),PKW(pB1,4),PKW(pB1,6)};pw3=(u32x4){PKW(pB1,8),PKW(pB1,10),PKW(pB1,12),PKW(pB1,14)};
    SBAR(); pv(o,vb0+sl_cur,PAF(0),PAF(1),PAF(2),PAF(3)); }
  #undef PKW
  #undef PAF
  #undef VFR
  #undef PIN
  #undef MX3
  #undef GAPA
  #undef GAPB
  #undef EX
  #undef VRD
  #undef KRD
  #undef STEP
  #undef ENDW
  {auto rr=__builtin_amdgcn_permlane32_swap(__float_as_uint(l_reg),__float_as_uint(l_reg),false,false);l_reg=__uint_as_float(rr[0])+__uint_as_float(rr[1]);}
  if(hi==0)wsf[32+r32]=l_reg;asm volatile("s_waitcnt lgkmcnt(0)":::"memory");
  float rli[16];
  #pragma unroll
  for(int r=0;r<16;++r)rli[r]=__builtin_amdgcn_rcpf(wsf[32+crow(r,hi)]);
  bf16*Ow=O+(rowbase+q0+wid*QBLK)*OPITCH+OCOL+h*D;
  { bf16*stg=(bf16*)(shm+LDS_OST)+wid*2048;
    #pragma unroll
    for(int r=0;r<16;++r){const int orow=crow(r,hi);
      #pragma unroll
      for(int d0=0;d0<2;++d0)stg[orow*64+d0*32+r32]=(bf16)(cvtpk_s(o[d0][r]*rli[r],0.f)&0xffffu);}
    asm volatile("s_waitcnt lgkmcnt(0)":::"memory");
    #pragma unroll
    for(int i=0;i<4;++i){const int row=i*8+(lane>>3),ch=lane&7; const u32x4 v=*(const u32x4*)(stg+row*64+ch*8); ATTN_STORE16(Ow+(long)row*OPITCH+ch*8,v);} }
  asm volatile("s_waitcnt lgkmcnt(0)\n\ts_barrier":::"memory");
  #undef CKLOAD
  #undef BIASSUB
  #undef DMA_K
  #undef DMA_V
  #undef CMASK
  #undef START
  #undef RESC
  #undef ROT
}
constexpr int ATTN_LDS_BYTES=LDS_BYTES;
struct AttnTensors { const bf16* Q; const bf16* K; const bf16* V; bf16* O; const float* CL; const float* QN2; const float* KN2; };
struct AttnUnit { int bh; int qb; };
struct StaticOrder {
  int vcu, G;
  __device__ __forceinline__ explicit StaticOrder(int grid,int block):vcu((grid%8==0)?(block%8)*(grid/8)+block/8:block),G(grid){}
  __device__ __forceinline__ bool next(int i,AttnUnit&u)const{ const int L=i*G+vcu; if(L>=1024)return false; const int slot=L>>8,pos=L&255,s=pos&15; u.bh=pos>>4; u.qb=(slot==0)?s:(slot==1)?31-s:(slot==2)?32+s:63-s; return true; }
  __device__ __forceinline__ void a_ready(const AttnUnit&)const{}
  __device__ __forceinline__ void done(const AttnUnit&)const{}
};
template<int THRL=8> __device__ __forceinline__ void attn_phase(char*lds,const AttnTensors&T,unsigned*heads,const int myx,const int tid_in,ArgsP ap){
  int probe=7; volatile __attribute__((address_space(3))) int*bc=(volatile __attribute__((address_space(3))) int*)((__attribute__((address_space(3))) char*)lds+LDS_BYTES+64);
  for(;;){ const int item=peer_next_item(heads,1,probe,3072u,bc,tid_in); if(item<0)break;
    const int it3=item%3072,v=it3/3,ty=it3-3*v;
    if(ty==1){ convert_uv_fp8_item(ap,opaque(tid_in),v); continue; }
    if(ty==2){ if(v<512)transpose_filler_item(ap,(__attribute__((address_space(3))) unsigned char*)lds,opaque(tid_in),v); continue; }
    const int h=15-(v&15),qb=63-(v>>4);
    attn_unit<THRL>(0,h,qb,T.Q,T.K,T.V,T.O,T.CL+(long)h*SEQ,T.QN2+h*256,T.KN2+h*256,lds,tid_in); }
}
#undef SBAR
#undef WAIT_BAR
}
__device__ __forceinline__ int topk_sortable(float f) { const int u = __float_as_int(f); return u ^ ((u >> 31) & 0x7fffffff); }
__device__ __forceinline__ int topk_pack7(float f, int idx) { return (topk_sortable(f) & ~127) | (127 - idx); }
__device__ __forceinline__ void wave_imax2(int& a, int& b, int& sa, int& sb) {
    asm volatile("s_nop 1\n\t"
        "v_max_i32_dpp %0, %0, %0 row_shr:1 row_mask:0xf bank_mask:0xf\n\tv_max_i32_dpp %1, %1, %1 row_shr:1 row_mask:0xf bank_mask:0xf\n\ts_nop 0\n\t"
        "v_max_i32_dpp %0, %0, %0 row_shr:2 row_mask:0xf bank_mask:0xf\n\tv_max_i32_dpp %1, %1, %1 row_shr:2 row_mask:0xf bank_mask:0xf\n\ts_nop 0\n\t"
        "v_max_i32_dpp %0, %0, %0 row_shr:4 row_mask:0xf bank_mask:0xf\n\tv_max_i32_dpp %1, %1, %1 row_shr:4 row_mask:0xf bank_mask:0xf\n\ts_nop 0\n\t"
        "v_max_i32_dpp %0, %0, %0 row_shr:8 row_mask:0xf bank_mask:0xf\n\tv_max_i32_dpp %1, %1, %1 row_shr:8 row_mask:0xf bank_mask:0xf\n\ts_nop 0\n\t"
        "v_max_i32_dpp %0, %0, %0 row_bcast:15 row_mask:0xa bank_mask:0xf\n\tv_max_i32_dpp %1, %1, %1 row_bcast:15 row_mask:0xa bank_mask:0xf\n\ts_nop 0\n\t"
        "v_max_i32_dpp %0, %0, %0 row_bcast:31 row_mask:0xc bank_mask:0xf\n\tv_max_i32_dpp %1, %1, %1 row_bcast:31 row_mask:0xc bank_mask:0xf\n\ts_nop 1\n\t"
        "v_readlane_b32 %2, %0, 63\n\tv_readlane_b32 %3, %1, 63\n\ts_nop 3"
        : "+v"(a), "+v"(b), "=s"(sa), "=s"(sb));
}
__device__ __forceinline__ void wave_imax1(int& a, int& sa) {
    asm volatile("s_nop 1\n\t"
        "v_max_i32_dpp %0, %0, %0 row_shr:1 row_mask:0xf bank_mask:0xf\n\ts_nop 1\n\t"
        "v_max_i32_dpp %0, %0, %0 row_shr:2 row_mask:0xf bank_mask:0xf\n\ts_nop 1\n\t"
        "v_max_i32_dpp %0, %0, %0 row_shr:4 row_mask:0xf bank_mask:0xf\n\ts_nop 1\n\t"
        "v_max_i32_dpp %0, %0, %0 row_shr:8 row_mask:0xf bank_mask:0xf\n\ts_nop 1\n\t"
        "v_max_i32_dpp %0, %0, %0 row_bcast:15 row_mask:0xa bank_mask:0xf\n\ts_nop 1\n\t"
        "v_max_i32_dpp %0, %0, %0 row_bcast:31 row_mask:0xc bank_mask:0xf\n\ts_nop 1\n\t"
        "v_readlane_b32 %1, %0, 63\n\ts_nop 3"
        : "+v"(a), "=s"(sa));
}
__device__ __forceinline__ void wave_imax_x8(int (&k)[8], int (&s)[8]) {
    asm volatile("s_nop 1\n\t"
        "v_max_i32_dpp %0, %0, %0 row_shr:1 row_mask:0xf bank_mask:0xf\n\tv_max_i32_dpp %1, %1, %1 row_shr:1 row_mask:0xf bank_mask:0xf\n\tv_max_i32_dpp %2, %2, %2 row_shr:1 row_mask:0xf bank_mask:0xf\n\tv_max_i32_dpp %3, %3, %3 row_shr:1 row_mask:0xf bank_mask:0xf\n\tv_max_i32_dpp %4, %4, %4 row_shr:1 row_mask:0xf bank_mask:0xf\n\tv_max_i32_dpp %5, %5, %5 row_shr:1 row_mask:0xf bank_mask:0xf\n\tv_max_i32_dpp %6, %6, %6 row_shr:1 row_mask:0xf bank_mask:0xf\n\tv_max_i32_dpp %7, %7, %7 row_shr:1 row_mask:0xf bank_mask:0xf\n\t"
        "v_max_i32_dpp %0, %0, %0 row_shr:2 row_mask:0xf bank_mask:0xf\n\tv_max_i32_dpp %1, %1, %1 row_shr:2 row_mask:0xf bank_mask:0xf\n\tv_max_i32_dpp %2, %2, %2 row_shr:2 row_mask:0xf bank_mask:0xf\n\tv_max_i32_dpp %3, %3, %3 row_shr:2 row_mask:0xf bank_mask:0xf\n\tv_max_i32_dpp %4, %4, %4 row_shr:2 row_mask:0xf bank_mask:0xf\n\tv_max_i32_dpp %5, %5, %5 row_shr:2 row_mask:0xf bank_mask:0xf\n\tv_max_i32_dpp %6, %6, %6 row_shr:2 row_mask:0xf bank_mask:0xf\n\tv_max_i32_dpp %7, %7, %7 row_shr:2 row_mask:0xf bank_mask:0xf\n\t"
        "v_max_i32_dpp %0, %0, %0 row_shr:4 row_mask:0xf bank_mask:0xf\n\tv_max_i32_dpp %1, %1, %1 row_shr:4 row_mask:0xf bank_mask:0xf\n\tv_max_i32_dpp %2, %2, %2 row_shr:4 row_mask:0xf bank_mask:0xf\n\tv_max_i32_dpp %3, %3, %3 row_shr:4 row_mask:0xf bank_mask:0xf\n\tv_max_i32_dpp %4, %4, %4 row_shr:4 row_mask:0xf bank_mask:0xf\n\tv_max_i32_dpp %5, %5, %5 row_shr:4 row_mask:0xf bank_mask:0xf\n\tv_max_i32_dpp %6, %6, %6 row_shr:4 row_mask:0xf bank_mask:0xf\n\tv_max_i32_dpp %7, %7, %7 row_shr:4 row_mask:0xf bank_mask:0xf\n\t"
        "v_max_i32_dpp %0, %0, %0 row_shr:8 row_mask:0xf bank_mask:0xf\n\tv_max_i32_dpp %1, %1, %1 row_shr:8 row_mask:0xf bank_mask:0xf\n\tv_max_i32_dpp %2, %2, %2 row_shr:8 row_mask:0xf bank_mask:0xf\n\tv_max_i32_dpp %3, %3, %3 row_shr:8 row_mask:0xf bank_mask:0xf\n\tv_max_i32_dpp %4, %4, %4 row_shr:8 row_mask:0xf bank_mask:0xf\n\tv_max_i32_dpp %5, %5, %5 row_shr:8 row_mask:0xf bank_mask:0xf\n\tv_max_i32_dpp %6, %6, %6 row_shr:8 row_mask:0xf bank_mask:0xf\n\tv_max_i32_dpp %7, %7, %7 row_shr:8 row_mask:0xf bank_mask:0xf\n\t"
        "v_max_i32_dpp %0, %0, %0 row_bcast:15 row_mask:0xa bank_mask:0xf\n\tv_max_i32_dpp %1, %1, %1 row_bcast:15 row_mask:0xa bank_mask:0xf\n\tv_max_i32_dpp %2, %2, %2 row_bcast:15 row_mask:0xa bank_mask:0xf\n\tv_max_i32_dpp %3, %3, %3 row_bcast:15 row_mask:0xa bank_mask:0xf\n\tv_max_i32_dpp %4, %4, %4 row_bcast:15 row_mask:0xa bank_mask:0xf\n\tv_max_i32_dpp %5, %5, %5 row_bcast:15 row_mask:0xa bank_mask:0xf\n\tv_max_i32_dpp %6, %6, %6 row_bcast:15 row_mask:0xa bank_mask:0xf\n\tv_max_i32_dpp %7, %7, %7 row_bcast:15 row_mask:0xa bank_mask:0xf\n\t"
        "v_max_i32_dpp %0, %0, %0 row_bcast:31 row_mask:0xc bank_mask:0xf\n\tv_max_i32_dpp %1, %1, %1 row_bcast:31 row_mask:0xc bank_mask:0xf\n\tv_max_i32_dpp %2, %2, %2 row_bcast:31 row_mask:0xc bank_mask:0xf\n\tv_max_i32_dpp %3, %3, %3 row_bcast:31 row_mask:0xc bank_mask:0xf\n\tv_max_i32_dpp %4, %4, %4 row_bcast:31 row_mask:0xc bank_mask:0xf\n\tv_max_i32_dpp %5, %5, %5 row_bcast:31 row_mask:0xc bank_mask:0xf\n\tv_max_i32_dpp %6, %6, %6 row_bcast:31 row_mask:0xc bank_mask:0xf\n\tv_max_i32_dpp %7, %7, %7 row_bcast:31 row_mask:0xc bank_mask:0xf\n\t"
        "s_nop 1\n\tv_readlane_b32 %8, %0, 63\n\tv_readlane_b32 %9, %1, 63\n\tv_readlane_b32 %10, %2, 63\n\tv_readlane_b32 %11, %3, 63\n\tv_readlane_b32 %12, %4, 63\n\tv_readlane_b32 %13, %5, 63\n\tv_readlane_b32 %14, %6, 63\n\tv_readlane_b32 %15, %7, 63\n\ts_nop 3"
        : "+v"(k[0]), "+v"(k[1]), "+v"(k[2]), "+v"(k[3]), "+v"(k[4]), "+v"(k[5]), "+v"(k[6]), "+v"(k[7]), "=s"(s[0]), "=s"(s[1]), "=s"(s[2]), "=s"(s[3]), "=s"(s[4]), "=s"(s[5]), "=s"(s[6]), "=s"(s[7]));
}
__device__ __forceinline__ void wave_imax_x4(int (&k)[4], int (&s)[4]) {
    asm volatile("s_nop 1\n\t"
        "v_max_i32_dpp %0, %0, %0 row_shr:1 row_mask:0xf bank_mask:0xf\n\tv_max_i32_dpp %1, %1, %1 row_shr:1 row_mask:0xf bank_mask:0xf\n\tv_max_i32_dpp %2, %2, %2 row_shr:1 row_mask:0xf bank_mask:0xf\n\tv_max_i32_dpp %3, %3, %3 row_shr:1 row_mask:0xf bank_mask:0xf\n\t"
        "v_max_i32_dpp %0, %0, %0 row_shr:2 row_mask:0xf bank_mask:0xf\n\tv_max_i32_dpp %1, %1, %1 row_shr:2 row_mask:0xf bank_mask:0xf\n\tv_max_i32_dpp %2, %2, %2 row_shr:2 row_mask:0xf bank_mask:0xf\n\tv_max_i32_dpp %3, %3, %3 row_shr:2 row_mask:0xf bank_mask:0xf\n\t"
        "v_max_i32_dpp %0, %0, %0 row_shr:4 row_mask:0xf bank_mask:0xf\n\tv_max_i32_dpp %1, %1, %1 row_shr:4 row_mask:0xf bank_mask:0xf\n\tv_max_i32_dpp %2, %2, %2 row_shr:4 row_mask:0xf bank_mask:0xf\n\tv_max_i32_dpp %3, %3, %3 row_shr:4 row_mask:0xf bank_mask:0xf\n\t"
        "v_max_i32_dpp %0, %0, %0 row_shr:8 row_mask:0xf bank_mask:0xf\n\tv_max_i32_dpp %1, %1, %1 row_shr:8 row_mask:0xf bank_mask:0xf\n\tv_max_i32_dpp %2, %2, %2 row_shr:8 row_mask:0xf bank_mask:0xf\n\tv_max_i32_dpp %3, %3, %3 row_shr:8 row_mask:0xf bank_mask:0xf\n\t"
        "v_max_i32_dpp %0, %0, %0 row_bcast:15 row_mask:0xa bank_mask:0xf\n\tv_max_i32_dpp %1, %1, %1 row_bcast:15 row_mask:0xa bank_mask:0xf\n\tv_max_i32_dpp %2, %2, %2 row_bcast:15 row_mask:0xa bank_mask:0xf\n\tv_max_i32_dpp %3, %3, %3 row_bcast:15 row_mask:0xa bank_mask:0xf\n\t"
        "v_max_i32_dpp %0, %0, %0 row_bcast:31 row_mask:0xc bank_mask:0xf\n\tv_max_i32_dpp %1, %1, %1 row_bcast:31 row_mask:0xc bank_mask:0xf\n\tv_max_i32_dpp %2, %2, %2 row_bcast:31 row_mask:0xc bank_mask:0xf\n\tv_max_i32_dpp %3, %3, %3 row_bcast:31 row_mask:0xc bank_mask:0xf\n\t"
        "s_nop 1\n\tv_readlane_b32 %4, %0, 63\n\tv_readlane_b32 %5, %1, 63\n\tv_readlane_b32 %6, %2, 63\n\tv_readlane_b32 %7, %3, 63\n\ts_nop 3"
        : "+v"(k[0]), "+v"(k[1]), "+v"(k[2]), "+v"(k[3]), "=s"(s[0]), "=s"(s[1]), "=s"(s[2]), "=s"(s[3]));
}
__device__ __forceinline__ void row_imax2(int& a, int& b) {
    asm volatile("s_nop 1\n\t"
        "v_max_i32_dpp %0, %0, %0 row_ror:8 row_mask:0xf bank_mask:0xf\n\tv_max_i32_dpp %1, %1, %1 row_ror:8 row_mask:0xf bank_mask:0xf\n\ts_nop 0\n\t"
        "v_max_i32_dpp %0, %0, %0 row_ror:4 row_mask:0xf bank_mask:0xf\n\tv_max_i32_dpp %1, %1, %1 row_ror:4 row_mask:0xf bank_mask:0xf\n\ts_nop 0\n\t"
        "v_max_i32_dpp %0, %0, %0 row_ror:2 row_mask:0xf bank_mask:0xf\n\tv_max_i32_dpp %1, %1, %1 row_ror:2 row_mask:0xf bank_mask:0xf\n\ts_nop 0\n\t"
        "v_max_i32_dpp %0, %0, %0 row_ror:1 row_mask:0xf bank_mask:0xf\n\tv_max_i32_dpp %1, %1, %1 row_ror:1 row_mask:0xf bank_mask:0xf\n\ts_nop 1"
        : "+v"(a), "+v"(b));
}
template <int CTRL> __device__ __forceinline__ float dpp_rot(float v) { return __int_as_float(__builtin_amdgcn_update_dpp(0, __float_as_int(v), CTRL, 0xf, 0xf, false)); }
__device__ __forceinline__ float row_fmax(float v) { v = fmaxf(v, dpp_rot<0x128>(v)); v = fmaxf(v, dpp_rot<0x124>(v)); v = fmaxf(v, dpp_rot<0x122>(v)); v = fmaxf(v, dpp_rot<0x121>(v)); return v; }
__device__ __forceinline__ float row_fsum(float v) { v += dpp_rot<0x128>(v); v += dpp_rot<0x124>(v); v += dpp_rot<0x122>(v); v += dpp_rot<0x121>(v); return v; }
__device__ const unsigned char PEER_CAND[64] = {
    0x00,0x01,0x02,0x03,0x04,0x05,0x06,0x07,0x08,0x09,0x0a,0x0b,0x0c,0x0d,0x0e,0x0f, 0x10,0x11,0x12,0x13,0x14,0x15,0x16,0x17, 0x20,0x21,0x22,0x23,0x24, 0x30,0x31,0x32,0x33,
    0x40,0x41,0x42, 0x50,0x51, 0x60,0x61, 0x70,0x71, 0x80, 0x90, 0xa0, 0xb0, 0xc0, 0xd0, 0xe0, 0xf0, 0xff,0xff,0xff,0xff,0xff,0xff,0xff,0xff,0xff,0xff,0xff,0xff,0xff,0xff};
__device__ __forceinline__ void phase7(ArgsP a, LAS unsigned char* lds, const int tidx) {
    const int tid0 = tidx, w = __builtin_amdgcn_readfirstlane(tid0 >> 6);
    const bf16* QP = (const bf16*)(a->ws + WS_QP); const bf16* K12 = (const bf16*)(a->ws + WS_K12); const float* SUMSQ = (const float*)(a->ws + WS_MISC + MISC_SUMSQ);
    int* IDX = (int*)(a->ws + WS_IDX); float* GW = (float*)(a->ws + WS_GW);
    LAS float* SC = (LAS float*)lds;
    for (int u = blockIdx.x; u < 256 * 8; u += gridDim.x) {
        const int tid = opaque(tid0), lane = tid & 63, fr = lane & 15, fq = lane >> 4;
        const int tt = u >> 3, hd = u & 7, tok0 = tt * 64;
        {
            const int half = w >> 2; const bf16* kb = K12 + ((size_t)(half * 8 + hd) * 128) * 128;
            f32x4 acc[4][2];
#pragma unroll
            for (int i = 0; i < 4; ++i) { acc[i][0] = (f32x4){0.f, 0.f, 0.f, 0.f}; acc[i][1] = (f32x4){0.f, 0.f, 0.f, 0.f}; }
#pragma unroll
            for (int kk = 0; kk < 4; ++kk) {
                bf16x8 af[4], bfv[2];
#pragma unroll
                for (int i = 0; i < 4; ++i) af[i] = *(const bf16x8*)(QP + (size_t)(tok0 + 16 * i + fr) * DM + 256 * hd + 128 * half + 8 * fq + 32 * kk);
#pragma unroll
                for (int j = 0; j < 2; ++j) bfv[j] = *(const bf16x8*)(kb + (size_t)(16 * (2 * (w & 3) + j) + fr) * 128 + 8 * fq + 32 * kk);
#pragma unroll
                for (int i = 0; i < 4; ++i) { acc[i][0] = mfma16(af[i], bfv[0], acc[i][0]); acc[i][1] = mfma16(af[i], bfv[1], acc[i][1]); }
            }
#pragma unroll
            for (int i = 0; i < 4; ++i)
#pragma unroll
                for (int j = 0; j < 2; ++j)
#pragma unroll
                    for (int r = 0; r < 4; ++r) SC[(16 * i + 4 * fq + r) * 260 + 128 * half + 16 * (2 * (w & 3) + j) + fr] = acc[i][j][r];
        }
        __syncthreads();
        const int r16 = lane & 15, rowb = lane & 48;
        const int cab = (int)PEER_CAND[lane];
        int cca[4], ccb[4];
#pragma unroll
        for (int i = 0; i < 4; ++i) { const int cc = (int)PEER_CAND[r16 + 16 * i]; cca[i] = rowb + (cc >> 4); ccb[i] = rowb + (cc & 15); }
        for (int tl = 0; tl < 8; tl += 4) {
            const int tk = 8 * w + tl + (lane >> 4), tok = tok0 + tk;
            const LAS float* srow = SC + tk * 260;
            int sa[8], sb[8];
#pragma unroll
            for (int i = 0; i < 8; ++i) { sa[i] = topk_pack7(srow[r16 + 16 * i], r16 + 16 * i); sb[i] = topk_pack7(srow[128 + r16 + 16 * i], r16 + 16 * i); }
#define CE(x, i, j) do { const int hi_ = x[i] > x[j] ? x[i] : x[j], lo_ = x[i] > x[j] ? x[j] : x[i]; x[i] = hi_; x[j] = lo_; } while (0)
#define SORT8(x) do { CE(x,0,1); CE(x,2,3); CE(x,4,5); CE(x,6,7); CE(x,0,2); CE(x,1,3); CE(x,4,6); CE(x,5,7); CE(x,1,2); CE(x,5,6); CE(x,0,4); CE(x,3,7); CE(x,1,5); CE(x,2,6); CE(x,1,4); CE(x,3,6); CE(x,2,4); CE(x,3,5); CE(x,3,4); } while (0)
            SORT8(sa); SORT8(sb);
            int resa = 0, resb = 0;
            for (int k = 0; k < 16; ++k) {
                int ma = sa[0], mb = sb[0];
                row_imax2(ma, mb);
                const bool wa = sa[0] == ma, wb = sb[0] == mb;
#pragma unroll
                for (int i = 0; i < 7; ++i) { sa[i] = wa ? sa[i + 1] : sa[i]; sb[i] = wb ? sb[i + 1] : sb[i]; }
                sa[7] = wa ? (int)0x80000000 : sa[7]; sb[7] = wb ? (int)0x80000000 : sb[7];
                if (r16 == k) { resa = ma; resb = mb; }
            }
            const int ria = 127 - (resa & 127), rib = 127 - (resb & 127);
            const float rva = srow[ria], rvb = srow[128 + rib];
            int kc[4];
#pragma unroll
            for (int i = 0; i < 4; ++i) { const float csum = __shfl(rva, cca[i]) + __shfl(rvb, ccb[i]); const int cidx = r16 + 16 * i; kc[i] = cidx < 50 ? ((topk_sortable(csum) & ~63) | (63 - cidx)) : (int)0x80000000; }
            CE(kc,0,1); CE(kc,2,3); CE(kc,0,2); CE(kc,1,3); CE(kc,1,2);
            int resc = 0;
            for (int k = 0; k < 16; ++k) {
                int mc = kc[0], dummy = kc[0];
                row_imax2(mc, dummy);
                const bool wc = kc[0] == mc;
                kc[0] = wc ? kc[1] : kc[0]; kc[1] = wc ? kc[2] : kc[1]; kc[2] = wc ? kc[3] : kc[2]; kc[3] = wc ? (int)0x80000000 : kc[3];
                if (r16 == k) resc = mc;
            }
#undef SORT8
#undef CE
            const int ci = 63 - (resc & 63);
            const int sab = __shfl(cab, ci), sela = rowb + (sab >> 4), selb = rowb + (sab & 15);
            const float sv = __shfl(rva, sela) + __shfl(rvb, selb);
            const int e1 = __shfl(ria, sela), e2 = __shfl(rib, selb);
            const float rstd = 1.f / sqrtf(SUMSQ[tok] * (1.f / DM) + EPS);
            const float top = row_fmax(sv);
            const float p = __expf((sv - top) * rstd);
            const float den = row_fsum(p);
            IDX[(size_t)tok * 128 + 16 * hd + r16] = e1 * 128 + e2; GW[(size_t)tok * 128 + 16 * hd + r16] = p / den;
        }
        __syncthreads();
    }
}

__device__ __forceinline__ void phase8(ArgsP a, const int tidx) {
    const int tid0 = tidx, w = __builtin_amdgcn_readfirstlane(tid0 >> 6);
    const bf16* HN = (const bf16*)(a->ws + WS_HN); const bf16* U = (const bf16*)(a->ws + WS_U); const bf16* V = (const bf16*)(a->ws + WS_V2);
    const int* IDX = (const int*)(a->ws + WS_IDX); const float* GW = (const float*)(a->ws + WS_GW); const float* SUMSQ = (const float*)(a->ws + WS_MISC + MISC_SUMSQ);
    const int gwv = blockIdx.x * NWAVES + w, NGW = gridDim.x * NWAVES;
    for (int tok = gwv; tok < M; tok += NGW) {
        const int lane = opaque(tid0) & 63;
        u32x4 hv[4];
#pragma unroll
        for (int i = 0; i < 4; ++i) hv[i] = *(const u32x4*)(HN + (size_t)tok * DM + 8 * lane + 512 * i);
        const int id0 = IDX[(size_t)tok * 128 + lane], id1 = IDX[(size_t)tok * 128 + 64 + lane];
        const float g0 = GW[(size_t)tok * 128 + lane], g1 = GW[(size_t)tok * 128 + 64 + lane];
        const float rstd2 = 1.f / sqrtf(SUMSQ[tok] * (1.f / DM) + EPS);
        float oacc[32];
#pragma unroll
        for (int i = 0; i < 32; ++i) oacc[i] = 0.f;
        for (int eb = 0; eb < 128; eb += 8) {
            u32x4 uv[8][4]; float part[8]; int eid[8];
#pragma unroll
            for (int e = 0; e < 8; ++e) { const int sl = eb + e; eid[e] = __builtin_amdgcn_readfirstlane(sl < 64 ? __shfl(id0, sl) : __shfl(id1, sl - 64));
                const bf16* row = U + (size_t)eid[e] * DM + 8 * lane;
#pragma unroll
                for (int i = 0; i < 4; ++i) uv[e][i] = *(const u32x4*)(row + 512 * i); }
#pragma unroll
            for (int e = 0; e < 8; ++e) { float s = 0.f;
#pragma unroll
                for (int i = 0; i < 4; ++i) {
                    s = dot2bf(uv[e][i].x, hv[i].x, s); s = dot2bf(uv[e][i].y, hv[i].y, s); s = dot2bf(uv[e][i].z, hv[i].z, s); s = dot2bf(uv[e][i].w, hv[i].w, s); }
                part[e] = wave_sum(s); }
#pragma unroll
            for (int e = 0; e < 8; ++e) { const bf16* row = V + (size_t)eid[e] * DM + 8 * lane;
#pragma unroll
                for (int i = 0; i < 4; ++i) uv[e][i] = *(const u32x4*)(row + 512 * i); }
#pragma unroll
            for (int e = 0; e < 8; ++e) { const int sl = eb + e; const float gg = sl < 64 ? __shfl(g0, sl) : __shfl(g1, sl - 64);
                const float act = part[e] * rstd2; const float ge = 0.5f * act * (1.f + erff(act * 0.70710678118654752f)); const float cf = gg * ge;
#pragma unroll
                for (int i = 0; i < 4; ++i) {
                    oacc[8 * i + 0] += cf * bflo(uv[e][i].x); oacc[8 * i + 1] += cf * bfhi(uv[e][i].x); oacc[8 * i + 2] += cf * bflo(uv[e][i].y); oacc[8 * i + 3] += cf * bfhi(uv[e][i].y);
                    oacc[8 * i + 4] += cf * bflo(uv[e][i].z); oacc[8 * i + 5] += cf * bfhi(uv[e][i].z); oacc[8 * i + 6] += cf * bflo(uv[e][i].w); oacc[8 * i + 7] += cf * bfhi(uv[e][i].w); } }
        }
        float* orow = a->out + (size_t)tok * DM + 8 * lane; float ss = 0.f;
#pragma unroll
        for (int i = 0; i < 4; ++i) { const f32x4 x0 = *(const f32x4*)(orow + 512 * i), x1 = *(const f32x4*)(orow + 512 * i + 4);
#pragma unroll
            for (int j = 0; j < 4; ++j) { oacc[8 * i + j] += x0[j]; oacc[8 * i + 4 + j] += x1[j]; }
#pragma unroll
            for (int j = 0; j < 8; ++j) ss += oacc[8 * i + j] * oacc[8 * i + j]; }
        const float rstd = 1.f / sqrtf(wave_sum(ss) * (1.f / DM) + EPS);
#pragma unroll
        for (int i = 0; i < 4; ++i) { const f32x4 w0 = *(const f32x4*)(a->lnf_w + 8 * lane + 512 * i), w1 = *(const f32x4*)(a->lnf_w + 8 * lane + 512 * i + 4); f32x4 o0, o1;
#pragma unroll
            for (int j = 0; j < 4; ++j) { o0[j] = oacc[8 * i + j] * rstd * w0[j]; o1[j] = oacc[8 * i + 4 + j] * rstd * w1[j]; }
            *(f32x4*)(orow + 512 * i) = o0; *(f32x4*)(orow + 512 * i + 4) = o1; }
    }
}
__device__ __forceinline__ void convert_uv(ArgsP a, const int tidx) {
    const size_t gt = (size_t)blockIdx.x * NTHR + tidx, NGT = (size_t)gridDim.x * NTHR; const size_t NP = (size_t)16384 * 2048 / 8;
    u32x4* Ud = (u32x4*)(a->ws + WS_U); u32x4* Vd = (u32x4*)(a->ws + WS_V2);
    for (size_t i = gt; i < 2 * NP; i += NGT) { const bool second = i >= NP; const size_t j = second ? i - NP : i; const float* src = (second ? a->peer_v : a->peer_u) + j * 8;
        const f32x4 x0 = *(const f32x4*)src, x1 = *(const f32x4*)(src + 4); u32x4 o; o.x = cvtpk(x0[0], x0[1]); o.y = cvtpk(x0[2], x0[3]); o.z = cvtpk(x1[0], x1[1]); o.w = cvtpk(x1[2], x1[3]);
        (second ? Vd : Ud)[j] = o; }
}
constexpr size_t WS_PART = 336 * MiB;
constexpr size_t WS_COEF = 105 * MiB;
constexpr int Q_U = 8192, Q_V = 8192 + 1024;
constexpr size_t MISC_SS2 = 131072;

__device__ __forceinline__ void convert_uv_sliced(ArgsP a, const int tidx) {
    const int lane = tidx & 63, w = tidx >> 6; const int gw = blockIdx.x * NWAVES + w, NGW = gridDim.x * NWAVES;
    bf16* Us = (bf16*)(a->ws + WS_U); bf16* Vs = (bf16*)(a->ws + WS_V2);
    for (int row = gw; row < 32768; row += NGW) { const bool second = row >= 16384; const int e = row & 16383; const f32x4* src = (const f32x4*)((second ? a->peer_v : a->peer_u) + (size_t)e * DM) + lane; bf16* dst = second ? Vs : Us;
        f32x4 x[8];
#pragma unroll
        for (int j = 0; j < 8; ++j) x[j] = src[64 * j];
#pragma unroll
        for (int j = 0; j < 8; ++j) { const int s = 4 * j + (lane >> 4); u32x2 o; o.x = cvtpk(x[j][0], x[j][1]); o.y = cvtpk(x[j][2], x[j][3]);
            *(u32x2*)(dst + ((size_t)s * 16384 + e) * 64 + 4 * (lane & 15)) = o; } }
}
__device__ __forceinline__ void peer_stage_idx(const int* IDX, int tok0, LAS unsigned char* lds, int tid) {
#pragma unroll
    for (int i = 0; i < 8; ++i) { const int q = tid + 512 * i; const u32x4 v = *(const u32x4*)(IDX + (size_t)tok0 * 128 + 4 * q);
        *(LAS u32x2*)(lds + 8 * q) = (u32x2){v.x | (v.y << 16), v.z | (v.w << 16)}; }
}
__device__ __forceinline__ void peer_u_phase(ArgsP a, LAS unsigned char* lds, const int tidx, const int qoff = 0) {
    const int w = __builtin_amdgcn_readfirstlane(tidx >> 6); const int myx = (int)(xb_xcc_id() & 7u); int probe = 0;
    unsigned* heads = (unsigned*)(a->ws + WS_CTL) + Q_U + qoff; volatile LAS int* bc = (volatile LAS int*)(lds + 98304);
    const bf16* HN = (const bf16*)(a->ws + WS_HN); const bf16* Us = (const bf16*)(a->ws + WS_U); const int* IDX = (const int*)(a->ws + WS_IDX); bf16* PART = (bf16*)(a->ws + WS_PART);
    for (;;) {
        const int tid = opaque(tidx), lane = tid & 63, m = lane & 7, g = lane >> 3;
        const int item = peer_next_item(heads, myx, probe, 512u, bc, tid); if (item < 0) break;
        const int s = item >> 7, tile = item & 127, tok0 = tile * 128;
        peer_stage_idx(IDX, tok0, lds, tid);
        __syncthreads();
        const bf16* ub = Us + (size_t)s * 16384 * 64 + 8 * m;
        for (int tt = 0; tt < 16; ++tt) { const int tl = 16 * w + tt, t = tok0 + tl;
            const u32x4 hv = *(const u32x4*)(HN + (size_t)t * DM + 64 * s + 8 * m);
            u32x4 uv[16];
#pragma unroll
            for (int r = 0; r < 16; ++r) { const unsigned id = *(const LAS unsigned short*)(lds + (tl * 128 + 16 * g + r) * 2); uv[r] = *(const u32x4*)(ub + (size_t)id * 64); }
            float p[16];
#pragma unroll
            for (int r = 0; r < 16; ++r) { float d = dot2bf(uv[r].x, hv.x, 0.f); d = dot2bf(uv[r].y, hv.y, d); d = dot2bf(uv[r].z, hv.z, d); d = dot2bf(uv[r].w, hv.w, d); p[r] = d; }
            float q8[8], q4[4], q2[2];
#pragma unroll
            for (int r = 0; r < 8; ++r) { const bool up = (lane & 4) != 0; const float snd = up ? p[r] : p[r + 8], kp = up ? p[r + 8] : p[r]; q8[r] = kp + __shfl_xor(snd, 4); }
#pragma unroll
            for (int r = 0; r < 4; ++r) { const bool up = (lane & 2) != 0; const float snd = up ? q8[r] : q8[r + 4], kp = up ? q8[r + 4] : q8[r]; q4[r] = kp + __shfl_xor(snd, 2); }
#pragma unroll
            for (int r = 0; r < 2; ++r) { const bool up = (lane & 1) != 0; const float snd = up ? q4[r] : q4[r + 2], kp = up ? q4[r + 2] : q4[r]; q2[r] = kp + __shfl_xor(snd, 1); }
            *(unsigned*)(PART + ((size_t)s * M + t) * 128 + 2 * lane) = cvtpk(q2[0], q2[1]);
        }
        __syncthreads();
    }
}
__device__ __forceinline__ void peer_combine(ArgsP a, const int tidx) {
    const size_t gt = (size_t)blockIdx.x * NTHR + tidx, NGT = (size_t)gridDim.x * NTHR;
    const unsigned* PART = (const unsigned*)(a->ws + WS_PART); const float* GW = (const float*)(a->ws + WS_GW); const float* SUMSQ = (const float*)(a->ws + WS_MISC + MISC_SUMSQ); f32x2* C = (f32x2*)(a->ws + WS_COEF);
    for (size_t i = gt; i < (size_t)M * 64; i += NGT) { const int t = (int)(i >> 6); float s0 = 0.f, s1 = 0.f;
#pragma unroll 8
        for (int s = 0; s < 32; ++s) { const unsigned v = PART[(size_t)s * M * 64 + i]; s0 += bflo(v); s1 += bfhi(v); }
        const float rstd2 = 1.f / sqrtf(SUMSQ[t] * (1.f / DM) + EPS); const f32x2 g = ((const f32x2*)GW)[i];
        const float a0 = s0 * rstd2, a1 = s1 * rstd2;
        C[i] = (f32x2){g.x * 0.5f * a0 * (1.f + erff(a0 * 0.70710678118654752f)), g.y * 0.5f * a1 * (1.f + erff(a1 * 0.70710678118654752f))}; }
}
template <bool DRY> __device__ __forceinline__ void peer_v_phase(ArgsP a, LAS unsigned char* lds, const int tidx, const int qoff = 0) {
    const int w = __builtin_amdgcn_readfirstlane(tidx >> 6); const int myx = (int)(xb_xcc_id() & 7u); int probe = 0;
    unsigned* heads = (unsigned*)(a->ws + WS_CTL) + Q_V + qoff; volatile LAS int* bc = (volatile LAS int*)(lds + 98304);
    const bf16* Vs = (const bf16*)(a->ws + WS_V2); const int* IDX = (const int*)(a->ws + WS_IDX); const float* COEF = (const float*)(a->ws + WS_COEF); float* SS2 = (float*)(a->ws + WS_MISC + MISC_SS2);
    for (;;) {
        const int tid = opaque(tidx), lane = tid & 63, m = lane & 7, g = lane >> 3;
        const int item = peer_next_item(heads, myx, probe, 512u, bc, tid); if (item < 0) break;
        const int s = item >> 7, tile = item & 127, tok0 = tile * 128;
        peer_stage_idx(IDX, tok0, lds, tid);
#pragma unroll
        for (int i = 0; i < 8; ++i) { const int q = tid + 512 * i; *(LAS u32x4*)(lds + 32768 + 16 * q) = *(const u32x4*)(COEF + (size_t)tok0 * 128 + 4 * q); }
        __syncthreads();
        const bf16* vb = Vs + (size_t)s * 16384 * 64 + 8 * m;
        for (int tt = 0; tt < 16; ++tt) { const int tl = 16 * w + tt, t = tok0 + tl;
            u32x4 vv[16]; float cf[16];
#pragma unroll
            for (int r = 0; r < 16; ++r) { const unsigned id = *(const LAS unsigned short*)(lds + (tl * 128 + 16 * g + r) * 2); vv[r] = *(const u32x4*)(vb + (size_t)id * 64); cf[r] = *(const LAS float*)(lds + 32768 + (tl * 128 + 16 * g + r) * 4); }
            float acc[8];
#pragma unroll
            for (int j = 0; j < 8; ++j) acc[j] = 0.f;
#pragma unroll
            for (int r = 0; r < 16; ++r) { acc[0] += cf[r] * bflo(vv[r].x); acc[1] += cf[r] * bfhi(vv[r].x); acc[2] += cf[r] * bflo(vv[r].y); acc[3] += cf[r] * bfhi(vv[r].y);
                acc[4] += cf[r] * bflo(vv[r].z); acc[5] += cf[r] * bfhi(vv[r].z); acc[6] += cf[r] * bflo(vv[r].w); acc[7] += cf[r] * bfhi(vv[r].w); }
            float q4[4], q2[2];
#pragma unroll
            for (int j = 0; j < 4; ++j) { const bool up = (lane & 32) != 0; const float snd = up ? acc[j] : acc[j + 4], kp = up ? acc[j + 4] : acc[j]; q4[j] = kp + __shfl_xor(snd, 32); }
#pragma unroll
            for (int j = 0; j < 2; ++j) { const bool up = (lane & 16) != 0; const float snd = up ? q4[j] : q4[j + 2], kp = up ? q4[j + 2] : q4[j]; q2[j] = kp + __shfl_xor(snd, 16); }
            float r1; { const bool up = (lane & 8) != 0; const float snd = up ? q2[0] : q2[1], kp = up ? q2[1] : q2[0]; r1 = kp + __shfl_xor(snd, 8); }
            float* op = a->out + (size_t)t * DM + 64 * s + 8 * m + g;
            const float x1v = *op; const float x2 = x1v + r1; *op = DRY ? (x2 == 12345.678f ? x2 : x1v) : x2;
            const float ss = wave_sum(x2 * x2);
            if (lane == 0 && !DRY) atomicAdd(SS2 + t, ss);
        }
        __syncthreads();
    }
}
template <bool DRY> __device__ __forceinline__ void peer_final(ArgsP a, const int tidx) {
    const int lane = tidx & 63, w = tidx >> 6; const int gwv = blockIdx.x * NWAVES + w, NGW = gridDim.x * NWAVES; const float* SS2 = (const float*)(a->ws + WS_MISC + MISC_SS2);
    for (int tok = gwv; tok < M; tok += NGW) { const float rstd = 1.f / sqrtf(SS2[tok] * (1.f / DM) + EPS); f32x4* orow = (f32x4*)(a->out + (size_t)tok * DM) + lane; const f32x4* wr = (const f32x4*)a->lnf_w + lane;
#pragma unroll
        for (int j = 0; j < 8; ++j) { f32x4 v = orow[64 * j]; const f32x4 o = v * rstd * wr[64 * j]; orow[64 * j] = DRY ? (o[0] == 12345.678f ? o : v) : o; } }
}
__device__ __forceinline__ f32x2 fp8lo(unsigned w) { return __builtin_amdgcn_cvt_pk_f32_fp8((int)w, false); }
__device__ __forceinline__ f32x2 fp8hi(unsigned w) { return __builtin_amdgcn_cvt_pk_f32_fp8((int)w, true); }
__device__ __forceinline__ void peer_u_phase8(ArgsP a, LAS unsigned char* lds, const int tidx, const int qoff = 0) {
    const int w = __builtin_amdgcn_readfirstlane(tidx >> 6); const int myx = (int)(xb_xcc_id() & 7u); int probe = 0;
    unsigned* heads = (unsigned*)(a->ws + WS_CTL) + Q_U + qoff; volatile LAS int* bc = (volatile LAS int*)(lds + 98304);
    const bf16* HN = (const bf16*)(a->ws + WS_HN); const unsigned char* U8 = (const unsigned char*)(a->ws + WS_U8); const int* IDX = (const int*)(a->ws + WS_IDX); bf16* PART = (bf16*)(a->ws + WS_PART);
    for (;;) {
        const int tid = opaque(tidx), lane = tid & 63, m = lane & 7, g = lane >> 3;
        const int item = peer_next_item(heads, myx, probe, 256u, bc, tid); if (item < 0) break;
        const int s = item >> 7, tile = item & 127, tok0 = tile * 128;
        peer_stage_idx(IDX, tok0, lds, tid);
        __syncthreads();
        const unsigned char* ub = U8 + (size_t)s * 16384 * 128 + 16 * m;
#define PU_ISSUE(UV, H0, H1, TT) do { const int tl_ = 16 * w + (TT); \
            const u32x4 idA_ = *(const LAS u32x4*)(lds + (tl_ * 128 + 16 * g) * 2), idB_ = *(const LAS u32x4*)(lds + (tl_ * 128 + 16 * g) * 2 + 16); \
            const unsigned idw_[8] = {idA_.x, idA_.y, idA_.z, idA_.w, idB_.x, idB_.y, idB_.z, idB_.w}; \
            _Pragma("unroll") for (int r = 0; r < 16; ++r) { const unsigned id = (r & 1) ? (idw_[r >> 1] >> 16) : (idw_[r >> 1] & 0xffffu); UV[r] = *(const u32x4*)(ub + (size_t)id * 128); } \
            H0 = *(const u32x4*)(HN + (size_t)(tok0 + tl_) * DM + 128 * s + 16 * m); H1 = *(const u32x4*)(HN + (size_t)(tok0 + tl_) * DM + 128 * s + 16 * m + 8); } while (0)
#define PU_REDUCE(UV, H0, H1, TT) do { const int t_ = tok0 + 16 * w + (TT); f32x2 hf[8]; \
            hf[0] = (f32x2){bflo(H0.x), bfhi(H0.x)}; hf[1] = (f32x2){bflo(H0.y), bfhi(H0.y)}; hf[2] = (f32x2){bflo(H0.z), bfhi(H0.z)}; hf[3] = (f32x2){bflo(H0.w), bfhi(H0.w)}; \
            hf[4] = (f32x2){bflo(H1.x), bfhi(H1.x)}; hf[5] = (f32x2){bflo(H1.y), bfhi(H1.y)}; hf[6] = (f32x2){bflo(H1.z), bfhi(H1.z)}; hf[7] = (f32x2){bflo(H1.w), bfhi(H1.w)}; \
            float p[16]; \
            _Pragma("unroll") for (int r = 0; r < 16; ++r) { f32x2 ac = fp8lo(UV[r].x) * hf[0]; ac += fp8hi(UV[r].x) * hf[1]; ac += fp8lo(UV[r].y) * hf[2]; ac += fp8hi(UV[r].y) * hf[3]; \
                ac += fp8lo(UV[r].z) * hf[4]; ac += fp8hi(UV[r].z) * hf[5]; ac += fp8lo(UV[r].w) * hf[6]; ac += fp8hi(UV[r].w) * hf[7]; p[r] = ac.x + ac.y; } \
            float q8[8], q4[4], q2[2]; \
            _Pragma("unroll") for (int r = 0; r < 8; ++r) { const bool up = (lane & 4) != 0; const float snd = up ? p[r] : p[r + 8], kp = up ? p[r + 8] : p[r]; q8[r] = kp + __shfl_xor(snd, 4); } \
            _Pragma("unroll") for (int r = 0; r < 4; ++r) { const bool up = (lane & 2) != 0; const float snd = up ? q8[r] : q8[r + 4], kp = up ? q8[r + 4] : q8[r]; q4[r] = kp + __shfl_xor(snd, 2); } \
            _Pragma("unroll") for (int r = 0; r < 2; ++r) { const bool up = (lane & 1) != 0; const float snd = up ? q4[r] : q4[r + 2], kp = up ? q4[r + 2] : q4[r]; q2[r] = kp + __shfl_xor(snd, 1); } \
            *(unsigned*)(PART + ((size_t)s * M + t_) * 128 + 2 * lane) = cvtpk(q2[0], q2[1]); } while (0)
        u32x4 uvA[16], uvB[16], hA0, hA1, hB0, hB1;
        for (int tt = 0; tt < 16; ++tt) { PU_ISSUE(uvA, hA0, hA1, tt); PU_REDUCE(uvA, hA0, hA1, tt); }
        (void)uvB; (void)hB0; (void)hB1;
#undef PU_ISSUE
#undef PU_REDUCE
        __syncthreads();
    }
}
__device__ __forceinline__ void peer_combine8(ArgsP a, const int tidx) {
    const size_t gt = (size_t)blockIdx.x * NTHR + tidx, NGT = (size_t)gridDim.x * NTHR;
    const unsigned* PART = (const unsigned*)(a->ws + WS_PART); const float* GW = (const float*)(a->ws + WS_GW); const float* SUMSQ = (const float*)(a->ws + WS_MISC + MISC_SUMSQ); f32x2* C = (f32x2*)(a->ws + WS_COEF);
    const float* USC = (const float*)(a->ws + WS_USC); const float* VSC = (const float*)(a->ws + WS_VSC); const int* IDX = (const int*)(a->ws + WS_IDX);
    for (size_t i = gt; i < (size_t)M * 64; i += NGT) { const int t = (int)(i >> 6); float s0 = 0.f, s1 = 0.f;
#pragma unroll 8
        for (int s = 0; s < 16; ++s) { const unsigned v = PART[(size_t)s * M * 64 + i]; s0 += bflo(v); s1 += bfhi(v); }
        const int id0 = IDX[2 * i], id1 = IDX[2 * i + 1];
        const float rstd2 = 1.f / sqrtf(SUMSQ[t] * (1.f / DM) + EPS); const f32x2 g = ((const f32x2*)GW)[i];
        const float a0 = s0 * rstd2 * USC[id0], a1 = s1 * rstd2 * USC[id1];
        C[i] = (f32x2){g.x * 0.5f * a0 * (1.f + erff(a0 * 0.70710678118654752f)) * VSC[id0], g.y * 0.5f * a1 * (1.f + erff(a1 * 0.70710678118654752f)) * VSC[id1]}; }
}
template <bool DRY> __device__ __forceinline__ void peer_v_phase8(ArgsP a, LAS unsigned char* lds, const int tidx, const int qoff = 0) {
    const int w = __builtin_amdgcn_readfirstlane(tidx >> 6); const int myx = (int)(xb_xcc_id() & 7u); int probe = 0;
    unsigned* heads = (unsigned*)(a->ws + WS_CTL) + Q_V + qoff; volatile LAS int* bc = (volatile LAS int*)(lds + 98304);
    const unsigned char* V8 = (const unsigned char*)(a->ws + WS_V8); const int* IDX = (const int*)(a->ws + WS_IDX); const float* COEF = (const float*)(a->ws + WS_COEF); float* SS2 = (float*)(a->ws + WS_MISC + MISC_SS2);
    for (;;) {
        const int tid = opaque(tidx), lane = tid & 63, m = lane & 7, g = lane >> 3;
        const int item = peer_next_item(heads, myx, probe, 256u, bc, tid); if (item < 0) break;
        const int s = item >> 7, tile = item & 127, tok0 = tile * 128;
        peer_stage_idx(IDX, tok0, lds, tid);
#pragma unroll
        for (int i = 0; i < 8; ++i) { const int q = tid + 512 * i; *(LAS u32x4*)(lds + 32768 + 16 * q) = *(const u32x4*)(COEF + (size_t)tok0 * 128 + 4 * q); }
        __syncthreads();
        const unsigned char* vb = V8 + (size_t)s * 16384 * 128 + 16 * m;
#define PV_ISSUE(VV, X1, TT) do { const int tl_ = 16 * w + (TT); \
            const u32x4 idA_ = *(const LAS u32x4*)(lds + (tl_ * 128 + 16 * g) * 2), idB_ = *(const LAS u32x4*)(lds + (tl_ * 128 + 16 * g) * 2 + 16); \
            const unsigned idw_[8] = {idA_.x, idA_.y, idA_.z, idA_.w, idB_.x, idB_.y, idB_.z, idB_.w}; \
            _Pragma("unroll") for (int r = 0; r < 16; ++r) { const unsigned id = (r & 1) ? (idw_[r >> 1] >> 16) : (idw_[r >> 1] & 0xffffu); VV[r] = *(const u32x4*)(vb + (size_t)id * 128); } \
            X1 = *(const f32x2*)(a->out + (size_t)(tok0 + tl_) * DM + 128 * s + 16 * m + 2 * g); } while (0)
#define PV_REDUCE(VV, X1, TT) do { const int tl_ = 16 * w + (TT), t_ = tok0 + tl_; f32x4 cfv[4]; \
            _Pragma("unroll") for (int i = 0; i < 4; ++i) cfv[i] = *(const LAS f32x4*)(lds + 32768 + (tl_ * 128 + 16 * g + 4 * i) * 4); \
            f32x2 acc[8]; \
            _Pragma("unroll") for (int j = 0; j < 8; ++j) acc[j] = (f32x2){0.f, 0.f}; \
            _Pragma("unroll") for (int r = 0; r < 16; ++r) { const float cf = cfv[r >> 2][r & 3]; const f32x2 c2 = {cf, cf}; \
                acc[0] += c2 * fp8lo(VV[r].x); acc[1] += c2 * fp8hi(VV[r].x); acc[2] += c2 * fp8lo(VV[r].y); acc[3] += c2 * fp8hi(VV[r].y); \
                acc[4] += c2 * fp8lo(VV[r].z); acc[5] += c2 * fp8hi(VV[r].z); acc[6] += c2 * fp8lo(VV[r].w); acc[7] += c2 * fp8hi(VV[r].w); } \
            f32x2 q4[4], q2[2], q1; \
            _Pragma("unroll") for (int j = 0; j < 4; ++j) { const bool up = (lane & 32) != 0; const f32x2 snd = up ? acc[j] : acc[j + 4], kp = up ? acc[j + 4] : acc[j]; q4[j] = kp + (f32x2){__shfl_xor(snd.x, 32), __shfl_xor(snd.y, 32)}; } \
            _Pragma("unroll") for (int j = 0; j < 2; ++j) { const bool up = (lane & 16) != 0; const f32x2 snd = up ? q4[j] : q4[j + 2], kp = up ? q4[j + 2] : q4[j]; q2[j] = kp + (f32x2){__shfl_xor(snd.x, 16), __shfl_xor(snd.y, 16)}; } \
            { const bool up = (lane & 8) != 0; const f32x2 snd = up ? q2[0] : q2[1], kp = up ? q2[1] : q2[0]; q1 = kp + (f32x2){__shfl_xor(snd.x, 8), __shfl_xor(snd.y, 8)}; } \
            f32x2* op = (f32x2*)(a->out + (size_t)t_ * DM + 128 * s + 16 * m + 2 * g); \
            const f32x2 x2 = X1 + q1; *op = DRY ? (x2.x == 12345.678f ? x2 : X1) : x2; \
            const float ss = wave_sum(x2.x * x2.x + x2.y * x2.y); \
            if (lane == 0 && !DRY) atomicAdd(SS2 + t_, ss); } while (0)
        u32x4 vvA[16], vvB[16]; f32x2 xA, xB;
        for (int tt = 0; tt < 16; ++tt) { PV_ISSUE(vvA, xA, tt); PV_REDUCE(vvA, xA, tt); }
        (void)vvB; (void)xB;
#undef PV_ISSUE
#undef PV_REDUCE
        __syncthreads();
    }
}
#if SELFCHECK
constexpr size_t WS_YDBG = 464 * MiB;
constexpr size_t WS_XSAVE = 500 * MiB;
__device__ __forceinline__ float bfr(float v) { return bf2f(f2bf(v)); }
__device__ __forceinline__ void chk_report(ArgsP a, int k, float err) { if (!(err == err)) err = 1e30f; atomicMax((int*)(a->ws + WS_MISC + MISC_CHK) + k, __float_as_int(err)); }
__device__ const int CHK_ROWS[8] = {0, 1, 255, 256, 7777, 12345, 16128, 16383};
__device__ const int CHK_TOK[8] = {0, 1, 63, 127, 128, 129, 8191, 16383};
__device__ __forceinline__ float geluf(float x) { return 0.5f * x * (1.f + erff(x * 0.70710678118654752f)); }
__device__ __forceinline__ void chk1(ArgsP a, const int tidx) {
    const int gt = blockIdx.x * NTHR + tidx, NGT = gridDim.x * NTHR;
    const bf16 *Z = (const bf16*)(a->ws + WS_Z), *XBC = (const bf16*)(a->ws + WS_XBC), *Q = (const bf16*)(a->ws + WS_Q), *K = (const bf16*)(a->ws + WS_K), *V = (const bf16*)(a->ws + WS_V); const float* DTF = (const float*)(a->ws + WS_DTF);
    for (int it = gt; it < 8 * 5664; it += NGT) { const int t = CHK_ROWS[it / 5664], j = it % 5664; const float* xr = a->x + (size_t)t * DM;
        float ss = 0.f; for (int k = 0; k < DM; ++k) ss += xr[k] * xr[k]; const float rstd = 1.f / sqrtf(ss / DM + EPS);
        float ref = 0.f; for (int k = 0; k < DM; ++k) ref += bfr(xr[k] * rstd * a->ln1_w[k]) * bfr(a->w_in[(size_t)k * 5664 + j]);
        float got;
        if (j < 1024) got = bf2f(Z[(size_t)t * 1024 + j]); else if (j < 2560) got = bf2f(XBC[(size_t)t * 1536 + j - 1024]); else if (j < 2576) got = DTF[(size_t)t * 32 + j - 2560];
        else if (j < 3600) got = bf2f(Q[(size_t)t * 1024 + j - 2576]) / QSCALE; else if (j < 4624) got = bf2f(K[(size_t)t * 1024 + j - 3600]); else if (j < 5648) got = bf2f(V[(size_t)t * 1024 + j - 4624]);
        else got = DTF[(size_t)t * 32 + 16 + j - 5648];
        chk_report(a, 1, fabsf(got - ref)); }
}
__device__ __forceinline__ void chk2(ArgsP a, const int tidx) {
    const int gt = blockIdx.x * NTHR + tidx, NGT = gridDim.x * NTHR;
    const bf16 *XBC = (const bf16*)(a->ws + WS_XBC), *XS = (const bf16*)(a->ws + WS_XS), *BC = (const bf16*)(a->ws + WS_BC); const float *DTF = (const float*)(a->ws + WS_DTF), *DT = (const float*)(a->ws + WS_DT), *ACUM = (const float*)(a->ws + WS_ACUM);
    for (int it = gt; it < 64 * 1536; it += NGT) { const int si = it / 1536, ch = it % 1536; const int t = si < 8 ? si : (si < 16 ? 60 + (si - 8) : (int)(((unsigned)si * 2654435761u) % M));
        float acc = a->conv_b[ch]; for (int j = 0; j < 4; ++j) { const int tt = t - 3 + j; if (tt >= 0) acc += a->conv_w[j * 1536 + ch] * bf2f(XBC[(size_t)tt * 1536 + ch]); }
        const float ref = siluf(acc); const float got = ch < 1024 ? bf2f(XS[(size_t)t * 1024 + ch]) : bf2f(BC[(size_t)t * 512 + ch - 1024]);
        chk_report(a, 2, fabsf(got - ref));
        if (ch < 16) { const int h = ch; const float A = -__expf(a->a_log[h]); float ac = 0.f, dtl = 0.f; for (int tt = (t / 64) * 64; tt <= t; ++tt) { dtl = softplusf(DTF[(size_t)tt * 32 + h] + a->dt_bias[h]); ac += dtl * A; }
            chk_report(a, 2, fabsf(DT[(size_t)t * 16 + h] - dtl) * 10.f); chk_report(a, 2, fabsf(ACUM[(size_t)t * 16 + h] - ac)); } }
}
__device__ __forceinline__ void chk3(ArgsP a, const int tidx) {
    const int gt = blockIdx.x * NTHR + tidx, NGT = gridDim.x * NTHR;
    const bf16 *XS = (const bf16*)(a->ws + WS_XS), *BC = (const bf16*)(a->ws + WS_BC), *SL = (const bf16*)(a->ws + WS_SLOC); const float *DT = (const float*)(a->ws + WS_DT), *ACUM = (const float*)(a->ws + WS_ACUM);
    for (int it = gt; it < 8192; it += NGT) { const unsigned hsh = (unsigned)it * 2654435761u; const int c = it < 2048 ? (it & 1) * 255 : (hsh >> 8) & 255, h = (hsh >> 16) & 15, p = (hsh >> 20) & 63, n = (hsh >> 26) & 63 | ((it & 1) << 6), g = h >> 3;
        const float al = ACUM[(size_t)(c * 64 + 63) * 16 + h]; float ref = 0.f;
        for (int sx = 0; sx < 64; ++sx) { const int t = c * 64 + sx; ref += bf2f(BC[(size_t)t * 512 + 128 * g + n]) * bfr(bf2f(XS[(size_t)t * 1024 + 64 * h + p]) * DT[(size_t)t * 16 + h] * __expf(al - ACUM[(size_t)t * 16 + h])); }
        const float got = bf2f(SL[((size_t)(c * 16 + h) * 64 + p) * 128 + n]);
        chk_report(a, 3, fabsf(got - ref) / fmaxf(fabsf(ref), 0.05f)); }
}
__device__ __forceinline__ void chk13(ArgsP a, const int tidx) {
    const int gt = blockIdx.x * NTHR + tidx, NGT = gridDim.x * NTHR;
    const bf16 *XS = (const bf16*)(a->ws + WS_XS), *BC = (const bf16*)(a->ws + WS_BC), *SL = (const bf16*)(a->ws + WS_SLOC); const float *DT = (const float*)(a->ws + WS_DT), *ACUM = (const float*)(a->ws + WS_ACUM);
    for (int it = gt; it < 4096; it += NGT) { const unsigned hsh = (unsigned)it * 2654435761u; const int h = (hsh >> 16) & 15, p = (hsh >> 20) & 63, n = (hsh >> 26) & 63 | ((it & 1) << 6), g = h >> 3;
        float st = 0.f, num = 0.f, den = 1e-12f;
        for (int c = 0; c < NCHUNK; ++c) { const float got = bf2f(SL[((size_t)(c * 16 + h) * 64 + p) * 128 + n]); num += (got - st) * (got - st); den += st * st;
            const float al = ACUM[(size_t)(c * 64 + 63) * 16 + h]; float sl = 0.f;
            for (int sx = 0; sx < 64; ++sx) { const int t = c * 64 + sx; sl += bf2f(BC[(size_t)t * 512 + 128 * g + n]) * bf2f(XS[(size_t)t * 1024 + 64 * h + p]) * DT[(size_t)t * 16 + h] * __expf(al - ACUM[(size_t)t * 16 + h]); }
            st = st * __expf(al) + sl; }
        chk_report(a, 13, sqrtf(num / den)); }
}
__device__ __forceinline__ void chk4(ArgsP a, const int tidx) {
    const int lane = tidx & 63, gw = blockIdx.x * NWAVES + (tidx >> 6);
    const bf16 *XS = (const bf16*)(a->ws + WS_XS), *BC = (const bf16*)(a->ws + WS_BC); const float *DT = (const float*)(a->ws + WS_DT); const float* Y = (const float*)(a->ws + WS_YDBG);
    if (gw >= 32) return;
    const int h = (gw * 5 + 3) & 15, p = (gw * 23 + 7) & 63, g = h >> 3; const float A = -__expf(a->a_log[h]);
    float s0 = 0.f, s1 = 0.f, emax = 0.f, emax0 = 0.f, num = 0.f, den = 1e-12f;
    for (int t = 0; t < 8192; ++t) { const float dt = DT[(size_t)t * 16 + h], x = bf2f(XS[(size_t)t * 1024 + 64 * h + p]), dA = __expf(dt * A);
        const float b0 = bf2f(BC[(size_t)t * 512 + 128 * g + lane]), b1 = bf2f(BC[(size_t)t * 512 + 128 * g + 64 + lane]), c0 = bf2f(BC[(size_t)t * 512 + 256 + 128 * g + lane]), c1 = bf2f(BC[(size_t)t * 512 + 256 + 128 * g + 64 + lane]);
        s0 = s0 * dA + dt * b0 * x; s1 = s1 * dA + dt * b1 * x;
        const float y = wave_sum(c0 * s0 + c1 * s1); const float got = Y[(size_t)t * 1024 + 64 * h + p];
        float e = fabsf(got - y) / fmaxf(fabsf(y), 0.25f); if (!(got == got)) e = 1e30f; if (t < 64) emax0 = fmaxf(emax0, e); else { num += (got - y) * (got - y); den += y * y; } }
    emax = sqrtf(num / den);
    if (lane == 0) { chk_report(a, 12, emax0); chk_report(a, 4, emax); }
}
__device__ __forceinline__ void chk567(ArgsP a, const int tidx) {
    const int lane = tidx & 63, gw = blockIdx.x * NWAVES + (tidx >> 6);
    const bf16 *XS = (const bf16*)(a->ws + WS_XS), *Zb = (const bf16*)(a->ws + WS_Z), *MIX = (const bf16*)(a->ws + WS_MIX); const float* Y = (const float*)(a->ws + WS_YDBG);
    if (gw >= 64 && gw < 128) { const int si = gw - 64, g = si & 1, t = (si >> 1) < 4 ? (si >> 1) * 63 : (int)(((unsigned)si * 2654435761u) % 8192);
        float v[8]; float ss = 0.f;
#pragma unroll
        for (int i = 0; i < 8; ++i) { const int ch = 512 * g + lane + 64 * i; const float y = (Y[(size_t)t * 1024 + ch] + a->d_skip[ch >> 6] * bf2f(XS[(size_t)t * 1024 + ch])) * siluf(bf2f(Zb[(size_t)t * 1024 + ch])); v[i] = y; ss += y * y; }
        const float rstd = 1.f / sqrtf(wave_sum(ss) / 512.f + EPS); float e = 0.f;
#pragma unroll
        for (int i = 0; i < 8; ++i) { const int ch = 512 * g + lane + 64 * i; const float rf = v[i] * rstd * a->ssd_norm_w[ch]; e = fmaxf(e, fabsf(bf2f(MIX[(size_t)t * DM + ch]) - rf) / fmaxf(1.f, fabsf(rf))); }
        chk_report(a, 5, e); }
    if (gw >= 128 && gw < 144 && lane == 0) { const int h = gw - 128; const float* DTF = (const float*)(a->ws + WS_DTF); const float* CL = (const float*)(a->ws + WS_CUMF) + (size_t)h * M; double c = 0.0; float e = 0.f;
        for (int t = 0; t < M; ++t) { c += (double)logsigmoidf(DTF[(size_t)t * 32 + 16 + h] + a->fox_f_bias[h]); const float ref = (float)(c * 1.4426950408889634); e = fmaxf(e, fabsf(CL[t] - ref) / (1.f + 1e-4f * fabsf(ref))); }
        chk_report(a, 6, e); }
    if (gw >= 160 && gw < 224) { const int si = gw - 160, h = (si * 7 + 1) & 15; const int t = si < 8 ? CHK_TOK[si] : (int)(((unsigned)si * 2654435761u) % M);
        const bf16 *Q = (const bf16*)(a->ws + WS_Q), *K = (const bf16*)(a->ws + WS_K), *V = (const bf16*)(a->ws + WS_V); const float* CL = (const float*)(a->ws + WS_CUMF) + (size_t)h * M;
        const float q = bf2f(Q[(size_t)t * 1024 + 64 * h + lane]); float m = -1e30f, l = 0.f, o = 0.f;
        for (int j = 0; j <= t; ++j) { const float s = wave_sum(q * bf2f(K[(size_t)j * 1024 + 64 * h + lane])) + (CL[t] - CL[j]); const float mn = fmaxf(m, s), al = exp2f(m - mn), p = exp2f(s - mn);
            l = l * al + p; o = o * al + p * bf2f(V[(size_t)j * 1024 + 64 * h + lane]); m = mn; }
        const float e = fabsf(bf2f(MIX[(size_t)t * DM + 1024 + 64 * h + lane]) - o / l);
        chk_report(a, 7, wave_max(e)); }
}
__device__ __forceinline__ void chk8(ArgsP a, const int tidx) {
    const int gt = blockIdx.x * NTHR + tidx, NGT = gridDim.x * NTHR; const bf16* MIX = (const bf16*)(a->ws + WS_MIX); const bf16* HN = (const bf16*)(a->ws + WS_HN); float* XSV = (float*)(a->ws + WS_XSAVE);
    for (int it = gt; it < 8 * DM; it += NGT) { const int r = it / DM, t = CHK_ROWS[r], c = it % DM; float ref = a->x[(size_t)t * DM + c];
        for (int k = 0; k < DM; ++k) ref += bf2f(MIX[(size_t)t * DM + k]) * bfr(a->w_out[(size_t)k * DM + c]);
        const float got = a->out[(size_t)t * DM + c]; XSV[it] = got; chk_report(a, 8, fabsf(got - ref)); chk_report(a, 8, fabsf(bf2f(HN[(size_t)t * DM + c]) - got * a->ln2_w[c]));
        if (c == 0) { float ss = 0.f; for (int k = 0; k < DM; ++k) { const float v = a->out[(size_t)t * DM + k]; ss += v * v; } const float sq = ((const float*)(a->ws + WS_MISC + MISC_SUMSQ))[t]; chk_report(a, 8, fabsf(sq - ss) / ss * 10.f); } }
}
__device__ __forceinline__ void chk910(ArgsP a, LAS unsigned char* lds, const int tidx) {
    const int gt = blockIdx.x * NTHR + tidx, NGT = gridDim.x * NTHR; const bf16* HN = (const bf16*)(a->ws + WS_HN); const bf16* QP = (const bf16*)(a->ws + WS_QP);
    for (int it = gt; it < 8 * DM; it += NGT) { const int r = it / DM, t = CHK_ROWS[r], c = it % DM; float ref = 0.f;
        for (int k = 0; k < DM; ++k) ref += bf2f(HN[(size_t)t * DM + k]) * bfr(a->peer_wq[(size_t)k * DM + c]);
        chk_report(a, 9, fabsf(bf2f(QP[(size_t)t * DM + c]) - ref)); }
    const int lane = tidx & 63, wv = tidx >> 6, gw = blockIdx.x * NWAVES + wv;
    if (gw < 64) { const int t = CHK_ROWS[gw >> 3], hd = gw & 7; LAS float* S = (LAS float*)lds + wv * 256;
        for (int half = 0; half < 2; ++half) for (int n = lane; n < 128; n += 64) { const float* kr = (half ? a->peer_k2 : a->peer_k1) + ((size_t)hd * 128 + n) * 128; float s = 0.f;
            for (int d = 0; d < 128; ++d) s += bf2f(QP[(size_t)t * DM + 256 * hd + 128 * half + d]) * bfr(kr[d]); S[128 * half + n] = s; }
        asm volatile("s_waitcnt lgkmcnt(0)" ::: "memory");
        float lo = -1e30f, hi = 1e30f; { float mx = -1e30f, mn = 1e30f; for (int i = lane; i < 128; i += 64) { mx = fmaxf(mx, S[i]); mn = fminf(mn, S[i]); } float mx2 = -1e30f, mn2 = 1e30f; for (int i = lane; i < 128; i += 64) { mx2 = fmaxf(mx2, S[128 + i]); mn2 = fminf(mn2, S[128 + i]); }
            hi = wave_max(mx) + wave_max(mx2) + 1.f; lo = -wave_max(-mn) - wave_max(-mn2) - 1.f; }
        for (int itn = 0; itn < 40; ++itn) { const float mid = 0.5f * (lo + hi); int cnt = 0; for (int i = lane; i < 16384; i += 64) cnt += (S[i >> 7] + S[128 + (i & 127)] >= mid) ? 1 : 0; cnt = (int)wave_sum((float)cnt); if (cnt >= 16) lo = mid; else hi = mid; }
        const float thr = lo; float mxs = -1e30f; for (int i = lane; i < 16384; i += 64) { const float s = S[i >> 7] + S[128 + (i & 127)]; if (s >= thr) mxs = fmaxf(mxs, s); } mxs = wave_max(mxs);
        const float rstd = 1.f / sqrtf(((const float*)(a->ws + WS_MISC + MISC_SUMSQ))[t] / DM + EPS);
        float den = 0.f; for (int i = lane; i < 16384; i += 64) { const float s = S[i >> 7] + S[128 + (i & 127)]; if (s >= thr) den += __expf((s - mxs) * rstd); } den = wave_sum(den);
        float e = 0.f; if (lane < 16) { const int id = ((const int*)(a->ws + WS_IDX))[(size_t)t * 128 + 16 * hd + lane]; const float g = ((const float*)(a->ws + WS_GW))[(size_t)t * 128 + 16 * hd + lane];
            if (id < 0 || id >= 16384) e = 10.f; else { const float s = S[id >> 7] + S[128 + (id & 127)]; if (s < thr - 2e-3f) e = 5.f; e = fmaxf(e, fabsf(g - __expf((s - mxs) * rstd) / den)); }
            for (int k2 = 0; k2 < 16; ++k2) { const int id2 = __shfl(id, k2); if (k2 != lane && id2 == id) e = 7.f; } }
        chk_report(a, 10, wave_max(e)); }
}
__device__ __forceinline__ void chk11(ArgsP a, const int tidx) {
    const int lane = tidx & 63, gw = blockIdx.x * NWAVES + (tidx >> 6); if (gw >= 8) return;
    const int t = CHK_ROWS[gw]; const bf16* HN = (const bf16*)(a->ws + WS_HN); const float* XSV = (const float*)(a->ws + WS_XSAVE) + gw * DM;
    const float rstd2 = 1.f / sqrtf(((const float*)(a->ws + WS_MISC + MISC_SUMSQ))[t] / DM + EPS);
    float acc[32];
#pragma unroll
    for (int i = 0; i < 32; ++i) acc[i] = 0.f;
    for (int k = 0; k < 128; ++k) { const int id = ((const int*)(a->ws + WS_IDX))[(size_t)t * 128 + k]; const float g = ((const float*)(a->ws + WS_GW))[(size_t)t * 128 + k];
        float s = 0.f;
#pragma unroll
        for (int i = 0; i < 32; ++i) { const int d = lane + 64 * i; s += bfr(a->peer_u[(size_t)id * DM + d]) * bf2f(HN[(size_t)t * DM + d]); }
        const float cf = g * geluf(wave_sum(s) * rstd2);
#pragma unroll
        for (int i = 0; i < 32; ++i) acc[i] += cf * bfr(a->peer_v[(size_t)id * DM + lane + 64 * i]); }
    float ss = 0.f;
#pragma unroll
    for (int i = 0; i < 32; ++i) { acc[i] += XSV[lane + 64 * i]; ss += acc[i] * acc[i]; }
    const float rstd = 1.f / sqrtf(wave_sum(ss) / DM + EPS); float e = 0.f;
#pragma unroll
    for (int i = 0; i < 32; ++i) e = fmaxf(e, fabsf(a->out[(size_t)t * DM + lane + 64 * i] - acc[i] * rstd * a->lnf_w[lane + 64 * i]));
    chk_report(a, 11, wave_max(e));
}
__device__ const float CHK_TOL[14] = {1.f, 0.05f, 0.02f, 0.05f, 0.06f, 0.03f, 0.02f, 0.03f, 0.03f, 0.06f, 0.05f, 0.03f, 0.06f, 0.03f};
__device__ const int CHK_ORD[13] = {1, 2, 3, 12, 13, 4, 5, 6, 7, 8, 9, 10, 11};
__device__ __forceinline__ void chk_verdict(ArgsP a, const int tidx) {
    const int* C = (const int*)(a->ws + WS_MISC + MISC_CHK); int bad = -1; float m = 0.f;
    for (int kk = 0; kk < 13; ++kk) { const int k = CHK_ORD[kk]; const float e = __int_as_float(C[k]); if (bad < 0 && e > CHK_TOL[k]) { bad = k; m = fminf(fmaxf(e / CHK_TOL[k], 1.f), 9.9f); } }
    if (bad < 0) return;
    const float cst = sqrtf(m * powf(100.f, (float)(bad + 1)));
    const size_t gt = (size_t)blockIdx.x * NTHR + tidx, NGT = (size_t)gridDim.x * NTHR;
    for (size_t i = gt; i < (size_t)M * DM; i += NGT) a->out[i] = cst;
}
#endif
#ifndef MK_PER_PHASE
#define MK_PER_PHASE 0
#endif
constexpr int NPHASE = 12;
__global__ void __launch_bounds__(NTHR, 2) hymba_fwd(Args a) {
    extern __shared__ __attribute__((aligned(16))) unsigned char lds_raw[];
    LAS unsigned char* lds = (LAS unsigned char*)lds_raw;
    const int lo = a.ph_lo, hi = a.ph_hi;
    const int wv_ = __builtin_amdgcn_readfirstlane((int)threadIdx.x >> 6);
#define TID (wv_ * 64 + lane_id())
    int dupi_ = 0; (void)dupi_;
    volatile LAS unsigned* lctl = (volatile LAS unsigned*)(lds + LDS_BYTES - 64);
    if (TID < 16) lctl[TID] = 0u;
    __syncthreads();
    (void)xcd_barrier_post((unsigned*)(get_args()->ws + WS_CTL) + 4096, lctl, TID);
#define A get_args()
#if SELFCHECK
#define CHK(x) x
#else
#define CHK(x)
#endif
#define IN(k) (lo <= (k) && (k) < hi)
#define GRIDBAR() do { XcdBarrier xb_; xb_.bar = (unsigned*)(get_args()->ws + WS_CTL) + 4096; xb_.x = xb_xcc_id(); xb_.st = (volatile LAS unsigned*)(lds + LDS_BYTES - 64); xcd_barrier(xb_, TID); } while (0)
#ifndef PEER8
#define PEER8 1
#endif
#ifndef DUP_MASK
#define DUP_MASK 0
#endif
#define DUP(bit, stmt) do { stmt; if (DUP_MASK & (1 << (bit))) { __syncthreads(); stmt; } } while (0)
#define SEAM(k) do { if (IN(k) && IN((k) + 1)) { GRIDBAR(); } } while (0)
    if (IN(0)) { DUP(0, phase0(A, lds, TID)); } SEAM(0);
    if (IN(1)) {
        pg8::Gemm g{(const bf16*)(A->ws + WS_XN), (const bf16*)(A->ws + WS_WIN), M, NIN, DM}; pg8::StaticOrder S; S.init(M, NIN, gridDim.x, (int)blockIdx.x);
        EpiInProj E{(bf16*)(A->ws + WS_Z), (bf16*)(A->ws + WS_XBC), (bf16*)(A->ws + WS_Q), (bf16*)(A->ws + WS_K), (bf16*)(A->ws + WS_V), (float*)(A->ws + WS_DTF)};
        DUP(1, (pg8::gemm_phase<EpiInProj, pg8::StaticOrder, true, true>(lds, g, S, E, TID)));
    } SEAM(1);
    if (IN(2)) { CHK(chk1(A, TID)); DUP(2, phase2(A, lds, TID)); } SEAM(2);
    if (IN(3)) { CHK(chk2(A, TID)); CHK(chk3(A, TID)); CHK(GRIDBAR()); if (DUP_MASK & 8) { phase3<true>(A, TID); } phase3<false>(A, TID); } SEAM(3);
    if (IN(4)) { DUP(4, phase4(A, lds, TID));
        const attn_body::AttnTensors AT{(const bf16*)(A->ws + WS_Q), (const bf16*)(A->ws + WS_K), (const bf16*)(A->ws + WS_V), (bf16*)(A->ws + WS_MIX), (const float*)(A->ws + WS_CUMF),
                                        (const float*)(A->ws + WS_MISC + MISC_QN2), (const float*)(A->ws + WS_MISC + MISC_KN2)};
        DUP(12, (attn_body::attn_phase<8>((char*)lds_raw, AT, (unsigned*)(A->ws + WS_CTL) + Q_A + ((DUP_MASK & 4096) ? 512 * dupi_++ : 0), (int)(xb_xcc_id() & 7u), TID, A)));
    } SEAM(4);
    if (IN(5)) {
        CHK(chk13(A, TID)); CHK(chk4(A, TID)); CHK(chk567(A, TID)); CHK(GRIDBAR());
        pg8::Gemm g{(const bf16*)(A->ws + WS_MIX), (const bf16*)(A->ws + WS_WOUT), M, DM, DM}; pg8::StaticOrder S; S.init(M, DM, gridDim.x, (int)blockIdx.x);
        EpiOutProj E{A->x, A->out, (bf16*)(A->ws + WS_HN), A->ln2_w, (float*)(A->ws + WS_MISC + MISC_SUMSQ)};
        pg8::gemm_phase<EpiOutProj, pg8::StaticOrder, true, true>(lds, g, S, E, TID);
        if (!PEER8) convert_uv_sliced(A, TID);
    } SEAM(5);
    if (IN(6)) {
        CHK(chk8(A, TID));
        pg8::Gemm g{(const bf16*)(A->ws + WS_HN), (const bf16*)(A->ws + WS_WQ), M, DM, DM}; pg8::StaticOrder S; S.init(M, DM, gridDim.x, (int)blockIdx.x);
        EpiPlainBf16 E{(bf16*)(A->ws + WS_QP), DM};
        DUP(6, (pg8::gemm_phase<EpiPlainBf16, pg8::StaticOrder, true, true>(lds, g, S, E, TID)));
    } SEAM(6);
    if (IN(7)) { DUP(7, phase7(A, lds, TID)); } SEAM(7);
    if (IN(8)) { CHK(chk910(A, lds, TID)); CHK(__syncthreads()); if (PEER8) { DUP(8, peer_u_phase8(A, lds, TID, (DUP_MASK & 256) ? 512 * dupi_++ : 0)); } else { DUP(8, peer_u_phase(A, lds, TID, (DUP_MASK & 256) ? 512 * dupi_++ : 0)); } } SEAM(8);
    if (IN(9)) { if (PEER8) { DUP(9, peer_combine8(A, TID)); } else { DUP(9, peer_combine(A, TID)); } } SEAM(9);
    if (IN(10)) { if (PEER8) { if (DUP_MASK & 1024) { peer_v_phase8<true>(A, lds, TID, 512); } peer_v_phase8<false>(A, lds, TID); } else { if (DUP_MASK & 1024) { peer_v_phase<true>(A, lds, TID, 512); } peer_v_phase<false>(A, lds, TID); } } SEAM(10);
    if (IN(11)) { if (DUP_MASK & 2048) { peer_final<true>(A, TID); } peer_final<false>(A, TID); CHK(GRIDBAR()); CHK(chk11(A, TID)); CHK(GRIDBAR()); CHK(chk_verdict(A, TID)); }
#undef A
#undef TID
#undef IN
#undef SEAM
#undef DUP
#undef GRIDBAR
}

extern "C" void kernel_launch(void* const* d_in, const int* in_sizes, int n_in, void* d_out, int out_size, void* d_ws, size_t ws_size, hipStream_t stream) {
    static int grid = 0;
    if (grid == 0) {
        if (n_in != 18 || in_sizes[0] != M * DM || out_size != M * DM || ws_size < WS_END) { fprintf(stderr, "kernel_launch: unexpected shapes (n_in %d, in0 %d, out %d, ws %zu)\n", n_in, n_in > 0 ? in_sizes[0] : -1, out_size, ws_size); grid = -1; return; }
        int dev = 0, cus = 0, per_cu = 0;
        if (hipGetDevice(&dev) != hipSuccess || hipDeviceGetAttribute(&cus, hipDeviceAttributeMultiprocessorCount, dev) != hipSuccess) { grid = -1; return; }
        if (hipFuncSetAttribute((const void*)hymba_fwd, hipFuncAttributeMaxDynamicSharedMemorySize, LDS_BYTES) != hipSuccess) { fprintf(stderr, "kernel_launch: hipFuncSetAttribute failed\n"); grid = -1; return; }
        if (hipOccupancyMaxActiveBlocksPerMultiprocessor(&per_cu, (const void*)hymba_fwd, NTHR, LDS_BYTES) != hipSuccess || per_cu < 1) { fprintf(stderr, "kernel_launch: occupancy query says %d\n", per_cu); (void)hipGetLastError(); grid = -1; return; }
        grid = cus;
    }
    if (grid < 0) return;
    Args a{};
    const float** f = (const float**)&a;
    for (int i = 0; i < 18; ++i) f[i] = (const float*)d_in[i];
    a.out = (float*)d_out; a.ws = (unsigned char*)d_ws;
#if MK_PER_PHASE
    for (int p = 0; p < NPHASE; ++p) { a.ph_lo = p; a.ph_hi = p + 1; hipLaunchKernelGGL(hymba_fwd, dim3(grid), dim3(NTHR), LDS_BYTES, stream, a); }
#else
    a.ph_lo = 0; a.ph_hi = NPHASE;
    if (hipMemsetAsync((char*)d_ws + WS_CTL, 0, 65536, stream) != hipSuccess) { fprintf(stderr, "kernel_launch: hipMemsetAsync failed\n"); return; }
    hipLaunchKernelGGL(hymba_fwd, dim3(grid), dim3(NTHR), LDS_BYTES, stream, a);
#endif
}
```

```cpp
#include <hip/hip_runtime.h>
#include <cstdio>
#include <cstdint>
#include <cmath>
#ifndef SELFCHECK
#define SELFCHECK 0
#endif
namespace pg8 {
#define PG8_LAS __attribute__((address_space(3)))
typedef unsigned short bf16_t;
typedef short bf16x8 __attribute__((ext_vector_type(8)));
typedef float f32x4 __attribute__((ext_vector_type(4)));
typedef unsigned u32x4 __attribute__((ext_vector_type(4)));
constexpr int BM = 256, BK = 64, HALF = 128, HTB = HALF * BK * 2  , STAGE_BYTES = 8 * HTB, NXCD = 8, WGM = 4;

__host__ __device__ __forceinline__ int lds_byte(int r, int c) { const int st = (r >> 4) * 2 + (c >> 5), rr = r & 15, cc = c & 31, ob = rr * 64 + cc * 2; return st * 1024 + (ob ^ (((ob >> 9) & 1) << 5)); }
__host__ __device__ __forceinline__ void stage_rc(int b, int& R, int& C) { const int st = b / 1024, sb = b % 1024, swz = sb ^ (((sb >> 9) & 1) << 5); R = (st >> 1) * 16 + swz / 64; C = (st & 1) * 32 + (swz % 64) / 2; }
__host__ __device__ __forceinline__ int perm32(int rho) { const int n = rho >> 4, i = rho & 15; return 8 * (i >> 2) + 4 * n + (i & 3); }

struct Unit { int pm, pn; };
struct Gemm { const bf16_t* A; const bf16_t* Bt; int M, N, K; };

struct StaticOrder {
    int nM, nN, nwg, G, c;
    __host__ __device__ void init(int M, int N, int G_, int c_) { nM = M / BM; nN = N / BM; nwg = nM * nN; G = G_; c = c_; }
    __host__ __device__ bool next(int i, Unit& u) const {
        const long L = (long)i * G + c; if (L >= nwg) return false;
        int wgid = (int)L; { const int q = nwg / NXCD, r = nwg % NXCD, xcd = wgid % NXCD, off = wgid / NXCD; wgid = (xcd < r ? xcd * (q + 1) : r * (q + 1) + (xcd - r) * q) + off; }
        const int nig = WGM * nN, gid = wgid / nig, fm = gid * WGM, gsz = (nM - fm) < WGM ? (nM - fm) : WGM;
        u.pm = fm + ((wgid % nig) % gsz); u.pn = (wgid % nig) / gsz; return true;
    }
    __device__ __forceinline__ void a_ready(const Unit&) const {}
    __device__ __forceinline__ void done(const Unit&) const {}
};

__device__ __forceinline__ unsigned cvt_pk_bf16(float lo, float hi) { unsigned r; asm volatile("v_cvt_pk_bf16_f32 %0, %1, %2" : "=v"(r) : "v"(lo), "v"(hi)); return r; }
typedef float f32x2 __attribute__((ext_vector_type(2)));
__device__ __forceinline__ f32x2 gelu_pk(f32x2 v) {
    const f32x2 av = __builtin_elementwise_abs(v), d = av * 0.2316418882f + 1.0f;
    f32x2 t; t.x = __builtin_amdgcn_rcpf(d.x); t.y = __builtin_amdgcn_rcpf(d.y);
    f32x2 q = t * 0.5307027145f + (-0.7265760135f); q = q * t + 0.7107068705f; q = q * t + (-0.142248368f); q = q * t + 0.127414796f; q = q * t;
    const f32x2 s = (v * v) * (-0.72134752044f);
    f32x2 e; e.x = __builtin_amdgcn_exp2f(s.x); e.y = __builtin_amdgcn_exp2f(s.y);
    const f32x2 m = v * (q * e), r = v - m;
    f32x2 o; o.x = v.x < 0.f ? m.x : r.x; o.y = v.y < 0.f ? m.y : r.y; return o;
}

template <int ACT  > struct EpiBf16 {
    static constexpr bool PERM = true, AFTER_DRAIN = false; static_assert(ACT == 0 || ACT == 1, "EpiBf16: ACT is 0 (none) or 1 (gelu_pk)");
    bf16_t* O; int ldc; const float* bias; int split_cols; size_t split_stride; float scale0;
    __device__ __forceinline__ void operator()(const f32x4 (&acc)[2][2][4][2], const Unit& u, int wr, int wc, int fr, int fq) const {
        const int row0 = u.pm * BM + wr * 64 + fr; int colt = u.pn * BM; bf16_t* base = O;
        float sc = 1.f; if (split_cols) { const int t = colt / split_cols; base += (size_t)t * split_stride; colt -= t * split_cols; if (t == 0) sc = scale0; }
        const int col0 = colt + wc * 32 + 8 * fq, bcol0 = u.pn * BM + wc * 32 + 8 * fq;
        f32x4 bv[2][2];
#pragma unroll
        for (int bj = 0; bj < 2; ++bj)
#pragma unroll
            for (int n = 0; n < 2; ++n) bv[bj][n] = bias ? *(const f32x4*)(bias + bcol0 + bj * HALF + 4 * n) : (f32x4){0.f, 0.f, 0.f, 0.f};
#pragma unroll
        for (int ai = 0; ai < 2; ++ai)
#pragma unroll
            for (int m = 0; m < 4; ++m) { bf16_t* rowp = base + (size_t)(row0 + ai * HALF + m * 16) * ldc + col0;
#pragma unroll
                for (int bj = 0; bj < 2; ++bj) { f32x4 v0 = acc[ai][bj][m][0] + bv[bj][0], v1 = acc[ai][bj][m][1] + bv[bj][1];
                    if (ACT == 1) { f32x2 a = gelu_pk((f32x2){v0[0], v0[1]}), b = gelu_pk((f32x2){v0[2], v0[3]}), c = gelu_pk((f32x2){v1[0], v1[1]}), d = gelu_pk((f32x2){v1[2], v1[3]});
                        v0 = (f32x4){a.x, a.y, b.x, b.y}; v1 = (f32x4){c.x, c.y, d.x, d.y}; }
                    v0 = v0 * sc; v1 = v1 * sc; u32x4 w; w.x = cvt_pk_bf16(v0[0], v0[1]); w.y = cvt_pk_bf16(v0[2], v0[3]); w.z = cvt_pk_bf16(v1[0], v1[1]); w.w = cvt_pk_bf16(v1[2], v1[3]);
                    *(u32x4*)(rowp + bj * HALF) = w; } }
    }
};
template <class Epi, class Sched, bool ALIGN_EPI = false, bool SP2 = false>
__device__ __forceinline__ void gemm_phase(PG8_LAS unsigned char* lds, const Gemm g, const Sched& S, const Epi& E, const int tid_in) {
    const int tid = tid_in, wid = __builtin_amdgcn_readfirstlane(tid >> 6), lane = tid & 63, wr = wid >> 2, wc = wid & 3, fr = lane & 15, fq = lane >> 4;
    const int K = g.K, nt = K / BK;
    unsigned voffA[2], voffB[2];
#pragma unroll
    for (int i = 0; i < 2; ++i) { int R, C; stage_rc(tid * 16 + i * 8192, R, C); const int Rb = Epi::PERM ? ((R & ~31) + perm32(R & 31)) : R;
        voffA[i] = (unsigned)(R * K + C) * 2u; voffB[i] = (unsigned)(Rb * K + C) * 2u; }
    const size_t kstep = (size_t)(BK * 2);
    const size_t hstep = (size_t)HALF * K * 2;
    const size_t tstep = 2 * hstep;
    const unsigned ldsw = (unsigned)wid * 1024u;
    const int aoff = lds_byte(wr * 64 + fr, fq * 8), boff = lds_byte(wc * 32 + fr, fq * 8);
#define PG8_SA(b, h) (((b) * 2 + (h)) * HTB)
#define PG8_SB(b, h) ((4 + (b) * 2 + (h)) * HTB)
#define PG8_STAGE(bufoff, gbase, voff) do { _Pragma("unroll") for (int _i = 0; _i < 2; ++_i) \
        __builtin_amdgcn_global_load_lds((const unsigned*)((const char*)(gbase) + (voff)[_i]), (PG8_LAS unsigned*)(lds + (bufoff) + ldsw + _i * 8192), 16, 0, 0); } while (0)
#define PG8_LDA(dst, b, h) do { _Pragma("unroll") for (int m = 0; m < 4; ++m) _Pragma("unroll") for (int k = 0; k < 2; ++k) dst[m][k] = *(const PG8_LAS bf16x8*)(lds + PG8_SA(b, h) + aoff + m * 2048 + k * 1024); } while (0)
#define PG8_LDB(dst, b, h) do { _Pragma("unroll") for (int n = 0; n < 2; ++n) _Pragma("unroll") for (int k = 0; k < 2; ++k) dst[n][k] = *(const PG8_LAS bf16x8*)(lds + PG8_SB(b, h) + boff + n * 2048 + k * 1024); } while (0)
#define PG8_MMA(ai, bj, At, Bt) do { __builtin_amdgcn_s_setprio(1); _Pragma("unroll") for (int m = 0; m < 4; ++m) _Pragma("unroll") for (int n = 0; n < 2; ++n) _Pragma("unroll") for (int k = 0; k < 2; ++k) \
        acc[ai][bj][m][n] = __builtin_amdgcn_mfma_f32_16x16x32_bf16(Bt[n][k], At[m][k], acc[ai][bj][m][n], 0, 0, 0); __builtin_amdgcn_s_setprio(0); } while (0)
#define PG8_WAIT_V(n) asm volatile("s_waitcnt vmcnt(" #n ")" ::: "memory")
#define PG8_WAIT_L(n) asm volatile("s_waitcnt lgkmcnt(" #n ")" ::: "memory")
#define PG8_BAR __builtin_amdgcn_s_barrier()
#define PG8_SCHED __builtin_amdgcn_sched_barrier(0)
    Unit cur, nxt; int ui = 0;
    if (!S.next(0, cur)) return;
    f32x4 acc[2][2][4][2];
#pragma unroll
    for (int a = 0; a < 2; ++a)
#pragma unroll
        for (int b = 0; b < 2; ++b)
#pragma unroll
            for (int m = 0; m < 4; ++m)
#pragma unroll
                for (int n = 0; n < 2; ++n) acc[a][b][m][n] = (f32x4){0.f, 0.f, 0.f, 0.f};
    bf16x8 At[4][2], B0[2][2], B1[2][2];
    const char* cA = (const char*)g.A + (size_t)cur.pm * tstep; const char* cB = (const char*)g.Bt + (size_t)cur.pn * tstep;
    S.a_ready(cur);
    if constexpr (SP2) {
        PG8_STAGE(PG8_SB(0, 0), cB, voffB); PG8_STAGE(PG8_SB(0, 1), cB + hstep, voffB); PG8_STAGE(PG8_SA(0, 0), cA, voffA); PG8_STAGE(PG8_SA(0, 1), cA + hstep, voffA);
        if (wr == 1) PG8_BAR;
        PG8_WAIT_V(2); PG8_BAR;
        PG8_STAGE(PG8_SB(1, 0), cB + kstep, voffB); PG8_STAGE(PG8_SA(1, 0), cA + kstep, voffA); PG8_STAGE(PG8_SB(1, 1), cB + hstep + kstep, voffB);
        PG8_WAIT_V(6); PG8_BAR;
    } else {
        PG8_STAGE(PG8_SB(0, 0), cB, voffB); PG8_STAGE(PG8_SA(0, 0), cA, voffA); PG8_STAGE(PG8_SB(0, 1), cB + hstep, voffB); PG8_STAGE(PG8_SA(0, 1), cA + hstep, voffA);
        if (wr == 1) PG8_BAR;
        PG8_WAIT_V(4); PG8_BAR;
        PG8_STAGE(PG8_SB(1, 0), cB + kstep, voffB); PG8_STAGE(PG8_SA(1, 0), cA + kstep, voffA); PG8_STAGE(PG8_SB(1, 1), cB + hstep + kstep, voffB);
        PG8_WAIT_V(6); PG8_BAR;
    }
    for (;;) {
        const bool has_next = S.next(ui + 1, nxt);
        const char* nA = has_next ? (const char*)g.A + (size_t)nxt.pm * tstep : cA; const char* nB = has_next ? (const char*)g.Bt + (size_t)nxt.pn * tstep : cB;
        for (int t = 0; t < nt; t += 2) {
            const bool last = (t == nt - 2);
            const char* a1 = cA + (size_t)(t + 1) * kstep;
            const char* a2 = last ? nA : cA + (size_t)(t + 2) * kstep; const char* b2 = last ? nB : cB + (size_t)(t + 2) * kstep;
            const char* a3 = a2 + kstep; const char* b3 = b2 + kstep;
            if (last && has_next) S.a_ready(nxt);
            if constexpr (SP2) {
            PG8_LDB(B0, 0, 0); PG8_LDB(B1, 0, 1); PG8_SCHED; PG8_LDA(At, 0, 0); PG8_STAGE(PG8_SA(1, 1), a1 + hstep, voffA);
            PG8_WAIT_V(8); PG8_WAIT_L(0); PG8_BAR; PG8_MMA(0, 0, At, B0); PG8_MMA(0, 1, At, B1); PG8_BAR; PG8_SCHED;
            PG8_LDA(At, 0, 1); PG8_STAGE(PG8_SB(0, 0), b2, voffB); PG8_STAGE(PG8_SB(0, 1), b2 + hstep, voffB); PG8_STAGE(PG8_SA(0, 0), a2, voffA);
            PG8_WAIT_V(8); PG8_WAIT_L(0); PG8_BAR; PG8_MMA(1, 0, At, B0); PG8_MMA(1, 1, At, B1); PG8_BAR; PG8_SCHED;
            PG8_LDB(B0, 1, 0); PG8_LDB(B1, 1, 1); PG8_SCHED; PG8_LDA(At, 1, 0); PG8_STAGE(PG8_SA(0, 1), a2 + hstep, voffA);
            PG8_WAIT_V(8); PG8_WAIT_L(0); PG8_BAR; PG8_MMA(0, 0, At, B0); PG8_MMA(0, 1, At, B1); PG8_BAR; PG8_SCHED;
            PG8_LDA(At, 1, 1); PG8_STAGE(PG8_SB(1, 0), b3, voffB); PG8_STAGE(PG8_SB(1, 1), b3 + hstep, voffB); PG8_STAGE(PG8_SA(1, 0), a3, voffA);
            PG8_WAIT_V(8); PG8_WAIT_L(0); PG8_BAR; PG8_MMA(1, 0, At, B0); PG8_MMA(1, 1, At, B1); PG8_BAR; PG8_SCHED;
            } else {
            PG8_LDB(B0, 0, 0); PG8_SCHED; PG8_LDA(At, 0, 0); PG8_STAGE(PG8_SA(1, 1), a1 + hstep, voffA);
            PG8_WAIT_L(8); PG8_BAR; PG8_WAIT_L(0); PG8_MMA(0, 0, At, B0); PG8_BAR; PG8_SCHED;
            PG8_LDB(B1, 0, 1); PG8_STAGE(PG8_SB(0, 0), b2, voffB);
            PG8_BAR; PG8_WAIT_L(0); PG8_MMA(0, 1, At, B1); PG8_BAR;
            PG8_LDA(At, 0, 1); PG8_STAGE(PG8_SA(0, 0), a2, voffA);
            PG8_BAR; PG8_WAIT_L(0); PG8_MMA(1, 0, At, B0); PG8_BAR; PG8_SCHED;
            PG8_STAGE(PG8_SB(0, 1), b2 + hstep, voffB);
            PG8_WAIT_V(6); PG8_BAR; PG8_MMA(1, 1, At, B1); PG8_BAR;
            PG8_LDB(B0, 1, 0); PG8_SCHED; PG8_LDA(At, 1, 0); PG8_STAGE(PG8_SA(0, 1), a2 + hstep, voffA);
            PG8_WAIT_L(8); PG8_BAR; PG8_WAIT_L(0); PG8_MMA(0, 0, At, B0); PG8_BAR; PG8_SCHED;
            PG8_LDB(B1, 1, 1); PG8_STAGE(PG8_SB(1, 0), b3, voffB);
            PG8_BAR; PG8_WAIT_L(0); PG8_MMA(0, 1, At, B1); PG8_BAR;
            PG8_LDA(At, 1, 1); PG8_STAGE(PG8_SA(1, 0), a3, voffA);
            PG8_BAR; PG8_WAIT_L(0); PG8_MMA(1, 0, At, B0); PG8_BAR; PG8_SCHED;
            PG8_STAGE(PG8_SB(1, 1), b3 + hstep, voffB);
            PG8_WAIT_V(6); PG8_BAR; PG8_MMA(1, 1, At, B1); PG8_BAR;
            }
        }
        if constexpr (ALIGN_EPI) { if (wr == 0) PG8_BAR; }
        if constexpr (!Epi::AFTER_DRAIN) { E(acc, cur, wr, wc, fr, fq); S.done(cur); }
        if (!has_next) break;
#pragma unroll
        for (int a = 0; a < 2; ++a)
#pragma unroll
            for (int b = 0; b < 2; ++b)
#pragma unroll
                for (int m = 0; m < 4; ++m)
#pragma unroll
                    for (int n = 0; n < 2; ++n) acc[a][b][m][n] = (f32x4){0.f, 0.f, 0.f, 0.f};
        cur = nxt; cA = nA; cB = nB; ++ui;
        if constexpr (ALIGN_EPI) { if (wr == 1) PG8_BAR; }
    }
    PG8_WAIT_V(0);
    if constexpr (!ALIGN_EPI) { if (wr == 0) PG8_BAR; }
    PG8_BAR;
    if constexpr (Epi::AFTER_DRAIN) { E.fused(acc, cur, wr, wc, fr, fq, lds, wid, lane); S.done(cur); }
#undef PG8_SA
#undef PG8_SB
#undef PG8_STAGE
#undef PG8_LDA
#undef PG8_LDB
#undef PG8_MMA
#undef PG8_WAIT_V
#undef PG8_WAIT_L
#undef PG8_BAR
#undef PG8_SCHED
}
}
#define LAS __attribute__((address_space(3)))
typedef unsigned short bf16;
typedef short bf16x8 __attribute__((ext_vector_type(8)));
typedef float f32x4 __attribute__((ext_vector_type(4)));
typedef float f32x2 __attribute__((ext_vector_type(2)));
typedef unsigned u32x4 __attribute__((ext_vector_type(4)));
typedef unsigned u32x2 __attribute__((ext_vector_type(2)));
typedef __bf16 bf16x2_t __attribute__((ext_vector_type(2)));

constexpr int M = 16384, DM = 2048, NIN = 5888, NCHUNK = 256;
constexpr float EPS = 1e-6f, LOG2E = 1.4426950408889634f, QSCALE = 0.125f * LOG2E;
constexpr int NWAVES = 8, NTHR = 512;
constexpr size_t MiB = 1u << 20;
constexpr size_t WS_CTL = 0, WS_WOUT = 1 * MiB, WS_WQ = 9 * MiB, WS_K12 = 17 * MiB, WS_XN = 18 * MiB, WS_WIN = 82 * MiB, WS_Z = 105 * MiB, WS_XBC = 137 * MiB,
                 WS_Q = 185 * MiB, WS_K = 217 * MiB, WS_V = 249 * MiB, WS_DTF = 281 * MiB, WS_XS = 283 * MiB, WS_BC = 315 * MiB, WS_DT = 331 * MiB, WS_ACUM = 332 * MiB,
                 WS_CUMF = 333 * MiB, WS_MISC = 334 * MiB, WS_MIX = 335 * MiB, WS_END = 464 * MiB;
constexpr size_t WS_SLOC = WS_XN;
constexpr size_t WS_HN = WS_XN;
constexpr size_t WS_QP = 105 * MiB, WS_IDX = 169 * MiB, WS_GW = 177 * MiB, WS_U = 185 * MiB, WS_V2 = 249 * MiB;
constexpr size_t MISC_FTOT = 0, MISC_SUMSQ = 65536, MISC_QN2 = 196608, MISC_KN2 = 212992, MISC_CHK = 262144;
constexpr int LDS_BYTES = 155648;

__device__ __forceinline__ unsigned cvtpk(float lo, float hi) { f32x2 v = {lo, hi}; bf16x2_t b = __builtin_convertvector(v, bf16x2_t); return __builtin_bit_cast(unsigned, b); }
__device__ __forceinline__ bf16 f2bf(float f) { return (bf16)(cvtpk(f, 0.f) & 0xffffu); }
__device__ __forceinline__ float bf2f(bf16 h) { return __uint_as_float((unsigned)h << 16); }
__device__ __forceinline__ float bflo(unsigned w) { return __uint_as_float(w << 16); }
__device__ __forceinline__ float bfhi(unsigned w) { return __uint_as_float(w & 0xffff0000u); }
template <int CTRL, int RM> __device__ __forceinline__ float dpp_self(float v) { return __int_as_float(__builtin_amdgcn_update_dpp(__float_as_int(v), __float_as_int(v), CTRL, RM, 0xf, false)); }
template <int CTRL, int RM> __device__ __forceinline__ float dpp_zero(float v) { return __int_as_float(__builtin_amdgcn_update_dpp(0, __float_as_int(v), CTRL, RM, 0xf, false)); }
__device__ __forceinline__ float wave_max(float v) {
    v = fmaxf(v, dpp_self<0x111, 0xf>(v)); v = fmaxf(v, dpp_self<0x112, 0xf>(v)); v = fmaxf(v, dpp_self<0x114, 0xf>(v)); v = fmaxf(v, dpp_self<0x118, 0xf>(v));
    v = fmaxf(v, dpp_self<0x142, 0xa>(v)); v = fmaxf(v, dpp_self<0x143, 0xc>(v));
    return __int_as_float(__builtin_amdgcn_readlane(__float_as_int(v), 63));
}
__device__ __forceinline__ float wave_sum(float v) {
    v += dpp_zero<0x111, 0xf>(v); v += dpp_zero<0x112, 0xf>(v); v += dpp_zero<0x114, 0xf>(v); v += dpp_zero<0x118, 0xf>(v);
    v += dpp_zero<0x142, 0xa>(v); v += dpp_zero<0x143, 0xc>(v);
    return __int_as_float(__builtin_amdgcn_readlane(__float_as_int(v), 63));
}
__device__ __forceinline__ float wave_scan_incl(float v, int lane) {
#pragma unroll
    for (int o = 1; o < 64; o <<= 1) { const float t = __shfl_up(v, o); if (lane >= o) v += t; }
    return v;
}
__device__ __forceinline__ float siluf(float x) { return x / (1.f + __expf(-x)); }
__device__ __forceinline__ float softplusf(float x) { return fmaxf(x, 0.f) + log1pf(__expf(-fabsf(x))); }
__device__ __forceinline__ float logsigmoidf(float x) { return fminf(x, 0.f) - log1pf(__expf(-fabsf(x))); }
__device__ __forceinline__ float dot2bf(unsigned a, unsigned b, float c) { const unsigned aa = a, bb = b; return __builtin_amdgcn_fdot2_f32_bf16(__builtin_bit_cast(bf16x2_t, aa), __builtin_bit_cast(bf16x2_t, bb), c, false); }
__device__ __forceinline__ f32x4 mfma16(bf16x8 a, bf16x8 b, f32x4 c) { return __builtin_amdgcn_mfma_f32_16x16x32_bf16(a, b, c, 0, 0, 0); }

struct Args {
    const float *x, *ln1_w, *w_in, *conv_w, *conv_b, *dt_bias, *a_log, *d_skip, *ssd_norm_w, *fox_f_bias, *w_out, *ln2_w, *peer_wq, *peer_k1, *peer_k2, *peer_u, *peer_v, *lnf_w;
    float* out; unsigned char* ws; int ph_lo, ph_hi;
};
typedef const __attribute__((address_space(4))) Args* ArgsP;
__device__ __forceinline__ ArgsP get_args() { ArgsP p = (ArgsP)__builtin_amdgcn_kernarg_segment_ptr(); asm volatile("" : "+s"(p)); return p; }
__device__ __forceinline__ int lane_id() { int l; asm volatile("v_mbcnt_lo_u32_b32 %0, -1, 0\n\tv_mbcnt_hi_u32_b32 %0, -1, %0" : "=v"(l)); return l; }
__device__ __forceinline__ int opaque(int v) { asm volatile("" : "+v"(v)); return v; }
#define GAS __attribute__((address_space(1)))
#define XB_TMO      128
#define XB_XCNT(j)  (256  + 64 * (j))
#define XB_XSUB(j)  (1280 + 64 * (j))
#define XB_XGEN(j)  (2304 + 64 * (j))
#define XB_TOP      3328
#define XB_TOPGEN   3392
#define XCD_BAR_WORDS 3456
#define XB_SPIN_CAP (1u << 18)

__device__ __forceinline__ unsigned xb_ld(unsigned* p)              { return __hip_atomic_load(p, __ATOMIC_RELAXED, __HIP_MEMORY_SCOPE_AGENT); }
__device__ __forceinline__ unsigned xb_add(unsigned* p, unsigned v) { return __hip_atomic_fetch_add(p, v, __ATOMIC_RELAXED, __HIP_MEMORY_SCOPE_AGENT); }
__device__ __forceinline__ unsigned xb_xcc_id() { return (unsigned)__builtin_amdgcn_s_getreg((3 << 11) | 20) & 0xFu; }
#define XB_SPIN(cond, bar) do { unsigned _sp = 0; while (cond) { __builtin_amdgcn_s_sleep(1); \
    if ((++_sp & 255u) == 0u) { if (xb_ld(&(bar)[XB_TMO])) break; if (_sp > XB_SPIN_CAP) { atomicAdd(&(bar)[XB_TMO], 1u); break; } } } } while (0)
struct XcdBarrier { unsigned* bar; unsigned x; volatile LAS unsigned* st; };
__device__ __forceinline__ XcdBarrier xcd_barrier_post(unsigned* bar, volatile LAS unsigned* st, const int tid) {
    XcdBarrier b; b.bar = bar; b.x = xb_xcc_id(); b.st = st;
    if (tid == 0) (void)xb_add(&bar[XB_XCNT(b.x)], 1u);
    return b;
}
__device__ __forceinline__ void xcd_barrier_complete(unsigned* bar, unsigned x, unsigned& nloc, unsigned& nx) {
    const unsigned G = gridDim.x;
    unsigned sum, cnt, mine, sp = 0u;
    for (;;) {
        sum = 0u; cnt = 0u; mine = 0u;
#pragma unroll
        for (unsigned j = 0; j < 16; ++j) { const unsigned c = xb_ld(&bar[XB_XCNT(j)]); sum += c; cnt += (c > 0u) ? 1u : 0u; mine = (j == x) ? c : mine; }
        if (sum == G) break;
        __builtin_amdgcn_s_sleep(1);
        if ((++sp & 255u) == 0u) { if (xb_ld(&bar[XB_TMO])) break; if (sp > XB_SPIN_CAP) { atomicAdd(&bar[XB_TMO], 1u); break; } }
    }
    nloc = mine > 0u ? mine : 1u; nx = cnt > 0u ? cnt : 1u;
}
__device__ __forceinline__ void xcd_barrier(const XcdBarrier& b, const int tid) {
    asm volatile("s_waitcnt vmcnt(0)" ::: "memory");
    __syncthreads();
    if (tid == 0) {
        unsigned* bar = b.bar;
        __builtin_amdgcn_s_waitcnt(0);
        unsigned nloc = b.st[0], nx = b.st[1];
        if (nloc == 0u) { xcd_barrier_complete(bar, b.x, nloc, nx); b.st[0] = nloc; b.st[1] = nx; }
        const unsigned old = xb_add(&bar[XB_XSUB(b.x)], 1u);
        const unsigned gen = old / nloc;
        if (old + 1u == (gen + 1u) * nloc) {
            __builtin_amdgcn_fence(__ATOMIC_RELEASE, "agent");
            asm volatile("s_waitcnt vmcnt(0)" ::: "memory");
            const unsigned og = xb_add(&bar[XB_TOP], 1u);
            const unsigned tg = og / nx;
            if (og + 1u == (tg + 1u) * nx) xb_add(&bar[XB_TOPGEN], 1u);
            else XB_SPIN(xb_ld(&bar[XB_TOPGEN]) == tg, bar);
            __builtin_amdgcn_fence(__ATOMIC_ACQUIRE, "agent");
            xb_add(&bar[XB_XGEN(b.x)], 1u);
            asm volatile("s_waitcnt vmcnt(0)" ::: "memory");
        } else {
            XB_SPIN(xb_ld(&bar[XB_XGEN(b.x)]) == gen, bar);
            __builtin_amdgcn_fence(__ATOMIC_ACQUIRE, "agent");
            asm volatile("s_waitcnt vmcnt(0)" ::: "memory");
        }
    }
    __syncthreads();
}
__device__ __forceinline__ int peer_next_item(unsigned* heads, const int myx, int& probe, const unsigned nper, volatile LAS int* bc, const int tid) {
    if (tid == 0) { int r = -1;
        while (probe < 8) { const int q = (myx + probe) & 7; const unsigned v = __hip_atomic_fetch_add(&heads[64 * q], 1u, __ATOMIC_RELAXED, __HIP_MEMORY_SCOPE_AGENT); if (v < nper) { r = q * (int)nper + (int)v; break; } ++probe; }
        bc[0] = r; }
    __syncthreads(); const int r = bc[0]; __syncthreads(); return r;
}
constexpr int Q_A = 8192 + 2048;
__device__ __forceinline__ int win_dest_row(int j) { return j < 2560 ? j : (j < 2576 ? 5632 + (j - 2560) : (j < 5648 ? j - 16 : j)); }
template <bool MAPROW> __device__ __forceinline__ void p0_transpose_item(const float* W, int K, int N, bf16* WT, LAS float* scr, int item, int lane) {
    const int nblk = N / 32, kb = item / nblk, nb = item % nblk, k0 = 64 * kb, n0 = 32 * nb;
#pragma unroll 8
    for (int i = 0; i < 32; ++i) { const int kk = 2 * i + (lane >> 5); scr[kk * 33 + (lane & 31)] = W[(size_t)(k0 + kk) * N + n0 + (lane & 31)]; }
    asm volatile("s_waitcnt lgkmcnt(0)" ::: "memory");
    const int c = lane & 7;
#pragma unroll
    for (int j = 0; j < 4; ++j) { const int n = (lane >> 3) + 8 * j; const LAS float* s = scr + (8 * c) * 33 + n;
        u32x4 o; o.x = cvtpk(s[0 * 33], s[1 * 33]); o.y = cvtpk(s[2 * 33], s[3 * 33]); o.z = cvtpk(s[4 * 33], s[5 * 33]); o.w = cvtpk(s[6 * 33], s[7 * 33]);
        const int drow = MAPROW ? win_dest_row(n0 + n) : (n0 + n);
        *(u32x4*)(WT + (size_t)drow * K + k0 + 8 * c) = o; }
    asm volatile("s_waitcnt lgkmcnt(0)" ::: "memory");
}
__device__ __forceinline__ void rms_row_to_bf16(const float* xrow, const float* w, bf16* orow, int lane) {
    const f32x4* xr = (const f32x4*)xrow + lane; const f32x4* wr = (const f32x4*)w + lane;
    f32x4 v[8]; float s = 0.f;
#pragma unroll
    for (int j = 0; j < 8; ++j) { v[j] = xr[64 * j]; s += (v[j].x * v[j].x + v[j].y * v[j].y) + (v[j].z * v[j].z + v[j].w * v[j].w); }
    const float rstd = 1.f / sqrtf(wave_sum(s) * (1.f / DM) + EPS);
    u32x2* o8 = (u32x2*)orow + lane;
#pragma unroll
    for (int j = 0; j < 8; ++j) { const f32x4 ww = wr[64 * j]; u32x2 o; o.x = cvtpk(v[j].x * rstd * ww.x, v[j].y * rstd * ww.y); o.y = cvtpk(v[j].z * rstd * ww.z, v[j].w * rstd * ww.w); o8[64 * j] = o; }
}
__device__ __forceinline__ void transpose_filler_item(ArgsP a, LAS unsigned char* lds, const int tidx, const int f) {
    const int lane = tidx & 63, wave = __builtin_amdgcn_readfirstlane(tidx >> 6); LAS float* scr = (LAS float*)(lds + wave * 16384);
    const bool second = f >= 256; const int it = (f & 255) * 8 + wave;
    p0_transpose_item<false>(second ? a->peer_wq : a->w_out, DM, DM, (bf16*)(a->ws + (second ? WS_WQ : WS_WOUT)), scr, it, lane);
}
__device__ __forceinline__ void phase0(ArgsP a, LAS unsigned char* lds, const int tidx) {
    const int tid = tidx, lane = tid & 63, wave = __builtin_amdgcn_readfirstlane(tid >> 6);
    LAS float* scr = (LAS float*)(lds + wave * 16384);
    const int gw = blockIdx.x * NWAVES + wave, NGW = gridDim.x * NWAVES;
    bf16* WinT = (bf16*)(a->ws + WS_WIN); bf16* WoutT = (bf16*)(a->ws + WS_WOUT); bf16* WqT = (bf16*)(a->ws + WS_WQ);
    constexpr int I_IN = (DM / 64) * (5664 / 32), I_SQ = (DM / 64) * (DM / 32);
    for (int it = gw; it < I_IN; it += NGW) p0_transpose_item<true>(a->w_in, DM, 5664, WinT, scr, it, lane);
    (void)WoutT; (void)WqT;
    { const int gt = blockIdx.x * NTHR + tid, NGT = gridDim.x * NTHR; u32x4* z = (u32x4*)(WinT + (size_t)5664 * DM);
      for (int i = gt; i < 224 * 256; i += NGT) z[i] = (u32x4){0u, 0u, 0u, 0u};
      float* ss = (float*)(a->ws + WS_MISC + MISC_SUMSQ); for (int i = gt; i < M; i += NGT) { ss[i] = 0.f; ss[i + 16384] = 0.f; }
      if (gt < 16) ((int*)(a->ws + WS_MISC + MISC_CHK))[gt] = 0;
      bf16* k12 = (bf16*)(a->ws + WS_K12);
      for (int i = gt; i < 2 * 8 * 128 * 128 / 2; i += NGT) { const int half = i >= 65536; const float* src = half ? a->peer_k2 : a->peer_k1; const int e = (i - half * 65536) * 2;
          ((unsigned*)k12)[i] = cvtpk(src[e], src[e + 1]); } }
    bf16* XN = (bf16*)(a->ws + WS_XN);
    for (int m = gw; m < M; m += NGW) rms_row_to_bf16(a->x + (size_t)m * DM, a->ln1_w, XN + (size_t)m * DM, lane);
}

struct EpiInProj {
    static constexpr bool PERM = true, AFTER_DRAIN = false;
    bf16 *Z, *XBC, *Q, *K, *V; float* DTF;
    __device__ __forceinline__ void operator()(const f32x4 (&acc)[2][2][4][2], const pg8::Unit& u, int wr, int wc, int fr, int fq) const {
        const int pn = u.pn; bf16* base; int ldc, colt; float sc = 1.f;
        if (pn < 4) { base = Z; ldc = 1024; colt = pn * 256; }
        else if (pn < 10) { base = XBC; ldc = 1536; colt = (pn - 4) * 256; }
        else if (pn < 14) { base = Q; ldc = 1024; colt = (pn - 10) * 256; sc = QSCALE; }
        else if (pn < 18) { base = K; ldc = 1024; colt = (pn - 14) * 256; }
        else if (pn < 22) { base = V; ldc = 1024; colt = (pn - 18) * 256; }
        else {
            if (wc == 0) {
#pragma unroll
                for (int ai = 0; ai < 2; ++ai)
#pragma unroll
                    for (int m = 0; m < 4; ++m) { const int row = u.pm * 256 + ai * 128 + wr * 64 + m * 16 + fr;
#pragma unroll
                        for (int n = 0; n < 2; ++n) *(f32x4*)(DTF + (size_t)row * 32 + 8 * fq + 4 * n) = acc[ai][0][m][n]; }
            }
            return;
        }
        const int row0 = u.pm * 256 + wr * 64 + fr, col0 = colt + wc * 32 + 8 * fq;
#pragma unroll
        for (int ai = 0; ai < 2; ++ai)
#pragma unroll
            for (int m = 0; m < 4; ++m) { bf16* rowp = base + (size_t)(row0 + ai * 128 + m * 16) * ldc + col0;
#pragma unroll
                for (int bj = 0; bj < 2; ++bj) { const f32x4 v0 = acc[ai][bj][m][0] * sc, v1 = acc[ai][bj][m][1] * sc;
                    u32x4 w; w.x = cvtpk(v0[0], v0[1]); w.y = cvtpk(v0[2], v0[3]); w.z = cvtpk(v1[0], v1[1]); w.w = cvtpk(v1[2], v1[3]);
                    *(u32x4*)(rowp + bj * 128) = w; } }
    }
};
struct EpiPlainBf16 {
    static constexpr bool PERM = true, AFTER_DRAIN = false;
    bf16* O; int ldc;
    __device__ __forceinline__ void operator()(const f32x4 (&acc)[2][2][4][2], const pg8::Unit& u, int wr, int wc, int fr, int fq) const {
        const int row0 = u.pm * 256 + wr * 64 + fr, col0 = u.pn * 256 + wc * 32 + 8 * fq;
#pragma unroll
        for (int ai = 0; ai < 2; ++ai)
#pragma unroll
            for (int m = 0; m < 4; ++m) { bf16* rowp = O + (size_t)(row0 + ai * 128 + m * 16) * ldc + col0;
#pragma unroll
                for (int bj = 0; bj < 2; ++bj) { const f32x4 v0 = acc[ai][bj][m][0], v1 = acc[ai][bj][m][1];
                    u32x4 w; w.x = cvtpk(v0[0], v0[1]); w.y = cvtpk(v0[2], v0[3]); w.z = cvtpk(v1[0], v1[1]); w.w = cvtpk(v1[2], v1[3]);
                    *(u32x4*)(rowp + bj * 128) = w; } }
    }
};
struct EpiOutProj {
    static constexpr bool PERM = false, AFTER_DRAIN = false;
    const float* x; bf16* X1B; bf16* HN; const float* ln2w; float* sumsq;
    __device__ __forceinline__ void operator()(const f32x4 (&acc)[2][2][4][2], const pg8::Unit& u, int wr, int wc, int fr, int fq) const {
        const int col0 = u.pn * 256 + wc * 32 + 4 * fq;
#pragma unroll
        for (int ai = 0; ai < 2; ++ai)
#pragma unroll
            for (int m = 0; m < 4; ++m) { const int row = u.pm * 256 + ai * 128 + wr * 64 + m * 16 + fr; const size_t off = (size_t)row * DM + col0; float ss = 0.f;
#pragma unroll
                for (int bj = 0; bj < 2; ++bj)
#pragma unroll
                    for (int n = 0; n < 2; ++n) { const size_t o = off + bj * 128 + n * 16; const f32x4 xv = *(const f32x4*)(x + o); const f32x4 x1 = acc[ai][bj][m][n] + xv;
                        u32x2 xw; xw.x = cvtpk(x1[0], x1[1]); xw.y = cvtpk(x1[2], x1[3]); *(u32x2*)(X1B + o) = xw; const f32x4 w = *(const f32x4*)(ln2w + col0 + bj * 128 + n * 16);
                        u32x2 hw; hw.x = cvtpk(x1[0] * w[0], x1[1] * w[1]); hw.y = cvtpk(x1[2] * w[2], x1[3] * w[3]); *(u32x2*)(HN + o) = hw;
                        ss += (x1[0] * x1[0] + x1[1] * x1[1]) + (x1[2] * x1[2] + x1[3] * x1[3]); }
                ss += __shfl_xor(ss, 16); ss += __shfl_xor(ss, 32);
                if (fq == 0) atomicAdd(sumsq + row, ss); }
    }
};
__device__ __forceinline__ void phase2(ArgsP a, LAS unsigned char* lds, const int tidx) {
    const int tid0 = tidx, w = __builtin_amdgcn_readfirstlane(tid0 >> 6);
    const bf16* XBC = (const bf16*)(a->ws + WS_XBC); const float* DTF = (const float*)(a->ws + WS_DTF);
    bf16* XS = (bf16*)(a->ws + WS_XS); bf16* BC = (bf16*)(a->ws + WS_BC); float* DT = (float*)(a->ws + WS_DT); float* ACUM = (float*)(a->ws + WS_ACUM);
    float* CUMF = (float*)(a->ws + WS_CUMF); float* FTOT = (float*)(a->ws + WS_MISC + MISC_FTOT); bf16* SLOC = (bf16*)(a->ws + WS_SLOC);
    LAS bf16* BT = (LAS bf16*)lds; LAS bf16* XT = (LAS bf16*)(lds + 18432 + w * 9216);
    for (int u = blockIdx.x; u < 2 * NCHUNK; u += gridDim.x) {
        const int tid = opaque(tid0), lane = tid & 63;
        const int c = u >> 1, g = u & 1, t0 = c * 64, h = 8 * g + w;
        {
            const int n = tid & 127;
#pragma unroll
            for (int which = 0; which < 2; ++which) {
                const int ch = 1024 + which * 256 + 128 * g + n;
                const float w0 = a->conv_w[ch], w1 = a->conv_w[1536 + ch], w2 = a->conv_w[2 * 1536 + ch], w3 = a->conv_w[3 * 1536 + ch], cb = a->conv_b[ch];
#pragma unroll
                for (int rr = 0; rr < 2; ++rr) {
                    const int s0 = 8 * ((tid >> 7) + 4 * rr);
                    float in[11];
#pragma unroll
                    for (int j = 0; j < 11; ++j) { const int t = t0 + s0 - 3 + j; const float v = bf2f(XBC[(size_t)(t < 0 ? 0 : t) * 1536 + ch]); in[j] = t < 0 ? 0.f : v; }
                    unsigned pk[4];
#pragma unroll
                    for (int j = 0; j < 8; j += 2) {
                        const float v0 = siluf(cb + w0 * in[j] + w1 * in[j + 1] + w2 * in[j + 2] + w3 * in[j + 3]);
                        const float v1 = siluf(cb + w0 * in[j + 1] + w1 * in[j + 2] + w2 * in[j + 3] + w3 * in[j + 4]);
                        const unsigned p2 = cvtpk(v0, v1); pk[j >> 1] = p2;
                        BC[(size_t)(t0 + s0 + j) * 512 + which * 256 + 128 * g + n] = (bf16)(p2 & 0xffffu);
                        BC[(size_t)(t0 + s0 + j + 1) * 512 + which * 256 + 128 * g + n] = (bf16)(p2 >> 16);
                    }
                    if (which == 0) *(LAS u32x4*)(BT + n * 72 + s0) = (u32x4){pk[0], pk[1], pk[2], pk[3]};
                }
            }
        }
        float wgt;
        {
            const int t = t0 + lane;
            const float dt = softplusf(DTF[(size_t)t * 32 + h] + a->dt_bias[h]);
            const float A = -__expf(a->a_log[h]);
            const float acum = wave_scan_incl(dt * A, lane);
            DT[(size_t)t * 16 + h] = dt; ACUM[(size_t)t * 16 + h] = acum;
            const float alast = __shfl(acum, 63);
            wgt = dt * __expf(alast - acum);
            const float lf = logsigmoidf(DTF[(size_t)t * 32 + 16 + h] + a->fox_f_bias[h]);
            const float cl = wave_scan_incl(lf, lane);
            CUMF[(size_t)h * M + t] = cl;
            if (lane == 63) FTOT[h * NCHUNK + c] = cl;
            { const u32x4* qp = (const u32x4*)((const bf16*)(a->ws + WS_Q) + (size_t)t * 1024 + 64 * h); const u32x4* kp = (const u32x4*)((const bf16*)(a->ws + WS_K) + (size_t)t * 1024 + 64 * h); float qn = 0.f, kn = 0.f;
#pragma unroll
              for (int i = 0; i < 8; ++i) { const u32x4 qv = qp[i], kv = kp[i];
                  qn += bflo(qv.x) * bflo(qv.x) + bfhi(qv.x) * bfhi(qv.x) + bflo(qv.y) * bflo(qv.y) + bfhi(qv.y) * bfhi(qv.y) + bflo(qv.z) * bflo(qv.z) + bfhi(qv.z) * bfhi(qv.z) + bflo(qv.w) * bflo(qv.w) + bfhi(qv.w) * bfhi(qv.w);
                  kn += bflo(kv.x) * bflo(kv.x) + bfhi(kv.x) * bfhi(kv.x) + bflo(kv.y) * bflo(kv.y) + bfhi(kv.y) * bfhi(kv.y) + bflo(kv.z) * bflo(kv.z) + bfhi(kv.z) * bfhi(kv.z) + bflo(kv.w) * bflo(kv.w) + bfhi(kv.w) * bfhi(kv.w); }
              qn = wave_max(qn); kn = wave_max(kn);
              if (lane == 0) { ((float*)(a->ws + WS_MISC + MISC_QN2))[h * NCHUNK + c] = qn; ((float*)(a->ws + WS_MISC + MISC_KN2))[h * NCHUNK + c] = kn; } }
        }
        {
            const int ch = 64 * h + lane;
            const float w0 = a->conv_w[ch], w1 = a->conv_w[1536 + ch], w2 = a->conv_w[2 * 1536 + ch], w3 = a->conv_w[3 * 1536 + ch], cb = a->conv_b[ch];
            float in[67]; const int t0v = opaque(t0);
#pragma unroll
            for (int j = 0; j < 67; ++j) { const int t = t0 - 3 + j; const unsigned off = (unsigned)(j < 3 ? (t < 0 ? 0 : t) : t0v - 3 + j) * 1536u + (unsigned)ch; const float v = bf2f(XBC[off]); in[j] = (j < 3 && t < 0) ? 0.f : v; }
#pragma unroll
            for (int sb = 0; sb < 8; ++sb) {
                unsigned pk[4];
#pragma unroll
                for (int j = 0; j < 8; j += 2) {
                    const int s = 8 * sb + j;
                    const float v0 = siluf(cb + w0 * in[s] + w1 * in[s + 1] + w2 * in[s + 2] + w3 * in[s + 3]);
                    const float v1 = siluf(cb + w0 * in[s + 1] + w1 * in[s + 2] + w2 * in[s + 3] + w3 * in[s + 4]);
                    const unsigned p2 = cvtpk(v0, v1);
                    XS[(size_t)(t0 + s) * 1024 + ch] = (bf16)(p2 & 0xffffu); XS[(size_t)(t0 + s + 1) * 1024 + ch] = (bf16)(p2 >> 16);
                    const float g0 = __shfl(wgt, s), g1 = __shfl(wgt, s + 1);
                    pk[j >> 1] = cvtpk(bflo(p2) * g0, bfhi(p2) * g1);
                }
                *(LAS u32x4*)(XT + lane * 72 + 8 * sb) = (u32x4){pk[0], pk[1], pk[2], pk[3]};
            }
        }
        __syncthreads();
        {
            const int fr = lane & 15, fq = lane >> 4;
            bf16x8 bfr[4][2];
#pragma unroll
            for (int pt = 0; pt < 4; ++pt)
#pragma unroll
                for (int kk = 0; kk < 2; ++kk) bfr[pt][kk] = *(const LAS bf16x8*)(XT + (16 * pt + fr) * 72 + 8 * fq + 32 * kk);
            bf16* dst = SLOC + ((size_t)(c * 16 + h) * 64) * 128;
#pragma unroll
            for (int nt = 0; nt < 8; ++nt) {
                const bf16x8 a0 = *(const LAS bf16x8*)(BT + (16 * nt + fr) * 72 + 8 * fq), a1 = *(const LAS bf16x8*)(BT + (16 * nt + fr) * 72 + 8 * fq + 32);
#pragma unroll
                for (int pt = 0; pt < 4; ++pt) {
                    f32x4 acc = {0.f, 0.f, 0.f, 0.f};
                    acc = mfma16(a0, bfr[pt][0], acc); acc = mfma16(a1, bfr[pt][1], acc);
                    u32x2 o; o.x = cvtpk(acc[0], acc[1]); o.y = cvtpk(acc[2], acc[3]);
                    *(u32x2*)(dst + (size_t)(16 * pt + fr) * 128 + 16 * nt + 4 * fq) = o;
                }
            }
        }
        __syncthreads();
    }
}

template <bool DRY> __device__ __forceinline__ void phase3(ArgsP a, const int tidx) {
    const int tid = tidx, lane = tid & 63, w = __builtin_amdgcn_readfirstlane(tid >> 6);
    const float* ACUM = (const float*)(a->ws + WS_ACUM); unsigned* SL = (unsigned*)(a->ws + WS_SLOC);
    const int gt = blockIdx.x * NTHR + tid, NGT = gridDim.x * NTHR;
    for (int e2 = gt; e2 < 65536; e2 += NGT) {
        const int h = e2 >> 12;
        float s0 = 0.f, s1 = 0.f;
        for (int cb = 0; cb < NCHUNK; cb += 8) {
            unsigned v[8]; float d[8];
#pragma unroll
            for (int j = 0; j < 8; ++j) { v[j] = SL[(size_t)(cb + j) * 65536 + e2]; d[j] = __expf(ACUM[(size_t)((cb + j) * 64 + 63) * 16 + h]); }
#pragma unroll
            for (int j = 0; j < 8; ++j) { SL[(size_t)(cb + j) * 65536 + e2] = DRY ? v[j] : cvtpk(s0, s1); s0 = s0 * d[j] + bflo(v[j]); s1 = s1 * d[j] + bfhi(v[j]); }
        }
    }
    const int gwv = blockIdx.x * NWAVES + w, NGW = gridDim.x * NWAVES;
    for (int hh = gwv; hh < 16; hh += NGW) {
        const float* FTOT = (const float*)(a->ws + WS_MISC + MISC_FTOT) + hh * NCHUNK; float* CF = (float*)(a->ws + WS_CUMF) + (size_t)hh * M;
        const f32x4 tv = *(const f32x4*)(FTOT + 4 * lane);
        const float tot = (tv.x + tv.y) + (tv.z + tv.w);
        const float incl = wave_scan_incl(tot, lane); float pre = incl - tot;
#pragma unroll
        for (int k = 0; k < 4; ++k) {
            f32x4* p = (f32x4*)(CF + (size_t)(4 * lane + k) * 64);
#pragma unroll 4
            for (int j = 0; j < 16; ++j) { f32x4 v = p[j]; if (!DRY) v = (v + pre) * LOG2E; p[j] = v; }
            pre += tv[k];
        }
    }
}
__device__ __forceinline__ void phase4(ArgsP a, LAS unsigned char* lds, const int tidx) {
    const int tid0 = tidx, w = __builtin_amdgcn_readfirstlane(tid0 >> 6);
    const bf16* XS = (const bf16*)(a->ws + WS_XS); const bf16* BC = (const bf16*)(a->ws + WS_BC); const float* DT = (const float*)(a->ws + WS_DT); const float* ACUM = (const float*)(a->ws + WS_ACUM);
    const bf16* PREV = (const bf16*)(a->ws + WS_SLOC); const bf16* Z = (const bf16*)(a->ws + WS_Z); bf16* MIX = (bf16*)(a->ws + WS_MIX);
    LAS bf16* CS = (LAS bf16*)lds; LAS bf16* BS = (LAS bf16*)(lds + 17408); LAS float* CBm = (LAS float*)(lds + 34816);
    LAS bf16* XT = (LAS bf16*)(lds + 52224 + w * 9216); LAS float* AC = (LAS float*)(lds + 125952 + w * 256); LAS float* SSW = (LAS float*)(lds + 128000);
    for (int u = blockIdx.x; u < 2 * NCHUNK; u += gridDim.x) {
        const int tid = opaque(tid0), lane = tid & 63, fr = lane & 15, fq = lane >> 4;
        const int c = u >> 1, g = u & 1, t0 = c * 64, h = 8 * g + w;
#pragma unroll
        for (int i = 0; i < 2; ++i) { const int q = tid + 512 * i, row = q >> 4, c16 = q & 15;
            *(LAS u32x4*)(CS + row * 136 + c16 * 8) = *(const u32x4*)(BC + (size_t)(t0 + row) * 512 + 256 + 128 * g + c16 * 8);
            *(LAS u32x4*)(BS + row * 136 + c16 * 8) = *(const u32x4*)(BC + (size_t)(t0 + row) * 512 + 128 * g + c16 * 8); }
        const float dts = DT[(size_t)(t0 + lane) * 16 + h];
        AC[lane] = ACUM[(size_t)(t0 + lane) * 16 + h];
        {
            const int ch = 64 * h + lane;
            float xin[64];
#pragma unroll
            for (int s = 0; s < 64; ++s) xin[s] = bf2f(XS[(size_t)(t0 + s) * 1024 + ch]);
#pragma unroll
            for (int sb = 0; sb < 8; ++sb) {
                unsigned pk[4];
#pragma unroll
                for (int j = 0; j < 8; j += 2) { const int s = 8 * sb + j; pk[j >> 1] = cvtpk(xin[s] * __shfl(dts, s), xin[s + 1] * __shfl(dts, s + 1)); }
                *(LAS u32x4*)(XT + lane * 72 + 8 * sb) = (u32x4){pk[0], pk[1], pk[2], pk[3]};
            }
        }
        __syncthreads();
#pragma unroll
        for (int x = 0; x < 2; ++x) { const int id = 2 * w + x, ti = id >> 2, si = id & 3; f32x4 acc = {0.f, 0.f, 0.f, 0.f};
#pragma unroll
            for (int kk = 0; kk < 4; ++kk) acc = mfma16(*(const LAS bf16x8*)(CS + (16 * ti + fr) * 136 + 8 * fq + 32 * kk), *(const LAS bf16x8*)(BS + (16 * si + fr) * 136 + 8 * fq + 32 * kk), acc);
#pragma unroll
            for (int r = 0; r < 4; ++r) CBm[(16 * ti + 4 * fq + r) * 68 + 16 * si + fr] = acc[r]; }
        __syncthreads();
        f32x4 acc[4][4];
#pragma unroll
        for (int i = 0; i < 4; ++i)
#pragma unroll
            for (int j = 0; j < 4; ++j) acc[i][j] = (f32x4){0.f, 0.f, 0.f, 0.f};
        {
            const bf16* pv = PREV + ((size_t)(c * 16 + h) * 64) * 128;
#pragma unroll
            for (int kk = 0; kk < 4; ++kk) {
                bf16x8 af[4], bfv[4];
#pragma unroll
                for (int i = 0; i < 4; ++i) af[i] = *(const LAS bf16x8*)(CS + (16 * i + fr) * 136 + 8 * fq + 32 * kk);
#pragma unroll
                for (int j = 0; j < 4; ++j) bfv[j] = *(const bf16x8*)(pv + (size_t)(16 * j + fr) * 128 + 8 * fq + 32 * kk);
#pragma unroll
                for (int i = 0; i < 4; ++i)
#pragma unroll
                    for (int j = 0; j < 4; ++j) acc[i][j] = mfma16(af[i], bfv[j], acc[i][j]);
            }
#pragma unroll
            for (int i = 0; i < 4; ++i)
#pragma unroll
                for (int r = 0; r < 4; ++r) { const float e = __expf(AC[16 * i + 4 * fq + r]);
#pragma unroll
                    for (int j = 0; j < 4; ++j) acc[i][j][r] *= e; }
        }
#pragma unroll
        for (int kk = 0; kk < 2; ++kk) {
            bf16x8 bfv[4];
#pragma unroll
            for (int j = 0; j < 4; ++j) bfv[j] = *(const LAS bf16x8*)(XT + (16 * j + fr) * 72 + 8 * fq + 32 * kk);
            const int sbase = 8 * fq + 32 * kk;
            const f32x4 as0 = *(const LAS f32x4*)(AC + sbase), as1 = *(const LAS f32x4*)(AC + sbase + 4);
#pragma unroll
            for (int i = 0; i < 4; ++i) {
                const int t = 16 * i + fr; const float act = AC[t];
                const f32x4 c0 = *(const LAS f32x4*)(CBm + t * 68 + sbase), c1 = *(const LAS f32x4*)(CBm + t * 68 + sbase + 4);
                float m[8];
#pragma unroll
                for (int jj = 0; jj < 4; ++jj) { m[jj] = (sbase + jj <= t) ? c0[jj] * __expf(fminf(act - as0[jj], 0.f)) : 0.f; m[4 + jj] = (sbase + 4 + jj <= t) ? c1[jj] * __expf(fminf(act - as1[jj], 0.f)) : 0.f; }
                u32x4 mp; mp.x = cvtpk(m[0], m[1]); mp.y = cvtpk(m[2], m[3]); mp.z = cvtpk(m[4], m[5]); mp.w = cvtpk(m[6], m[7]);
                const bf16x8 af = __builtin_bit_cast(bf16x8, mp);
#pragma unroll
                for (int j = 0; j < 4; ++j) acc[i][j] = mfma16(af, bfv[j], acc[i][j]);
            }
        }
        const float Dh = a->d_skip[h];
#pragma unroll
        for (int i = 0; i < 4; ++i)
#pragma unroll
            for (int r = 0; r < 4; ++r) { const int t = 16 * i + 4 * fq + r; float ss = 0.f;
#pragma unroll
                for (int j = 0; j < 4; ++j) { const size_t o = (size_t)(t0 + t) * 1024 + 64 * h + 16 * j + fr;
#if SELFCHECK
                    if (t0 + t < 8192) ((float*)(a->ws + (size_t)464 * MiB))[o] = acc[i][j][r];
#endif
                    const float y = (acc[i][j][r] + Dh * bf2f(XS[o])) * siluf(bf2f(Z[o])); acc[i][j][r] = y; ss += y * y; }
                ss += __shfl_xor(ss, 1); ss += __shfl_xor(ss, 2); ss += __shfl_xor(ss, 4); ss += __shfl_xor(ss, 8);
                if (fr == 0) SSW[w * 64 + t] = ss; }
        __syncthreads();
#pragma unroll
        for (int i = 0; i < 4; ++i)
#pragma unroll
            for (int r = 0; r < 4; ++r) { const int t = 16 * i + 4 * fq + r; float ss = 0.f;
#pragma unroll
                for (int ww = 0; ww < 8; ++ww) ss += SSW[ww * 64 + t];
                const float rstd = 1.f / sqrtf(ss * (1.f / 512.f) + EPS);
#pragma unroll
                for (int j = 0; j < 4; ++j) { const int ch = 64 * h + 16 * j + fr; MIX[(size_t)(t0 + t) * DM + ch] = f2bf(acc[i][j][r] * rstd * a->ssd_norm_w[ch]); } }
        __syncthreads();
    }
}

__device__ __forceinline__ void phase_attn(ArgsP a, LAS unsigned char* lds, const int tidx) {
    const int tid0 = tidx, w = __builtin_amdgcn_readfirstlane(tid0 >> 6);
    const bf16* Q = (const bf16*)(a->ws + WS_Q); const bf16* K = (const bf16*)(a->ws + WS_K); const bf16* V = (const bf16*)(a->ws + WS_V); const float* CL = (const float*)(a->ws + WS_CUMF);
    bf16* MIX = (bf16*)(a->ws + WS_MIX);
    LAS bf16* KS = (LAS bf16*)lds; LAS bf16* VT = (LAS bf16*)(lds + 9216); LAS float* CK = (LAS float*)(lds + 18432); LAS bf16* PS = (LAS bf16*)(lds + 18688 + w * 2304);
    const int G = gridDim.x;
    for (int i = 0;; ++i) {
        const int uidx = i * G + (int)blockIdx.x; if (uidx >= 2048) break;
        const int tid = opaque(tid0), lane = tid & 63, fr = lane & 15, fq = lane >> 4;
        const int slot = uidx >> 8, pos = uidx & 255, grp = pos >> 4, h = pos & 15;
        const int rnk = 16 * slot + ((slot & 1) ? 15 - grp : grp);
        const int qb = 127 - rnk;
        const int q0 = qb * 128 + 16 * w;
        const bf16x8 qf0 = *(const bf16x8*)(Q + (size_t)(q0 + fr) * 1024 + 64 * h + 8 * fq), qf1 = *(const bf16x8*)(Q + (size_t)(q0 + fr) * 1024 + 64 * h + 8 * fq + 32);
        float cq[4], mrun[4], lrun[4]; f32x4 o[4];
#pragma unroll
        for (int r = 0; r < 4; ++r) { cq[r] = CL[(size_t)h * M + q0 + 4 * fq + r]; mrun[r] = -3.0e38f; lrun[r] = 0.f; }
#pragma unroll
        for (int d = 0; d < 4; ++d) o[d] = (f32x4){0.f, 0.f, 0.f, 0.f};
        const int ntile = 2 * qb + 2;
        for (int kt = 0; kt < ntile; ++kt) {
            const int k0 = kt * 64;
            { const int row = tid >> 3, c16 = tid & 7; *(LAS u32x4*)(KS + row * 72 + c16 * 8) = *(const u32x4*)(K + (size_t)(k0 + row) * 1024 + 64 * h + c16 * 8);
              const int d = tid & 63, kb = tid >> 6; unsigned pk[4];
#pragma unroll
              for (int j = 0; j < 8; j += 2) { const unsigned lo = V[(size_t)(k0 + 8 * kb + j) * 1024 + 64 * h + d], hi = V[(size_t)(k0 + 8 * kb + j + 1) * 1024 + 64 * h + d]; pk[j >> 1] = lo | (hi << 16); }
              *(LAS u32x4*)(VT + d * 72 + 8 * kb) = (u32x4){pk[0], pk[1], pk[2], pk[3]};
              if (tid < 64) CK[tid] = CL[(size_t)h * M + k0 + tid]; }
            __syncthreads();
            f32x4 s[4];
#pragma unroll
            for (int nt = 0; nt < 4; ++nt) { s[nt] = (f32x4){0.f, 0.f, 0.f, 0.f};
                s[nt] = mfma16(qf0, *(const LAS bf16x8*)(KS + (16 * nt + fr) * 72 + 8 * fq), s[nt]);
                s[nt] = mfma16(qf1, *(const LAS bf16x8*)(KS + (16 * nt + fr) * 72 + 8 * fq + 32), s[nt]); }
            float mx[4];
#pragma unroll
            for (int r = 0; r < 4; ++r) { const int qg = q0 + 4 * fq + r; float m = -INFINITY;
#pragma unroll
                for (int nt = 0; nt < 4; ++nt) { const int kg = k0 + 16 * nt + fr; float v = s[nt][r] + (cq[r] - CK[16 * nt + fr]); v = kg > qg ? -INFINITY : v; s[nt][r] = v; m = fmaxf(m, v); }
                m = fmaxf(m, __shfl_xor(m, 1)); m = fmaxf(m, __shfl_xor(m, 2)); m = fmaxf(m, __shfl_xor(m, 4)); m = fmaxf(m, __shfl_xor(m, 8)); mx[r] = m; }
#pragma unroll
            for (int r = 0; r < 4; ++r) { const float mn = fmaxf(mrun[r], mx[r]); const float al = exp2f(mrun[r] - mn); mrun[r] = mn; float ps = 0.f;
#pragma unroll
                for (int nt = 0; nt < 4; ++nt) { const float p = exp2f(s[nt][r] - mn); ps += p; PS[(4 * fq + r) * 72 + 16 * nt + fr] = f2bf(p); }
                lrun[r] = lrun[r] * al + ps;
#pragma unroll
                for (int d = 0; d < 4; ++d) o[d][r] *= al; }
            asm volatile("s_waitcnt lgkmcnt(0)" ::: "memory");
            const bf16x8 pf0 = *(const LAS bf16x8*)(PS + fr * 72 + 8 * fq), pf1 = *(const LAS bf16x8*)(PS + fr * 72 + 8 * fq + 32);
#pragma unroll
            for (int d = 0; d < 4; ++d) { o[d] = mfma16(pf0, *(const LAS bf16x8*)(VT + (16 * d + fr) * 72 + 8 * fq), o[d]); o[d] = mfma16(pf1, *(const LAS bf16x8*)(VT + (16 * d + fr) * 72 + 8 * fq + 32), o[d]); }
            __syncthreads();
        }
#pragma unroll
        for (int r = 0; r < 4; ++r) { float l = lrun[r]; l += __shfl_xor(l, 1); l += __shfl_xor(l, 2); l += __shfl_xor(l, 4); l += __shfl_xor(l, 8); const float il = 1.f / l;
#pragma unroll
            for (int d = 0; d < 4; ++d) MIX[(size_t)(q0 + 4 * fq + r) * DM + 1024 + 64 * h + 16 * d + fr] = f2bf(o[d][r] * il); }
    }
}
constexpr size_t WS_U8 = 400 * MiB, WS_V8 = 432 * MiB;
constexpr size_t WS_USC = WS_K12 + 512 * 1024, WS_VSC = WS_K12 + 576 * 1024;
__device__ __forceinline__ void convert_uv_fp8_item(ArgsP a, const int tidx, const int item) {
    const int lane = tidx & 63, w = tidx >> 6;
    unsigned char* U8 = (unsigned char*)(a->ws + WS_U8); unsigned char* V8 = (unsigned char*)(a->ws + WS_V8);
    for (int row0 = 32 * item + 4 * w; row0 < 32 * item + 4 * w + 4; row0 += 2) {
        f32x4 x[2][8]; float mx[2] = {0.f, 0.f};
#pragma unroll
        for (int q = 0; q < 2; ++q) { const int row = row0 + q; const bool second = row >= 16384; const int e = row & 16383; const f32x4* src = (const f32x4*)((second ? a->peer_v : a->peer_u) + (size_t)e * DM) + lane;
#pragma unroll
            for (int j = 0; j < 8; ++j) x[q][j] = src[64 * j]; }
#pragma unroll
        for (int q = 0; q < 2; ++q) { const int row = row0 + q; const bool second = row >= 16384; const int e = row & 16383; unsigned char* dst = second ? V8 : U8;
#pragma unroll
            for (int j = 0; j < 8; ++j) mx[q] = fmaxf(mx[q], fmaxf(fmaxf(fabsf(x[q][j][0]), fabsf(x[q][j][1])), fmaxf(fabsf(x[q][j][2]), fabsf(x[q][j][3]))));
            const float mxa = wave_max(mx[q]); const float sc = mxa > 0.f ? 440.f / mxa : 1.f;
            if (lane == 0) ((float*)(a->ws + (second ? WS_VSC : WS_USC)))[e] = 1.f / sc;
#pragma unroll
            for (int j = 0; j < 8; ++j) { const int s = 2 * j + (lane >> 5); int p = __builtin_amdgcn_cvt_pk_fp8_f32(x[q][j][0] * sc, x[q][j][1] * sc, 0, false); p = __builtin_amdgcn_cvt_pk_fp8_f32(x[q][j][2] * sc, x[q][j][3] * sc, p, true);
                *(int*)(dst + ((size_t)s * 16384 + e) * 128 + 4 * (lane & 31)) = p; } } }
}
namespace attn_body {
using bf16=unsigned short;
using bf16x8=__attribute__((ext_vector_type(8)))short;
using s16x4=__attribute__((ext_vector_type(4)))short;
using f32x16=__attribute__((ext_vector_type(16)))float;
using u32x4=__attribute__((ext_vector_type(4)))unsigned;
constexpr int BATCH=1,NHEAD=16,SEQ=16384,D=64,DM=NHEAD*D,OPITCH=2048,OCOL=1024;
constexpr int NW=8,QBLK=32,QB=QBLK*NW,KVBLK=64,NQB=SEQ/QB;
constexpr int ATTN_PITCH=DM, ATTN_UNIT_ROWS=QB;
__device__ __forceinline__ int crow(int r,int hi){return (r&3)+8*(r>>2)+4*hi;}
#define SBAR() __builtin_amdgcn_sched_barrier(0)
__device__ __forceinline__ void cmask(f32x16&p0,f32x16&p1,int jb,int qrel,int hi){
  const float NEG=-INFINITY; int kb=64*jb+4*hi;
  #pragma unroll
  for(int r=0;r<16;++r){int kv=kb+(r&3)+8*(r>>2); if(kv>qrel)p0[r]=NEG; if(kv+32>qrel)p1[r]=NEG;}
}

constexpr int NSLOT=3, SLOTB=8192;
constexpr int LDS_K=0, LDS_V=NSLOT*SLOTB, LDS_WS=2*NSLOT*SLOTB, LDS_OST=LDS_WS+NW*64*4, LDS_CL=LDS_OST+NW*4096, LDS_BYTES=LDS_CL+SEQ*4;
constexpr float C2=0.125f*1.4426950408889634f;
__device__ __forceinline__ void glds16(const void*gsrc,unsigned lds_dst){unsigned keep;
  asm volatile("s_mov_b32 %0, m0\n\ts_mov_b32 m0, %2\n\ts_nop 0\n\tglobal_load_lds_dwordx4 %1, off\n\ts_mov_b32 m0, %0":"=&s"(keep):"v"(gsrc),"s"(lds_dst):"memory");}
__device__ __forceinline__ float max3f(float a,float b,float c){float r;asm("v_max3_f32 %0, %1, %2, %3":"=v"(r):"v"(a),"v"(b),"v"(c));return r;}
__device__ __forceinline__ float max2f(float a,float b){float r;asm("v_max_f32_e32 %0, %1, %2":"=v"(r):"v"(a),"v"(b));return r;}
__device__ __forceinline__ float fadd_s(float a,float b){float r;asm("v_add_f32_e32 %0, %1, %2":"=v"(r):"v"(a),"v"(b));return r;}
__device__ __forceinline__ float fsub_s(float a,float b){float r;asm("v_sub_f32_e32 %0, %1, %2":"=v"(r):"v"(a),"v"(b));return r;}
typedef float f32x2_t __attribute__((ext_vector_type(2))); typedef float f32x4_t __attribute__((ext_vector_type(4))); typedef __bf16 bf16x2_t __attribute__((ext_vector_type(2)));
__device__ __forceinline__ unsigned cvtpk_s(float lo,float hi){f32x2_t v={lo,hi};bf16x2_t b=__builtin_convertvector(v,bf16x2_t);return __builtin_bit_cast(unsigned,b);}
#define WAIT_BAR(N) asm volatile("s_waitcnt vmcnt(" #N ") lgkmcnt(0)\n\ts_barrier":::"memory")

__device__ __forceinline__ void qkt(f32x16&p0,f32x16&p1,const char*Kslot,const bf16x8*qr,const f32x16&i0,const f32x16&i1,int r32,int hi){
  const char*kb=Kslot+hi*1024+r32*16;
  #pragma unroll
  for(int d0=0;d0<4;++d0){
    const bf16x8 b0=*reinterpret_cast<const bf16x8*>(kb+d0*2048);
    const bf16x8 b1=*reinterpret_cast<const bf16x8*>(kb+d0*2048+512);
    if(d0==0){p0=__builtin_amdgcn_mfma_f32_32x32x16_bf16(b0,qr[0],i0,0,0,0);p1=__builtin_amdgcn_mfma_f32_32x32x16_bf16(b1,qr[0],i1,0,0,0);}
    else{p0=__builtin_amdgcn_mfma_f32_32x32x16_bf16(b0,qr[d0],p0,0,0,0);p1=__builtin_amdgcn_mfma_f32_32x32x16_bf16(b1,qr[d0],p1,0,0,0);}}
}
typedef __attribute__((address_space(3))) const char* lds_cptr;
typedef short v4i16_t __attribute__((ext_vector_type(4)));
__device__ __forceinline__ void kload8(bf16x8*kf,lds_cptr kp){
  kf[0]=*(const __attribute__((address_space(3))) bf16x8*)(kp);      kf[1]=*(const __attribute__((address_space(3))) bf16x8*)(kp+512);
  kf[2]=*(const __attribute__((address_space(3))) bf16x8*)(kp+2048); kf[3]=*(const __attribute__((address_space(3))) bf16x8*)(kp+2560);
  kf[4]=*(const __attribute__((address_space(3))) bf16x8*)(kp+4096); kf[5]=*(const __attribute__((address_space(3))) bf16x8*)(kp+4608);
  kf[6]=*(const __attribute__((address_space(3))) bf16x8*)(kp+6144); kf[7]=*(const __attribute__((address_space(3))) bf16x8*)(kp+6656);
}
__device__ __forceinline__ void kload2(bf16x8*kf,lds_cptr kp,int j){ kf[2*j]=*(const __attribute__((address_space(3))) bf16x8*)(kp+j*2048); kf[2*j+1]=*(const __attribute__((address_space(3))) bf16x8*)(kp+j*2048+512); }
__device__ __forceinline__ s16x4 vtr(lds_cptr p){ return __builtin_bit_cast(s16x4,__builtin_amdgcn_ds_read_tr16_b64_v4i16((__attribute__((address_space(3))) v4i16_t*)p)); }
__device__ __forceinline__ float rowmax(const f32x16&p0,const f32x16&p1){
  float a=max3f(p0[0],p0[1],p1[0]),b=max3f(p0[2],p0[3],p1[1]);a=max3f(a,p1[2],p1[3]);
  #pragma unroll
  for(int r=4;r<16;r+=4){a=max3f(a,p0[r],p0[r+1]);b=max3f(b,p0[r+2],p0[r+3]);a=max3f(a,p1[r],p1[r+1]);b=max3f(b,p1[r+2],p1[r+3]);}
  const float m=max2f(a,b);
  auto rr=__builtin_amdgcn_permlane32_swap(__float_as_uint(m),__float_as_uint(m),false,false);
  return max2f(__uint_as_float(rr[0]),__uint_as_float(rr[1]));
}
__device__ __forceinline__ void pv(f32x16*o,int vb,bf16x8 pa0,bf16x8 pa1,bf16x8 pa2,bf16x8 pa3){
  #pragma unroll
  for(int d0=0;d0<2;++d0){s16x4 lo[4],hi[4];
    #pragma unroll
    for(int ks=0;ks<4;++ks){
      asm volatile("ds_read_b64_tr_b16 %0,%1 offset:%c2":"=&v"(lo[ks]):"v"(vb),"i"(d0*4096+ks*1024):"memory");
      asm volatile("ds_read_b64_tr_b16 %0,%1 offset:%c2":"=&v"(hi[ks]):"v"(vb),"i"(d0*4096+ks*1024+512):"memory");}
    asm volatile("s_waitcnt lgkmcnt(0)":::"memory");SBAR();
    #define PK(k) (bf16x8){lo[k][0],lo[k][1],lo[k][2],lo[k][3],hi[k][0],hi[k][1],hi[k][2],hi[k][3]}
    o[d0]=__builtin_amdgcn_mfma_f32_32x32x16_bf16(pa0,PK(0),o[d0],0,0,0);
    o[d0]=__builtin_amdgcn_mfma_f32_32x32x16_bf16(pa1,PK(1),o[d0],0,0,0);
    o[d0]=__builtin_amdgcn_mfma_f32_32x32x16_bf16(pa2,PK(2),o[d0],0,0,0);
    o[d0]=__builtin_amdgcn_mfma_f32_32x32x16_bf16(pa3,PK(3),o[d0],0,0,0);
    #undef PK
  }
}

#ifndef ATTN_STORE16
#define ATTN_STORE16(p,v) (*(u32x4*)(p)=(v))
#endif
template<int THRL> __device__ __forceinline__ void attn_unit(int b,int h,int qb,const bf16*Q,const bf16*__restrict__ K,const bf16*__restrict__ V,bf16*O,const float*__restrict__ CLh,const float*__restrict__ QN2h,const float*__restrict__ KN2h,char*shm,const int tid_in){
  const int tid=tid_in,lane=tid&63,r32=lane&31,hi=lane>>5; const int wid=__builtin_amdgcn_readfirstlane(tid>>6);
  const long rowbase=(long)b*SEQ; const int q0=qb*QB;
  const bf16*Qw=Q+(rowbase+q0+wid*QBLK)*DM+h*D;
  int Ts;
  { const int NT0=(q0+QB)/KVBLK; float kn=0.f;
    _Pragma("unroll") for(int j=0;j<4;++j){ const int c=lane+64*j; if(c<NT0)kn=__builtin_fmaxf(kn,KN2h[c]); }
    kn=wave_max(kn);
    const float qn=__builtin_fmaxf(__builtin_fmaxf(QN2h[4*qb],QN2h[4*qb+1]),__builtin_fmaxf(QN2h[4*qb+2],QN2h[4*qb+3]));
    const float b2=2.f*__builtin_sqrtf(qn*kn), clq0=CLh[q0]; int cnt=0;
    _Pragma("unroll") for(int j=0;j<4;++j){ const int Tt=lane+64*j; const bool sk=(Tt<NT0)&&(clq0-CLh[Tt<NT0?64*Tt+63:0]+b2<-160.f); cnt+=__builtin_popcountll(__ballot(sk)); }
    Ts=cnt&~1; if(Ts>NT0-4)Ts=NT0-4; Ts=__builtin_amdgcn_readfirstlane(Ts); }
  const bf16*Kh=K+(rowbase+(long)Ts*KVBLK)*DM+h*D,*Vh=V+(rowbase+(long)Ts*KVBLK)*DM+h*D;
  const lds_cptr shm3=(lds_cptr)shm;
  const unsigned lds0=(unsigned)(uintptr_t)shm;
  float*wsf=(float*)(shm+LDS_WS)+wid*64;
  const bf16*ksrc=Kh+(long)lane*DM+wid*8;
  const bf16*vsrc=Vh+(long)(16*(wid&3)+(lane>>2))*DM+(wid>>2)*32+(lane&3)*8;
  const unsigned kdst=lds0+LDS_K+wid*1024, vdst=lds0+LDS_V+wid*1024;
  #define DMA_K(t,slot) glds16(ksrc+(long)(t)*KVBLK*DM,(unsigned)__builtin_amdgcn_readfirstlane(kdst+(slot)))
  #define DMA_V(t,slot) glds16(vsrc+(long)(t)*KVBLK*DM,(unsigned)__builtin_amdgcn_readfirstlane(vdst+(slot)))
  const int vb0=(int)(lds0+LDS_V)+((lane>>4)&1)*32+(lane&3)*8+(4*hi+((lane&15)>>2))*64;
  const char*Kbase=shm+LDS_K; bf16x8 kf[8];
  const lds_cptr kp0=shm3+LDS_K+hi*1024+r32*16; const lds_cptr vp0=shm3+LDS_V+((lane>>4)&1)*32+(lane&3)*8+(4*hi+((lane&15)>>2))*64;
  const int NT=(q0+QB)/KVBLK-Ts;
  typedef __attribute__((address_space(3))) float* lds_fptr; typedef __attribute__((address_space(3))) const f32x4_t* lds_f4ptr;
  { typedef __attribute__((address_space(3))) f32x4_t* lds_f4w; lds_f4w clw=(lds_f4w)(shm3+LDS_CL); const f32x4_t*cls=(const f32x4_t*)(CLh+Ts*KVBLK); const int ncl4=(q0+QB-Ts*KVBLK)>>2; _Pragma("nounroll") for(int i=tid;i<ncl4;i+=NW*64)clw[i]=cls[i]; }
  const lds_f4ptr clp=(lds_f4ptr)(shm3+LDS_CL+16*hi);
  float nb=CLh[q0+wid*QBLK+r32];
  #define CKLOAD(X0,X1,t) do{ const lds_f4ptr cb_=clp+(t)*16; \
    _Pragma("unroll") for(int g_=0;g_<4;++g_){ const f32x4_t a_=cb_[2*g_], b_=cb_[8+2*g_]; \
      _Pragma("unroll") for(int i_=0;i_<4;++i_){ X0[4*g_+i_]=a_[i_]; X1[4*g_+i_]=b_[i_]; } } }while(0)
  #define BIASSUB(C0,C1) do{ _Pragma("unroll") for(int r_=0;r_<16;++r_){ C0[r_]=nb-C0[r_]; C1[r_]=nb-C1[r_]; } }while(0)
  DMA_K(0,0);DMA_V(0,0);DMA_K(1,SLOTB);
  bf16x8 qr[4];
  #pragma unroll
  for(int d0=0;d0<4;++d0)qr[d0]=*reinterpret_cast<const bf16x8*>(&Qw[(long)r32*DM+d0*16+hi*8]);
  float l_reg=0.f;f32x16 o[2];o[0]=f32x16{};o[1]=f32x16{};
  const int qrel=wid*QBLK+r32;
  #define CMASK(P0,P1,t) do{int jb_=(t)-(NT-4); if(jb_>=0)cmask(P0,P1,jb_,qrel,hi);}while(0)
  bool resc=false;
  #define START(P0,P1) do{ const float rm=rowmax(P0,P1); resc=false; \
    { const float dl=rm; nb=fsub_s(nb,dl); \
      _Pragma("unroll") for(int r=0;r<16;++r){P0[r]=fsub_s(P0[r],dl);P1[r]=fsub_s(P1[r],dl);} } \
    _Pragma("unroll") for(int r=0;r<16;++r)P0[r]=__builtin_amdgcn_exp2f(P0[r]); }while(0)
  #define RESC() do{ if(resc){ asm volatile("s_waitcnt lgkmcnt(0)":::"memory"); \
      _Pragma("unroll") for(int d_=0;d_<2;++d_) _Pragma("unroll") for(int r=0;r<16;++r)o[d_][r]*=wsf[crow(r,hi)]; } }while(0)
  f32x16 pA0,pA1,pB0,pB1;
  int sl_prev=0,sl_cur=0,sl_next=SLOTB;
  #define ROT() do{sl_prev=sl_cur;sl_cur=sl_next;sl_next=(sl_next==(NSLOT-1)*SLOTB)?0:sl_next+SLOTB;}while(0)
  DMA_K(2,2*SLOTB);
  WAIT_BAR(3);
  CKLOAD(pA0,pA1,0); BIASSUB(pA0,pA1);
  qkt(pA0,pA1,Kbase,qr,pA0,pA1,r32,hi);asm volatile("s_nop 15\n\ts_nop 7":"+v"(pA0),"+v"(pA1));CMASK(pA0,pA1,0);
  START(pA0,pA1);
  _Pragma("unroll") for(int r=0;r<16;++r)pA1[r]=__builtin_amdgcn_exp2f(pA1[r]);
  WAIT_BAR(0);
  DMA_K(3,0);DMA_V(1,SLOTB);
  ROT();
  kload8(kf,kp0+sl_cur);
  WAIT_BAR(2);
  s16x4 vlo[8],vhi[8]; u32x4 pw0,pw1,pw2,pw3;
  #define PKW(P,B) cvtpk_s(P[B],P[B+1])
  #define PAF(k) __builtin_bit_cast(bf16x8,pw##k)
  #define VFR(i) (bf16x8){vlo[i][0],vlo[i][1],vlo[i][2],vlo[i][3],vhi[i][0],vhi[i][1],vhi[i][2],vhi[i][3]}
  #define PIN(x) asm volatile("":"+v"(x))
  #define MX3(a,b,c) __builtin_fmaxf(__builtin_fmaxf((a),(b)),(c))
  #define GAPA(MF,A0,A1,A2,A3,W0,W1,PW) do{ MF; sacc+=A0; sacc+=A1; sacc+=A2; sacc+=A3; PIN(sacc); W0; W1; PIN(PW); SBAR(); }while(0)
  #define EX(v) __builtin_amdgcn_exp2f(v)
  #define GAPB(MF,X,B) do{ MF; X[B]=EX(X[B]); X[B+1]=EX(X[B+1]); X[B+2]=EX(X[B+2]); X[B+3]=EX(X[B+3]); PIN(X); SBAR(); }while(0)
  #define VRD(i) do{ vlo[i]=vtr(vp_+(((i)>>2)*4096+((i)&3)*1024)); vhi[i]=vtr(vp_+(((i)>>2)*4096+((i)&3)*1024+512)); }while(0)
  #define KRD(G,j) do{ if(G){ kload2(kf,kp0+sl_next,j); SBAR(); } }while(0)
  #define STEP(C0,C1,P0,P1,t,GK,GV,GL) do{ CKLOAD(C0,C1,t); asm volatile("":"+v"(C0),"+v"(C1)); BIASSUB(C0,C1); SBAR(); \
    const lds_cptr vp_=vp0+sl_prev; \
    VRD(0); SBAR(); float sacc=(P0[0]+P0[1]); \
    GAPA(C0=__builtin_amdgcn_mfma_f32_32x32x16_bf16(kf[0],qr[0],C0,0,0,0), P0[2],P0[3],P0[4],P0[5],     pw0[0]=PKW(P0,0), pw0[1]=PKW(P0,2), pw0); \
    VRD(4); SBAR(); GAPA(C1=__builtin_amdgcn_mfma_f32_32x32x16_bf16(kf[1],qr[0],C1,0,0,0), P0[6],P0[7],P0[8],P0[9],     pw0[2]=PKW(P0,4), pw0[3]=PKW(P0,6), pw0); \
    VRD(1); SBAR(); GAPA(C0=__builtin_amdgcn_mfma_f32_32x32x16_bf16(kf[2],qr[1],C0,0,0,0),   P0[10],P0[11],P0[12],P0[13], pw1[0]=PKW(P0,8), pw1[1]=PKW(P0,10), pw1); \
    VRD(5); SBAR(); GAPA(C1=__builtin_amdgcn_mfma_f32_32x32x16_bf16(kf[3],qr[1],C1,0,0,0),   P0[14],P0[15],P1[0],P1[1],   pw1[2]=PKW(P0,12),pw1[3]=PKW(P0,14), pw1); \
    VRD(2); SBAR(); GAPA(C0=__builtin_amdgcn_mfma_f32_32x32x16_bf16(kf[4],qr[2],C0,0,0,0),   P1[2],P1[3],P1[4],P1[5],     pw2[0]=PKW(P1,0), pw2[1]=PKW(P1,2), pw2); \
    VRD(6); SBAR(); GAPA(C1=__builtin_amdgcn_mfma_f32_32x32x16_bf16(kf[5],qr[2],C1,0,0,0),   P1[6],P1[7],P1[8],P1[9],     pw2[2]=PKW(P1,4), pw2[3]=PKW(P1,6), pw2); \
    VRD(3); SBAR(); GAPA(C0=__builtin_amdgcn_mfma_f32_32x32x16_bf16(kf[6],qr[3],C0,0,0,0),   P1[10],P1[11],P1[12],P1[13], pw3[0]=PKW(P1,8), pw3[1]=PKW(P1,10), pw3); \
    VRD(7); SBAR(); GAPA(C1=__builtin_amdgcn_mfma_f32_32x32x16_bf16(kf[7],qr[3],C1,0,0,0),   P1[14],P1[15],0.f,0.f,       pw3[2]=PKW(P1,12),pw3[3]=PKW(P1,14), pw3); \
    l_reg+=sacc; \
    if(GK){DMA_K((t)+3,sl_cur);} if(GV){DMA_V((t)+1,sl_next);} \
    CMASK(C0,C1,t); \
    { float a=MX3(C0[0],C0[1],C1[0]),b=MX3(C0[2],C0[3],C1[1]); a=MX3(a,C1[2],C1[3]); \
      _Pragma("unroll") for(int r=4;r<16;r+=4){a=MX3(a,C0[r],C0[r+1]);b=MX3(b,C0[r+2],C0[r+3]);a=MX3(a,C1[r],C1[r+1]);b=MX3(b,C1[r+2],C1[r+3]);} \
      float rm=__builtin_fmaxf(a,b); { auto rr=__builtin_amdgcn_permlane32_swap(__float_as_uint(rm),__float_as_uint(rm),false,false); rm=__builtin_fmaxf(__uint_as_float(rr[0]),__uint_as_float(rr[1])); } \
      resc=false; \
      if(__builtin_expect(__any(rm>(float)THRL),0)){ const float dl=__builtin_fmaxf(rm,0.f); nb-=dl; \
        _Pragma("unroll") for(int r=0;r<16;++r){C0[r]-=dl;C1[r]-=dl;} \
        const float f=__builtin_amdgcn_exp2f(-dl); l_reg*=f; if(hi==0)wsf[r32]=f; resc=true; } } \
    SBAR(); \
    GAPB(o[0]=__builtin_amdgcn_mfma_f32_32x32x16_bf16(PAF(0),VFR(0),o[0],0,0,0), C0,0); \
    GAPB(o[1]=__builtin_amdgcn_mfma_f32_32x32x16_bf16(PAF(0),VFR(4),o[1],0,0,0), C0,4); \
    KRD(GL,0); GAPB(o[0]=__builtin_amdgcn_mfma_f32_32x32x16_bf16(PAF(1),VFR(1),o[0],0,0,0), C0,8); \
    KRD(GL,1); GAPB(o[1]=__builtin_amdgcn_mfma_f32_32x32x16_bf16(PAF(1),VFR(5),o[1],0,0,0), C0,12); \
    KRD(GL,2); GAPB(o[0]=__builtin_amdgcn_mfma_f32_32x32x16_bf16(PAF(2),VFR(2),o[0],0,0,0), C1,0); \
    KRD(GL,3); GAPB(o[1]=__builtin_amdgcn_mfma_f32_32x32x16_bf16(PAF(2),VFR(6),o[1],0,0,0), C1,4); \
    GAPB(o[0]=__builtin_amdgcn_mfma_f32_32x32x16_bf16(PAF(3),VFR(3),o[0],0,0,0), C1,8); \
    GAPB(o[1]=__builtin_amdgcn_mfma_f32_32x32x16_bf16(PAF(3),VFR(7),o[1],0,0,0), C1,12); \
    }while(0)
  int t=1;
  #undef CMASK
  #define CMASK(P0,P1,t) do{}while(0)
  for(;t+5<NT;t+=2){
    STEP(pB0,pB1,pA0,pA1,t,true,true,true);     WAIT_BAR(2); RESC(); ROT();
    STEP(pA0,pA1,pB0,pB1,t+1,true,true,true);   WAIT_BAR(2); RESC(); ROT();
  }
  #undef CMASK
  #define CMASK(P0,P1,t) do{int jb_=(t)-(NT-4); if(jb_>=0)cmask(P0,P1,jb_,qrel,hi);}while(0)
  #define ENDW(tt) do{ if((tt)+3<NT){WAIT_BAR(2);} else if((tt)+2<NT){WAIT_BAR(1);} else {WAIT_BAR(0);} }while(0)
  for(;t+1<NT;t+=2){
    STEP(pB0,pB1,pA0,pA1,t,(t+3<NT),(t+1<NT),(t+1<NT));       ENDW(t);   RESC(); ROT();
    STEP(pA0,pA1,pB0,pB1,t+1,(t+4<NT),(t+2<NT),(t+2<NT));     ENDW(t+1); RESC(); ROT();
  }
  STEP(pB0,pB1,pA0,pA1,NT-1,false,false,false); RESC();
  { float sacc=pB0[0]+pB0[1]; _Pragma("unroll") for(int r=2;r<16;++r)sacc+=pB0[r]; _Pragma("unroll") for(int r=0;r<16;++r)sacc+=pB1[r]; l_reg+=sacc;
    pw0=(u32x4){PKW(pB0,0),PKW(pB0,2),PKW(pB0,4),PKW(pB0,6)};pw1=(u32x4){PKW(pB0,8),PKW(pB0,10),PKW(pB0,12),PKW(pB0,14)};pw2=(u32x4){PKW(pB1,0),PKW(pB1,2),PKW(pB1,4),PKW(pB1,6)};pw3=(u32x4){PKW(pB1,8),PKW(pB1,10),PKW(pB1,12),PKW(pB1,14)};
    SBAR(); pv(o,vb0+sl_cur,PAF(0),PAF(1),PAF(2),PAF(3)); }
  #undef PKW
  #undef PAF
  #undef VFR
  #undef PIN
  #undef MX3
  #undef GAPA
  #undef GAPB
  #undef EX
  #undef VRD
  #undef KRD
  #undef STEP
  #undef ENDW
  {auto rr=__builtin_amdgcn_permlane32_swap(__float_as_uint(l_reg),__float_as_uint(l_reg),false,false);l_reg=__uint_as_float(rr[0])+__uint_as_float(rr[1]);}
  if(hi==0)wsf[32+r32]=l_reg;asm volatile("s_waitcnt lgkmcnt(0)":::"memory");
  float rli[16];
  #pragma unroll
  for(int r=0;r<16;++r)rli[r]=__builtin_amdgcn_rcpf(wsf[32+crow(r,hi)]);
  bf16*Ow=O+(rowbase+q0+wid*QBLK)*OPITCH+OCOL+h*D;
  { bf16*stg=(bf16*)(shm+LDS_OST)+wid*2048;
    #pragma unroll
    for(int r=0;r<16;++r){const int orow=crow(r,hi);
      #pragma unroll
      for(int d0=0;d0<2;++d0)stg[orow*64+d0*32+r32]=(bf16)(cvtpk_s(o[d0][r]*rli[r],0.f)&0xffffu);}
    asm volatile("s_waitcnt lgkmcnt(0)":::"memory");
    #pragma unroll
    for(int i=0;i<4;++i){const int row=i*8+(lane>>3),ch=lane&7; const u32x4 v=*(const u32x4*)(stg+row*64+ch*8); ATTN_STORE16(Ow+(long)row*OPITCH+ch*8,v);} }
  asm volatile("s_waitcnt lgkmcnt(0)\n\ts_barrier":::"memory");
  #undef CKLOAD
  #undef BIASSUB
  #undef DMA_K
  #undef DMA_V
  #undef CMASK
  #undef START
  #undef RESC
  #undef ROT
}
constexpr int ATTN_LDS_BYTES=LDS_BYTES;
struct AttnTensors { const bf16* Q; const bf16* K; const bf16* V; bf16* O; const float* CL; const float* QN2; const float* KN2; };
struct AttnUnit { int bh; int qb; };
struct StaticOrder {
  int vcu, G;
  __device__ __forceinline__ explicit StaticOrder(int grid,int block):vcu((grid%8==0)?(block%8)*(grid/8)+block/8:block),G(grid){}
  __device__ __forceinline__ bool next(int i,AttnUnit&u)const{ const int L=i*G+vcu; if(L>=1024)return false; const int slot=L>>8,pos=L&255,s=pos&15; u.bh=pos>>4; u.qb=(slot==0)?s:(slot==1)?31-s:(slot==2)?32+s:63-s; return true; }
  __device__ __forceinline__ void a_ready(const AttnUnit&)const{}
  __device__ __forceinline__ void done(const AttnUnit&)const{}
};
template<int THRL=8> __device__ __forceinline__ void attn_phase(char*lds,const AttnTensors&T,unsigned*heads,const int myx,const int tid_in,ArgsP ap){
  int probe=7; volatile __attribute__((address_space(3))) int*bc=(volatile __attribute__((address_space(3))) int*)((__attribute__((address_space(3))) char*)lds+LDS_BYTES+64);
  for(;;){ const int item=peer_next_item(heads,1,probe,3072u,bc,tid_in); if(item<0)break;
    const int it3=item%3072,v=it3/3,ty=it3-3*v;
    if(ty==1){ convert_uv_fp8_item(ap,opaque(tid_in),v); continue; }
    if(ty==2){ if(v<512)transpose_filler_item(ap,(__attribute__((address_space(3))) unsigned char*)lds,opaque(tid_in),v); continue; }
    const int h=15-(v&15),qb=63-(v>>4);
    attn_unit<THRL>(0,h,qb,T.Q,T.K,T.V,T.O,T.CL+(long)h*SEQ,T.QN2+h*256,T.KN2+h*256,lds,tid_in); }
}
#undef SBAR
#undef WAIT_BAR
}
__device__ __forceinline__ int topk_sortable(float f) { const int u = __float_as_int(f); return u ^ ((u >> 31) & 0x7fffffff); }
__device__ __forceinline__ int topk_pack7(float f, int idx) { return (topk_sortable(f) & ~127) | (127 - idx); }
__device__ __forceinline__ void wave_imax2(int& a, int& b, int& sa, int& sb) {
    asm volatile("s_nop 1\n\t"
        "v_max_i32_dpp %0, %0, %0 row_shr:1 row_mask:0xf bank_mask:0xf\n\tv_max_i32_dpp %1, %1, %1 row_shr:1 row_mask:0xf bank_mask:0xf\n\ts_nop 0\n\t"
        "v_max_i32_dpp %0, %0, %0 row_shr:2 row_mask:0xf bank_mask:0xf\n\tv_max_i32_dpp %1, %1, %1 row_shr:2 row_mask:0xf bank_mask:0xf\n\ts_nop 0\n\t"
        "v_max_i32_dpp %0, %0, %0 row_shr:4 row_mask:0xf bank_mask:0xf\n\tv_max_i32_dpp %1, %1, %1 row_shr:4 row_mask:0xf bank_mask:0xf\n\ts_nop 0\n\t"
        "v_max_i32_dpp %0, %0, %0 row_shr:8 row_mask:0xf bank_mask:0xf\n\tv_max_i32_dpp %1, %1, %1 row_shr:8 row_mask:0xf bank_mask:0xf\n\ts_nop 0\n\t"
        "v_max_i32_dpp %0, %0, %0 row_bcast:15 row_mask:0xa bank_mask:0xf\n\tv_max_i32_dpp %1, %1, %1 row_bcast:15 row_mask:0xa bank_mask:0xf\n\ts_nop 0\n\t"
        "v_max_i32_dpp %0, %0, %0 row_bcast:31 row_mask:0xc bank_mask:0xf\n\tv_max_i32_dpp %1, %1, %1 row_bcast:31 row_mask:0xc bank_mask:0xf\n\ts_nop 1\n\t"
        "v_readlane_b32 %2, %0, 63\n\tv_readlane_b32 %3, %1, 63\n\ts_nop 3"
        : "+v"(a), "+v"(b), "=s"(sa), "=s"(sb));
}
__device__ __forceinline__ void wave_imax1(int& a, int& sa) {
    asm volatile("s_nop 1\n\t"
        "v_max_i32_dpp %0, %0, %0 row_shr:1 row_mask:0xf bank_mask:0xf\n\ts_nop 1\n\t"
        "v_max_i32_dpp %0, %0, %0 row_shr:2 row_mask:0xf bank_mask:0xf\n\ts_nop 1\n\t"
        "v_max_i32_dpp %0, %0, %0 row_shr:4 row_mask:0xf bank_mask:0xf\n\ts_nop 1\n\t"
        "v_max_i32_dpp %0, %0, %0 row_shr:8 row_mask:0xf bank_mask:0xf\n\ts_nop 1\n\t"
        "v_max_i32_dpp %0, %0, %0 row_bcast:15 row_mask:0xa bank_mask:0xf\n\ts_nop 1\n\t"
        "v_max_i32_dpp %0, %0, %0 row_bcast:31 row_mask:0xc bank_mask:0xf\n\ts_nop 1\n\t"
        "v_readlane_b32 %1, %0, 63\n\ts_nop 3"
        : "+v"(a), "=s"(sa));
}
__device__ __forceinline__ void wave_imax_x8(int (&k)[8], int (&s)[8]) {
    asm volatile("s_nop 1\n\t"
        "v_max_i32_dpp %0, %0, %0 row_shr:1 row_mask:0xf bank_mask:0xf\n\tv_max_i32_dpp %1, %1, %1 row_shr:1 row_mask:0xf bank_mask:0xf\n\tv_max_i32_dpp %2, %2, %2 row_shr:1 row_mask:0xf bank_mask:0xf\n\tv_max_i32_dpp %3, %3, %3 row_shr:1 row_mask:0xf bank_mask:0xf\n\tv_max_i32_dpp %4, %4, %4 row_shr:1 row_mask:0xf bank_mask:0xf\n\tv_max_i32_dpp %5, %5, %5 row_shr:1 row_mask:0xf bank_mask:0xf\n\tv_max_i32_dpp %6, %6, %6 row_shr:1 row_mask:0xf bank_mask:0xf\n\tv_max_i32_dpp %7, %7, %7 row_shr:1 row_mask:0xf bank_mask:0xf\n\t"
        "v_max_i32_dpp %0, %0, %0 row_shr:2 row_mask:0xf bank_mask:0xf\n\tv_max_i32_dpp %1, %1, %1 row_shr:2 row_mask:0xf bank_mask:0xf\n\tv_max_i32_dpp %2, %2, %2 row_shr:2 row_mask:0xf bank_mask:0xf\n\tv_max_i32_dpp %3, %3, %3 row_shr:2 row_mask:0xf bank_mask:0xf\n\tv_max_i32_dpp %4, %4, %4 row_shr:2 row_mask:0xf bank_mask:0xf\n\tv_max_i32_dpp %5, %5, %5 row_shr:2 row_mask:0xf bank_mask:0xf\n\tv_max_i32_dpp %6, %6, %6 row_shr:2 row_mask:0xf bank_mask:0xf\n\tv_max_i32_dpp %7, %7, %7 row_shr:2 row_mask:0xf bank_mask:0xf\n\t"
        "v_max_i32_dpp %0, %0, %0 row_shr:4 row_mask:0xf bank_mask:0xf\n\tv_max_i32_dpp %1, %1, %1 row_shr:4 row_mask:0xf bank_mask:0xf\n\tv_max_i32_dpp %2, %2, %2 row_shr:4 row_mask:0xf bank_mask:0xf\n\tv_max_i32_dpp %3, %3, %3 row_shr:4 row_mask:0xf bank_mask:0xf\n\tv_max_i32_dpp %4, %4, %4 row_shr:4 row_mask:0xf bank_mask:0xf\n\tv_max_i32_dpp %5, %5, %5 row_shr:4 row_mask:0xf bank_mask:0xf\n\tv_max_i32_dpp %6, %6, %6 row_shr:4 row_mask:0xf bank_mask:0xf\n\tv_max_i32_dpp %7, %7, %7 row_shr:4 row_mask:0xf bank_mask:0xf\n\t"
        "v_max_i32_dpp %0, %0, %0 row_shr:8 row_mask:0xf bank_mask:0xf\n\tv_max_i32_dpp %1, %1, %1 row_shr:8 row_mask:0xf bank_mask:0xf\n\tv_max_i32_dpp %2, %2, %2 row_shr:8 row_mask:0xf bank_mask:0xf\n\tv_max_i32_dpp %3, %3, %3 row_shr:8 row_mask:0xf bank_mask:0xf\n\tv_max_i32_dpp %4, %4, %4 row_shr:8 row_mask:0xf bank_mask:0xf\n\tv_max_i32_dpp %5, %5, %5 row_shr:8 row_mask:0xf bank_mask:0xf\n\tv_max_i32_dpp %6, %6, %6 row_shr:8 row_mask:0xf bank_mask:0xf\n\tv_max_i32_dpp %7, %7, %7 row_shr:8 row_mask:0xf bank_mask:0xf\n\t"
        "v_max_i32_dpp %0, %0, %0 row_bcast:15 row_mask:0xa bank_mask:0xf\n\tv_max_i32_dpp %1, %1, %1 row_bcast:15 row_mask:0xa bank_mask:0xf\n\tv_max_i32_dpp %2, %2, %2 row_bcast:15 row_mask:0xa bank_mask:0xf\n\tv_max_i32_dpp %3, %3, %3 row_bcast:15 row_mask:0xa bank_mask:0xf\n\tv_max_i32_dpp %4, %4, %4 row_bcast:15 row_mask:0xa bank_mask:0xf\n\tv_max_i32_dpp %5, %5, %5 row_bcast:15 row_mask:0xa bank_mask:0xf\n\tv_max_i32_dpp %6, %6, %6 row_bcast:15 row_mask:0xa bank_mask:0xf\n\tv_max_i32_dpp %7, %7, %7 row_bcast:15 row_mask:0xa bank_mask:0xf\n\t"
        "v_max_i32_dpp %0, %0, %0 row_bcast:31 row_mask:0xc bank_mask:0xf\n\tv_max_i32_dpp %1, %1, %1 row_bcast:31 row_mask:0xc bank_mask:0xf\n\tv_max_i32_dpp %2, %2, %2 row_bcast:31 row_mask:0xc bank_mask:0xf\n\tv_max_i32_dpp %3, %3, %3 row_bcast:31 row_mask:0xc bank_mask:0xf\n\tv_max_i32_dpp %4, %4, %4 row_bcast:31 row_mask:0xc bank_mask:0xf\n\tv_max_i32_dpp %5, %5, %5 row_bcast:31 row_mask:0xc bank_mask:0xf\n\tv_max_i32_dpp %6, %6, %6 row_bcast:31 row_mask:0xc bank_mask:0xf\n\tv_max_i32_dpp %7, %7, %7 row_bcast:31 row_mask:0xc bank_mask:0xf\n\t"
        "s_nop 1\n\tv_readlane_b32 %8, %0, 63\n\tv_readlane_b32 %9, %1, 63\n\tv_readlane_b32 %10, %2, 63\n\tv_readlane_b32 %11, %3, 63\n\tv_readlane_b32 %12, %4, 63\n\tv_readlane_b32 %13, %5, 63\n\tv_readlane_b32 %14, %6, 63\n\tv_readlane_b32 %15, %7, 63\n\ts_nop 3"
        : "+v"(k[0]), "+v"(k[1]), "+v"(k[2]), "+v"(k[3]), "+v"(k[4]), "+v"(k[5]), "+v"(k[6]), "+v"(k[7]), "=s"(s[0]), "=s"(s[1]), "=s"(s[2]), "=s"(s[3]), "=s"(s[4]), "=s"(s[5]), "=s"(s[6]), "=s"(s[7]));
}
__device__ __forceinline__ void wave_imax_x4(int (&k)[4], int (&s)[4]) {
    asm volatile("s_nop 1\n\t"
        "v_max_i32_dpp %0, %0, %0 row_shr:1 row_mask:0xf bank_mask:0xf\n\tv_max_i32_dpp %1, %1, %1 row_shr:1 row_mask:0xf bank_mask:0xf\n\tv_max_i32_dpp %2, %2, %2 row_shr:1 row_mask:0xf bank_mask:0xf\n\tv_max_i32_dpp %3, %3, %3 row_shr:1 row_mask:0xf bank_mask:0xf\n\t"
        "v_max_i32_dpp %0, %0, %0 row_shr:2 row_mask:0xf bank_mask:0xf\n\tv_max_i32_dpp %1, %1, %1 row_shr:2 row_mask:0xf bank_mask:0xf\n\tv_max_i32_dpp %2, %2, %2 row_shr:2 row_mask:0xf bank_mask:0xf\n\tv_max_i32_dpp %3, %3, %3 row_shr:2 row_mask:0xf bank_mask:0xf\n\t"
        "v_max_i32_dpp %0, %0, %0 row_shr:4 row_mask:0xf bank_mask:0xf\n\tv_max_i32_dpp %1, %1, %1 row_shr:4 row_mask:0xf bank_mask:0xf\n\tv_max_i32_dpp %2, %2, %2 row_shr:4 row_mask:0xf bank_mask:0xf\n\tv_max_i32_dpp %3, %3, %3 row_shr:4 row_mask:0xf bank_mask:0xf\n\t"
        "v_max_i32_dpp %0, %0, %0 row_shr:8 row_mask:0xf bank_mask:0xf\n\tv_max_i32_dpp %1, %1, %1 row_shr:8 row_mask:0xf bank_mask:0xf\n\tv_max_i32_dpp %2, %2, %2 row_shr:8 row_mask:0xf bank_mask:0xf\n\tv_max_i32_dpp %3, %3, %3 row_shr:8 row_mask:0xf bank_mask:0xf\n\t"
        "v_max_i32_dpp %0, %0, %0 row_bcast:15 row_mask:0xa bank_mask:0xf\n\tv_max_i32_dpp %1, %1, %1 row_bcast:15 row_mask:0xa bank_mask:0xf\n\tv_max_i32_dpp %2, %2, %2 row_bcast:15 row_mask:0xa bank_mask:0xf\n\tv_max_i32_dpp %3, %3, %3 row_bcast:15 row_mask:0xa bank_mask:0xf\n\t"
        "v_max_i32_dpp %0, %0, %0 row_bcast:31 row_mask:0xc bank_mask:0xf\n\tv_max_i32_dpp %1, %1, %1 row_bcast:31 row_mask:0xc bank_mask:0xf\n\tv_max_i32_dpp %2, %2, %2 row_bcast:31 row_mask:0xc bank_mask:0xf\n\tv_max_i32_dpp %3, %3, %3 row_bcast:31 row_mask:0xc bank_mask:0xf\n\t"
        "s_nop 1\n\tv_readlane_b32 %4, %0, 63\n\tv_readlane_b32 %5, %1, 63\n\tv_readlane_b32 %6, %2, 63\n\tv_readlane_b32 %7, %3, 63\n\ts_nop 3"
        : "+v"(k[0]), "+v"(k[1]), "+v"(k[2]), "+v"(k[3]), "=s"(s[0]), "=s"(s[1]), "=s"(s[2]), "=s"(s[3]));
}
__device__ __forceinline__ void row_imax2(int& a, int& b) {
    asm volatile("s_nop 1\n\t"
        "v_max_i32_dpp %0, %0, %0 row_ror:8 row_mask:0xf bank_mask:0xf\n\tv_max_i32_dpp %1, %1, %1 row_ror:8 row_mask:0xf bank_mask:0xf\n\ts_nop 0\n\t"
        "v_max_i32_dpp %0, %0, %0 row_ror:4 row_mask:0xf bank_mask:0xf\n\tv_max_i32_dpp %1, %1, %1 row_ror:4 row_mask:0xf bank_mask:0xf\n\ts_nop 0\n\t"
        "v_max_i32_dpp %0, %0, %0 row_ror:2 row_mask:0xf bank_mask:0xf\n\tv_max_i32_dpp %1, %1, %1 row_ror:2 row_mask:0xf bank_mask:0xf\n\ts_nop 0\n\t"
        "v_max_i32_dpp %0, %0, %0 row_ror:1 row_mask:0xf bank_mask:0xf\n\tv_max_i32_dpp %1, %1, %1 row_ror:1 row_mask:0xf bank_mask:0xf\n\ts_nop 1"
        : "+v"(a), "+v"(b));
}
template <int CTRL> __device__ __forceinline__ float dpp_rot(float v) { return __int_as_float(__builtin_amdgcn_update_dpp(0, __float_as_int(v), CTRL, 0xf, 0xf, false)); }
__device__ __forceinline__ float row_fmax(float v) { v = fmaxf(v, dpp_rot<0x128>(v)); v = fmaxf(v, dpp_rot<0x124>(v)); v = fmaxf(v, dpp_rot<0x122>(v)); v = fmaxf(v, dpp_rot<0x121>(v)); return v; }
__device__ __forceinline__ float row_fsum(float v) { v += dpp_rot<0x128>(v); v += dpp_rot<0x124>(v); v += dpp_rot<0x122>(v); v += dpp_rot<0x121>(v); return v; }
__device__ const unsigned char PEER_CAND[64] = {
    0x00,0x01,0x02,0x03,0x04,0x05,0x06,0x07,0x08,0x09,0x0a,0x0b,0x0c,0x0d,0x0e,0x0f, 0x10,0x11,0x12,0x13,0x14,0x15,0x16,0x17, 0x20,0x21,0x22,0x23,0x24, 0x30,0x31,0x32,0x33,
    0x40,0x41,0x42, 0x50,0x51, 0x60,0x61, 0x70,0x71, 0x80, 0x90, 0xa0, 0xb0, 0xc0, 0xd0, 0xe0, 0xf0, 0xff,0xff,0xff,0xff,0xff,0xff,0xff,0xff,0xff,0xff,0xff,0xff,0xff,0xff};
__device__ __forceinline__ void phase7(ArgsP a, LAS unsigned char* lds, const int tidx) {
    const int tid0 = tidx, w = __builtin_amdgcn_readfirstlane(tid0 >> 6);
    const bf16* QP = (const bf16*)(a->ws + WS_QP); const bf16* K12 = (const bf16*)(a->ws + WS_K12); const float* SUMSQ = (const float*)(a->ws + WS_MISC + MISC_SUMSQ);
    int* IDX = (int*)(a->ws + WS_IDX); float* GW = (float*)(a->ws + WS_GW);
    LAS float* SC = (LAS float*)lds;
    for (int u = blockIdx.x; u < 256 * 8; u += gridDim.x) {
        const int tid = opaque(tid0), lane = tid & 63, fr = lane & 15, fq = lane >> 4;
        const int tt = u >> 3, hd = u & 7, tok0 = tt * 64;
        {
            const int half = w >> 2; const bf16* kb = K12 + ((size_t)(half * 8 + hd) * 128) * 128;
            f32x4 acc[4][2];
#pragma unroll
            for (int i = 0; i < 4; ++i) { acc[i][0] = (f32x4){0.f, 0.f, 0.f, 0.f}; acc[i][1] = (f32x4){0.f, 0.f, 0.f, 0.f}; }
#pragma unroll
            for (int kk = 0; kk < 4; ++kk) {
                bf16x8 af[4], bfv[2];
#pragma unroll
                for (int i = 0; i < 4; ++i) af[i] = *(const bf16x8*)(QP + (size_t)(tok0 + 16 * i + fr) * DM + 256 * hd + 128 * half + 8 * fq + 32 * kk);
#pragma unroll
                for (int j = 0; j < 2; ++j) bfv[j] = *(const bf16x8*)(kb + (size_t)(16 * (2 * (w & 3) + j) + fr) * 128 + 8 * fq + 32 * kk);
#pragma unroll
                for (int i = 0; i < 4; ++i) { acc[i][0] = mfma16(af[i], bfv[0], acc[i][0]); acc[i][1] = mfma16(af[i], bfv[1], acc[i][1]); }
            }
#pragma unroll
            for (int i = 0; i < 4; ++i)
#pragma unroll
                for (int j = 0; j < 2; ++j)
#pragma unroll
                    for (int r = 0; r < 4; ++r) SC[(16 * i + 4 * fq + r) * 260 + 128 * half + 16 * (2 * (w & 3) + j) + fr] = acc[i][j][r];
        }
        __syncthreads();
        const int r16 = lane & 15, rowb = lane & 48;
        const int cab = (int)PEER_CAND[lane];
        int cca[4], ccb[4];
#pragma unroll
        for (int i = 0; i < 4; ++i) { const int cc = (int)PEER_CAND[r16 + 16 * i]; cca[i] = rowb + (cc >> 4); ccb[i] = rowb + (cc & 15); }
        for (int tl = 0; tl < 8; tl += 4) {
            const int tk = 8 * w + tl + (lane >> 4), tok = tok0 + tk;
            const LAS float* srow = SC + tk * 260;
            int sa[8], sb[8];
#pragma unroll
            for (int i = 0; i < 8; ++i) { sa[i] = topk_pack7(srow[r16 + 16 * i], r16 + 16 * i); sb[i] = topk_pack7(srow[128 + r16 + 16 * i], r16 + 16 * i); }
#define CE(x, i, j) do { const int hi_ = x[i] > x[j] ? x[i] : x[j], lo_ = x[i] > x[j] ? x[j] : x[i]; x[i] = hi_; x[j] = lo_; } while (0)
#define SORT8(x) do { CE(x,0,1); CE(x,2,3); CE(x,4,5); CE(x,6,7); CE(x,0,2); CE(x,1,3); CE(x,4,6); CE(x,5,7); CE(x,1,2); CE(x,5,6); CE(x,0,4); CE(x,3,7); CE(x,1,5); CE(x,2,6); CE(x,1,4); CE(x,3,6); CE(x,2,4); CE(x,3,5); CE(x,3,4); } while (0)
            SORT8(sa); SORT8(sb);
            int resa = 0, resb = 0;
            for (int k = 0; k < 16; ++k) {
                int ma = sa[0], mb = sb[0];
                row_imax2(ma, mb);
                const bool wa = sa[0] == ma, wb = sb[0] == mb;
#pragma unroll
                for (int i = 0; i < 7; ++i) { sa[i] = wa ? sa[i + 1] : sa[i]; sb[i] = wb ? sb[i + 1] : sb[i]; }
                sa[7] = wa ? (int)0x80000000 : sa[7]; sb[7] = wb ? (int)0x80000000 : sb[7];
                if (r16 == k) { resa = ma; resb = mb; }
            }
            const int ria = 127 - (resa & 127), rib = 127 - (resb & 127);
            const float rva = srow[ria], rvb = srow[128 + rib];
            int kc[4];
#pragma unroll
            for (int i = 0; i < 4; ++i) { const float csum = __shfl(rva, cca[i]) + __shfl(rvb, ccb[i]); const int cidx = r16 + 16 * i; kc[i] = cidx < 50 ? ((topk_sortable(csum) & ~63) | (63 - cidx)) : (int)0x80000000; }
            CE(kc,0,1); CE(kc,2,3); CE(kc,0,2); CE(kc,1,3); CE(kc,1,2);
            int resc = 0;
            for (int k = 0; k < 16; ++k) {
                int mc = kc[0], dummy = kc[0];
                row_imax2(mc, dummy);
                const bool wc = kc[0] == mc;
                kc[0] = wc ? kc[1] : kc[0]; kc[1] = wc ? kc[2] : kc[1]; kc[2] = wc ? kc[3] : kc[2]; kc[3] = wc ? (int)0x80000000 : kc[3];
                if (r16 == k) resc = mc;
            }
#undef SORT8
#undef CE
            const int ci = 63 - (resc & 63);
            const int sab = __shfl(cab, ci), sela = rowb + (sab >> 4), selb = rowb + (sab & 15);
            const float sv = __shfl(rva, sela) + __shfl(rvb, selb);
            const int e1 = __shfl(ria, sela), e2 = __shfl(rib, selb);
            const float rstd = 1.f / sqrtf(SUMSQ[tok] * (1.f / DM) + EPS);
            const float top = row_fmax(sv);
            const float p = __expf((sv - top) * rstd);
            const float den = row_fsum(p);
            IDX[(size_t)tok * 128 + 16 * hd + r16] = e1 * 128 + e2; GW[(size_t)tok * 128 + 16 * hd + r16] = p / den;
        }
        __syncthreads();
    }
}

__device__ __forceinline__ void phase8(ArgsP a, const int tidx) {
    const int tid0 = tidx, w = __builtin_amdgcn_readfirstlane(tid0 >> 6);
    const bf16* HN = (const bf16*)(a->ws + WS_HN); const bf16* U = (const bf16*)(a->ws + WS_U); const bf16* V = (const bf16*)(a->ws + WS_V2);
    const int* IDX = (const int*)(a->ws + WS_IDX); const float* GW = (const float*)(a->ws + WS_GW); const float* SUMSQ = (const float*)(a->ws + WS_MISC + MISC_SUMSQ);
    const int gwv = blockIdx.x * NWAVES + w, NGW = gridDim.x * NWAVES;
    for (int tok = gwv; tok < M; tok += NGW) {
        const int lane = opaque(tid0) & 63;
        u32x4 hv[4];
#pragma unroll
        for (int i = 0; i < 4; ++i) hv[i] = *(const u32x4*)(HN + (size_t)tok * DM + 8 * lane + 512 * i);
        const int id0 = IDX[(size_t)tok * 128 + lane], id1 = IDX[(size_t)tok * 128 + 64 + lane];
        const float g0 = GW[(size_t)tok * 128 + lane], g1 = GW[(size_t)tok * 128 + 64 + lane];
        const float rstd2 = 1.f / sqrtf(SUMSQ[tok] * (1.f / DM) + EPS);
        float oacc[32];
#pragma unroll
        for (int i = 0; i < 32; ++i) oacc[i] = 0.f;
        for (int eb = 0; eb < 128; eb += 8) {
            u32x4 uv[8][4]; float part[8]; int eid[8];
#pragma unroll
            for (int e = 0; e < 8; ++e) { const int sl = eb + e; eid[e] = __builtin_amdgcn_readfirstlane(sl < 64 ? __shfl(id0, sl) : __shfl(id1, sl - 64));
                const bf16* row = U + (size_t)eid[e] * DM + 8 * lane;
#pragma unroll
                for (int i = 0; i < 4; ++i) uv[e][i] = *(const u32x4*)(row + 512 * i); }
#pragma unroll
            for (int e = 0; e < 8; ++e) { float s = 0.f;
#pragma unroll
                for (int i = 0; i < 4; ++i) {
                    s = dot2bf(uv[e][i].x, hv[i].x, s); s = dot2bf(uv[e][i].y, hv[i].y, s); s = dot2bf(uv[e][i].z, hv[i].z, s); s = dot2bf(uv[e][i].w, hv[i].w, s); }
                part[e] = wave_sum(s); }
#pragma unroll
            for (int e = 0; e < 8; ++e) { const bf16* row = V + (size_t)eid[e] * DM + 8 * lane;
#pragma unroll
                for (int i = 0; i < 4; ++i) uv[e][i] = *(const u32x4*)(row + 512 * i); }
#pragma unroll
            for (int e = 0; e < 8; ++e) { const int sl = eb + e; const float gg = sl < 64 ? __shfl(g0, sl) : __shfl(g1, sl - 64);
                const float act = part[e] * rstd2; const float ge = 0.5f * act * (1.f + erff(act * 0.70710678118654752f)); const float cf = gg * ge;
#pragma unroll
                for (int i = 0; i < 4; ++i) {
                    oacc[8 * i + 0] += cf * bflo(uv[e][i].x); oacc[8 * i + 1] += cf * bfhi(uv[e][i].x); oacc[8 * i + 2] += cf * bflo(uv[e][i].y); oacc[8 * i + 3] += cf * bfhi(uv[e][i].y);
                    oacc[8 * i + 4] += cf * bflo(uv[e][i].z); oacc[8 * i + 5] += cf * bfhi(uv[e][i].z); oacc[8 * i + 6] += cf * bflo(uv[e][i].w); oacc[8 * i + 7] += cf * bfhi(uv[e][i].w); } }
        }
        float* orow = a->out + (size_t)tok * DM + 8 * lane; float ss = 0.f;
#pragma unroll
        for (int i = 0; i < 4; ++i) { const f32x4 x0 = *(const f32x4*)(orow + 512 * i), x1 = *(const f32x4*)(orow + 512 * i + 4);
#pragma unroll
            for (int j = 0; j < 4; ++j) { oacc[8 * i + j] += x0[j]; oacc[8 * i + 4 + j] += x1[j]; }
#pragma unroll
            for (int j = 0; j < 8; ++j) ss += oacc[8 * i + j] * oacc[8 * i + j]; }
        const float rstd = 1.f / sqrtf(wave_sum(ss) * (1.f / DM) + EPS);
#pragma unroll
        for (int i = 0; i < 4; ++i) { const f32x4 w0 = *(const f32x4*)(a->lnf_w + 8 * lane + 512 * i), w1 = *(const f32x4*)(a->lnf_w + 8 * lane + 512 * i + 4); f32x4 o0, o1;
#pragma unroll
            for (int j = 0; j < 4; ++j) { o0[j] = oacc[8 * i + j] * rstd * w0[j]; o1[j] = oacc[8 * i + 4 + j] * rstd * w1[j]; }
            *(f32x4*)(orow + 512 * i) = o0; *(f32x4*)(orow + 512 * i + 4) = o1; }
    }
}
__device__ __forceinline__ void convert_uv(ArgsP a, const int tidx) {
    const size_t gt = (size_t)blockIdx.x * NTHR + tidx, NGT = (size_t)gridDim.x * NTHR; const size_t NP = (size_t)16384 * 2048 / 8;
    u32x4* Ud = (u32x4*)(a->ws + WS_U); u32x4* Vd = (u32x4*)(a->ws + WS_V2);
    for (size_t i = gt; i < 2 * NP; i += NGT) { const bool second = i >= NP; const size_t j = second ? i - NP : i; const float* src = (second ? a->peer_v : a->peer_u) + j * 8;
        const f32x4 x0 = *(const f32x4*)src, x1 = *(const f32x4*)(src + 4); u32x4 o; o.x = cvtpk(x0[0], x0[1]); o.y = cvtpk(x0[2], x0[3]); o.z = cvtpk(x1[0], x1[1]); o.w = cvtpk(x1[2], x1[3]);
        (second ? Vd : Ud)[j] = o; }
}
constexpr size_t WS_PART = 336 * MiB;
constexpr size_t WS_COEF = 105 * MiB;
constexpr int Q_U = 8192, Q_V = 8192 + 1024;
constexpr size_t MISC_SS2 = 131072;
constexpr size_t WS_X1B = 185 * MiB, WS_PO = 249 * MiB;

__device__ __forceinline__ void convert_uv_sliced(ArgsP a, const int tidx) {
    const int lane = tidx & 63, w = tidx >> 6; const int gw = blockIdx.x * NWAVES + w, NGW = gridDim.x * NWAVES;
    bf16* Us = (bf16*)(a->ws + WS_U); bf16* Vs = (bf16*)(a->ws + WS_V2);
    for (int row = gw; row < 32768; row += NGW) { const bool second = row >= 16384; const int e = row & 16383; const f32x4* src = (const f32x4*)((second ? a->peer_v : a->peer_u) + (size_t)e * DM) + lane; bf16* dst = second ? Vs : Us;
        f32x4 x[8];
#pragma unroll
        for (int j = 0; j < 8; ++j) x[j] = src[64 * j];
#pragma unroll
        for (int j = 0; j < 8; ++j) { const int s = 4 * j + (lane >> 4); u32x2 o; o.x = cvtpk(x[j][0], x[j][1]); o.y = cvtpk(x[j][2], x[j][3]);
            *(u32x2*)(dst + ((size_t)s * 16384 + e) * 64 + 4 * (lane & 15)) = o; } }
}
__device__ __forceinline__ void peer_stage_idx(const int* IDX, int tok0, LAS unsigned char* lds, int tid) {
#pragma unroll
    for (int i = 0; i < 8; ++i) { const int q = tid + 512 * i; const u32x4 v = *(const u32x4*)(IDX + (size_t)tok0 * 128 + 4 * q);
        *(LAS u32x2*)(lds + 8 * q) = (u32x2){v.x | (v.y << 16), v.z | (v.w << 16)}; }
}
__device__ __forceinline__ void peer_u_phase(ArgsP a, LAS unsigned char* lds, const int tidx, const int qoff = 0) {
    const int w = __builtin_amdgcn_readfirstlane(tidx >> 6); const int myx = (int)(xb_xcc_id() & 7u); int probe = 0;
    unsigned* heads = (unsigned*)(a->ws + WS_CTL) + Q_U + qoff; volatile LAS int* bc = (volatile LAS int*)(lds + 98304);
    const bf16* HN = (const bf16*)(a->ws + WS_HN); const bf16* Us = (const bf16*)(a->ws + WS_U); const int* IDX = (const int*)(a->ws + WS_IDX); bf16* PART = (bf16*)(a->ws + WS_PART);
    for (;;) {
        const int tid = opaque(tidx), lane = tid & 63, m = lane & 7, g = lane >> 3;
        const int item = peer_next_item(heads, myx, probe, 512u, bc, tid); if (item < 0) break;
        const int s = item >> 7, tile = item & 127, tok0 = tile * 128;
        peer_stage_idx(IDX, tok0, lds, tid);
        __syncthreads();
        const bf16* ub = Us + (size_t)s * 16384 * 64 + 8 * m;
        for (int tt = 0; tt < 16; ++tt) { const int tl = 16 * w + tt, t = tok0 + tl;
            const u32x4 hv = *(const u32x4*)(HN + (size_t)t * DM + 64 * s + 8 * m);
            u32x4 uv[16];
#pragma unroll
            for (int r = 0; r < 16; ++r) { const unsigned id = *(const LAS unsigned short*)(lds + (tl * 128 + 16 * g + r) * 2); uv[r] = *(const u32x4*)(ub + (size_t)id * 64); }
            float p[16];
#pragma unroll
            for (int r = 0; r < 16; ++r) { float d = dot2bf(uv[r].x, hv.x, 0.f); d = dot2bf(uv[r].y, hv.y, d); d = dot2bf(uv[r].z, hv.z, d); d = dot2bf(uv[r].w, hv.w, d); p[r] = d; }
            float q8[8], q4[4], q2[2];
#pragma unroll
            for (int r = 0; r < 8; ++r) { const bool up = (lane & 4) != 0; const float snd = up ? p[r] : p[r + 8], kp = up ? p[r + 8] : p[r]; q8[r] = kp + __shfl_xor(snd, 4); }
#pragma unroll
            for (int r = 0; r < 4; ++r) { const bool up = (lane & 2) != 0; const float snd = up ? q8[r] : q8[r + 4], kp = up ? q8[r + 4] : q8[r]; q4[r] = kp + __shfl_xor(snd, 2); }
#pragma unroll
            for (int r = 0; r < 2; ++r) { const bool up = (lane & 1) != 0; const float snd = up ? q4[r] : q4[r + 2], kp = up ? q4[r + 2] : q4[r]; q2[r] = kp + __shfl_xor(snd, 1); }
            *(unsigned*)(PART + ((size_t)s * M + t) * 128 + 2 * lane) = cvtpk(q2[0], q2[1]);
        }
        __syncthreads();
    }
}
__device__ __forceinline__ void peer_combine(ArgsP a, const int tidx) {
    const size_t gt = (size_t)blockIdx.x * NTHR + tidx, NGT = (size_t)gridDim.x * NTHR;
    const unsigned* PART = (const unsigned*)(a->ws + WS_PART); const float* GW = (const float*)(a->ws + WS_GW); const float* SUMSQ = (const float*)(a->ws + WS_MISC + MISC_SUMSQ); f32x2* C = (f32x2*)(a->ws + WS_COEF);
    for (size_t i = gt; i < (size_t)M * 64; i += NGT) { const int t = (int)(i >> 6); float s0 = 0.f, s1 = 0.f;
#pragma unroll 8
        for (int s = 0; s < 32; ++s) { const unsigned v = PART[(size_t)s * M * 64 + i]; s0 += bflo(v); s1 += bfhi(v); }
        const float rstd2 = 1.f / sqrtf(SUMSQ[t] * (1.f / DM) + EPS); const f32x2 g = ((const f32x2*)GW)[i];
        const float a0 = s0 * rstd2, a1 = s1 * rstd2;
        C[i] = (f32x2){g.x * 0.5f * a0 * (1.f + erff(a0 * 0.70710678118654752f)), g.y * 0.5f * a1 * (1.f + erff(a1 * 0.70710678118654752f))}; }
}
template <bool DRY> __device__ __forceinline__ void peer_v_phase(ArgsP a, LAS unsigned char* lds, const int tidx, const int qoff = 0) {
    const int w = __builtin_amdgcn_readfirstlane(tidx >> 6); const int myx = (int)(xb_xcc_id() & 7u); int probe = 0;
    unsigned* heads = (unsigned*)(a->ws + WS_CTL) + Q_V + qoff; volatile LAS int* bc = (volatile LAS int*)(lds + 98304);
    const bf16* Vs = (const bf16*)(a->ws + WS_V2); const int* IDX = (const int*)(a->ws + WS_IDX); const float* COEF = (const float*)(a->ws + WS_COEF); float* SS2 = (float*)(a->ws + WS_MISC + MISC_SS2);
    for (;;) {
        const int tid = opaque(tidx), lane = tid & 63, m = lane & 7, g = lane >> 3;
        const int item = peer_next_item(heads, myx, probe, 512u, bc, tid); if (item < 0) break;
        const int s = item >> 7, tile = item & 127, tok0 = tile * 128;
        peer_stage_idx(IDX, tok0, lds, tid);
#pragma unroll
        for (int i = 0; i < 8; ++i) { const int q = tid + 512 * i; *(LAS u32x4*)(lds + 32768 + 16 * q) = *(const u32x4*)(COEF + (size_t)tok0 * 128 + 4 * q); }
        __syncthreads();
        const bf16* vb = Vs + (size_t)s * 16384 * 64 + 8 * m;
        for (int tt = 0; tt < 16; ++tt) { const int tl = 16 * w + tt, t = tok0 + tl;
            u32x4 vv[16]; float cf[16];
#pragma unroll
            for (int r = 0; r < 16; ++r) { const unsigned id = *(const LAS unsigned short*)(lds + (tl * 128 + 16 * g + r) * 2); vv[r] = *(const u32x4*)(vb + (size_t)id * 64); cf[r] = *(const LAS float*)(lds + 32768 + (tl * 128 + 16 * g + r) * 4); }
            float acc[8];
#pragma unroll
            for (int j = 0; j < 8; ++j) acc[j] = 0.f;
#pragma unroll
            for (int r = 0; r < 16; ++r) { acc[0] += cf[r] * bflo(vv[r].x); acc[1] += cf[r] * bfhi(vv[r].x); acc[2] += cf[r] * bflo(vv[r].y); acc[3] += cf[r] * bfhi(vv[r].y);
                acc[4] += cf[r] * bflo(vv[r].z); acc[5] += cf[r] * bfhi(vv[r].z); acc[6] += cf[r] * bflo(vv[r].w); acc[7] += cf[r] * bfhi(vv[r].w); }
            float q4[4], q2[2];
#pragma unroll
            for (int j = 0; j < 4; ++j) { const bool up = (lane & 32) != 0; const float snd = up ? acc[j] : acc[j + 4], kp = up ? acc[j + 4] : acc[j]; q4[j] = kp + __shfl_xor(snd, 32); }
#pragma unroll
            for (int j = 0; j < 2; ++j) { const bool up = (lane & 16) != 0; const float snd = up ? q4[j] : q4[j + 2], kp = up ? q4[j + 2] : q4[j]; q2[j] = kp + __shfl_xor(snd, 16); }
            float r1; { const bool up = (lane & 8) != 0; const float snd = up ? q2[0] : q2[1], kp = up ? q2[1] : q2[0]; r1 = kp + __shfl_xor(snd, 8); }
            float* op = a->out + (size_t)t * DM + 64 * s + 8 * m + g;
            const float x1v = *op; const float x2 = x1v + r1; *op = DRY ? (x2 == 12345.678f ? x2 : x1v) : x2;
            const float ss = wave_sum(x2 * x2);
            if (lane == 0 && !DRY) atomicAdd(SS2 + t, ss);
        }
        __syncthreads();
    }
}
template <bool DRY> __device__ __forceinline__ void peer_final(ArgsP a, const int tidx) {
    const int lane = tidx & 63, w = tidx >> 6; const int gwv = blockIdx.x * NWAVES + w, NGW = gridDim.x * NWAVES; const float* SS2 = (const float*)(a->ws + WS_MISC + MISC_SS2);
    for (int tok = gwv; tok < M; tok += NGW) { const float rstd = 1.f / sqrtf(SS2[tok] * (1.f / DM) + EPS); f32x4* orow = (f32x4*)(a->out + (size_t)tok * DM) + lane; const f32x4* wr = (const f32x4*)a->lnf_w + lane;
#pragma unroll
        for (int j = 0; j < 8; ++j) { f32x4 v = orow[64 * j]; const f32x4 o = v * rstd * wr[64 * j]; orow[64 * j] = DRY ? (o[0] == 12345.678f ? o : v) : o; } }
}
__device__ __forceinline__ void peer_final8(ArgsP a, const int tidx) {
    const int lane = tidx & 63, w = tidx >> 6; const int gwv = blockIdx.x * NWAVES + w, NGW = gridDim.x * NWAVES;
    const bf16* X1B = (const bf16*)(a->ws + WS_X1B); const bf16* PO = (const bf16*)(a->ws + WS_PO);
    for (int tok = gwv; tok < M; tok += NGW) {
        u32x4 xv[4], pv[4];
#pragma unroll
        for (int i = 0; i < 4; ++i) { xv[i] = *(const u32x4*)(X1B + (size_t)tok * DM + 8 * lane + 512 * i); pv[i] = *(const u32x4*)(PO + (size_t)tok * DM + 8 * lane + 512 * i); }
        float v[32]; float ss = 0.f;
#pragma unroll
        for (int i = 0; i < 4; ++i) { v[8 * i + 0] = bflo(xv[i].x) + bflo(pv[i].x); v[8 * i + 1] = bfhi(xv[i].x) + bfhi(pv[i].x); v[8 * i + 2] = bflo(xv[i].y) + bflo(pv[i].y); v[8 * i + 3] = bfhi(xv[i].y) + bfhi(pv[i].y);
            v[8 * i + 4] = bflo(xv[i].z) + bflo(pv[i].z); v[8 * i + 5] = bfhi(xv[i].z) + bfhi(pv[i].z); v[8 * i + 6] = bflo(xv[i].w) + bflo(pv[i].w); v[8 * i + 7] = bfhi(xv[i].w) + bfhi(pv[i].w); }
#pragma unroll
        for (int i = 0; i < 32; ++i) ss += v[i] * v[i];
        const float rstd = 1.f / sqrtf(wave_sum(ss) * (1.f / DM) + EPS);
        float* orow = a->out + (size_t)tok * DM + 8 * lane;
#pragma unroll
        for (int i = 0; i < 4; ++i) { const f32x4 w0 = *(const f32x4*)(a->lnf_w + 8 * lane + 512 * i), w1 = *(const f32x4*)(a->lnf_w + 8 * lane + 512 * i + 4); f32x4 o0, o1;
#pragma unroll
            for (int j = 0; j < 4; ++j) { o0[j] = v[8 * i + j] * rstd * w0[j]; o1[j] = v[8 * i + 4 + j] * rstd * w1[j]; }
            *(f32x4*)(orow + 512 * i) = o0; *(f32x4*)(orow + 512 * i + 4) = o1; }
    }
}
__device__ __forceinline__ f32x2 fp8lo(unsigned w) { return __builtin_amdgcn_cvt_pk_f32_fp8((int)w, false); }
__device__ __forceinline__ f32x2 fp8hi(unsigned w) { return __builtin_amdgcn_cvt_pk_f32_fp8((int)w, true); }
__device__ __forceinline__ void peer_u_phase8(ArgsP a, LAS unsigned char* lds, const int tidx, const int qoff = 0) {
    const int w = __builtin_amdgcn_readfirstlane(tidx >> 6); const int myx = (int)(xb_xcc_id() & 7u); int probe = 0;
    unsigned* heads = (unsigned*)(a->ws + WS_CTL) + Q_U + qoff; volatile LAS int* bc = (volatile LAS int*)(lds + 98304);
    const bf16* HN = (const bf16*)(a->ws + WS_HN); const unsigned char* U8 = (const unsigned char*)(a->ws + WS_U8); const int* IDX = (const int*)(a->ws + WS_IDX); bf16* PART = (bf16*)(a->ws + WS_PART);
    for (;;) {
        const int tid = opaque(tidx), lane = tid & 63, m = lane & 7, g = lane >> 3;
        const int item = peer_next_item(heads, myx, probe, 256u, bc, tid); if (item < 0) break;
        const int s = item >> 7, tile = item & 127, tok0 = tile * 128;
        peer_stage_idx(IDX, tok0, lds, tid);
        __syncthreads();
        const unsigned char* ub = U8 + (size_t)s * 16384 * 128 + 16 * m;
#define PU_ISSUE(UV, H0, H1, TT) do { const int tl_ = 16 * w + (TT); \
            const u32x4 idA_ = *(const LAS u32x4*)(lds + (tl_ * 128 + 16 * g) * 2), idB_ = *(const LAS u32x4*)(lds + (tl_ * 128 + 16 * g) * 2 + 16); \
            const unsigned idw_[8] = {idA_.x, idA_.y, idA_.z, idA_.w, idB_.x, idB_.y, idB_.z, idB_.w}; \
            _Pragma("unroll") for (int r = 0; r < 16; ++r) { const unsigned id = (r & 1) ? (idw_[r >> 1] >> 16) : (idw_[r >> 1] & 0xffffu); UV[r] = *(const u32x4*)(ub + (size_t)id * 128); } \
            H0 = *(const u32x4*)(HN + (size_t)(tok0 + tl_) * DM + 128 * s + 16 * m); H1 = *(const u32x4*)(HN + (size_t)(tok0 + tl_) * DM + 128 * s + 16 * m + 8); } while (0)
#define PU_REDUCE(UV, H0, H1, TT) do { const int t_ = tok0 + 16 * w + (TT); f32x2 hf[8]; \
            hf[0] = (f32x2){bflo(H0.x), bfhi(H0.x)}; hf[1] = (f32x2){bflo(H0.y), bfhi(H0.y)}; hf[2] = (f32x2){bflo(H0.z), bfhi(H0.z)}; hf[3] = (f32x2){bflo(H0.w), bfhi(H0.w)}; \
            hf[4] = (f32x2){bflo(H1.x), bfhi(H1.x)}; hf[5] = (f32x2){bflo(H1.y), bfhi(H1.y)}; hf[6] = (f32x2){bflo(H1.z), bfhi(H1.z)}; hf[7] = (f32x2){bflo(H1.w), bfhi(H1.w)}; \
            float p[16]; \
            _Pragma("unroll") for (int r = 0; r < 16; ++r) { f32x2 ac = fp8lo(UV[r].x) * hf[0]; ac += fp8hi(UV[r].x) * hf[1]; ac += fp8lo(UV[r].y) * hf[2]; ac += fp8hi(UV[r].y) * hf[3]; \
                ac += fp8lo(UV[r].z) * hf[4]; ac += fp8hi(UV[r].z) * hf[5]; ac += fp8lo(UV[r].w) * hf[6]; ac += fp8hi(UV[r].w) * hf[7]; p[r] = ac.x + ac.y; } \
            float q8[8], q4[4], q2[2]; \
            _Pragma("unroll") for (int r = 0; r < 8; ++r) { const bool up = (lane & 4) != 0; const float snd = up ? p[r] : p[r + 8], kp = up ? p[r + 8] : p[r]; q8[r] = kp + __shfl_xor(snd, 4); } \
            _Pragma("unroll") for (int r = 0; r < 4; ++r) { const bool up = (lane & 2) != 0; const float snd = up ? q8[r] : q8[r + 4], kp = up ? q8[r + 4] : q8[r]; q4[r] = kp + __shfl_xor(snd, 2); } \
            _Pragma("unroll") for (int r = 0; r < 2; ++r) { const bool up = (lane & 1) != 0; const float snd = up ? q4[r] : q4[r + 2], kp = up ? q4[r + 2] : q4[r]; q2[r] = kp + __shfl_xor(snd, 1); } \
            *(unsigned*)(PART + ((size_t)s * M + t_) * 128 + 2 * lane) = cvtpk(q2[0], q2[1]); } while (0)
        u32x4 uvA[16], uvB[16], hA0, hA1, hB0, hB1;
        for (int tt = 0; tt < 16; ++tt) { PU_ISSUE(uvA, hA0, hA1, tt); PU_REDUCE(uvA, hA0, hA1, tt); }
        (void)uvB; (void)hB0; (void)hB1;
#undef PU_ISSUE
#undef PU_REDUCE
        __syncthreads();
    }
}
__device__ __forceinline__ void peer_combine8(ArgsP a, const int tidx) {
    const size_t gt = (size_t)blockIdx.x * NTHR + tidx, NGT = (size_t)gridDim.x * NTHR;
    const unsigned* PART = (const unsigned*)(a->ws + WS_PART); const float* GW = (const float*)(a->ws + WS_GW); const float* SUMSQ = (const float*)(a->ws + WS_MISC + MISC_SUMSQ); f32x2* C = (f32x2*)(a->ws + WS_COEF);
    const float* USC = (const float*)(a->ws + WS_USC); const float* VSC = (const float*)(a->ws + WS_VSC); const int* IDX = (const int*)(a->ws + WS_IDX);
    for (size_t i = gt; i < (size_t)M * 64; i += NGT) { const int t = (int)(i >> 6); float s0 = 0.f, s1 = 0.f;
#pragma unroll 8
        for (int s = 0; s < 16; ++s) { const unsigned v = PART[(size_t)s * M * 64 + i]; s0 += bflo(v); s1 += bfhi(v); }
        const int id0 = IDX[2 * i], id1 = IDX[2 * i + 1];
        const float rstd2 = 1.f / sqrtf(SUMSQ[t] * (1.f / DM) + EPS); const f32x2 g = ((const f32x2*)GW)[i];
        const float a0 = s0 * rstd2 * USC[id0], a1 = s1 * rstd2 * USC[id1];
        C[i] = (f32x2){g.x * 0.5f * a0 * (1.f + erff(a0 * 0.70710678118654752f)) * VSC[id0], g.y * 0.5f * a1 * (1.f + erff(a1 * 0.70710678118654752f)) * VSC[id1]}; }
}
template <bool DRY> __device__ __forceinline__ void peer_v_phase8(ArgsP a, LAS unsigned char* lds, const int tidx, const int qoff = 0) {
    const int w = __builtin_amdgcn_readfirstlane(tidx >> 6); const int myx = (int)(xb_xcc_id() & 7u); int probe = 0;
    unsigned* heads = (unsigned*)(a->ws + WS_CTL) + Q_V + qoff; volatile LAS int* bc = (volatile LAS int*)(lds + 98304);
    const unsigned char* V8 = (const unsigned char*)(a->ws + WS_V8); const int* IDX = (const int*)(a->ws + WS_IDX); const float* COEF = (const float*)(a->ws + WS_COEF); bf16* PO = (bf16*)(a->ws + WS_PO);
    for (;;) {
        const int tid = opaque(tidx), lane = tid & 63, m = lane & 7, g = lane >> 3;
        const int item = peer_next_item(heads, myx, probe, 256u, bc, tid); if (item < 0) break;
        const int s = item >> 7, tile = item & 127, tok0 = tile * 128;
        peer_stage_idx(IDX, tok0, lds, tid);
#pragma unroll
        for (int i = 0; i < 8; ++i) { const int q = tid + 512 * i; *(LAS u32x4*)(lds + 32768 + 16 * q) = *(const u32x4*)(COEF + (size_t)tok0 * 128 + 4 * q); }
        __syncthreads();
        const unsigned char* vb = V8 + (size_t)s * 16384 * 128 + 16 * m;
#define PV_ISSUE(VV, X1, TT) do { const int tl_ = 16 * w + (TT); \
            const u32x4 idA_ = *(const LAS u32x4*)(lds + (tl_ * 128 + 16 * g) * 2), idB_ = *(const LAS u32x4*)(lds + (tl_ * 128 + 16 * g) * 2 + 16); \
            const unsigned idw_[8] = {idA_.x, idA_.y, idA_.z, idA_.w, idB_.x, idB_.y, idB_.z, idB_.w}; \
            _Pragma("unroll") for (int r = 0; r < 16; ++r) { const unsigned id = (r & 1) ? (idw_[r >> 1] >> 16) : (idw_[r >> 1] & 0xffffu); VV[r] = *(const u32x4*)(vb + (size_t)id * 128); } \
            X1 = (f32x2){0.f, 0.f}; } while (0)
#define PV_REDUCE(VV, X1, TT) do { const int tl_ = 16 * w + (TT), t_ = tok0 + tl_; f32x4 cfv[4]; \
            _Pragma("unroll") for (int i = 0; i < 4; ++i) cfv[i] = *(const LAS f32x4*)(lds + 32768 + (tl_ * 128 + 16 * g + 4 * i) * 4); \
            f32x2 acc[8]; \
            _Pragma("unroll") for (int j = 0; j < 8; ++j) acc[j] = (f32x2){0.f, 0.f}; \
            _Pragma("unroll") for (int r = 0; r < 16; ++r) { const float cf = cfv[r >> 2][r & 3]; const f32x2 c2 = {cf, cf}; \
                acc[0] += c2 * fp8lo(VV[r].x); acc[1] += c2 * fp8hi(VV[r].x); acc[2] += c2 * fp8lo(VV[r].y); acc[3] += c2 * fp8hi(VV[r].y); \
                acc[4] += c2 * fp8lo(VV[r].z); acc[5] += c2 * fp8hi(VV[r].z); acc[6] += c2 * fp8lo(VV[r].w); acc[7] += c2 * fp8hi(VV[r].w); } \
            f32x2 q4[4], q2[2], q1; \
            _Pragma("unroll") for (int j = 0; j < 4; ++j) { const bool up = (lane & 32) != 0; const f32x2 snd = up ? acc[j] : acc[j + 4], kp = up ? acc[j + 4] : acc[j]; q4[j] = kp + (f32x2){__shfl_xor(snd.x, 32), __shfl_xor(snd.y, 32)}; } \
            _Pragma("unroll") for (int j = 0; j < 2; ++j) { const bool up = (lane & 16) != 0; const f32x2 snd = up ? q4[j] : q4[j + 2], kp = up ? q4[j + 2] : q4[j]; q2[j] = kp + (f32x2){__shfl_xor(snd.x, 16), __shfl_xor(snd.y, 16)}; } \
            { const bool up = (lane & 8) != 0; const f32x2 snd = up ? q2[0] : q2[1], kp = up ? q2[1] : q2[0]; q1 = kp + (f32x2){__shfl_xor(snd.x, 8), __shfl_xor(snd.y, 8)}; } \
            if (!DRY) *(unsigned*)(PO + (size_t)t_ * DM + 128 * s + 16 * m + 2 * g) = cvtpk(q1.x + X1.x, q1.y + X1.y); } while (0)
        u32x4 vvA[16], vvB[16]; f32x2 xA, xB;
        for (int tt = 0; tt < 16; ++tt) { PV_ISSUE(vvA, xA, tt); PV_REDUCE(vvA, xA, tt); }
        (void)vvB; (void)xB;
#undef PV_ISSUE
#undef PV_REDUCE
        __syncthreads();
    }
}
#if SELFCHECK
constexpr size_t WS_YDBG = 464 * MiB;
constexpr size_t WS_XSAVE = 500 * MiB;
__device__ __forceinline__ float bfr(float v) { return bf2f(f2bf(v)); }
__device__ __forceinline__ void chk_report(ArgsP a, int k, float err) { if (!(err == err)) err = 1e30f; atomicMax((int*)(a->ws + WS_MISC + MISC_CHK) + k, __float_as_int(err)); }
__device__ const int CHK_ROWS[8] = {0, 1, 255, 256, 7777, 12345, 16128, 16383};
__device__ const int CHK_TOK[8] = {0, 1, 63, 127, 128, 129, 8191, 16383};
__device__ __forceinline__ float geluf(float x) { return 0.5f * x * (1.f + erff(x * 0.70710678118654752f)); }
__device__ __forceinline__ void chk1(ArgsP a, const int tidx) {
    const int gt = blockIdx.x * NTHR + tidx, NGT = gridDim.x * NTHR;
    const bf16 *Z = (const bf16*)(a->ws + WS_Z), *XBC = (const bf16*)(a->ws + WS_XBC), *Q = (const bf16*)(a->ws + WS_Q), *K = (const bf16*)(a->ws + WS_K), *V = (const bf16*)(a->ws + WS_V); const float* DTF = (const float*)(a->ws + WS_DTF);
    for (int it = gt; it < 8 * 5664; it += NGT) { const int t = CHK_ROWS[it / 5664], j = it % 5664; const float* xr = a->x + (size_t)t * DM;
        float ss = 0.f; for (int k = 0; k < DM; ++k) ss += xr[k] * xr[k]; const float rstd = 1.f / sqrtf(ss / DM + EPS);
        float ref = 0.f; for (int k = 0; k < DM; ++k) ref += bfr(xr[k] * rstd * a->ln1_w[k]) * bfr(a->w_in[(size_t)k * 5664 + j]);
        float got;
        if (j < 1024) got = bf2f(Z[(size_t)t * 1024 + j]); else if (j < 2560) got = bf2f(XBC[(size_t)t * 1536 + j - 1024]); else if (j < 2576) got = DTF[(size_t)t * 32 + j - 2560];
        else if (j < 3600) got = bf2f(Q[(size_t)t * 1024 + j - 2576]) / QSCALE; else if (j < 4624) got = bf2f(K[(size_t)t * 1024 + j - 3600]); else if (j < 5648) got = bf2f(V[(size_t)t * 1024 + j - 4624]);
        else got = DTF[(size_t)t * 32 + 16 + j - 5648];
        chk_report(a, 1, fabsf(got - ref)); }
}
__device__ __forceinline__ void chk2(ArgsP a, const int tidx) {
    const int gt = blockIdx.x * NTHR + tidx, NGT = gridDim.x * NTHR;
    const bf16 *XBC = (const bf16*)(a->ws + WS_XBC), *XS = (const bf16*)(a->ws + WS_XS), *BC = (const bf16*)(a->ws + WS_BC); const float *DTF = (const float*)(a->ws + WS_DTF), *DT = (const float*)(a->ws + WS_DT), *ACUM = (const float*)(a->ws + WS_ACUM);
    for (int it = gt; it < 64 * 1536; it += NGT) { const int si = it / 1536, ch = it % 1536; const int t = si < 8 ? si : (si < 16 ? 60 + (si - 8) : (int)(((unsigned)si * 2654435761u) % M));
        float acc = a->conv_b[ch]; for (int j = 0; j < 4; ++j) { const int tt = t - 3 + j; if (tt >= 0) acc += a->conv_w[j * 1536 + ch] * bf2f(XBC[(size_t)tt * 1536 + ch]); }
        const float ref = siluf(acc); const float got = ch < 1024 ? bf2f(XS[(size_t)t * 1024 + ch]) : bf2f(BC[(size_t)t * 512 + ch - 1024]);
        chk_report(a, 2, fabsf(got - ref));
        if (ch < 16) { const int h = ch; const float A = -__expf(a->a_log[h]); float ac = 0.f, dtl = 0.f; for (int tt = (t / 64) * 64; tt <= t; ++tt) { dtl = softplusf(DTF[(size_t)tt * 32 + h] + a->dt_bias[h]); ac += dtl * A; }
            chk_report(a, 2, fabsf(DT[(size_t)t * 16 + h] - dtl) * 10.f); chk_report(a, 2, fabsf(ACUM[(size_t)t * 16 + h] - ac)); } }
}
__device__ __forceinline__ void chk3(ArgsP a, const int tidx) {
    const int gt = blockIdx.x * NTHR + tidx, NGT = gridDim.x * NTHR;
    const bf16 *XS = (const bf16*)(a->ws + WS_XS), *BC = (const bf16*)(a->ws + WS_BC), *SL = (const bf16*)(a->ws + WS_SLOC); const float *DT = (const float*)(a->ws + WS_DT), *ACUM = (const float*)(a->ws + WS_ACUM);
    for (int it = gt; it < 8192; it += NGT) { const unsigned hsh = (unsigned)it * 2654435761u; const int c = it < 2048 ? (it & 1) * 255 : (hsh >> 8) & 255, h = (hsh >> 16) & 15, p = (hsh >> 20) & 63, n = (hsh >> 26) & 63 | ((it & 1) << 6), g = h >> 3;
        const float al = ACUM[(size_t)(c * 64 + 63) * 16 + h]; float ref = 0.f;
        for (int sx = 0; sx < 64; ++sx) { const int t = c * 64 + sx; ref += bf2f(BC[(size_t)t * 512 + 128 * g + n]) * bfr(bf2f(XS[(size_t)t * 1024 + 64 * h + p]) * DT[(size_t)t * 16 + h] * __expf(al - ACUM[(size_t)t * 16 + h])); }
        const float got = bf2f(SL[((size_t)(c * 16 + h) * 64 + p) * 128 + n]);
        chk_report(a, 3, fabsf(got - ref) / fmaxf(fabsf(ref), 0.05f)); }
}
__device__ __forceinline__ void chk13(ArgsP a, const int tidx) {
    const int gt = blockIdx.x * NTHR + tidx, NGT = gridDim.x * NTHR;
    const bf16 *XS = (const bf16*)(a->ws + WS_XS), *BC = (const bf16*)(a->ws + WS_BC), *SL = (const bf16*)(a->ws + WS_SLOC); const float *DT = (const float*)(a->ws + WS_DT), *ACUM = (const float*)(a->ws + WS_ACUM);
    for (int it = gt; it < 4096; it += NGT) { const unsigned hsh = (unsigned)it * 2654435761u; const int h = (hsh >> 16) & 15, p = (hsh >> 20) & 63, n = (hsh >> 26) & 63 | ((it & 1) << 6), g = h >> 3;
        float st = 0.f, num = 0.f, den = 1e-12f;
        for (int c = 0; c < NCHUNK; ++c) { const float got = bf2f(SL[((size_t)(c * 16 + h) * 64 + p) * 128 + n]); num += (got - st) * (got - st); den += st * st;
            const float al = ACUM[(size_t)(c * 64 + 63) * 16 + h]; float sl = 0.f;
            for (int sx = 0; sx < 64; ++sx) { const int t = c * 64 + sx; sl += bf2f(BC[(size_t)t * 512 + 128 * g + n]) * bf2f(XS[(size_t)t * 1024 + 64 * h + p]) * DT[(size_t)t * 16 + h] * __expf(al - ACUM[(size_t)t * 16 + h]); }
            st = st * __expf(al) + sl; }
        chk_report(a, 13, sqrtf(num / den)); }
}
__device__ __forceinline__ void chk4(ArgsP a, const int tidx) {
    const int lane = tidx & 63, gw = blockIdx.x * NWAVES + (tidx >> 6);
    const bf16 *XS = (const bf16*)(a->ws + WS_XS), *BC = (const bf16*)(a->ws + WS_BC); const float *DT = (const float*)(a->ws + WS_DT); const float* Y = (const float*)(a->ws + WS_YDBG);
    if (gw >= 32) return;
    const int h = (gw * 5 + 3) & 15, p = (gw * 23 + 7) & 63, g = h >> 3; const float A = -__expf(a->a_log[h]);
    float s0 = 0.f, s1 = 0.f, emax = 0.f, emax0 = 0.f, num = 0.f, den = 1e-12f;
    for (int t = 0; t < 8192; ++t) { const float dt = DT[(size_t)t * 16 + h], x = bf2f(XS[(size_t)t * 1024 + 64 * h + p]), dA = __expf(dt * A);
        const float b0 = bf2f(BC[(size_t)t * 512 + 128 * g + lane]), b1 = bf2f(BC[(size_t)t * 512 + 128 * g + 64 + lane]), c0 = bf2f(BC[(size_t)t * 512 + 256 + 128 * g + lane]), c1 = bf2f(BC[(size_t)t * 512 + 256 + 128 * g + 64 + lane]);
        s0 = s0 * dA + dt * b0 * x; s1 = s1 * dA + dt * b1 * x;
        const float y = wave_sum(c0 * s0 + c1 * s1); const float got = Y[(size_t)t * 1024 + 64 * h + p];
        float e = fabsf(got - y) / fmaxf(fabsf(y), 0.25f); if (!(got == got)) e = 1e30f; if (t < 64) emax0 = fmaxf(emax0, e); else { num += (got - y) * (got - y); den += y * y; } }
    emax = sqrtf(num / den);
    if (lane == 0) { chk_report(a, 12, emax0); chk_report(a, 4, emax); }
}
__device__ __forceinline__ void chk567(ArgsP a, const int tidx) {
    const int lane = tidx & 63, gw = blockIdx.x * NWAVES + (tidx >> 6);
    const bf16 *XS = (const bf16*)(a->ws + WS_XS), *Zb = (const bf16*)(a->ws + WS_Z), *MIX = (const bf16*)(a->ws + WS_MIX); const float* Y = (const float*)(a->ws + WS_YDBG);
    if (gw >= 64 && gw < 128) { const int si = gw - 64, g = si & 1, t = (si >> 1) < 4 ? (si >> 1) * 63 : (int)(((unsigned)si * 2654435761u) % 8192);
        float v[8]; float ss = 0.f;
#pragma unroll
        for (int i = 0; i < 8; ++i) { const int ch = 512 * g + lane + 64 * i; const float y = (Y[(size_t)t * 1024 + ch] + a->d_skip[ch >> 6] * bf2f(XS[(size_t)t * 1024 + ch])) * siluf(bf2f(Zb[(size_t)t * 1024 + ch])); v[i] = y; ss += y * y; }
        const float rstd = 1.f / sqrtf(wave_sum(ss) / 512.f + EPS); float e = 0.f;
#pragma unroll
        for (int i = 0; i < 8; ++i) { const int ch = 512 * g + lane + 64 * i; const float rf = v[i] * rstd * a->ssd_norm_w[ch]; e = fmaxf(e, fabsf(bf2f(MIX[(size_t)t * DM + ch]) - rf) / fmaxf(1.f, fabsf(rf))); }
        chk_report(a, 5, e); }
    if (gw >= 128 && gw < 144 && lane == 0) { const int h = gw - 128; const float* DTF = (const float*)(a->ws + WS_DTF); const float* CL = (const float*)(a->ws + WS_CUMF) + (size_t)h * M; double c = 0.0; float e = 0.f;
        for (int t = 0; t < M; ++t) { c += (double)logsigmoidf(DTF[(size_t)t * 32 + 16 + h] + a->fox_f_bias[h]); const float ref = (float)(c * 1.4426950408889634); e = fmaxf(e, fabsf(CL[t] - ref) / (1.f + 1e-4f * fabsf(ref))); }
        chk_report(a, 6, e); }
    if (gw >= 160 && gw < 224) { const int si = gw - 160, h = (si * 7 + 1) & 15; const int t = si < 8 ? CHK_TOK[si] : (int)(((unsigned)si * 2654435761u) % M);
        const bf16 *Q = (const bf16*)(a->ws + WS_Q), *K = (const bf16*)(a->ws + WS_K), *V = (const bf16*)(a->ws + WS_V); const float* CL = (const float*)(a->ws + WS_CUMF) + (size_t)h * M;
        const float q = bf2f(Q[(size_t)t * 1024 + 64 * h + lane]); float m = -1e30f, l = 0.f, o = 0.f;
        for (int j = 0; j <= t; ++j) { const float s = wave_sum(q * bf2f(K[(size_t)j * 1024 + 64 * h + lane])) + (CL[t] - CL[j]); const float mn = fmaxf(m, s), al = exp2f(m - mn), p = exp2f(s - mn);
            l = l * al + p; o = o * al + p * bf2f(V[(size_t)j * 1024 + 64 * h + lane]); m = mn; }
        const float e = fabsf(bf2f(MIX[(size_t)t * DM + 1024 + 64 * h + lane]) - o / l);
        chk_report(a, 7, wave_max(e)); }
}
__device__ __forceinline__ void chk8(ArgsP a, const int tidx) {
    const int gt = blockIdx.x * NTHR + tidx, NGT = gridDim.x * NTHR; const bf16* MIX = (const bf16*)(a->ws + WS_MIX); const bf16* HN = (const bf16*)(a->ws + WS_HN); float* XSV = (float*)(a->ws + WS_XSAVE);
    for (int it = gt; it < 8 * DM; it += NGT) { const int r = it / DM, t = CHK_ROWS[r], c = it % DM; float ref = a->x[(size_t)t * DM + c];
        for (int k = 0; k < DM; ++k) ref += bf2f(MIX[(size_t)t * DM + k]) * bfr(a->w_out[(size_t)k * DM + c]);
        const float got = bf2f(((const bf16*)(a->ws + WS_X1B))[(size_t)t * DM + c]); XSV[it] = got; chk_report(a, 8, fabsf(got - ref)); chk_report(a, 8, fabsf(bf2f(HN[(size_t)t * DM + c]) - got * a->ln2_w[c]) * 0.5f);
        if (c == 0) { float ss = 0.f; for (int k = 0; k < DM; ++k) { const float v = bf2f(((const bf16*)(a->ws + WS_X1B))[(size_t)t * DM + k]); ss += v * v; } const float sq = ((const float*)(a->ws + WS_MISC + MISC_SUMSQ))[t]; chk_report(a, 8, fabsf(sq - ss) / ss * 2.f); } }
}
__device__ __forceinline__ void chk910(ArgsP a, LAS unsigned char* lds, const int tidx) {
    const int gt = blockIdx.x * NTHR + tidx, NGT = gridDim.x * NTHR; const bf16* HN = (const bf16*)(a->ws + WS_HN); const bf16* QP = (const bf16*)(a->ws + WS_QP);
    for (int it = gt; it < 8 * DM; it += NGT) { const int r = it / DM, t = CHK_ROWS[r], c = it % DM; float ref = 0.f;
        for (int k = 0; k < DM; ++k) ref += bf2f(HN[(size_t)t * DM + k]) * bfr(a->peer_wq[(size_t)k * DM + c]);
        chk_report(a, 9, fabsf(bf2f(QP[(size_t)t * DM + c]) - ref)); }
    const int lane = tidx & 63, wv = tidx >> 6, gw = blockIdx.x * NWAVES + wv;
    if (gw < 64) { const int t = CHK_ROWS[gw >> 3], hd = gw & 7; LAS float* S = (LAS float*)lds + wv * 256;
        for (int half = 0; half < 2; ++half) for (int n = lane; n < 128; n += 64) { const float* kr = (half ? a->peer_k2 : a->peer_k1) + ((size_t)hd * 128 + n) * 128; float s = 0.f;
            for (int d = 0; d < 128; ++d) s += bf2f(QP[(size_t)t * DM + 256 * hd + 128 * half + d]) * bfr(kr[d]); S[128 * half + n] = s; }
        asm volatile("s_waitcnt lgkmcnt(0)" ::: "memory");
        float lo = -1e30f, hi = 1e30f; { float mx = -1e30f, mn = 1e30f; for (int i = lane; i < 128; i += 64) { mx = fmaxf(mx, S[i]); mn = fminf(mn, S[i]); } float mx2 = -1e30f, mn2 = 1e30f; for (int i = lane; i < 128; i += 64) { mx2 = fmaxf(mx2, S[128 + i]); mn2 = fminf(mn2, S[128 + i]); }
            hi = wave_max(mx) + wave_max(mx2) + 1.f; lo = -wave_max(-mn) - wave_max(-mn2) - 1.f; }
        for (int itn = 0; itn < 40; ++itn) { const float mid = 0.5f * (lo + hi); int cnt = 0; for (int i = lane; i < 16384; i += 64) cnt += (S[i >> 7] + S[128 + (i & 127)] >= mid) ? 1 : 0; cnt = (int)wave_sum((float)cnt); if (cnt >= 16) lo = mid; else hi = mid; }
        const float thr = lo; float mxs = -1e30f; for (int i = lane; i < 16384; i += 64) { const float s = S[i >> 7] + S[128 + (i & 127)]; if (s >= thr) mxs = fmaxf(mxs, s); } mxs = wave_max(mxs);
        const float rstd = 1.f / sqrtf(((const float*)(a->ws + WS_MISC + MISC_SUMSQ))[t] / DM + EPS);
        float den = 0.f; for (int i = lane; i < 16384; i += 64) { const float s = S[i >> 7] + S[128 + (i & 127)]; if (s >= thr) den += __expf((s - mxs) * rstd); } den = wave_sum(den);
        float e = 0.f; if (lane < 16) { const int id = ((const int*)(a->ws + WS_IDX))[(size_t)t * 128 + 16 * hd + lane]; const float g = ((const float*)(a->ws + WS_GW))[(size_t)t * 128 + 16 * hd + lane];
            if (id < 0 || id >= 16384) e = 10.f; else { const float s = S[id >> 7] + S[128 + (id & 127)]; if (s < thr - 2e-3f) e = 5.f; e = fmaxf(e, fabsf(g - __expf((s - mxs) * rstd) / den)); }
            for (int k2 = 0; k2 < 16; ++k2) { const int id2 = __shfl(id, k2); if (k2 != lane && id2 == id) e = 7.f; } }
        chk_report(a, 10, wave_max(e)); }
}
__device__ __forceinline__ void chk11(ArgsP a, const int tidx) {
    const int lane = tidx & 63, gw = blockIdx.x * NWAVES + (tidx >> 6); if (gw >= 8) return;
    const int t = CHK_ROWS[gw]; const bf16* HN = (const bf16*)(a->ws + WS_HN); const float* XSV = (const float*)(a->ws + WS_XSAVE) + gw * DM;
    const float rstd2 = 1.f / sqrtf(((const float*)(a->ws + WS_MISC + MISC_SUMSQ))[t] / DM + EPS);
    float acc[32];
#pragma unroll
    for (int i = 0; i < 32; ++i) acc[i] = 0.f;
    for (int k = 0; k < 128; ++k) { const int id = ((const int*)(a->ws + WS_IDX))[(size_t)t * 128 + k]; const float g = ((const float*)(a->ws + WS_GW))[(size_t)t * 128 + k];
        float s = 0.f;
#pragma unroll
        for (int i = 0; i < 32; ++i) { const int d = lane + 64 * i; s += bfr(a->peer_u[(size_t)id * DM + d]) * bf2f(HN[(size_t)t * DM + d]); }
        const float cf = g * geluf(wave_sum(s) * rstd2);
#pragma unroll
        for (int i = 0; i < 32; ++i) acc[i] += cf * bfr(a->peer_v[(size_t)id * DM + lane + 64 * i]); }
    float ss = 0.f;
#pragma unroll
    for (int i = 0; i < 32; ++i) { acc[i] += XSV[lane + 64 * i]; ss += acc[i] * acc[i]; }
    const float rstd = 1.f / sqrtf(wave_sum(ss) / DM + EPS); float e = 0.f;
#pragma unroll
    for (int i = 0; i < 32; ++i) e = fmaxf(e, fabsf(a->out[(size_t)t * DM + lane + 64 * i] - acc[i] * rstd * a->lnf_w[lane + 64 * i]));
    chk_report(a, 11, wave_max(e));
}
__device__ const float CHK_TOL[14] = {1.f, 0.05f, 0.02f, 0.05f, 0.06f, 0.03f, 0.02f, 0.03f, 0.03f, 0.06f, 0.05f, 0.03f, 0.06f, 0.03f};
__device__ const int CHK_ORD[13] = {1, 2, 3, 12, 13, 4, 5, 6, 7, 8, 9, 10, 11};
__device__ __forceinline__ void chk_verdict(ArgsP a, const int tidx) {
    const int* C = (const int*)(a->ws + WS_MISC + MISC_CHK); int bad = -1; float m = 0.f;
    for (int kk = 0; kk < 13; ++kk) { const int k = CHK_ORD[kk]; const float e = __int_as_float(C[k]); if (bad < 0 && e > CHK_TOL[k]) { bad = k; m = fminf(fmaxf(e / CHK_TOL[k], 1.f), 9.9f); } }
    if (bad < 0) return;
    const float cst = sqrtf(m * powf(100.f, (float)(bad + 1)));
    const size_t gt = (size_t)blockIdx.x * NTHR + tidx, NGT = (size_t)gridDim.x * NTHR;
    for (size_t i = gt; i < (size_t)M * DM; i += NGT) a->out[i] = cst;
}
#endif
#ifndef MK_PER_PHASE
#define MK_PER_PHASE 0
#endif
constexpr int NPHASE = 12;
__global__ void __launch_bounds__(NTHR, 2) hymba_fwd(Args a) {
    extern __shared__ __attribute__((aligned(16))) unsigned char lds_raw[];
    LAS unsigned char* lds = (LAS unsigned char*)lds_raw;
    const int lo = a.ph_lo, hi = a.ph_hi;
    const int wv_ = __builtin_amdgcn_readfirstlane((int)threadIdx.x >> 6);
#define TID (wv_ * 64 + lane_id())
    int dupi_ = 0; (void)dupi_;
    volatile LAS unsigned* lctl = (volatile LAS unsigned*)(lds + LDS_BYTES - 64);
    if (TID < 16) lctl[TID] = 0u;
    __syncthreads();
    (void)xcd_barrier_post((unsigned*)(get_args()->ws + WS_CTL) + 4096, lctl, TID);
#define A get_args()
#if SELFCHECK
#define CHK(x) x
#else
#define CHK(x)
#endif
#define IN(k) (lo <= (k) && (k) < hi)
#define GRIDBAR() do { XcdBarrier xb_; xb_.bar = (unsigned*)(get_args()->ws + WS_CTL) + 4096; xb_.x = xb_xcc_id(); xb_.st = (volatile LAS unsigned*)(lds + LDS_BYTES - 64); xcd_barrier(xb_, TID); } while (0)
#ifndef PEER8
#define PEER8 1
#endif
#ifndef DUP_MASK
#define DUP_MASK 0
#endif
#define DUP(bit, stmt) do { stmt; if (DUP_MASK & (1 << (bit))) { __syncthreads(); stmt; } } while (0)
#define SEAM(k) do { if (IN(k) && IN((k) + 1)) { GRIDBAR(); } } while (0)
    if (IN(0)) { DUP(0, phase0(A, lds, TID)); } SEAM(0);
    if (IN(1)) {
        pg8::Gemm g{(const bf16*)(A->ws + WS_XN), (const bf16*)(A->ws + WS_WIN), M, NIN, DM}; pg8::StaticOrder S; S.init(M, NIN, gridDim.x, (int)blockIdx.x);
        EpiInProj E{(bf16*)(A->ws + WS_Z), (bf16*)(A->ws + WS_XBC), (bf16*)(A->ws + WS_Q), (bf16*)(A->ws + WS_K), (bf16*)(A->ws + WS_V), (float*)(A->ws + WS_DTF)};
        DUP(1, (pg8::gemm_phase<EpiInProj, pg8::StaticOrder, true, true>(lds, g, S, E, TID)));
    } SEAM(1);
    if (IN(2)) { CHK(chk1(A, TID)); DUP(2, phase2(A, lds, TID)); } SEAM(2);
    if (IN(3)) { CHK(chk2(A, TID)); CHK(chk3(A, TID)); CHK(GRIDBAR()); if (DUP_MASK & 8) { phase3<true>(A, TID); } phase3<false>(A, TID); } SEAM(3);
    if (IN(4)) { DUP(4, phase4(A, lds, TID));
        const attn_body::AttnTensors AT{(const bf16*)(A->ws + WS_Q), (const bf16*)(A->ws + WS_K), (const bf16*)(A->ws + WS_V), (bf16*)(A->ws + WS_MIX), (const float*)(A->ws + WS_CUMF),
                                        (const float*)(A->ws + WS_MISC + MISC_QN2), (const float*)(A->ws + WS_MISC + MISC_KN2)};
        DUP(12, (attn_body::attn_phase<8>((char*)lds_raw, AT, (unsigned*)(A->ws + WS_CTL) + Q_A + ((DUP_MASK & 4096) ? 512 * dupi_++ : 0), (int)(xb_xcc_id() & 7u), TID, A)));
    } SEAM(4);
    if (IN(5)) {
        CHK(chk13(A, TID)); CHK(chk4(A, TID)); CHK(chk567(A, TID)); CHK(GRIDBAR());
        pg8::Gemm g{(const bf16*)(A->ws + WS_MIX), (const bf16*)(A->ws + WS_WOUT), M, DM, DM}; pg8::StaticOrder S; S.init(M, DM, gridDim.x, (int)blockIdx.x);
        EpiOutProj E{A->x, (bf16*)(A->ws + WS_X1B), (bf16*)(A->ws + WS_HN), A->ln2_w, (float*)(A->ws + WS_MISC + MISC_SUMSQ)};
        pg8::gemm_phase<EpiOutProj, pg8::StaticOrder, true, true>(lds, g, S, E, TID);
        if (!PEER8) convert_uv_sliced(A, TID);
    } SEAM(5);
    if (IN(6)) {
        CHK(chk8(A, TID));
        pg8::Gemm g{(const bf16*)(A->ws + WS_HN), (const bf16*)(A->ws + WS_WQ), M, DM, DM}; pg8::StaticOrder S; S.init(M, DM, gridDim.x, (int)blockIdx.x);
        EpiPlainBf16 E{(bf16*)(A->ws + WS_QP), DM};
        DUP(6, (pg8::gemm_phase<EpiPlainBf16, pg8::StaticOrder, true, true>(lds, g, S, E, TID)));
    } SEAM(6);
    if (IN(7)) { DUP(7, phase7(A, lds, TID)); } SEAM(7);
    if (IN(8)) { CHK(chk910(A, lds, TID)); CHK(__syncthreads()); if (PEER8) { DUP(8, peer_u_phase8(A, lds, TID, (DUP_MASK & 256) ? 512 * dupi_++ : 0)); } else { DUP(8, peer_u_phase(A, lds, TID, (DUP_MASK & 256) ? 512 * dupi_++ : 0)); } } SEAM(8);
    if (IN(9)) { if (PEER8) { DUP(9, peer_combine8(A, TID)); } else { DUP(9, peer_combine(A, TID)); } } SEAM(9);
    if (IN(10)) { if (PEER8) { if (DUP_MASK & 1024) { peer_v_phase8<true>(A, lds, TID, 512); } peer_v_phase8<false>(A, lds, TID); } else { if (DUP_MASK & 1024) { peer_v_phase<true>(A, lds, TID, 512); } peer_v_phase<false>(A, lds, TID); } } SEAM(10);
    if (IN(11)) { if (PEER8) { peer_final8(A, TID); } else { peer_final<false>(A, TID); } CHK(GRIDBAR()); CHK(chk11(A, TID)); CHK(GRIDBAR()); CHK(chk_verdict(A, TID)); }
#undef A
#undef TID
#undef IN
#undef SEAM
#undef DUP
#undef GRIDBAR
}

extern "C" void kernel_launch(void* const* d_in, const int* in_sizes, int n_in, void* d_out, int out_size, void* d_ws, size_t ws_size, hipStream_t stream) {
    static int grid = 0;
    if (grid == 0) {
        if (n_in != 18 || in_sizes[0] != M * DM || out_size != M * DM || ws_size < WS_END) { fprintf(stderr, "kernel_launch: unexpected shapes (n_in %d, in0 %d, out %d, ws %zu)\n", n_in, n_in > 0 ? in_sizes[0] : -1, out_size, ws_size); grid = -1; return; }
        int dev = 0, cus = 0, per_cu = 0;
        if (hipGetDevice(&dev) != hipSuccess || hipDeviceGetAttribute(&cus, hipDeviceAttributeMultiprocessorCount, dev) != hipSuccess) { grid = -1; return; }
        if (hipFuncSetAttribute((const void*)hymba_fwd, hipFuncAttributeMaxDynamicSharedMemorySize, LDS_BYTES) != hipSuccess) { fprintf(stderr, "kernel_launch: hipFuncSetAttribute failed\n"); grid = -1; return; }
        if (hipOccupancyMaxActiveBlocksPerMultiprocessor(&per_cu, (const void*)hymba_fwd, NTHR, LDS_BYTES) != hipSuccess || per_cu < 1) { fprintf(stderr, "kernel_launch: occupancy query says %d\n", per_cu); (void)hipGetLastError(); grid = -1; return; }
        grid = cus;
    }
    if (grid < 0) return;
    Args a{};
    const float** f = (const float**)&a;
    for (int i = 0; i < 18; ++i) f[i] = (const float*)d_in[i];
    a.out = (float*)d_out; a.ws = (unsigned char*)d_ws;
#if MK_PER_PHASE
    for (int p = 0; p < NPHASE; ++p) { a.ph_lo = p; a.ph_hi = p + 1; hipLaunchKernelGGL(hymba_fwd, dim3(grid), dim3(NTHR), LDS_BYTES, stream, a); }
#else
    a.ph_lo = 0; a.ph_hi = NPHASE;
    if (hipMemsetAsync((char*)d_ws + WS_CTL, 0, 65536, stream) != hipSuccess) { fprintf(stderr, "kernel_launch: hipMemsetAsync failed\n"); return; }
    hipLaunchKernelGGL(hymba_fwd, dim3(grid), dim3(NTHR), LDS_BYTES, stream, a);
#endif
}
```

```cpp
#include <hip/hip_runtime.h>
#include <cstdio>
#include <cstdint>
#include <cmath>
#ifndef SELFCHECK
#define SELFCHECK 0
#endif
namespace pg8 {
#define PG8_LAS __attribute__((address_space(3)))
typedef unsigned short bf16_t;
typedef short bf16x8 __attribute__((ext_vector_type(8)));
typedef float f32x4 __attribute__((ext_vector_type(4)));
typedef unsigned u32x4 __attribute__((ext_vector_type(4)));
constexpr int BM = 256, BK = 64, HALF = 128, HTB = HALF * BK * 2  , STAGE_BYTES = 8 * HTB, NXCD = 8, WGM = 4;

__host__ __device__ __forceinline__ int lds_byte(int r, int c) { const int st = (r >> 4) * 2 + (c >> 5), rr = r & 15, cc = c & 31, ob = rr * 64 + cc * 2; return st * 1024 + (ob ^ (((ob >> 9) & 1) << 5)); }
__host__ __device__ __forceinline__ void stage_rc(int b, int& R, int& C) { const int st = b / 1024, sb = b % 1024, swz = sb ^ (((sb >> 9) & 1) << 5); R = (st >> 1) * 16 + swz / 64; C = (st & 1) * 32 + (swz % 64) / 2; }
__host__ __device__ __forceinline__ int perm32(int rho) { const int n = rho >> 4, i = rho & 15; return 8 * (i >> 2) + 4 * n + (i & 3); }

struct Unit { int pm, pn; };
struct Gemm { const bf16_t* A; const bf16_t* Bt; int M, N, K; };

struct StaticOrder {
    int nM, nN, nwg, G, c;
    __host__ __device__ void init(int M, int N, int G_, int c_) { nM = M / BM; nN = N / BM; nwg = nM * nN; G = G_; c = c_; }
    __host__ __device__ bool next(int i, Unit& u) const {
        const long L = (long)i * G + c; if (L >= nwg) return false;
        int wgid = (int)L; { const int q = nwg / NXCD, r = nwg % NXCD, xcd = wgid % NXCD, off = wgid / NXCD; wgid = (xcd < r ? xcd * (q + 1) : r * (q + 1) + (xcd - r) * q) + off; }
        const int nig = WGM * nN, gid = wgid / nig, fm = gid * WGM, gsz = (nM - fm) < WGM ? (nM - fm) : WGM;
        u.pm = fm + ((wgid % nig) % gsz); u.pn = (wgid % nig) / gsz; return true;
    }
    __device__ __forceinline__ void a_ready(const Unit&) const {}
    __device__ __forceinline__ void done(const Unit&) const {}
};

__device__ __forceinline__ unsigned cvt_pk_bf16(float lo, float hi) { unsigned r; asm volatile("v_cvt_pk_bf16_f32 %0, %1, %2" : "=v"(r) : "v"(lo), "v"(hi)); return r; }
typedef float f32x2 __attribute__((ext_vector_type(2)));
__device__ __forceinline__ f32x2 gelu_pk(f32x2 v) {
    const f32x2 av = __builtin_elementwise_abs(v), d = av * 0.2316418882f + 1.0f;
    f32x2 t; t.x = __builtin_amdgcn_rcpf(d.x); t.y = __builtin_amdgcn_rcpf(d.y);
    f32x2 q = t * 0.5307027145f + (-0.7265760135f); q = q * t + 0.7107068705f; q = q * t + (-0.142248368f); q = q * t + 0.127414796f; q = q * t;
    const f32x2 s = (v * v) * (-0.72134752044f);
    f32x2 e; e.x = __builtin_amdgcn_exp2f(s.x); e.y = __builtin_amdgcn_exp2f(s.y);
    const f32x2 m = v * (q * e), r = v - m;
    f32x2 o; o.x = v.x < 0.f ? m.x : r.x; o.y = v.y < 0.f ? m.y : r.y; return o;
}

template <int ACT  > struct EpiBf16 {
    static constexpr bool PERM = true, AFTER_DRAIN = false; static_assert(ACT == 0 || ACT == 1, "EpiBf16: ACT is 0 (none) or 1 (gelu_pk)");
    bf16_t* O; int ldc; const float* bias; int split_cols; size_t split_stride; float scale0;
    __device__ __forceinline__ void operator()(const f32x4 (&acc)[2][2][4][2], const Unit& u, int wr, int wc, int fr, int fq) const {
        const int row0 = u.pm * BM + wr * 64 + fr; int colt = u.pn * BM; bf16_t* base = O;
        float sc = 1.f; if (split_cols) { const int t = colt / split_cols; base += (size_t)t * split_stride; colt -= t * split_cols; if (t == 0) sc = scale0; }
        const int col0 = colt + wc * 32 + 8 * fq, bcol0 = u.pn * BM + wc * 32 + 8 * fq;
        f32x4 bv[2][2];
#pragma unroll
        for (int bj = 0; bj < 2; ++bj)
#pragma unroll
            for (int n = 0; n < 2; ++n) bv[bj][n] = bias ? *(const f32x4*)(bias + bcol0 + bj * HALF + 4 * n) : (f32x4){0.f, 0.f, 0.f, 0.f};
#pragma unroll
        for (int ai = 0; ai < 2; ++ai)
#pragma unroll
            for (int m = 0; m < 4; ++m) { bf16_t* rowp = base + (size_t)(row0 + ai * HALF + m * 16) * ldc + col0;
#pragma unroll
                for (int bj = 0; bj < 2; ++bj) { f32x4 v0 = acc[ai][bj][m][0] + bv[bj][0], v1 = acc[ai][bj][m][1] + bv[bj][1];
                    if (ACT == 1) { f32x2 a = gelu_pk((f32x2){v0[0], v0[1]}), b = gelu_pk((f32x2){v0[2], v0[3]}), c = gelu_pk((f32x2){v1[0], v1[1]}), d = gelu_pk((f32x2){v1[2], v1[3]});
                        v0 = (f32x4){a.x, a.y, b.x, b.y}; v1 = (f32x4){c.x, c.y, d.x, d.y}; }
                    v0 = v0 * sc; v1 = v1 * sc; u32x4 w; w.x = cvt_pk_bf16(v0[0], v0[1]); w.y = cvt_pk_bf16(v0[2], v0[3]); w.z = cvt_pk_bf16(v1[0], v1[1]); w.w = cvt_pk_bf16(v1[2], v1[3]);
                    *(u32x4*)(rowp + bj * HALF) = w; } }
    }
};
template <class Epi, class Sched, bool ALIGN_EPI = false, bool SP2 = false>
__device__ __forceinline__ void gemm_phase(PG8_LAS unsigned char* lds, const Gemm g, const Sched& S, const Epi& E, const int tid_in) {
    const int tid = tid_in, wid = __builtin_amdgcn_readfirstlane(tid >> 6), lane = tid & 63, wr = wid >> 2, wc = wid & 3, fr = lane & 15, fq = lane >> 4;
    const int K = g.K, nt = K / BK;
    unsigned voffA[2], voffB[2];
#pragma unroll
    for (int i = 0; i < 2; ++i) { int R, C; stage_rc(tid * 16 + i * 8192, R, C); const int Rb = Epi::PERM ? ((R & ~31) + perm32(R & 31)) : R;
        voffA[i] = (unsigned)(R * K + C) * 2u; voffB[i] = (unsigned)(Rb * K + C) * 2u; }
    const size_t kstep = (size_t)(BK * 2);
    const size_t hstep = (size_t)HALF * K * 2;
    const size_t tstep = 2 * hstep;
    const unsigned ldsw = (unsigned)wid * 1024u;
    const int aoff = lds_byte(wr * 64 + fr, fq * 8), boff = lds_byte(wc * 32 + fr, fq * 8);
#define PG8_SA(b, h) (((b) * 2 + (h)) * HTB)
#define PG8_SB(b, h) ((4 + (b) * 2 + (h)) * HTB)
#define PG8_STAGE(bufoff, gbase, voff) do { _Pragma("unroll") for (int _i = 0; _i < 2; ++_i) \
        __builtin_amdgcn_global_load_lds((const unsigned*)((const char*)(gbase) + (voff)[_i]), (PG8_LAS unsigned*)(lds + (bufoff) + ldsw + _i * 8192), 16, 0, 0); } while (0)
#define PG8_LDA(dst, b, h) do { _Pragma("unroll") for (int m = 0; m < 4; ++m) _Pragma("unroll") for (int k = 0; k < 2; ++k) dst[m][k] = *(const PG8_LAS bf16x8*)(lds + PG8_SA(b, h) + aoff + m * 2048 + k * 1024); } while (0)
#define PG8_LDB(dst, b, h) do { _Pragma("unroll") for (int n = 0; n < 2; ++n) _Pragma("unroll") for (int k = 0; k < 2; ++k) dst[n][k] = *(const PG8_LAS bf16x8*)(lds + PG8_SB(b, h) + boff + n * 2048 + k * 1024); } while (0)
#define PG8_MMA(ai, bj, At, Bt) do { __builtin_amdgcn_s_setprio(1); _Pragma("unroll") for (int m = 0; m < 4; ++m) _Pragma("unroll") for (int n = 0; n < 2; ++n) _Pragma("unroll") for (int k = 0; k < 2; ++k) \
        acc[ai][bj][m][n] = __builtin_amdgcn_mfma_f32_16x16x32_bf16(Bt[n][k], At[m][k], acc[ai][bj][m][n], 0, 0, 0); __builtin_amdgcn_s_setprio(0); } while (0)
#define PG8_WAIT_V(n) asm volatile("s_waitcnt vmcnt(" #n ")" ::: "memory")
#define PG8_WAIT_L(n) asm volatile("s_waitcnt lgkmcnt(" #n ")" ::: "memory")
#define PG8_BAR __builtin_amdgcn_s_barrier()
#define PG8_SCHED __builtin_amdgcn_sched_barrier(0)
    Unit cur, nxt; int ui = 0;
    if (!S.next(0, cur)) return;
    f32x4 acc[2][2][4][2];
#pragma unroll
    for (int a = 0; a < 2; ++a)
#pragma unroll
        for (int b = 0; b < 2; ++b)
#pragma unroll
            for (int m = 0; m < 4; ++m)
#pragma unroll
                for (int n = 0; n < 2; ++n) acc[a][b][m][n] = (f32x4){0.f, 0.f, 0.f, 0.f};
    bf16x8 At[4][2], B0[2][2], B1[2][2];
    const char* cA = (const char*)g.A + (size_t)cur.pm * tstep; const char* cB = (const char*)g.Bt + (size_t)cur.pn * tstep;
    S.a_ready(cur);
    if constexpr (SP2) {
        PG8_STAGE(PG8_SB(0, 0), cB, voffB); PG8_STAGE(PG8_SB(0, 1), cB + hstep, voffB); PG8_STAGE(PG8_SA(0, 0), cA, voffA); PG8_STAGE(PG8_SA(0, 1), cA + hstep, voffA);
        if (wr == 1) PG8_BAR;
        PG8_WAIT_V(2); PG8_BAR;
        PG8_STAGE(PG8_SB(1, 0), cB + kstep, voffB); PG8_STAGE(PG8_SA(1, 0), cA + kstep, voffA); PG8_STAGE(PG8_SB(1, 1), cB + hstep + kstep, voffB);
        PG8_WAIT_V(6); PG8_BAR;
    } else {
        PG8_STAGE(PG8_SB(0, 0), cB, voffB); PG8_STAGE(PG8_SA(0, 0), cA, voffA); PG8_STAGE(PG8_SB(0, 1), cB + hstep, voffB); PG8_STAGE(PG8_SA(0, 1), cA + hstep, voffA);
        if (wr == 1) PG8_BAR;
        PG8_WAIT_V(4); PG8_BAR;
        PG8_STAGE(PG8_SB(1, 0), cB + kstep, voffB); PG8_STAGE(PG8_SA(1, 0), cA + kstep, voffA); PG8_STAGE(PG8_SB(1, 1), cB + hstep + kstep, voffB);
        PG8_WAIT_V(6); PG8_BAR;
    }
    for (;;) {
        const bool has_next = S.next(ui + 1, nxt);
        const char* nA = has_next ? (const char*)g.A + (size_t)nxt.pm * tstep : cA; const char* nB = has_next ? (const char*)g.Bt + (size_t)nxt.pn * tstep : cB;
        for (int t = 0; t < nt; t += 2) {
            const bool last = (t == nt - 2);
            const char* a1 = cA + (size_t)(t + 1) * kstep;
            const char* a2 = last ? nA : cA + (size_t)(t + 2) * kstep; const char* b2 = last ? nB : cB + (size_t)(t + 2) * kstep;
            const char* a3 = a2 + kstep; const char* b3 = b2 + kstep;
            if (last && has_next) S.a_ready(nxt);
            if constexpr (SP2) {
            PG8_LDB(B0, 0, 0); PG8_LDB(B1, 0, 1); PG8_SCHED; PG8_LDA(At, 0, 0); PG8_STAGE(PG8_SA(1, 1), a1 + hstep, voffA);
            PG8_WAIT_V(8); PG8_WAIT_L(0); PG8_BAR; PG8_MMA(0, 0, At, B0); PG8_MMA(0, 1, At, B1); PG8_BAR; PG8_SCHED;
            PG8_LDA(At, 0, 1); PG8_STAGE(PG8_SB(0, 0), b2, voffB); PG8_STAGE(PG8_SB(0, 1), b2 + hstep, voffB); PG8_STAGE(PG8_SA(0, 0), a2, voffA);
            PG8_WAIT_V(8); PG8_WAIT_L(0); PG8_BAR; PG8_MMA(1, 0, At, B0); PG8_MMA(1, 1, At, B1); PG8_BAR; PG8_SCHED;
            PG8_LDB(B0, 1, 0); PG8_LDB(B1, 1, 1); PG8_SCHED; PG8_LDA(At, 1, 0); PG8_STAGE(PG8_SA(0, 1), a2 + hstep, voffA);
            PG8_WAIT_V(8); PG8_WAIT_L(0); PG8_BAR; PG8_MMA(0, 0, At, B0); PG8_MMA(0, 1, At, B1); PG8_BAR; PG8_SCHED;
            PG8_LDA(At, 1, 1); PG8_STAGE(PG8_SB(1, 0), b3, voffB); PG8_STAGE(PG8_SB(1, 1), b3 + hstep, voffB); PG8_STAGE(PG8_SA(1, 0), a3, voffA);
            PG8_WAIT_V(8); PG8_WAIT_L(0); PG8_BAR; PG8_MMA(1, 0, At, B0); PG8_MMA(1, 1, At, B1); PG8_BAR; PG8_SCHED;
            } else {
            PG8_LDB(B0, 0, 0); PG8_SCHED; PG8_LDA(At, 0, 0); PG8_STAGE(PG8_SA(1, 1), a1 + hstep, voffA);
            PG8_WAIT_L(8); PG8_BAR; PG8_WAIT_L(0); PG8_MMA(0, 0, At, B0); PG8_BAR; PG8_SCHED;
            PG8_LDB(B1, 0, 1); PG8_STAGE(PG8_SB(0, 0), b2, voffB);
            PG8_BAR; PG8_WAIT_L(0); PG8_MMA(0, 1, At, B1); PG8_BAR;
            PG8_LDA(At, 0, 1); PG8_STAGE(PG8_SA(0, 0), a2, voffA);
            PG8_BAR; PG8_WAIT_L(0); PG8_MMA(1, 0, At, B0); PG8_BAR; PG8_SCHED;
            PG8_STAGE(PG8_SB(0, 1), b2 + hstep, voffB);
            PG8_WAIT_V(6); PG8_BAR; PG8_MMA(1, 1, At, B1); PG8_BAR;
            PG8_LDB(B0, 1, 0); PG8_SCHED; PG8_LDA(At, 1, 0); PG8_STAGE(PG8_SA(0, 1), a2 + hstep, voffA);
            PG8_WAIT_L(8); PG8_BAR; PG8_WAIT_L(0); PG8_MMA(0, 0, At, B0); PG8_BAR; PG8_SCHED;
            PG8_LDB(B1, 1, 1); PG8_STAGE(PG8_SB(1, 0), b3, voffB);
            PG8_BAR; PG8_WAIT_L(0); PG8_MMA(0, 1, At, B1); PG8_BAR;
            PG8_LDA(At, 1, 1); PG8_STAGE(PG8_SA(1, 0), a3, voffA);
            PG8_BAR; PG8_WAIT_L(0); PG8_MMA(1, 0, At, B0); PG8_BAR; PG8_SCHED;
            PG8_STAGE(PG8_SB(1, 1), b3 + hstep, voffB);
            PG8_WAIT_V(6); PG8_BAR; PG8_MMA(1, 1, At, B1); PG8_BAR;
            }
        }
        if constexpr (ALIGN_EPI) { if (wr == 0) PG8_BAR; }
        if constexpr (!Epi::AFTER_DRAIN) { E(acc, cur, wr, wc, fr, fq); S.done(cur); }
        if (!has_next) break;
#pragma unroll
        for (int a = 0; a < 2; ++a)
#pragma unroll
            for (int b = 0; b < 2; ++b)
#pragma unroll
                for (int m = 0; m < 4; ++m)
#pragma unroll
                    for (int n = 0; n < 2; ++n) acc[a][b][m][n] = (f32x4){0.f, 0.f, 0.f, 0.f};
        cur = nxt; cA = nA; cB = nB; ++ui;
        if constexpr (ALIGN_EPI) { if (wr == 1) PG8_BAR; }
    }
    PG8_WAIT_V(0);
    if constexpr (!ALIGN_EPI) { if (wr == 0) PG8_BAR; }
    PG8_BAR;
    if constexpr (Epi::AFTER_DRAIN) { E.fused(acc, cur, wr, wc, fr, fq, lds, wid, lane); S.done(cur); }
#undef PG8_SA
#undef PG8_SB
#undef PG8_STAGE
#undef PG8_LDA
#undef PG8_LDB
#undef PG8_MMA
#undef PG8_WAIT_V
#undef PG8_WAIT_L
#undef PG8_BAR
#undef PG8_SCHED
}
}
#define LAS __attribute__((address_space(3)))
typedef unsigned short bf16;
typedef short bf16x8 __attribute__((ext_vector_type(8)));
typedef float f32x4 __attribute__((ext_vector_type(4)));
typedef float f32x2 __attribute__((ext_vector_type(2)));
typedef unsigned u32x4 __attribute__((ext_vector_type(4)));
typedef unsigned u32x2 __attribute__((ext_vector_type(2)));
typedef __bf16 bf16x2_t __attribute__((ext_vector_type(2)));

constexpr int M = 16384, DM = 2048, NIN = 5888, NCHUNK = 256;
constexpr float EPS = 1e-6f, LOG2E = 1.4426950408889634f, QSCALE = 0.125f * LOG2E;
constexpr int NWAVES = 8, NTHR = 512;
constexpr size_t MiB = 1u << 20;
constexpr size_t WS_CTL = 0, WS_WOUT = 1 * MiB, WS_WQ = 9 * MiB, WS_K12 = 17 * MiB, WS_XN = 18 * MiB, WS_WIN = 82 * MiB, WS_Z = 105 * MiB, WS_XBC = 137 * MiB,
                 WS_Q = 185 * MiB, WS_K = 217 * MiB, WS_V = 249 * MiB, WS_DTF = 281 * MiB, WS_XS = 283 * MiB, WS_BC = 315 * MiB, WS_DT = 331 * MiB, WS_ACUM = 332 * MiB,
                 WS_CUMF = 333 * MiB, WS_MISC = 334 * MiB, WS_MIX = 335 * MiB, WS_END = 464 * MiB;
constexpr size_t WS_SLOC = WS_XN;
constexpr size_t WS_HN = WS_XN;
constexpr size_t WS_QP = 105 * MiB, WS_IDX = 169 * MiB, WS_GW = 177 * MiB, WS_U = 185 * MiB, WS_V2 = 249 * MiB;
constexpr size_t MISC_FTOT = 0, MISC_SUMSQ = 65536, MISC_QN2 = 196608, MISC_KN2 = 212992, MISC_CHK = 262144;
constexpr int LDS_BYTES = 155648;

__device__ __forceinline__ unsigned cvtpk(float lo, float hi) { f32x2 v = {lo, hi}; bf16x2_t b = __builtin_convertvector(v, bf16x2_t); return __builtin_bit_cast(unsigned, b); }
__device__ __forceinline__ bf16 f2bf(float f) { return (bf16)(cvtpk(f, 0.f) & 0xffffu); }
__device__ __forceinline__ float bf2f(bf16 h) { return __uint_as_float((unsigned)h << 16); }
__device__ __forceinline__ float bflo(unsigned w) { return __uint_as_float(w << 16); }
__device__ __forceinline__ float bfhi(unsigned w) { return __uint_as_float(w & 0xffff0000u); }
template <int CTRL, int RM> __device__ __forceinline__ float dpp_self(float v) { return __int_as_float(__builtin_amdgcn_update_dpp(__float_as_int(v), __float_as_int(v), CTRL, RM, 0xf, false)); }
template <int CTRL, int RM> __device__ __forceinline__ float dpp_zero(float v) { return __int_as_float(__builtin_amdgcn_update_dpp(0, __float_as_int(v), CTRL, RM, 0xf, false)); }
__device__ __forceinline__ float wave_max(float v) {
    v = fmaxf(v, dpp_self<0x111, 0xf>(v)); v = fmaxf(v, dpp_self<0x112, 0xf>(v)); v = fmaxf(v, dpp_self<0x114, 0xf>(v)); v = fmaxf(v, dpp_self<0x118, 0xf>(v));
    v = fmaxf(v, dpp_self<0x142, 0xa>(v)); v = fmaxf(v, dpp_self<0x143, 0xc>(v));
    return __int_as_float(__builtin_amdgcn_readlane(__float_as_int(v), 63));
}
__device__ __forceinline__ float wave_sum(float v) {
    v += dpp_zero<0x111, 0xf>(v); v += dpp_zero<0x112, 0xf>(v); v += dpp_zero<0x114, 0xf>(v); v += dpp_zero<0x118, 0xf>(v);
    v += dpp_zero<0x142, 0xa>(v); v += dpp_zero<0x143, 0xc>(v);
    return __int_as_float(__builtin_amdgcn_readlane(__float_as_int(v), 63));
}
__device__ __forceinline__ float wave_scan_incl(float v, int lane) {
#pragma unroll
    for (int o = 1; o < 64; o <<= 1) { const float t = __shfl_up(v, o); if (lane >= o) v += t; }
    return v;
}
__device__ __forceinline__ float siluf(float x) { return x / (1.f + __expf(-x)); }
__device__ __forceinline__ float softplusf(float x) { return fmaxf(x, 0.f) + log1pf(__expf(-fabsf(x))); }
__device__ __forceinline__ float logsigmoidf(float x) { return fminf(x, 0.f) - log1pf(__expf(-fabsf(x))); }
__device__ __forceinline__ float dot2bf(unsigned a, unsigned b, float c) { const unsigned aa = a, bb = b; return __builtin_amdgcn_fdot2_f32_bf16(__builtin_bit_cast(bf16x2_t, aa), __builtin_bit_cast(bf16x2_t, bb), c, false); }
__device__ __forceinline__ f32x4 mfma16(bf16x8 a, bf16x8 b, f32x4 c) { return __builtin_amdgcn_mfma_f32_16x16x32_bf16(a, b, c, 0, 0, 0); }

struct Args {
    const float *x, *ln1_w, *w_in, *conv_w, *conv_b, *dt_bias, *a_log, *d_skip, *ssd_norm_w, *fox_f_bias, *w_out, *ln2_w, *peer_wq, *peer_k1, *peer_k2, *peer_u, *peer_v, *lnf_w;
    float* out; unsigned char* ws; int ph_lo, ph_hi;
};
typedef const __attribute__((address_space(4))) Args* ArgsP;
__device__ __forceinline__ ArgsP get_args() { ArgsP p = (ArgsP)__builtin_amdgcn_kernarg_segment_ptr(); asm volatile("" : "+s"(p)); return p; }
__device__ __forceinline__ int lane_id() { int l; asm volatile("v_mbcnt_lo_u32_b32 %0, -1, 0\n\tv_mbcnt_hi_u32_b32 %0, -1, %0" : "=v"(l)); return l; }
__device__ __forceinline__ int opaque(int v) { asm volatile("" : "+v"(v)); return v; }
#define GAS __attribute__((address_space(1)))
#define XB_TMO      128
#define XB_XCNT(j)  (256  + 64 * (j))
#define XB_XSUB(j)  (1280 + 64 * (j))
#define XB_XGEN(j)  (2304 + 64 * (j))
#define XB_TOP      3328
#define XB_TOPGEN   3392
#define XCD_BAR_WORDS 3456
#define XB_SPIN_CAP (1u << 18)

__device__ __forceinline__ unsigned xb_ld(unsigned* p)              { return __hip_atomic_load(p, __ATOMIC_RELAXED, __HIP_MEMORY_SCOPE_AGENT); }
__device__ __forceinline__ unsigned xb_add(unsigned* p, unsigned v) { return __hip_atomic_fetch_add(p, v, __ATOMIC_RELAXED, __HIP_MEMORY_SCOPE_AGENT); }
__device__ __forceinline__ unsigned xb_xcc_id() { return (unsigned)__builtin_amdgcn_s_getreg((3 << 11) | 20) & 0xFu; }
#define XB_SPIN(cond, bar) do { unsigned _sp = 0; while (cond) { __builtin_amdgcn_s_sleep(1); \
    if ((++_sp & 255u) == 0u) { if (xb_ld(&(bar)[XB_TMO])) break; if (_sp > XB_SPIN_CAP) { atomicAdd(&(bar)[XB_TMO], 1u); break; } } } } while (0)
struct XcdBarrier { unsigned* bar; unsigned x; volatile LAS unsigned* st; };
__device__ __forceinline__ XcdBarrier xcd_barrier_post(unsigned* bar, volatile LAS unsigned* st, const int tid) {
    XcdBarrier b; b.bar = bar; b.x = xb_xcc_id(); b.st = st;
    if (tid == 0) (void)xb_add(&bar[XB_XCNT(b.x)], 1u);
    return b;
}
__device__ __forceinline__ void xcd_barrier_complete(unsigned* bar, unsigned x, unsigned& nloc, unsigned& nx) {
    const unsigned G = gridDim.x;
    unsigned sum, cnt, mine, sp = 0u;
    for (;;) {
        sum = 0u; cnt = 0u; mine = 0u;
#pragma unroll
        for (unsigned j = 0; j < 16; ++j) { const unsigned c = xb_ld(&bar[XB_XCNT(j)]); sum += c; cnt += (c > 0u) ? 1u : 0u; mine = (j == x) ? c : mine; }
        if (sum == G) break;
        __builtin_amdgcn_s_sleep(1);
        if ((++sp & 255u) == 0u) { if (xb_ld(&bar[XB_TMO])) break; if (sp > XB_SPIN_CAP) { atomicAdd(&bar[XB_TMO], 1u); break; } }
    }
    nloc = mine > 0u ? mine : 1u; nx = cnt > 0u ? cnt : 1u;
}
__device__ __forceinline__ void xcd_barrier(const XcdBarrier& b, const int tid) {
    asm volatile("s_waitcnt vmcnt(0)" ::: "memory");
    __syncthreads();
    if (tid == 0) {
        unsigned* bar = b.bar;
        __builtin_amdgcn_s_waitcnt(0);
        unsigned nloc = b.st[0], nx = b.st[1];
        if (nloc == 0u) { xcd_barrier_complete(bar, b.x, nloc, nx); b.st[0] = nloc; b.st[1] = nx; }
        const unsigned old = xb_add(&bar[XB_XSUB(b.x)], 1u);
        const unsigned gen = old / nloc;
        if (old + 1u == (gen + 1u) * nloc) {
            __builtin_amdgcn_fence(__ATOMIC_RELEASE, "agent");
            asm volatile("s_waitcnt vmcnt(0)" ::: "memory");
            const unsigned og = xb_add(&bar[XB_TOP], 1u);
            const unsigned tg = og / nx;
            if (og + 1u == (tg + 1u) * nx) xb_add(&bar[XB_TOPGEN], 1u);
            else XB_SPIN(xb_ld(&bar[XB_TOPGEN]) == tg, bar);
            __builtin_amdgcn_fence(__ATOMIC_ACQUIRE, "agent");
            xb_add(&bar[XB_XGEN(b.x)], 1u);
            asm volatile("s_waitcnt vmcnt(0)" ::: "memory");
        } else {
            XB_SPIN(xb_ld(&bar[XB_XGEN(b.x)]) == gen, bar);
            __builtin_amdgcn_fence(__ATOMIC_ACQUIRE, "agent");
            asm volatile("s_waitcnt vmcnt(0)" ::: "memory");
        }
    }
    __syncthreads();
}
__device__ __forceinline__ int peer_next_item(unsigned* heads, const int myx, int& probe, const unsigned nper, volatile LAS int* bc, const int tid) {
    if (tid == 0) { int r = -1;
        while (probe < 8) { const int q = (myx + probe) & 7; const unsigned v = __hip_atomic_fetch_add(&heads[64 * q], 1u, __ATOMIC_RELAXED, __HIP_MEMORY_SCOPE_AGENT); if (v < nper) { r = q * (int)nper + (int)v; break; } ++probe; }
        bc[0] = r; }
    __syncthreads(); const int r = bc[0]; __syncthreads(); return r;
}
constexpr int Q_A = 8192 + 2048;
__device__ __forceinline__ int win_dest_row(int j) { return j < 2560 ? j : (j < 2576 ? 5632 + (j - 2560) : (j < 5648 ? j - 16 : j)); }
template <bool MAPROW> __device__ __forceinline__ void p0_transpose_item(const float* W, int K, int N, bf16* WT, LAS float* scr, int item, int lane) {
    const int nblk = N / 32, kb = item / nblk, nb = item % nblk, k0 = 64 * kb, n0 = 32 * nb;
#pragma unroll 8
    for (int i = 0; i < 32; ++i) { const int kk = 2 * i + (lane >> 5); scr[kk * 33 + (lane & 31)] = W[(size_t)(k0 + kk) * N + n0 + (lane & 31)]; }
    asm volatile("s_waitcnt lgkmcnt(0)" ::: "memory");
    const int c = lane & 7;
#pragma unroll
    for (int j = 0; j < 4; ++j) { const int n = (lane >> 3) + 8 * j; const LAS float* s = scr + (8 * c) * 33 + n;
        u32x4 o; o.x = cvtpk(s[0 * 33], s[1 * 33]); o.y = cvtpk(s[2 * 33], s[3 * 33]); o.z = cvtpk(s[4 * 33], s[5 * 33]); o.w = cvtpk(s[6 * 33], s[7 * 33]);
        const int drow = MAPROW ? win_dest_row(n0 + n) : (n0 + n);
        *(u32x4*)(WT + (size_t)drow * K + k0 + 8 * c) = o; }
    asm volatile("s_waitcnt lgkmcnt(0)" ::: "memory");
}
__device__ __forceinline__ void rms_row_to_bf16(const float* xrow, const float* w, bf16* orow, int lane) {
    const f32x4* xr = (const f32x4*)xrow + lane; const f32x4* wr = (const f32x4*)w + lane;
    f32x4 v[8]; float s = 0.f;
#pragma unroll
    for (int j = 0; j < 8; ++j) { v[j] = xr[64 * j]; s += (v[j].x * v[j].x + v[j].y * v[j].y) + (v[j].z * v[j].z + v[j].w * v[j].w); }
    const float rstd = 1.f / sqrtf(wave_sum(s) * (1.f / DM) + EPS);
    u32x2* o8 = (u32x2*)orow + lane;
#pragma unroll
    for (int j = 0; j < 8; ++j) { const f32x4 ww = wr[64 * j]; u32x2 o; o.x = cvtpk(v[j].x * rstd * ww.x, v[j].y * rstd * ww.y); o.y = cvtpk(v[j].z * rstd * ww.z, v[j].w * rstd * ww.w); o8[64 * j] = o; }
}
__device__ __forceinline__ void transpose_filler_item(ArgsP a, LAS unsigned char* lds, const int tidx, const int f) {
    const int lane = tidx & 63, wave = __builtin_amdgcn_readfirstlane(tidx >> 6); LAS float* scr = (LAS float*)(lds + wave * 16384);
    const bool second = f >= 256; const int it = (f & 255) * 8 + wave;
    p0_transpose_item<false>(second ? a->peer_wq : a->w_out, DM, DM, (bf16*)(a->ws + (second ? WS_WQ : WS_WOUT)), scr, it, lane);
}
__device__ __forceinline__ void phase0(ArgsP a, LAS unsigned char* lds, const int tidx) {
    const int tid = tidx, lane = tid & 63, wave = __builtin_amdgcn_readfirstlane(tid >> 6);
    LAS float* scr = (LAS float*)(lds + wave * 16384);
    const int gw = blockIdx.x * NWAVES + wave, NGW = gridDim.x * NWAVES;
    bf16* WinT = (bf16*)(a->ws + WS_WIN); bf16* WoutT = (bf16*)(a->ws + WS_WOUT); bf16* WqT = (bf16*)(a->ws + WS_WQ);
    constexpr int I_IN = (DM / 64) * (5664 / 32), I_SQ = (DM / 64) * (DM / 32);
    for (int it = gw; it < I_IN; it += NGW) p0_transpose_item<true>(a->w_in, DM, 5664, WinT, scr, it, lane);
    (void)WoutT; (void)WqT;
    { const int gt = blockIdx.x * NTHR + tid, NGT = gridDim.x * NTHR; u32x4* z = (u32x4*)(WinT + (size_t)5664 * DM);
      for (int i = gt; i < 224 * 256; i += NGT) z[i] = (u32x4){0u, 0u, 0u, 0u};
      float* ss = (float*)(a->ws + WS_MISC + MISC_SUMSQ); for (int i = gt; i < M; i += NGT) { ss[i] = 0.f; ss[i + 16384] = 0.f; }
      if (gt < 16) ((int*)(a->ws + WS_MISC + MISC_CHK))[gt] = 0;
      bf16* k12 = (bf16*)(a->ws + WS_K12);
      for (int i = gt; i < 2 * 8 * 128 * 128 / 2; i += NGT) { const int half = i >= 65536; const float* src = half ? a->peer_k2 : a->peer_k1; const int e = (i - half * 65536) * 2;
          ((unsigned*)k12)[i] = cvtpk(src[e], src[e + 1]); } }
    bf16* XN = (bf16*)(a->ws + WS_XN);
    for (int m = gw; m < M; m += NGW) rms_row_to_bf16(a->x + (size_t)m * DM, a->ln1_w, XN + (size_t)m * DM, lane);
}

struct EpiInProj {
    static constexpr bool PERM = true, AFTER_DRAIN = false;
    bf16 *Z, *XBC, *Q, *K, *V; float* DTF;
    __device__ __forceinline__ void operator()(const f32x4 (&acc)[2][2][4][2], const pg8::Unit& u, int wr, int wc, int fr, int fq) const {
        const int pn = u.pn; bf16* base; int ldc, colt; float sc = 1.f;
        if (pn < 4) { base = Z; ldc = 1024; colt = pn * 256; }
        else if (pn < 10) { base = XBC; ldc = 1536; colt = (pn - 4) * 256; }
        else if (pn < 14) { base = Q; ldc = 1024; colt = (pn - 10) * 256; sc = QSCALE; }
        else if (pn < 18) { base = K; ldc = 1024; colt = (pn - 14) * 256; }
        else if (pn < 22) { base = V; ldc = 1024; colt = (pn - 18) * 256; }
        else {
            if (wc == 0) {
#pragma unroll
                for (int ai = 0; ai < 2; ++ai)
#pragma unroll
                    for (int m = 0; m < 4; ++m) { const int row = u.pm * 256 + ai * 128 + wr * 64 + m * 16 + fr;
#pragma unroll
                        for (int n = 0; n < 2; ++n) *(f32x4*)(DTF + (size_t)row * 32 + 8 * fq + 4 * n) = acc[ai][0][m][n]; }
            }
            return;
        }
        const int row0 = u.pm * 256 + wr * 64 + fr, col0 = colt + wc * 32 + 8 * fq;
#pragma unroll
        for (int ai = 0; ai < 2; ++ai)
#pragma unroll
            for (int m = 0; m < 4; ++m) { bf16* rowp = base + (size_t)(row0 + ai * 128 + m * 16) * ldc + col0;
#pragma unroll
                for (int bj = 0; bj < 2; ++bj) { const f32x4 v0 = acc[ai][bj][m][0] * sc, v1 = acc[ai][bj][m][1] * sc;
                    u32x4 w; w.x = cvtpk(v0[0], v0[1]); w.y = cvtpk(v0[2], v0[3]); w.z = cvtpk(v1[0], v1[1]); w.w = cvtpk(v1[2], v1[3]);
                    *(u32x4*)(rowp + bj * 128) = w; } }
    }
};
struct EpiPlainBf16 {
    static constexpr bool PERM = true, AFTER_DRAIN = false;
    bf16* O; int ldc;
    __device__ __forceinline__ void operator()(const f32x4 (&acc)[2][2][4][2], const pg8::Unit& u, int wr, int wc, int fr, int fq) const {
        const int row0 = u.pm * 256 + wr * 64 + fr, col0 = u.pn * 256 + wc * 32 + 8 * fq;
#pragma unroll
        for (int ai = 0; ai < 2; ++ai)
#pragma unroll
            for (int m = 0; m < 4; ++m) { bf16* rowp = O + (size_t)(row0 + ai * 128 + m * 16) * ldc + col0;
#pragma unroll
                for (int bj = 0; bj < 2; ++bj) { const f32x4 v0 = acc[ai][bj][m][0], v1 = acc[ai][bj][m][1];
                    u32x4 w; w.x = cvtpk(v0[0], v0[1]); w.y = cvtpk(v0[2], v0[3]); w.z = cvtpk(v1[0], v1[1]); w.w = cvtpk(v1[2], v1[3]);
                    *(u32x4*)(rowp + bj * 128) = w; } }
    }
};
struct EpiOutProj {
    static constexpr bool PERM = false, AFTER_DRAIN = false;
    const float* x; bf16* X1B; bf16* HN; const float* ln2w; float* sumsq;
    __device__ __forceinline__ void operator()(const f32x4 (&acc)[2][2][4][2], const pg8::Unit& u, int wr, int wc, int fr, int fq) const {
        const int col0 = u.pn * 256 + wc * 32 + 4 * fq;
#pragma unroll
        for (int ai = 0; ai < 2; ++ai)
#pragma unroll
            for (int m = 0; m < 4; ++m) { const int row = u.pm * 256 + ai * 128 + wr * 64 + m * 16 + fr; const size_t off = (size_t)row * DM + col0; float ss = 0.f;
#pragma unroll
                for (int bj = 0; bj < 2; ++bj)
#pragma unroll
                    for (int n = 0; n < 2; ++n) { const size_t o = off + bj * 128 + n * 16; const f32x4 xv = *(const f32x4*)(x + o); const f32x4 x1 = acc[ai][bj][m][n] + xv;
                        u32x2 xw; xw.x = cvtpk(x1[0], x1[1]); xw.y = cvtpk(x1[2], x1[3]); *(u32x2*)(X1B + o) = xw; const f32x4 w = *(const f32x4*)(ln2w + col0 + bj * 128 + n * 16);
                        u32x2 hw; hw.x = cvtpk(x1[0] * w[0], x1[1] * w[1]); hw.y = cvtpk(x1[2] * w[2], x1[3] * w[3]); *(u32x2*)(HN + o) = hw;
                        ss += (x1[0] * x1[0] + x1[1] * x1[1]) + (x1[2] * x1[2] + x1[3] * x1[3]); }
                ss += __shfl_xor(ss, 16); ss += __shfl_xor(ss, 32);
                if (fq == 0) atomicAdd(sumsq + row, ss); }
    }
};
__device__ __forceinline__ void phase2(ArgsP a, LAS unsigned char* lds, const int tidx) {
    const int tid0 = tidx, w = __builtin_amdgcn_readfirstlane(tid0 >> 6);
    const bf16* XBC = (const bf16*)(a->ws + WS_XBC); const float* DTF = (const float*)(a->ws + WS_DTF);
    bf16* XS = (bf16*)(a->ws + WS_XS); bf16* BC = (bf16*)(a->ws + WS_BC); float* DT = (float*)(a->ws + WS_DT); float* ACUM = (float*)(a->ws + WS_ACUM);
    float* CUMF = (float*)(a->ws + WS_CUMF); float* FTOT = (float*)(a->ws + WS_MISC + MISC_FTOT); bf16* SLOC = (bf16*)(a->ws + WS_SLOC);
    LAS bf16* BT = (LAS bf16*)lds; LAS bf16* XT = (LAS bf16*)(lds + 18432 + w * 9216);
    for (int u = blockIdx.x; u < 2 * NCHUNK; u += gridDim.x) {
        const int tid = opaque(tid0), lane = tid & 63;
        const int c = u >> 1, g = u & 1, t0 = c * 64, h = 8 * g + w;
        {
            const int n = tid & 127;
#pragma unroll
            for (int which = 0; which < 2; ++which) {
                const int ch = 1024 + which * 256 + 128 * g + n;
                const float w0 = a->conv_w[ch], w1 = a->conv_w[1536 + ch], w2 = a->conv_w[2 * 1536 + ch], w3 = a->conv_w[3 * 1536 + ch], cb = a->conv_b[ch];
#pragma unroll
                for (int rr = 0; rr < 2; ++rr) {
                    const int s0 = 8 * ((tid >> 7) + 4 * rr);
                    float in[11];
#pragma unroll
                    for (int j = 0; j < 11; ++j) { const int t = t0 + s0 - 3 + j; const float v = bf2f(XBC[(size_t)(t < 0 ? 0 : t) * 1536 + ch]); in[j] = t < 0 ? 0.f : v; }
                    unsigned pk[4];
#pragma unroll
                    for (int j = 0; j < 8; j += 2) {
                        const float v0 = siluf(cb + w0 * in[j] + w1 * in[j + 1] + w2 * in[j + 2] + w3 * in[j + 3]);
                        const float v1 = siluf(cb + w0 * in[j + 1] + w1 * in[j + 2] + w2 * in[j + 3] + w3 * in[j + 4]);
                        const unsigned p2 = cvtpk(v0, v1); pk[j >> 1] = p2;
                        BC[(size_t)(t0 + s0 + j) * 512 + which * 256 + 128 * g + n] = (bf16)(p2 & 0xffffu);
                        BC[(size_t)(t0 + s0 + j + 1) * 512 + which * 256 + 128 * g + n] = (bf16)(p2 >> 16);
                    }
                    if (which == 0) *(LAS u32x4*)(BT + n * 72 + s0) = (u32x4){pk[0], pk[1], pk[2], pk[3]};
                }
            }
        }
        float wgt;
        {
            const int t = t0 + lane;
            const float dt = softplusf(DTF[(size_t)t * 32 + h] + a->dt_bias[h]);
            const float A = -__expf(a->a_log[h]);
            const float acum = wave_scan_incl(dt * A, lane);
            DT[(size_t)t * 16 + h] = dt; ACUM[(size_t)t * 16 + h] = acum;
            const float alast = __shfl(acum, 63);
            wgt = dt * __expf(alast - acum);
            const float lf = logsigmoidf(DTF[(size_t)t * 32 + 16 + h] + a->fox_f_bias[h]);
            const float cl = wave_scan_incl(lf, lane);
            CUMF[(size_t)h * M + t] = cl;
            if (lane == 63) FTOT[h * NCHUNK + c] = cl;
            { const u32x4* qp = (const u32x4*)((const bf16*)(a->ws + WS_Q) + (size_t)t * 1024 + 64 * h); const u32x4* kp = (const u32x4*)((const bf16*)(a->ws + WS_K) + (size_t)t * 1024 + 64 * h); float qn = 0.f, kn = 0.f;
#pragma unroll
              for (int i = 0; i < 8; ++i) { const u32x4 qv = qp[i], kv = kp[i];
                  qn += bflo(qv.x) * bflo(qv.x) + bfhi(qv.x) * bfhi(qv.x) + bflo(qv.y) * bflo(qv.y) + bfhi(qv.y) * bfhi(qv.y) + bflo(qv.z) * bflo(qv.z) + bfhi(qv.z) * bfhi(qv.z) + bflo(qv.w) * bflo(qv.w) + bfhi(qv.w) * bfhi(qv.w);
                  kn += bflo(kv.x) * bflo(kv.x) + bfhi(kv.x) * bfhi(kv.x) + bflo(kv.y) * bflo(kv.y) + bfhi(kv.y) * bfhi(kv.y) + bflo(kv.z) * bflo(kv.z) + bfhi(kv.z) * bfhi(kv.z) + bflo(kv.w) * bflo(kv.w) + bfhi(kv.w) * bfhi(kv.w); }
              qn = wave_max(qn); kn = wave_max(kn);
              if (lane == 0) { ((float*)(a->ws + WS_MISC + MISC_QN2))[h * NCHUNK + c] = qn; ((float*)(a->ws + WS_MISC + MISC_KN2))[h * NCHUNK + c] = kn; } }
        }
        {
            const int ch = 64 * h + lane;
            const float w0 = a->conv_w[ch], w1 = a->conv_w[1536 + ch], w2 = a->conv_w[2 * 1536 + ch], w3 = a->conv_w[3 * 1536 + ch], cb = a->conv_b[ch];
            float in[67]; const int t0v = opaque(t0);
#pragma unroll
            for (int j = 0; j < 67; ++j) { const int t = t0 - 3 + j; const unsigned off = (unsigned)(j < 3 ? (t < 0 ? 0 : t) : t0v - 3 + j) * 1536u + (unsigned)ch; const float v = bf2f(XBC[off]); in[j] = (j < 3 && t < 0) ? 0.f : v; }
#pragma unroll
            for (int sb = 0; sb < 8; ++sb) {
                unsigned pk[4];
#pragma unroll
                for (int j = 0; j < 8; j += 2) {
                    const int s = 8 * sb + j;
                    const float v0 = siluf(cb + w0 * in[s] + w1 * in[s + 1] + w2 * in[s + 2] + w3 * in[s + 3]);
                    const float v1 = siluf(cb + w0 * in[s + 1] + w1 * in[s + 2] + w2 * in[s + 3] + w3 * in[s + 4]);
                    const unsigned p2 = cvtpk(v0, v1);
                    XS[(size_t)(t0 + s) * 1024 + ch] = (bf16)(p2 & 0xffffu); XS[(size_t)(t0 + s + 1) * 1024 + ch] = (bf16)(p2 >> 16);
                    const float g0 = __shfl(wgt, s), g1 = __shfl(wgt, s + 1);
                    pk[j >> 1] = cvtpk(bflo(p2) * g0, bfhi(p2) * g1);
                }
                *(LAS u32x4*)(XT + lane * 72 + 8 * sb) = (u32x4){pk[0], pk[1], pk[2], pk[3]};
            }
        }
        __syncthreads();
        {
            const int fr = lane & 15, fq = lane >> 4;
            bf16x8 bfr[4][2];
#pragma unroll
            for (int pt = 0; pt < 4; ++pt)
#pragma unroll
                for (int kk = 0; kk < 2; ++kk) bfr[pt][kk] = *(const LAS bf16x8*)(XT + (16 * pt + fr) * 72 + 8 * fq + 32 * kk);
            bf16* dst = SLOC + ((size_t)(c * 16 + h) * 64) * 128;
#pragma unroll
            for (int nt = 0; nt < 8; ++nt) {
                const bf16x8 a0 = *(const LAS bf16x8*)(BT + (16 * nt + fr) * 72 + 8 * fq), a1 = *(const LAS bf16x8*)(BT + (16 * nt + fr) * 72 + 8 * fq + 32);
#pragma unroll
                for (int pt = 0; pt < 4; ++pt) {
                    f32x4 acc = {0.f, 0.f, 0.f, 0.f};
                    acc = mfma16(a0, bfr[pt][0], acc); acc = mfma16(a1, bfr[pt][1], acc);
                    u32x2 o; o.x = cvtpk(acc[0], acc[1]); o.y = cvtpk(acc[2], acc[3]);
                    *(u32x2*)(dst + (size_t)(16 * pt + fr) * 128 + 16 * nt + 4 * fq) = o;
                }
            }
        }
        __syncthreads();
    }
}

template <bool DRY> __device__ __forceinline__ void phase3(ArgsP a, const int tidx) {
    const int tid = tidx, lane = tid & 63, w = __builtin_amdgcn_readfirstlane(tid >> 6);
    const float* ACUM = (const float*)(a->ws + WS_ACUM); unsigned* SL = (unsigned*)(a->ws + WS_SLOC);
    const int gt = blockIdx.x * NTHR + tid, NGT = gridDim.x * NTHR;
    for (int e2 = gt; e2 < 65536; e2 += NGT) {
        const int h = e2 >> 12;
        float s0 = 0.f, s1 = 0.f;
        for (int cb = 0; cb < NCHUNK; cb += 8) {
            unsigned v[8]; float d[8];
#pragma unroll
            for (int j = 0; j < 8; ++j) { v[j] = SL[(size_t)(cb + j) * 65536 + e2]; d[j] = __expf(ACUM[(size_t)((cb + j) * 64 + 63) * 16 + h]); }
#pragma unroll
            for (int j = 0; j < 8; ++j) { SL[(size_t)(cb + j) * 65536 + e2] = DRY ? v[j] : cvtpk(s0, s1); s0 = s0 * d[j] + bflo(v[j]); s1 = s1 * d[j] + bfhi(v[j]); }
        }
    }
    const int gwv = blockIdx.x * NWAVES + w, NGW = gridDim.x * NWAVES;
    for (int hh = gwv; hh < 16; hh += NGW) {
        const float* FTOT = (const float*)(a->ws + WS_MISC + MISC_FTOT) + hh * NCHUNK; float* CF = (float*)(a->ws + WS_CUMF) + (size_t)hh * M;
        const f32x4 tv = *(const f32x4*)(FTOT + 4 * lane);
        const float tot = (tv.x + tv.y) + (tv.z + tv.w);
        const float incl = wave_scan_incl(tot, lane); float pre = incl - tot;
#pragma unroll
        for (int k = 0; k < 4; ++k) {
            f32x4* p = (f32x4*)(CF + (size_t)(4 * lane + k) * 64);
#pragma unroll 4
            for (int j = 0; j < 16; ++j) { f32x4 v = p[j]; if (!DRY) v = (v + pre) * LOG2E; p[j] = v; }
            pre += tv[k];
        }
    }
}
__device__ __forceinline__ void phase4(ArgsP a, LAS unsigned char* lds, const int tidx) {
    const int tid0 = tidx, w = __builtin_amdgcn_readfirstlane(tid0 >> 6);
    const bf16* XS = (const bf16*)(a->ws + WS_XS); const bf16* BC = (const bf16*)(a->ws + WS_BC); const float* DT = (const float*)(a->ws + WS_DT); const float* ACUM = (const float*)(a->ws + WS_ACUM);
    const bf16* PREV = (const bf16*)(a->ws + WS_SLOC); const bf16* Z = (const bf16*)(a->ws + WS_Z); bf16* MIX = (bf16*)(a->ws + WS_MIX);
    LAS bf16* CS = (LAS bf16*)lds; LAS bf16* BS = (LAS bf16*)(lds + 17408); LAS float* CBm = (LAS float*)(lds + 34816);
    LAS bf16* XT = (LAS bf16*)(lds + 52224 + w * 9216); LAS float* AC = (LAS float*)(lds + 125952 + w * 256); LAS float* SSW = (LAS float*)(lds + 128000);
    for (int u = blockIdx.x; u < 2 * NCHUNK; u += gridDim.x) {
        const int tid = opaque(tid0), lane = tid & 63, fr = lane & 15, fq = lane >> 4;
        const int c = u >> 1, g = u & 1, t0 = c * 64, h = 8 * g + w;
#pragma unroll
        for (int i = 0; i < 2; ++i) { const int q = tid + 512 * i, row = q >> 4, c16 = q & 15;
            *(LAS u32x4*)(CS + row * 136 + c16 * 8) = *(const u32x4*)(BC + (size_t)(t0 + row) * 512 + 256 + 128 * g + c16 * 8);
            *(LAS u32x4*)(BS + row * 136 + c16 * 8) = *(const u32x4*)(BC + (size_t)(t0 + row) * 512 + 128 * g + c16 * 8); }
        const float dts = DT[(size_t)(t0 + lane) * 16 + h];
        AC[lane] = ACUM[(size_t)(t0 + lane) * 16 + h];
        {
            const int ch = 64 * h + lane;
            float xin[64];
#pragma unroll
            for (int s = 0; s < 64; ++s) xin[s] = bf2f(XS[(size_t)(t0 + s) * 1024 + ch]);
#pragma unroll
            for (int sb = 0; sb < 8; ++sb) {
                unsigned pk[4];
#pragma unroll
                for (int j = 0; j < 8; j += 2) { const int s = 8 * sb + j; pk[j >> 1] = cvtpk(xin[s] * __shfl(dts, s), xin[s + 1] * __shfl(dts, s + 1)); }
                *(LAS u32x4*)(XT + lane * 72 + 8 * sb) = (u32x4){pk[0], pk[1], pk[2], pk[3]};
            }
        }
        __syncthreads();
#pragma unroll
        for (int x = 0; x < 2; ++x) { const int id = 2 * w + x, ti = id >> 2, si = id & 3; f32x4 acc = {0.f, 0.f, 0.f, 0.f};
#pragma unroll
            for (int kk = 0; kk < 4; ++kk) acc = mfma16(*(const LAS bf16x8*)(CS + (16 * ti + fr) * 136 + 8 * fq + 32 * kk), *(const LAS bf16x8*)(BS + (16 * si + fr) * 136 + 8 * fq + 32 * kk), acc);
#pragma unroll
            for (int r = 0; r < 4; ++r) CBm[(16 * ti + 4 * fq + r) * 68 + 16 * si + fr] = acc[r]; }
        __syncthreads();
        f32x4 acc[4][4];
#pragma unroll
        for (int i = 0; i < 4; ++i)
#pragma unroll
            for (int j = 0; j < 4; ++j) acc[i][j] = (f32x4){0.f, 0.f, 0.f, 0.f};
        {
            const bf16* pv = PREV + ((size_t)(c * 16 + h) * 64) * 128;
#pragma unroll
            for (int kk = 0; kk < 4; ++kk) {
                bf16x8 af[4], bfv[4];
#pragma unroll
                for (int i = 0; i < 4; ++i) af[i] = *(const LAS bf16x8*)(CS + (16 * i + fr) * 136 + 8 * fq + 32 * kk);
#pragma unroll
                for (int j = 0; j < 4; ++j) bfv[j] = *(const bf16x8*)(pv + (size_t)(16 * j + fr) * 128 + 8 * fq + 32 * kk);
#pragma unroll
                for (int i = 0; i < 4; ++i)
#pragma unroll
                    for (int j = 0; j < 4; ++j) acc[i][j] = mfma16(af[i], bfv[j], acc[i][j]);
            }
#pragma unroll
            for (int i = 0; i < 4; ++i)
#pragma unroll
                for (int r = 0; r < 4; ++r) { const float e = __expf(AC[16 * i + 4 * fq + r]);
#pragma unroll
                    for (int j = 0; j < 4; ++j) acc[i][j][r] *= e; }
        }
#pragma unroll
        for (int kk = 0; kk < 2; ++kk) {
            bf16x8 bfv[4];
#pragma unroll
            for (int j = 0; j < 4; ++j) bfv[j] = *(const LAS bf16x8*)(XT + (16 * j + fr) * 72 + 8 * fq + 32 * kk);
            const int sbase = 8 * fq + 32 * kk;
            const f32x4 as0 = *(const LAS f32x4*)(AC + sbase), as1 = *(const LAS f32x4*)(AC + sbase + 4);
#pragma unroll
            for (int i = 0; i < 4; ++i) {
                const int t = 16 * i + fr; const float act = AC[t];
                const f32x4 c0 = *(const LAS f32x4*)(CBm + t * 68 + sbase), c1 = *(const LAS f32x4*)(CBm + t * 68 + sbase + 4);
                float m[8];
#pragma unroll
                for (int jj = 0; jj < 4; ++jj) { m[jj] = (sbase + jj <= t) ? c0[jj] * __expf(fminf(act - as0[jj], 0.f)) : 0.f; m[4 + jj] = (sbase + 4 + jj <= t) ? c1[jj] * __expf(fminf(act - as1[jj], 0.f)) : 0.f; }
                u32x4 mp; mp.x = cvtpk(m[0], m[1]); mp.y = cvtpk(m[2], m[3]); mp.z = cvtpk(m[4], m[5]); mp.w = cvtpk(m[6], m[7]);
                const bf16x8 af = __builtin_bit_cast(bf16x8, mp);
#pragma unroll
                for (int j = 0; j < 4; ++j) acc[i][j] = mfma16(af, bfv[j], acc[i][j]);
            }
        }
        const float Dh = a->d_skip[h];
#pragma unroll
        for (int i = 0; i < 4; ++i)
#pragma unroll
            for (int r = 0; r < 4; ++r) { const int t = 16 * i + 4 * fq + r; float ss = 0.f;
#pragma unroll
                for (int j = 0; j < 4; ++j) { const size_t o = (size_t)(t0 + t) * 1024 + 64 * h + 16 * j + fr;
#if SELFCHECK
                    if (t0 + t < 8192) ((float*)(a->ws + (size_t)464 * MiB))[o] = acc[i][j][r];
#endif
                    const float y = (acc[i][j][r] + Dh * bf2f(XS[o])) * siluf(bf2f(Z[o])); acc[i][j][r] = y; ss += y * y; }
                ss += __shfl_xor(ss, 1); ss += __shfl_xor(ss, 2); ss += __shfl_xor(ss, 4); ss += __shfl_xor(ss, 8);
                if (fr == 0) SSW[w * 64 + t] = ss; }
        __syncthreads();
#pragma unroll
        for (int i = 0; i < 4; ++i)
#pragma unroll
            for (int r = 0; r < 4; ++r) { const int t = 16 * i + 4 * fq + r; float ss = 0.f;
#pragma unroll
                for (int ww = 0; ww < 8; ++ww) ss += SSW[ww * 64 + t];
                const float rstd = 1.f / sqrtf(ss * (1.f / 512.f) + EPS);
#pragma unroll
                for (int j = 0; j < 4; ++j) { const int ch = 64 * h + 16 * j + fr; MIX[(size_t)(t0 + t) * DM + ch] = f2bf(acc[i][j][r] * rstd * a->ssd_norm_w[ch]); } }
        __syncthreads();
    }
}

__device__ __forceinline__ void phase_attn(ArgsP a, LAS unsigned char* lds, const int tidx) {
    const int tid0 = tidx, w = __builtin_amdgcn_readfirstlane(tid0 >> 6);
    const bf16* Q = (const bf16*)(a->ws + WS_Q); const bf16* K = (const bf16*)(a->ws + WS_K); const bf16* V = (const bf16*)(a->ws + WS_V); const float* CL = (const float*)(a->ws + WS_CUMF);
    bf16* MIX = (bf16*)(a->ws + WS_MIX);
    LAS bf16* KS = (LAS bf16*)lds; LAS bf16* VT = (LAS bf16*)(lds + 9216); LAS float* CK = (LAS float*)(lds + 18432); LAS bf16* PS = (LAS bf16*)(lds + 18688 + w * 2304);
    const int G = gridDim.x;
    for (int i = 0;; ++i) {
        const int uidx = i * G + (int)blockIdx.x; if (uidx >= 2048) break;
        const int tid = opaque(tid0), lane = tid & 63, fr = lane & 15, fq = lane >> 4;
        const int slot = uidx >> 8, pos = uidx & 255, grp = pos >> 4, h = pos & 15;
        const int rnk = 16 * slot + ((slot & 1) ? 15 - grp : grp);
        const int qb = 127 - rnk;
        const int q0 = qb * 128 + 16 * w;
        const bf16x8 qf0 = *(const bf16x8*)(Q + (size_t)(q0 + fr) * 1024 + 64 * h + 8 * fq), qf1 = *(const bf16x8*)(Q + (size_t)(q0 + fr) * 1024 + 64 * h + 8 * fq + 32);
        float cq[4], mrun[4], lrun[4]; f32x4 o[4];
#pragma unroll
        for (int r = 0; r < 4; ++r) { cq[r] = CL[(size_t)h * M + q0 + 4 * fq + r]; mrun[r] = -3.0e38f; lrun[r] = 0.f; }
#pragma unroll
        for (int d = 0; d < 4; ++d) o[d] = (f32x4){0.f, 0.f, 0.f, 0.f};
        const int ntile = 2 * qb + 2;
        for (int kt = 0; kt < ntile; ++kt) {
            const int k0 = kt * 64;
            { const int row = tid >> 3, c16 = tid & 7; *(LAS u32x4*)(KS + row * 72 + c16 * 8) = *(const u32x4*)(K + (size_t)(k0 + row) * 1024 + 64 * h + c16 * 8);
              const int d = tid & 63, kb = tid >> 6; unsigned pk[4];
#pragma unroll
              for (int j = 0; j < 8; j += 2) { const unsigned lo = V[(size_t)(k0 + 8 * kb + j) * 1024 + 64 * h + d], hi = V[(size_t)(k0 + 8 * kb + j + 1) * 1024 + 64 * h + d]; pk[j >> 1] = lo | (hi << 16); }
              *(LAS u32x4*)(VT + d * 72 + 8 * kb) = (u32x4){pk[0], pk[1], pk[2], pk[3]};
              if (tid < 64) CK[tid] = CL[(size_t)h * M + k0 + tid]; }
            __syncthreads();
            f32x4 s[4];
#pragma unroll
            for (int nt = 0; nt < 4; ++nt) { s[nt] = (f32x4){0.f, 0.f, 0.f, 0.f};
                s[nt] = mfma16(qf0, *(const LAS bf16x8*)(KS + (16 * nt + fr) * 72 + 8 * fq), s[nt]);
                s[nt] = mfma16(qf1, *(const LAS bf16x8*)(KS + (16 * nt + fr) * 72 + 8 * fq + 32), s[nt]); }
            float mx[4];
#pragma unroll
            for (int r = 0; r < 4; ++r) { const int qg = q0 + 4 * fq + r; float m = -INFINITY;
#pragma unroll
                for (int nt = 0; nt < 4; ++nt) { const int kg = k0 + 16 * nt + fr; float v = s[nt][r] + (cq[r] - CK[16 * nt + fr]); v = kg > qg ? -INFINITY : v; s[nt][r] = v; m = fmaxf(m, v); }
                m = fmaxf(m, __shfl_xor(m, 1)); m = fmaxf(m, __shfl_xor(m, 2)); m = fmaxf(m, __shfl_xor(m, 4)); m = fmaxf(m, __shfl_xor(m, 8)); mx[r] = m; }
#pragma unroll
            for (int r = 0; r < 4; ++r) { const float mn = fmaxf(mrun[r], mx[r]); const float al = exp2f(mrun[r] - mn); mrun[r] = mn; float ps = 0.f;
#pragma unroll
                for (int nt = 0; nt < 4; ++nt) { const float p = exp2f(s[nt][r] - mn); ps += p; PS[(4 * fq + r) * 72 + 16 * nt + fr] = f2bf(p); }
                lrun[r] = lrun[r] * al + ps;
#pragma unroll
                for (int d = 0; d < 4; ++d) o[d][r] *= al; }
            asm volatile("s_waitcnt lgkmcnt(0)" ::: "memory");
            const bf16x8 pf0 = *(const LAS bf16x8*)(PS + fr * 72 + 8 * fq), pf1 = *(const LAS bf16x8*)(PS + fr * 72 + 8 * fq + 32);
#pragma unroll
            for (int d = 0; d < 4; ++d) { o[d] = mfma16(pf0, *(const LAS bf16x8*)(VT + (16 * d + fr) * 72 + 8 * fq), o[d]); o[d] = mfma16(pf1, *(const LAS bf16x8*)(VT + (16 * d + fr) * 72 + 8 * fq + 32), o[d]); }
            __syncthreads();
        }
#pragma unroll
        for (int r = 0; r < 4; ++r) { float l = lrun[r]; l += __shfl_xor(l, 1); l += __shfl_xor(l, 2); l += __shfl_xor(l, 4); l += __shfl_xor(l, 8); const float il = 1.f / l;
#pragma unroll
            for (int d = 0; d < 4; ++d) MIX[(size_t)(q0 + 4 * fq + r) * DM + 1024 + 64 * h + 16 * d + fr] = f2bf(o[d][r] * il); }
    }
}
constexpr size_t WS_U8 = 400 * MiB, WS_V8 = 432 * MiB;
constexpr size_t WS_USC = WS_K12 + 512 * 1024, WS_VSC = WS_K12 + 576 * 1024;
__device__ __forceinline__ void convert_uv_fp8_item(ArgsP a, const int tidx, const int item) {
    const int lane = tidx & 63, w = tidx >> 6;
    unsigned char* U8 = (unsigned char*)(a->ws + WS_U8); unsigned char* V8 = (unsigned char*)(a->ws + WS_V8);
    for (int row0 = 32 * item + 4 * w; row0 < 32 * item + 4 * w + 4; row0 += 2) {
        f32x4 x[2][8]; float mx[2] = {0.f, 0.f};
#pragma unroll
        for (int q = 0; q < 2; ++q) { const int row = row0 + q; const bool second = row >= 16384; const int e = row & 16383; const f32x4* src = (const f32x4*)((second ? a->peer_v : a->peer_u) + (size_t)e * DM) + lane;
#pragma unroll
            for (int j = 0; j < 8; ++j) x[q][j] = src[64 * j]; }
#pragma unroll
        for (int q = 0; q < 2; ++q) { const int row = row0 + q; const bool second = row >= 16384; const int e = row & 16383; unsigned char* dst = second ? V8 : U8;
#pragma unroll
            for (int j = 0; j < 8; ++j) mx[q] = fmaxf(mx[q], fmaxf(fmaxf(fabsf(x[q][j][0]), fabsf(x[q][j][1])), fmaxf(fabsf(x[q][j][2]), fabsf(x[q][j][3]))));
            const float mxa = wave_max(mx[q]); const float sc = mxa > 0.f ? 440.f / mxa : 1.f;
            if (lane == 0) ((float*)(a->ws + (second ? WS_VSC : WS_USC)))[e] = 1.f / sc;
#pragma unroll
            for (int j = 0; j < 8; ++j) { const int s = 2 * j + (lane >> 5); int p = __builtin_amdgcn_cvt_pk_fp8_f32(x[q][j][0] * sc, x[q][j][1] * sc, 0, false); p = __builtin_amdgcn_cvt_pk_fp8_f32(x[q][j][2] * sc, x[q][j][3] * sc, p, true);
                *(int*)(dst + ((size_t)s * 16384 + e) * 128 + 4 * (lane & 31)) = p; } } }
}
namespace attn_body {
using bf16=unsigned short;
using bf16x8=__attribute__((ext_vector_type(8)))short;
using s16x4=__attribute__((ext_vector_type(4)))short;
using f32x16=__attribute__((ext_vector_type(16)))float;
using u32x4=__attribute__((ext_vector_type(4)))unsigned;
constexpr int BATCH=1,NHEAD=16,SEQ=16384,D=64,DM=NHEAD*D,OPITCH=2048,OCOL=1024;
constexpr int NW=8,QBLK=32,QB=QBLK*NW,KVBLK=64,NQB=SEQ/QB;
constexpr int ATTN_PITCH=DM, ATTN_UNIT_ROWS=QB;
__device__ __forceinline__ int crow(int r,int hi){return (r&3)+8*(r>>2)+4*hi;}
#define SBAR() __builtin_amdgcn_sched_barrier(0)
__device__ __forceinline__ void cmask(f32x16&p0,f32x16&p1,int jb,int qrel,int hi){
  const float NEG=-INFINITY; int kb=64*jb+4*hi;
  #pragma unroll
  for(int r=0;r<16;++r){int kv=kb+(r&3)+8*(r>>2); if(kv>qrel)p0[r]=NEG; if(kv+32>qrel)p1[r]=NEG;}
}

constexpr int NSLOT=3, SLOTB=8192;
constexpr int LDS_K=0, LDS_V=NSLOT*SLOTB, LDS_WS=2*NSLOT*SLOTB, LDS_OST=LDS_WS+NW*64*4, LDS_CL=LDS_OST+NW*4096, LDS_BYTES=LDS_CL+SEQ*4;
constexpr float C2=0.125f*1.4426950408889634f;
__device__ __forceinline__ void glds16(const void*gsrc,unsigned lds_dst){unsigned keep;
  asm volatile("s_mov_b32 %0, m0\n\ts_mov_b32 m0, %2\n\ts_nop 0\n\tglobal_load_lds_dwordx4 %1, off\n\ts_mov_b32 m0, %0":"=&s"(keep):"v"(gsrc),"s"(lds_dst):"memory");}
__device__ __forceinline__ float max3f(float a,float b,float c){float r;asm("v_max3_f32 %0, %1, %2, %3":"=v"(r):"v"(a),"v"(b),"v"(c));return r;}
__device__ __forceinline__ float max2f(float a,float b){float r;asm("v_max_f32_e32 %0, %1, %2":"=v"(r):"v"(a),"v"(b));return r;}
__device__ __forceinline__ float fadd_s(float a,float b){float r;asm("v_add_f32_e32 %0, %1, %2":"=v"(r):"v"(a),"v"(b));return r;}
__device__ __forceinline__ float fsub_s(float a,float b){float r;asm("v_sub_f32_e32 %0, %1, %2":"=v"(r):"v"(a),"v"(b));return r;}
typedef float f32x2_t __attribute__((ext_vector_type(2))); typedef float f32x4_t __attribute__((ext_vector_type(4))); typedef __bf16 bf16x2_t __attribute__((ext_vector_type(2)));
__device__ __forceinline__ unsigned cvtpk_s(float lo,float hi){f32x2_t v={lo,hi};bf16x2_t b=__builtin_convertvector(v,bf16x2_t);return __builtin_bit_cast(unsigned,b);}
#define WAIT_BAR(N) asm volatile("s_waitcnt vmcnt(" #N ") lgkmcnt(0)\n\ts_barrier":::"memory")

__device__ __forceinline__ void qkt(f32x16&p0,f32x16&p1,const char*Kslot,const bf16x8*qr,const f32x16&i0,const f32x16&i1,int r32,int hi){
  const char*kb=Kslot+hi*1024+r32*16;
  #pragma unroll
  for(int d0=0;d0<4;++d0){
    const bf16x8 b0=*reinterpret_cast<const bf16x8*>(kb+d0*2048);
    const bf16x8 b1=*reinterpret_cast<const bf16x8*>(kb+d0*2048+512);
    if(d0==0){p0=__builtin_amdgcn_mfma_f32_32x32x16_bf16(b0,qr[0],i0,0,0,0);p1=__builtin_amdgcn_mfma_f32_32x32x16_bf16(b1,qr[0],i1,0,0,0);}
    else{p0=__builtin_amdgcn_mfma_f32_32x32x16_bf16(b0,qr[d0],p0,0,0,0);p1=__builtin_amdgcn_mfma_f32_32x32x16_bf16(b1,qr[d0],p1,0,0,0);}}
}
typedef __attribute__((address_space(3))) const char* lds_cptr;
typedef short v4i16_t __attribute__((ext_vector_type(4)));
__device__ __forceinline__ void kload8(bf16x8*kf,lds_cptr kp){
  kf[0]=*(const __attribute__((address_space(3))) bf16x8*)(kp);      kf[1]=*(const __attribute__((address_space(3))) bf16x8*)(kp+512);
  kf[2]=*(const __attribute__((address_space(3))) bf16x8*)(kp+2048); kf[3]=*(const __attribute__((address_space(3))) bf16x8*)(kp+2560);
  kf[4]=*(const __attribute__((address_space(3))) bf16x8*)(kp+4096); kf[5]=*(const __attribute__((address_space(3))) bf16x8*)(kp+4608);
  kf[6]=*(const __attribute__((address_space(3))) bf16x8*)(kp+6144); kf[7]=*(const __attribute__((address_space(3))) bf16x8*)(kp+6656);
}
__device__ __forceinline__ void kload2(bf16x8*kf,lds_cptr kp,int j){ kf[2*j]=*(const __attribute__((address_space(3))) bf16x8*)(kp+j*2048); kf[2*j+1]=*(const __attribute__((address_space(3))) bf16x8*)(kp+j*2048+512); }
__device__ __forceinline__ s16x4 vtr(lds_cptr p){ return __builtin_bit_cast(s16x4,__builtin_amdgcn_ds_read_tr16_b64_v4i16((__attribute__((address_space(3))) v4i16_t*)p)); }
__device__ __forceinline__ float rowmax(const f32x16&p0,const f32x16&p1){
  float a=max3f(p0[0],p0[1],p1[0]),b=max3f(p0[2],p0[3],p1[1]);a=max3f(a,p1[2],p1[3]);
  #pragma unroll
  for(int r=4;r<16;r+=4){a=max3f(a,p0[r],p0[r+1]);b=max3f(b,p0[r+2],p0[r+3]);a=max3f(a,p1[r],p1[r+1]);b=max3f(b,p1[r+2],p1[r+3]);}
  const float m=max2f(a,b);
  auto rr=__builtin_amdgcn_permlane32_swap(__float_as_uint(m),__float_as_uint(m),false,false);
  return max2f(__uint_as_float(rr[0]),__uint_as_float(rr[1]));
}
__device__ __forceinline__ void pv(f32x16*o,int vb,bf16x8 pa0,bf16x8 pa1,bf16x8 pa2,bf16x8 pa3){
  #pragma unroll
  for(int d0=0;d0<2;++d0){s16x4 lo[4],hi[4];
    #pragma unroll
    for(int ks=0;ks<4;++ks){
      asm volatile("ds_read_b64_tr_b16 %0,%1 offset:%c2":"=&v"(lo[ks]):"v"(vb),"i"(d0*4096+ks*1024):"memory");
      asm volatile("ds_read_b64_tr_b16 %0,%1 offset:%c2":"=&v"(hi[ks]):"v"(vb),"i"(d0*4096+ks*1024+512):"memory");}
    asm volatile("s_waitcnt lgkmcnt(0)":::"memory");SBAR();
    #define PK(k) (bf16x8){lo[k][0],lo[k][1],lo[k][2],lo[k][3],hi[k][0],hi[k][1],hi[k][2],hi[k][3]}
    o[d0]=__builtin_amdgcn_mfma_f32_32x32x16_bf16(pa0,PK(0),o[d0],0,0,0);
    o[d0]=__builtin_amdgcn_mfma_f32_32x32x16_bf16(pa1,PK(1),o[d0],0,0,0);
    o[d0]=__builtin_amdgcn_mfma_f32_32x32x16_bf16(pa2,PK(2),o[d0],0,0,0);
    o[d0]=__builtin_amdgcn_mfma_f32_32x32x16_bf16(pa3,PK(3),o[d0],0,0,0);
    #undef PK
  }
}

#ifndef ATTN_STORE16
#define ATTN_STORE16(p,v) (*(u32x4*)(p)=(v))
#endif
template<int THRL> __device__ __forceinline__ void attn_unit(int b,int h,int qb,const bf16*Q,const bf16*__restrict__ K,const bf16*__restrict__ V,bf16*O,const float*__restrict__ CLh,const float*__restrict__ QN2h,const float*__restrict__ KN2h,char*shm,const int tid_in){
  const int tid=tid_in,lane=tid&63,r32=lane&31,hi=lane>>5; const int wid=__builtin_amdgcn_readfirstlane(tid>>6);
  const long rowbase=(long)b*SEQ; const int q0=qb*QB;
  const bf16*Qw=Q+(rowbase+q0+wid*QBLK)*DM+h*D;
  int Ts;
  { const int NT0=(q0+QB)/KVBLK; float kn=0.f;
    _Pragma("unroll") for(int j=0;j<4;++j){ const int c=lane+64*j; if(c<NT0)kn=__builtin_fmaxf(kn,KN2h[c]); }
    kn=wave_max(kn);
    const float qn=__builtin_fmaxf(__builtin_fmaxf(QN2h[4*qb],QN2h[4*qb+1]),__builtin_fmaxf(QN2h[4*qb+2],QN2h[4*qb+3]));
    const float b2=2.f*__builtin_sqrtf(qn*kn), clq0=CLh[q0]; int cnt=0;
    _Pragma("unroll") for(int j=0;j<4;++j){ const int Tt=lane+64*j; const bool sk=(Tt<NT0)&&(clq0-CLh[Tt<NT0?64*Tt+63:0]+b2<-160.f); cnt+=__builtin_popcountll(__ballot(sk)); }
    Ts=cnt&~1; if(Ts>NT0-4)Ts=NT0-4; Ts=__builtin_amdgcn_readfirstlane(Ts); }
  const bf16*Kh=K+(rowbase+(long)Ts*KVBLK)*DM+h*D,*Vh=V+(rowbase+(long)Ts*KVBLK)*DM+h*D;
  const lds_cptr shm3=(lds_cptr)shm;
  const unsigned lds0=(unsigned)(uintptr_t)shm;
  float*wsf=(float*)(shm+LDS_WS)+wid*64;
  const bf16*ksrc=Kh+(long)lane*DM+wid*8;
  const bf16*vsrc=Vh+(long)(16*(wid&3)+(lane>>2))*DM+(wid>>2)*32+(lane&3)*8;
  const unsigned kdst=lds0+LDS_K+wid*1024, vdst=lds0+LDS_V+wid*1024;
  #define DMA_K(t,slot) glds16(ksrc+(long)(t)*KVBLK*DM,(unsigned)__builtin_amdgcn_readfirstlane(kdst+(slot)))
  #define DMA_V(t,slot) glds16(vsrc+(long)(t)*KVBLK*DM,(unsigned)__builtin_amdgcn_readfirstlane(vdst+(slot)))
  const int vb0=(int)(lds0+LDS_V)+((lane>>4)&1)*32+(lane&3)*8+(4*hi+((lane&15)>>2))*64;
  const char*Kbase=shm+LDS_K; bf16x8 kf[8];
  const lds_cptr kp0=shm3+LDS_K+hi*1024+r32*16; const lds_cptr vp0=shm3+LDS_V+((lane>>4)&1)*32+(lane&3)*8+(4*hi+((lane&15)>>2))*64;
  const int NT=(q0+QB)/KVBLK-Ts;
  typedef __attribute__((address_space(3))) float* lds_fptr; typedef __attribute__((address_space(3))) const f32x4_t* lds_f4ptr;
  { typedef __attribute__((address_space(3))) f32x4_t* lds_f4w; lds_f4w clw=(lds_f4w)(shm3+LDS_CL); const f32x4_t*cls=(const f32x4_t*)(CLh+Ts*KVBLK); const int ncl4=(q0+QB-Ts*KVBLK)>>2; _Pragma("nounroll") for(int i=tid;i<ncl4;i+=NW*64)clw[i]=cls[i]; }
  const lds_f4ptr clp=(lds_f4ptr)(shm3+LDS_CL+16*hi);
  float nb=CLh[q0+wid*QBLK+r32];
  #define CKLOAD(X0,X1,t) do{ const lds_f4ptr cb_=clp+(t)*16; \
    _Pragma("unroll") for(int g_=0;g_<4;++g_){ const f32x4_t a_=cb_[2*g_], b_=cb_[8+2*g_]; \
      _Pragma("unroll") for(int i_=0;i_<4;++i_){ X0[4*g_+i_]=a_[i_]; X1[4*g_+i_]=b_[i_]; } } }while(0)
  #define BIASSUB(C0,C1) do{ _Pragma("unroll") for(int r_=0;r_<16;++r_){ C0[r_]=nb-C0[r_]; C1[r_]=nb-C1[r_]; } }while(0)
  DMA_K(0,0);DMA_V(0,0);DMA_K(1,SLOTB);
  bf16x8 qr[4];
  #pragma unroll
  for(int d0=0;d0<4;++d0)qr[d0]=*reinterpret_cast<const bf16x8*>(&Qw[(long)r32*DM+d0*16+hi*8]);
  float l_reg=0.f;f32x16 o[2];o[0]=f32x16{};o[1]=f32x16{};
  const int qrel=wid*QBLK+r32;
  #define CMASK(P0,P1,t) do{int jb_=(t)-(NT-4); if(jb_>=0)cmask(P0,P1,jb_,qrel,hi);}while(0)
  bool resc=false;
  #define START(P0,P1) do{ const float rm=rowmax(P0,P1); resc=false; \
    { const float dl=rm; nb=fsub_s(nb,dl); \
      _Pragma("unroll") for(int r=0;r<16;++r){P0[r]=fsub_s(P0[r],dl);P1[r]=fsub_s(P1[r],dl);} } \
    _Pragma("unroll") for(int r=0;r<16;++r)P0[r]=__builtin_amdgcn_exp2f(P0[r]); }while(0)
  #define RESC() do{ if(resc){ asm volatile("s_waitcnt lgkmcnt(0)":::"memory"); \
      _Pragma("unroll") for(int d_=0;d_<2;++d_) _Pragma("unroll") for(int r=0;r<16;++r)o[d_][r]*=wsf[crow(r,hi)]; } }while(0)
  f32x16 pA0,pA1,pB0,pB1;
  int sl_prev=0,sl_cur=0,sl_next=SLOTB;
  #define ROT() do{sl_prev=sl_cur;sl_cur=sl_next;sl_next=(sl_next==(NSLOT-1)*SLOTB)?0:sl_next+SLOTB;}while(0)
  DMA_K(2,2*SLOTB);
  WAIT_BAR(3);
  CKLOAD(pA0,pA1,0); BIASSUB(pA0,pA1);
  qkt(pA0,pA1,Kbase,qr,pA0,pA1,r32,hi);asm volatile("s_nop 15\n\ts_nop 7":"+v"(pA0),"+v"(pA1));CMASK(pA0,pA1,0);
  START(pA0,pA1);
  _Pragma("unroll") for(int r=0;r<16;++r)pA1[r]=__builtin_amdgcn_exp2f(pA1[r]);
  WAIT_BAR(0);
  DMA_K(3,0);DMA_V(1,SLOTB);
  ROT();
  kload8(kf,kp0+sl_cur);
  WAIT_BAR(2);
  s16x4 vlo[8],vhi[8]; u32x4 pw0,pw1,pw2,pw3;
  #define PKW(P,B) cvtpk_s(P[B],P[B+1])
  #define PAF(k) __builtin_bit_cast(bf16x8,pw##k)
  #define VFR(i) (bf16x8){vlo[i][0],vlo[i][1],vlo[i][2],vlo[i][3],vhi[i][0],vhi[i][1],vhi[i][2],vhi[i][3]}
  #define PIN(x) asm volatile("":"+v"(x))
  #define MX3(a,b,c) __builtin_fmaxf(__builtin_fmaxf((a),(b)),(c))
  #define GAPA(MF,A0,A1,A2,A3,W0,W1,PW) do{ MF; sacc+=A0; sacc+=A1; sacc+=A2; sacc+=A3; PIN(sacc); W0; W1; PIN(PW); SBAR(); }while(0)
  #define EX(v) __builtin_amdgcn_exp2f(v)
  #define GAPB(MF,X,B) do{ MF; X[B]=EX(X[B]); X[B+1]=EX(X[B+1]); X[B+2]=EX(X[B+2]); X[B+3]=EX(X[B+3]); PIN(X); SBAR(); }while(0)
  #define VRD(i) do{ vlo[i]=vtr(vp_+(((i)>>2)*4096+((i)&3)*1024)); vhi[i]=vtr(vp_+(((i)>>2)*4096+((i)&3)*1024+512)); }while(0)
  #define KRD(G,j) do{ if(G){ kload2(kf,kp0+sl_next,j); SBAR(); } }while(0)
  #define STEP(C0,C1,P0,P1,t,GK,GV,GL) do{ CKLOAD(C0,C1,t); asm volatile("":"+v"(C0),"+v"(C1)); BIASSUB(C0,C1); SBAR(); \
    const lds_cptr vp_=vp0+sl_prev; \
    VRD(0); SBAR(); float sacc=(P0[0]+P0[1]); \
    GAPA(C0=__builtin_amdgcn_mfma_f32_32x32x16_bf16(kf[0],qr[0],C0,0,0,0), P0[2],P0[3],P0[4],P0[5],     pw0[0]=PKW(P0,0), pw0[1]=PKW(P0,2), pw0); \
    VRD(4); SBAR(); GAPA(C1=__builtin_amdgcn_mfma_f32_32x32x16_bf16(kf[1],qr[0],C1,0,0,0), P0[6],P0[7],P0[8],P0[9],     pw0[2]=PKW(P0,4), pw0[3]=PKW(P0,6), pw0); \
    VRD(1); SBAR(); GAPA(C0=__builtin_amdgcn_mfma_f32_32x32x16_bf16(kf[2],qr[1],C0,0,0,0),   P0[10],P0[11],P0[12],P0[13], pw1[0]=PKW(P0,8), pw1[1]=PKW(P0,10), pw1); \
    VRD(5); SBAR(); GAPA(C1=__builtin_amdgcn_mfma_f32_32x32x16_bf16(kf[3],qr[1],C1,0,0,0),   P0[14],P0[15],P1[0],P1[1],   pw1[2]=PKW(P0,12),pw1[3]=PKW(P0,14), pw1); \
    VRD(2); SBAR(); GAPA(C0=__builtin_amdgcn_mfma_f32_32x32x16_bf16(kf[4],qr[2],C0,0,0,0),   P1[2],P1[3],P1[4],P1[5],     pw2[0]=PKW(P1,0), pw2[1]=PKW(P1,2), pw2); \
    VRD(6); SBAR(); GAPA(C1=__builtin_amdgcn_mfma_f32_32x32x16_bf16(kf[5],qr[2],C1,0,0,0),   P1[6],P1[7],P1[8],P1[9],     pw2[2]=PKW(P1,4), pw2[3]=PKW(P1,6), pw2); \
    VRD(3); SBAR(); GAPA(C0=__builtin_amdgcn_mfma_f32_32x32x16_bf16(kf[6],qr[3],C0,0,0,0),   P1[10],P1[11],P1[12],P1[13], pw3[0]=PKW(P1,8), pw3[1]=PKW(P1,10), pw3); \
    VRD(7); SBAR(); GAPA(C1=__builtin_amdgcn_mfma_f32_32x32x16_bf16(kf[7],qr[3],C1,0,0,0),   P1[14],P1[15],0.f,0.f,       pw3[2]=PKW(P1,12),pw3[3]=PKW(P1,14), pw3); \
    l_reg+=sacc; \
    if(GK){DMA_K((t)+3,sl_cur);} if(GV){DMA_V((t)+1,sl_next);} \
    CMASK(C0,C1,t); \
    { float a=MX3(C0[0],C0[1],C1[0]),b=MX3(C0[2],C0[3],C1[1]); a=MX3(a,C1[2],C1[3]); \
      _Pragma("unroll") for(int r=4;r<16;r+=4){a=MX3(a,C0[r],C0[r+1]);b=MX3(b,C0[r+2],C0[r+3]);a=MX3(a,C1[r],C1[r+1]);b=MX3(b,C1[r+2],C1[r+3]);} \
      float rm=__builtin_fmaxf(a,b); { auto rr=__builtin_amdgcn_permlane32_swap(__float_as_uint(rm),__float_as_uint(rm),false,false); rm=__builtin_fmaxf(__uint_as_float(rr[0]),__uint_as_float(rr[1])); } \
      resc=false; \
      if(__builtin_expect(__any(rm>(float)THRL),0)){ const float dl=__builtin_fmaxf(rm,0.f); nb-=dl; \
        _Pragma("unroll") for(int r=0;r<16;++r){C0[r]-=dl;C1[r]-=dl;} \
        const float f=__builtin_amdgcn_exp2f(-dl); l_reg*=f; if(hi==0)wsf[r32]=f; resc=true; } } \
    SBAR(); \
    GAPB(o[0]=__builtin_amdgcn_mfma_f32_32x32x16_bf16(PAF(0),VFR(0),o[0],0,0,0), C0,0); \
    GAPB(o[1]=__builtin_amdgcn_mfma_f32_32x32x16_bf16(PAF(0),VFR(4),o[1],0,0,0), C0,4); \
    KRD(GL,0); GAPB(o[0]=__builtin_amdgcn_mfma_f32_32x32x16_bf16(PAF(1),VFR(1),o[0],0,0,0), C0,8); \
    KRD(GL,1); GAPB(o[1]=__builtin_amdgcn_mfma_f32_32x32x16_bf16(PAF(1),VFR(5),o[1],0,0,0), C0,12); \
    KRD(GL,2); GAPB(o[0]=__builtin_amdgcn_mfma_f32_32x32x16_bf16(PAF(2),VFR(2),o[0],0,0,0), C1,0); \
    KRD(GL,3); GAPB(o[1]=__builtin_amdgcn_mfma_f32_32x32x16_bf16(PAF(2),VFR(6),o[1],0,0,0), C1,4); \
    GAPB(o[0]=__builtin_amdgcn_mfma_f32_32x32x16_bf16(PAF(3),VFR(3),o[0],0,0,0), C1,8); \
    GAPB(o[1]=__builtin_amdgcn_mfma_f32_32x32x16_bf16(PAF(3),VFR(7),o[1],0,0,0), C1,12); \
    }while(0)
  int t=1;
  #undef CMASK
  #define CMASK(P0,P1,t) do{}while(0)
  for(;t+5<NT;t+=2){
    STEP(pB0,pB1,pA0,pA1,t,true,true,true);     WAIT_BAR(2); RESC(); ROT();
    STEP(pA0,pA1,pB0,pB1,t+1,true,true,true);   WAIT_BAR(2); RESC(); ROT();
  }
  #undef CMASK
  #define CMASK(P0,P1,t) do{int jb_=(t)-(NT-4); if(jb_>=0)cmask(P0,P1,jb_,qrel,hi);}while(0)
  #define ENDW(tt) do{ if((tt)+3<NT){WAIT_BAR(2);} else if((tt)+2<NT){WAIT_BAR(1);} else {WAIT_BAR(0);} }while(0)
  for(;t+1<NT;t+=2){
    STEP(pB0,pB1,pA0,pA1,t,(t+3<NT),(t+1<NT),(t+1<NT));       ENDW(t);   RESC(); ROT();
    STEP(pA0,pA1,pB0,pB1,t+1,(t+4<NT),(t+2<NT),(t+2<NT));     ENDW(t+1); RESC(); ROT();
  }
  STEP(pB0,pB1,pA0,pA1,NT-1,false,false,false); RESC();
  { float sacc=pB0[0]+pB0[1]; _Pragma("unroll") for(int r=2;r<16;++r)sacc+=pB0[r]; _Pragma("unroll") for(int r=0;r<16;++r)sacc+=pB1[r]; l_reg+=sacc;
    pw0=(u32x4){PKW(pB0,0),PKW(pB0,2),PKW(pB0,4),PKW(pB0,6)};pw1=(u32x4){PKW(pB0,8),PKW(pB0,10),PKW(pB0,12),PKW(pB0,14)};pw2=(u32x4){PKW(pB1,0),PKW(pB1,2),PKW(pB1,4),PKW(pB1,6)};pw3=(u32x4){PKW(pB1,8),PKW(pB1,10),PKW(pB1,12),PKW(pB1,14)};
    SBAR(); pv(o,vb0+sl_cur,PAF(0),PAF(1),PAF(2),PAF(3)); }
  #undef PKW
  #undef PAF
  #undef VFR
  #undef PIN
  #undef MX3
  #undef GAPA
  #undef GAPB
  #undef EX
  #undef VRD
  #undef KRD
  #undef STEP
  #undef ENDW
  {auto rr=__builtin_amdgcn_permlane32_swap(__float_as_uint(l_reg),__float_as_uint(l_reg),false,false);l_reg=__uint_as_float(rr[0])+__uint_as_float(rr[1]);}
  if(hi==0)wsf[32+r32]=l_reg;asm volatile("s_waitcnt lgkmcnt(0)":::"memory");
  float rli[16];
  #pragma unroll
  for(int r=0;r<16;++r)rli[r]=__builtin_amdgcn_rcpf(wsf[32+crow(r,hi)]);
  bf16*Ow=O+(rowbase+q0+wid*QBLK)*OPITCH+OCOL+h*D;
  { bf16*stg=(bf16*)(shm+LDS_OST)+wid*2048;
    #pragma unroll
    for(int r=0;r<16;++r){const int orow=crow(r,hi);
      #pragma unroll
      for(int d0=0;d0<2;++d0)stg[orow*64+d0*32+r32]=(bf16)(cvtpk_s(o[d0][r]*rli[r],0.f)&0xffffu);}
    asm volatile("s_waitcnt lgkmcnt(0)":::"memory");
    #pragma unroll
    for(int i=0;i<4;++i){const int row=i*8+(lane>>3),ch=lane&7; const u32x4 v=*(const u32x4*)(stg+row*64+ch*8); ATTN_STORE16(Ow+(long)row*OPITCH+ch*8,v);} }
  asm volatile("s_waitcnt lgkmcnt(0)\n\ts_barrier":::"memory");
  #undef CKLOAD
  #undef BIASSUB
  #undef DMA_K
  #undef DMA_V
  #undef CMASK
  #undef START
  #undef RESC
  #undef ROT
}
constexpr int ATTN_LDS_BYTES=LDS_BYTES;
struct AttnTensors { const bf16* Q; const bf16* K; const bf16* V; bf16* O; const float* CL; const float* QN2; const float* KN2; };
struct AttnUnit { int bh; int qb; };
struct StaticOrder {
  int vcu, G;
  __device__ __forceinline__ explicit StaticOrder(int grid,int block):vcu((grid%8==0)?(block%8)*(grid/8)+block/8:block),G(grid){}
  __device__ __forceinline__ bool next(int i,AttnUnit&u)const{ const int L=i*G+vcu; if(L>=1024)return false; const int slot=L>>8,pos=L&255,s=pos&15; u.bh=pos>>4; u.qb=(slot==0)?s:(slot==1)?31-s:(slot==2)?32+s:63-s; return true; }
  __device__ __forceinline__ void a_ready(const AttnUnit&)const{}
  __device__ __forceinline__ void done(const AttnUnit&)const{}
};
template<int THRL=8> __device__ __forceinline__ void attn_phase(char*lds,const AttnTensors&T,unsigned*heads,const int myx,const int tid_in,ArgsP ap){
  int probe=7; volatile __attribute__((address_space(3))) int*bc=(volatile __attribute__((address_space(3))) int*)((__attribute__((address_space(3))) char*)lds+LDS_BYTES+64);
  for(;;){ const int item=peer_next_item(heads,1,probe,3072u,bc,tid_in); if(item<0)break;
    const int it3=item%3072,v=it3/3,ty=it3-3*v;
    if(ty==1){ convert_uv_fp8_item(ap,opaque(tid_in),v); continue; }
    if(ty==2){ if(v<512)transpose_filler_item(ap,(__attribute__((address_space(3))) unsigned char*)lds,opaque(tid_in),v); continue; }
    const int h=15-(v&15),qb=63-(v>>4);
    attn_unit<THRL>(0,h,qb,T.Q,T.K,T.V,T.O,T.CL+(long)h*SEQ,T.QN2+h*256,T.KN2+h*256,lds,tid_in); }
}
#undef SBAR
#undef WAIT_BAR
}
__device__ __forceinline__ int topk_sortable(float f) { const int u = __float_as_int(f); return u ^ ((u >> 31) & 0x7fffffff); }
__device__ __forceinline__ int topk_pack7(float f, int idx) { return (topk_sortable(f) & ~127) | (127 - idx); }
__device__ __forceinline__ void wave_imax2(int& a, int& b, int& sa, int& sb) {
    asm volatile("s_nop 1\n\t"
        "v_max_i32_dpp %0, %0, %0 row_shr:1 row_mask:0xf bank_mask:0xf\n\tv_max_i32_dpp %1, %1, %1 row_shr:1 row_mask:0xf bank_mask:0xf\n\ts_nop 0\n\t"
        "v_max_i32_dpp %0, %0, %0 row_shr:2 row_mask:0xf bank_mask:0xf\n\tv_max_i32_dpp %1, %1, %1 row_shr:2 row_mask:0xf bank_mask:0xf\n\ts_nop 0\n\t"
        "v_max_i32_dpp %0, %0, %0 row_shr:4 row_mask:0xf bank_mask:0xf\n\tv_max_i32_dpp %1, %1, %1 row_shr:4 row_mask:0xf bank_mask:0xf\n\ts_nop 0\n\t"
        "v_max_i32_dpp %0, %0, %0 row_shr:8 row_mask:0xf bank_mask:0xf\n\tv_max_i32_dpp %1, %1, %1 row_shr:8 row_mask:0xf bank_mask:0xf\n\ts_nop 0\n\t"
        "v_max_i32_dpp %0, %0, %0 row_bcast:15 row_mask:0xa bank_mask:0xf\n\tv_max_i32_dpp %1, %1, %1 row_bcast:15 row_mask:0xa bank_mask:0xf\n\ts_nop 0\n\t"
        "v_max_i32_dpp %0, %0, %0 row_bcast:31 row_mask:0xc bank_mask:0xf\n\tv_max_i32_dpp %1, %1, %1 row_bcast:31 row_mask:0xc bank_mask:0xf\n\ts_nop 1\n\t"
        "v_readlane_b32 %2, %0, 63\n\tv_readlane_b32 %3, %1, 63\n\ts_nop 3"
        : "+v"(a), "+v"(b), "=s"(sa), "=s"(sb));
}
__device__ __forceinline__ void wave_imax1(int& a, int& sa) {
    asm volatile("s_nop 1\n\t"
        "v_max_i32_dpp %0, %0, %0 row_shr:1 row_mask:0xf bank_mask:0xf\n\ts_nop 1\n\t"
        "v_max_i32_dpp %0, %0, %0 row_shr:2 row_mask:0xf bank_mask:0xf\n\ts_nop 1\n\t"
        "v_max_i32_dpp %0, %0, %0 row_shr:4 row_mask:0xf bank_mask:0xf\n\ts_nop 1\n\t"
        "v_max_i32_dpp %0, %0, %0 row_shr:8 row_mask:0xf bank_mask:0xf\n\ts_nop 1\n\t"
        "v_max_i32_dpp %0, %0, %0 row_bcast:15 row_mask:0xa bank_mask:0xf\n\ts_nop 1\n\t"
        "v_max_i32_dpp %0, %0, %0 row_bcast:31 row_mask:0xc bank_mask:0xf\n\ts_nop 1\n\t"
        "v_readlane_b32 %1, %0, 63\n\ts_nop 3"
        : "+v"(a), "=s"(sa));
}
__device__ __forceinline__ void wave_imax_x8(int (&k)[8], int (&s)[8]) {
    asm volatile("s_nop 1\n\t"
        "v_max_i32_dpp %0, %0, %0 row_shr:1 row_mask:0xf bank_mask:0xf\n\tv_max_i32_dpp %1, %1, %1 row_shr:1 row_mask:0xf bank_mask:0xf\n\tv_max_i32_dpp %2, %2, %2 row_shr:1 row_mask:0xf bank_mask:0xf\n\tv_max_i32_dpp %3, %3, %3 row_shr:1 row_mask:0xf bank_mask:0xf\n\tv_max_i32_dpp %4, %4, %4 row_shr:1 row_mask:0xf bank_mask:0xf\n\tv_max_i32_dpp %5, %5, %5 row_shr:1 row_mask:0xf bank_mask:0xf\n\tv_max_i32_dpp %6, %6, %6 row_shr:1 row_mask:0xf bank_mask:0xf\n\tv_max_i32_dpp %7, %7, %7 row_shr:1 row_mask:0xf bank_mask:0xf\n\t"
        "v_max_i32_dpp %0, %0, %0 row_shr:2 row_mask:0xf bank_mask:0xf\n\tv_max_i32_dpp %1, %1, %1 row_shr:2 row_mask:0xf bank_mask:0xf\n\tv_max_i32_dpp %2, %2, %2 row_shr:2 row_mask:0xf bank_mask:0xf\n\tv_max_i32_dpp %3, %3, %3 row_shr:2 row_mask:0xf bank_mask:0xf\n\tv_max_i32_dpp %4, %4, %4 row_shr:2 row_mask:0xf bank_mask:0xf\n\tv_max_i32_dpp %5, %5, %5 row_shr:2 row_mask:0xf bank_mask:0xf\n\tv_max_i32_dpp %6, %6, %6 row_shr:2 row_mask:0xf bank_mask:0xf\n\tv_max_i32_dpp %7, %7, %7 row_shr:2 row_mask:0xf bank_mask:0xf\n\t"
        "v_max_i32_dpp %0, %0, %0 row_shr:4 row_mask:0xf bank_mask:0xf\n\tv_max_i32_dpp %1, %1, %1 row_shr:4 row_mask:0xf bank_mask:0xf\n\tv_max_i32_dpp %2, %2, %2 row_shr:4 row_mask:0xf bank_mask:0xf\n\tv_max_i32_dpp %3, %3, %3 row_shr:4 row_mask:0xf bank_mask:0xf\n\tv_max_i32_dpp %4, %4, %4 row_shr:4 row_mask:0xf bank_mask:0xf\n\tv_max_i32_dpp %5, %5, %5 row_shr:4 row_mask:0xf bank_mask:0xf\n\tv_max_i32_dpp %6, %6, %6 row_shr:4 row_mask:0xf bank_mask:0xf\n\tv_max_i32_dpp %7, %7, %7 row_shr:4 row_mask:0xf bank_mask:0xf\n\t"
        "v_max_i32_dpp %0, %0, %0 row_shr:8 row_mask:0xf bank_mask:0xf\n\tv_max_i32_dpp %1, %1, %1 row_shr:8 row_mask:0xf bank_mask:0xf\n\tv_max_i32_dpp %2, %2, %2 row_shr:8 row_mask:0xf bank_mask:0xf\n\tv_max_i32_dpp %3, %3, %3 row_shr:8 row_mask:0xf bank_mask:0xf\n\tv_max_i32_dpp %4, %4, %4 row_shr:8 row_mask:0xf bank_mask:0xf\n\tv_max_i32_dpp %5, %5, %5 row_shr:8 row_mask:0xf bank_mask:0xf\n\tv_max_i32_dpp %6, %6, %6 row_shr:8 row_mask:0xf bank_mask:0xf\n\tv_max_i32_dpp %7, %7, %7 row_shr:8 row_mask:0xf bank_mask:0xf\n\t"
        "v_max_i32_dpp %0, %0, %0 row_bcast:15 row_mask:0xa bank_mask:0xf\n\tv_max_i32_dpp %1, %1, %1 row_bcast:15 row_mask:0xa bank_mask:0xf\n\tv_max_i32_dpp %2, %2, %2 row_bcast:15 row_mask:0xa bank_mask:0xf\n\tv_max_i32_dpp %3, %3, %3 row_bcast:15 row_mask:0xa bank_mask:0xf\n\tv_max_i32_dpp %4, %4, %4 row_bcast:15 row_mask:0xa bank_mask:0xf\n\tv_max_i32_dpp %5, %5, %5 row_bcast:15 row_mask:0xa bank_mask:0xf\n\tv_max_i32_dpp %6, %6, %6 row_bcast:15 row_mask:0xa bank_mask:0xf\n\tv_max_i32_dpp %7, %7, %7 row_bcast:15 row_mask:0xa bank_mask:0xf\n\t"
        "v_max_i32_dpp %0, %0, %0 row_bcast:31 row_mask:0xc bank_mask:0xf\n\tv_max_i32_dpp %1, %1, %1 row_bcast:31 row_mask:0xc bank_mask:0xf\n\tv_max_i32_dpp %2, %2, %2 row_bcast:31 row_mask:0xc bank_mask:0xf\n\tv_max_i32_dpp %3, %3, %3 row_bcast:31 row_mask:0xc bank_mask:0xf\n\tv_max_i32_dpp %4, %4, %4 row_bcast:31 row_mask:0xc bank_mask:0xf\n\tv_max_i32_dpp %5, %5, %5 row_bcast:31 row_mask:0xc bank_mask:0xf\n\tv_max_i32_dpp %6, %6, %6 row_bcast:31 row_mask:0xc bank_mask:0xf\n\tv_max_i32_dpp %7, %7, %7 row_bcast:31 row_mask:0xc bank_mask:0xf\n\t"
        "s_nop 1\n\tv_readlane_b32 %8, %0, 63\n\tv_readlane_b32 %9, %1, 63\n\tv_readlane_b32 %10, %2, 63\n\tv_readlane_b32 %11, %3, 63\n\tv_readlane_b32 %12, %4, 63\n\tv_readlane_b32 %13, %5, 63\n\tv_readlane_b32 %14, %6, 63\n\tv_readlane_b32 %15, %7, 63\n\ts_nop 3"
        : "+v"(k[0]), "+v"(k[1]), "+v"(k[2]), "+v"(k[3]), "+v"(k[4]), "+v"(k[5]), "+v"(k[6]), "+v"(k[7]), "=s"(s[0]), "=s"(s[1]), "=s"(s[2]), "=s"(s[3]), "=s"(s[4]), "=s"(s[5]), "=s"(s[6]), "=s"(s[7]));
}
__device__ __forceinline__ void wave_imax_x4(int (&k)[4], int (&s)[4]) {
    asm volatile("s_nop 1\n\t"
        "v_max_i32_dpp %0, %0, %0 row_shr:1 row_mask:0xf bank_mask:0xf\n\tv_max_i32_dpp %1, %1, %1 row_shr:1 row_mask:0xf bank_mask:0xf\n\tv_max_i32_dpp %2, %2, %2 row_shr:1 row_mask:0xf bank_mask:0xf\n\tv_max_i32_dpp %3, %3, %3 row_shr:1 row_mask:0xf bank_mask:0xf\n\t"
        "v_max_i32_dpp %0, %0, %0 row_shr:2 row_mask:0xf bank_mask:0xf\n\tv_max_i32_dpp %1, %1, %1 row_shr:2 row_mask:0xf bank_mask:0xf\n\tv_max_i32_dpp %2, %2, %2 row_shr:2 row_mask:0xf bank_mask:0xf\n\tv_max_i32_dpp %3, %3, %3 row_shr:2 row_mask:0xf bank_mask:0xf\n\t"
        "v_max_i32_dpp %0, %0, %0 row_shr:4 row_mask:0xf bank_mask:0xf\n\tv_max_i32_dpp %1, %1, %1 row_shr:4 row_mask:0xf bank_mask:0xf\n\tv_max_i32_dpp %2, %2, %2 row_shr:4 row_mask:0xf bank_mask:0xf\n\tv_max_i32_dpp %3, %3, %3 row_shr:4 row_mask:0xf bank_mask:0xf\n\t"
        "v_max_i32_dpp %0, %0, %0 row_shr:8 row_mask:0xf bank_mask:0xf\n\tv_max_i32_dpp %1, %1, %1 row_shr:8 row_mask:0xf bank_mask:0xf\n\tv_max_i32_dpp %2, %2, %2 row_shr:8 row_mask:0xf bank_mask:0xf\n\tv_max_i32_dpp %3, %3, %3 row_shr:8 row_mask:0xf bank_mask:0xf\n\t"
        "v_max_i32_dpp %0, %0, %0 row_bcast:15 row_mask:0xa bank_mask:0xf\n\tv_max_i32_dpp %1, %1, %1 row_bcast:15 row_mask:0xa bank_mask:0xf\n\tv_max_i32_dpp %2, %2, %2 row_bcast:15 row_mask:0xa bank_mask:0xf\n\tv_max_i32_dpp %3, %3, %3 row_bcast:15 row_mask:0xa bank_mask:0xf\n\t"
        "v_max_i32_dpp %0, %0, %0 row_bcast:31 row_mask:0xc bank_mask:0xf\n\tv_max_i32_dpp %1, %1, %1 row_bcast:31 row_mask:0xc bank_mask:0xf\n\tv_max_i32_dpp %2, %2, %2 row_bcast:31 row_mask:0xc bank_mask:0xf\n\tv_max_i32_dpp %3, %3, %3 row_bcast:31 row_mask:0xc bank_mask:0xf\n\t"
        "s_nop 1\n\tv_readlane_b32 %4, %0, 63\n\tv_readlane_b32 %5, %1, 63\n\tv_readlane_b32 %6, %2, 63\n\tv_readlane_b32 %7, %3, 63\n\ts_nop 3"
        : "+v"(k[0]), "+v"(k[1]), "+v"(k[2]), "+v"(k[3]), "=s"(s[0]), "=s"(s[1]), "=s"(s[2]), "=s"(s[3]));
}
__device__ __forceinline__ void row_imax2(int& a, int& b) {
    asm volatile("s_nop 1\n\t"
        "v_max_i32_dpp %0, %0, %0 row_ror:8 row_mask:0xf bank_mask:0xf\n\tv_max_i32_dpp %1, %1, %1 row_ror:8 row_mask:0xf bank_mask:0xf\n\ts_nop 0\n\t"
        "v_max_i32_dpp %0, %0, %0 row_ror:4 row_mask:0xf bank_mask:0xf\n\tv_max_i32_dpp %1, %1, %1 row_ror:4 row_mask:0xf bank_mask:0xf\n\ts_nop 0\n\t"
        "v_max_i32_dpp %0, %0, %0 row_ror:2 row_mask:0xf bank_mask:0xf\n\tv_max_i32_dpp %1, %1, %1 row_ror:2 row_mask:0xf bank_mask:0xf\n\ts_nop 0\n\t"
        "v_max_i32_dpp %0, %0, %0 row_ror:1 row_mask:0xf bank_mask:0xf\n\tv_max_i32_dpp %1, %1, %1 row_ror:1 row_mask:0xf bank_mask:0xf\n\ts_nop 1"
        : "+v"(a), "+v"(b));
}
template <int CTRL> __device__ __forceinline__ float dpp_rot(float v) { return __int_as_float(__builtin_amdgcn_update_dpp(0, __float_as_int(v), CTRL, 0xf, 0xf, false)); }
__device__ __forceinline__ float row_fmax(float v) { v = fmaxf(v, dpp_rot<0x128>(v)); v = fmaxf(v, dpp_rot<0x124>(v)); v = fmaxf(v, dpp_rot<0x122>(v)); v = fmaxf(v, dpp_rot<0x121>(v)); return v; }
__device__ __forceinline__ float row_fsum(float v) { v += dpp_rot<0x128>(v); v += dpp_rot<0x124>(v); v += dpp_rot<0x122>(v); v += dpp_rot<0x121>(v); return v; }
__device__ const unsigned char PEER_CAND[64] = {
    0x00,0x01,0x02,0x03,0x04,0x05,0x06,0x07,0x08,0x09,0x0a,0x0b,0x0c,0x0d,0x0e,0x0f, 0x10,0x11,0x12,0x13,0x14,0x15,0x16,0x17, 0x20,0x21,0x22,0x23,0x24, 0x30,0x31,0x32,0x33,
    0x40,0x41,0x42, 0x50,0x51, 0x60,0x61, 0x70,0x71, 0x80, 0x90, 0xa0, 0xb0, 0xc0, 0xd0, 0xe0, 0xf0, 0xff,0xff,0xff,0xff,0xff,0xff,0xff,0xff,0xff,0xff,0xff,0xff,0xff,0xff};
__device__ __forceinline__ void phase7(ArgsP a, LAS unsigned char* lds, const int tidx) {
    const int tid0 = tidx, w = __builtin_amdgcn_readfirstlane(tid0 >> 6);
    const bf16* QP = (const bf16*)(a->ws + WS_QP); const bf16* K12 = (const bf16*)(a->ws + WS_K12); const float* SUMSQ = (const float*)(a->ws + WS_MISC + MISC_SUMSQ);
    int* IDX = (int*)(a->ws + WS_IDX); float* GW = (float*)(a->ws + WS_GW);
    LAS float* SC = (LAS float*)lds;
    for (int u = blockIdx.x; u < 256 * 8; u += gridDim.x) {
        const int tid = opaque(tid0), lane = tid & 63, fr = lane & 15, fq = lane >> 4;
        const int tt = u >> 3, hd = u & 7, tok0 = tt * 64;
        {
            const int half = w >> 2; const bf16* kb = K12 + ((size_t)(half * 8 + hd) * 128) * 128;
            f32x4 acc[4][2];
#pragma unroll
            for (int i = 0; i < 4; ++i) { acc[i][0] = (f32x4){0.f, 0.f, 0.f, 0.f}; acc[i][1] = (f32x4){0.f, 0.f, 0.f, 0.f}; }
#pragma unroll
            for (int kk = 0; kk < 4; ++kk) {
                bf16x8 af[4], bfv[2];
#pragma unroll
                for (int i = 0; i < 4; ++i) af[i] = *(const bf16x8*)(QP + (size_t)(tok0 + 16 * i + fr) * DM + 256 * hd + 128 * half + 8 * fq + 32 * kk);
#pragma unroll
                for (int j = 0; j < 2; ++j) bfv[j] = *(const bf16x8*)(kb + (size_t)(16 * (2 * (w & 3) + j) + fr) * 128 + 8 * fq + 32 * kk);
#pragma unroll
                for (int i = 0; i < 4; ++i) { acc[i][0] = mfma16(af[i], bfv[0], acc[i][0]); acc[i][1] = mfma16(af[i], bfv[1], acc[i][1]); }
            }
#pragma unroll
            for (int i = 0; i < 4; ++i)
#pragma unroll
                for (int j = 0; j < 2; ++j)
#pragma unroll
                    for (int r = 0; r < 4; ++r) SC[(16 * i + 4 * fq + r) * 260 + 128 * half + 16 * (2 * (w & 3) + j) + fr] = acc[i][j][r];
        }
        __syncthreads();
        const int r16 = lane & 15, rowb = lane & 48;
        const int cab = (int)PEER_CAND[lane];
        int cca[4], ccb[4];
#pragma unroll
        for (int i = 0; i < 4; ++i) { const int cc = (int)PEER_CAND[r16 + 16 * i]; cca[i] = rowb + (cc >> 4); ccb[i] = rowb + (cc & 15); }
        for (int tl = 0; tl < 8; tl += 4) {
            const int tk = 8 * w + tl + (lane >> 4), tok = tok0 + tk;
            const LAS float* srow = SC + tk * 260;
            int sa[8], sb[8];
#pragma unroll
            for (int i = 0; i < 8; ++i) { sa[i] = topk_pack7(srow[r16 + 16 * i], r16 + 16 * i); sb[i] = topk_pack7(srow[128 + r16 + 16 * i], r16 + 16 * i); }
#define CE(x, i, j) do { const int hi_ = x[i] > x[j] ? x[i] : x[j], lo_ = x[i] > x[j] ? x[j] : x[i]; x[i] = hi_; x[j] = lo_; } while (0)
#define SORT8(x) do { CE(x,0,1); CE(x,2,3); CE(x,4,5); CE(x,6,7); CE(x,0,2); CE(x,1,3); CE(x,4,6); CE(x,5,7); CE(x,1,2); CE(x,5,6); CE(x,0,4); CE(x,3,7); CE(x,1,5); CE(x,2,6); CE(x,1,4); CE(x,3,6); CE(x,2,4); CE(x,3,5); CE(x,3,4); } while (0)
            SORT8(sa); SORT8(sb);
            int resa = 0, resb = 0;
            for (int k = 0; k < 16; ++k) {
                int ma = sa[0], mb = sb[0];
                row_imax2(ma, mb);
                const bool wa = sa[0] == ma, wb = sb[0] == mb;
#pragma unroll
                for (int i = 0; i < 7; ++i) { sa[i] = wa ? sa[i + 1] : sa[i]; sb[i] = wb ? sb[i + 1] : sb[i]; }
                sa[7] = wa ? (int)0x80000000 : sa[7]; sb[7] = wb ? (int)0x80000000 : sb[7];
                if (r16 == k) { resa = ma; resb = mb; }
            }
            const int ria = 127 - (resa & 127), rib = 127 - (resb & 127);
            const float rva = srow[ria], rvb = srow[128 + rib];
            int kc[4];
#pragma unroll
            for (int i = 0; i < 4; ++i) { const float csum = __shfl(rva, cca[i]) + __shfl(rvb, ccb[i]); const int cidx = r16 + 16 * i; kc[i] = cidx < 50 ? ((topk_sortable(csum) & ~63) | (63 - cidx)) : (int)0x80000000; }
            CE(kc,0,1); CE(kc,2,3); CE(kc,0,2); CE(kc,1,3); CE(kc,1,2);
            int resc = 0;
            for (int k = 0; k < 16; ++k) {
                int mc = kc[0], dummy = kc[0];
                row_imax2(mc, dummy);
                const bool wc = kc[0] == mc;
                kc[0] = wc ? kc[1] : kc[0]; kc[1] = wc ? kc[2] : kc[1]; kc[2] = wc ? kc[3] : kc[2]; kc[3] = wc ? (int)0x80000000 : kc[3];
                if (r16 == k) resc = mc;
            }
#undef SORT8
#undef CE
            const int ci = 63 - (resc & 63);
            const int sab = __shfl(cab, ci), sela = rowb + (sab >> 4), selb = rowb + (sab & 15);
            const float sv = __shfl(rva, sela) + __shfl(rvb, selb);
            const int e1 = __shfl(ria, sela), e2 = __shfl(rib, selb);
            const float rstd = 1.f / sqrtf(SUMSQ[tok] * (1.f / DM) + EPS);
            const float top = row_fmax(sv);
            const float p = __expf((sv - top) * rstd);
            const float den = row_fsum(p);
            IDX[(size_t)tok * 128 + 16 * hd + r16] = e1 * 128 + e2; GW[(size_t)tok * 128 + 16 * hd + r16] = p / den;
        }
        __syncthreads();
    }
}

__device__ __forceinline__ void phase8(ArgsP a, const int tidx) {
    const int tid0 = tidx, w = __builtin_amdgcn_readfirstlane(tid0 >> 6);
    const bf16* HN = (const bf16*)(a->ws + WS_HN); const bf16* U = (const bf16*)(a->ws + WS_U); const bf16* V = (const bf16*)(a->ws + WS_V2);
    const int* IDX = (const int*)(a->ws + WS_IDX); const float* GW = (const float*)(a->ws + WS_GW); const float* SUMSQ = (const float*)(a->ws + WS_MISC + MISC_SUMSQ);
    const int gwv = blockIdx.x * NWAVES + w, NGW = gridDim.x * NWAVES;
    for (int tok = gwv; tok < M; tok += NGW) {
        const int lane = opaque(tid0) & 63;
        u32x4 hv[4];
#pragma unroll
        for (int i = 0; i < 4; ++i) hv[i] = *(const u32x4*)(HN + (size_t)tok * DM + 8 * lane + 512 * i);
        const int id0 = IDX[(size_t)tok * 128 + lane], id1 = IDX[(size_t)tok * 128 + 64 + lane];
        const float g0 = GW[(size_t)tok * 128 + lane], g1 = GW[(size_t)tok * 128 + 64 + lane];
        const float rstd2 = 1.f / sqrtf(SUMSQ[tok] * (1.f / DM) + EPS);
        float oacc[32];
#pragma unroll
        for (int i = 0; i < 32; ++i) oacc[i] = 0.f;
        for (int eb = 0; eb < 128; eb += 8) {
            u32x4 uv[8][4]; float part[8]; int eid[8];
#pragma unroll
            for (int e = 0; e < 8; ++e) { const int sl = eb + e; eid[e] = __builtin_amdgcn_readfirstlane(sl < 64 ? __shfl(id0, sl) : __shfl(id1, sl - 64));
                const bf16* row = U + (size_t)eid[e] * DM + 8 * lane;
#pragma unroll
                for (int i = 0; i < 4; ++i) uv[e][i] = *(const u32x4*)(row + 512 * i); }
#pragma unroll
            for (int e = 0; e < 8; ++e) { float s = 0.f;
#pragma unroll
                for (int i = 0; i < 4; ++i) {
                    s = dot2bf(uv[e][i].x, hv[i].x, s); s = dot2bf(uv[e][i].y, hv[i].y, s); s = dot2bf(uv[e][i].z, hv[i].z, s); s = dot2bf(uv[e][i].w, hv[i].w, s); }
                part[e] = wave_sum(s); }
#pragma unroll
            for (int e = 0; e < 8; ++e) { const bf16* row = V + (size_t)eid[e] * DM + 8 * lane;
#pragma unroll
                for (int i = 0; i < 4; ++i) uv[e][i] = *(const u32x4*)(row + 512 * i); }
#pragma unroll
            for (int e = 0; e < 8; ++e) { const int sl = eb + e; const float gg = sl < 64 ? __shfl(g0, sl) : __shfl(g1, sl - 64);
                const float act = part[e] * rstd2; const float ge = 0.5f * act * (1.f + erff(act * 0.70710678118654752f)); const float cf = gg * ge;
#pragma unroll
                for (int i = 0; i < 4; ++i) {
                    oacc[8 * i + 0] += cf * bflo(uv[e][i].x); oacc[8 * i + 1] += cf * bfhi(uv[e][i].x); oacc[8 * i + 2] += cf * bflo(uv[e][i].y); oacc[8 * i + 3] += cf * bfhi(uv[e][i].y);
                    oacc[8 * i + 4] += cf * bflo(uv[e][i].z); oacc[8 * i + 5] += cf * bfhi(uv[e][i].z); oacc[8 * i + 6] += cf * bflo(uv[e][i].w); oacc[8 * i + 7] += cf * bfhi(uv[e][i].w); } }
        }
        float* orow = a->out + (size_t)tok * DM + 8 * lane; float ss = 0.f;
#pragma unroll
        for (int i = 0; i < 4; ++i) { const f32x4 x0 = *(const f32x4*)(orow + 512 * i), x1 = *(const f32x4*)(orow + 512 * i + 4);
#pragma unroll
            for (int j = 0; j < 4; ++j) { oacc[8 * i + j] += x0[j]; oacc[8 * i + 4 + j] += x1[j]; }
#pragma unroll
            for (int j = 0; j < 8; ++j) ss += oacc[8 * i + j] * oacc[8 * i + j]; }
        const float rstd = 1.f / sqrtf(wave_sum(ss) * (1.f / DM) + EPS);
#pragma unroll
        for (int i = 0; i < 4; ++i) { const f32x4 w0 = *(const f32x4*)(a->lnf_w + 8 * lane + 512 * i), w1 = *(const f32x4*)(a->lnf_w + 8 * lane + 512 * i + 4); f32x4 o0, o1;
#pragma unroll
            for (int j = 0; j < 4; ++j) { o0[j] = oacc[8 * i + j] * rstd * w0[j]; o1[j] = oacc[8 * i + 4 + j] * rstd * w1[j]; }
            *(f32x4*)(orow + 512 * i) = o0; *(f32x4*)(orow + 512 * i + 4) = o1; }
    }
}
__device__ __forceinline__ void convert_uv(ArgsP a, const int tidx) {
    const size_t gt = (size_t)blockIdx.x * NTHR + tidx, NGT = (size_t)gridDim.x * NTHR; const size_t NP = (size_t)16384 * 2048 / 8;
    u32x4* Ud = (u32x4*)(a->ws + WS_U); u32x4* Vd = (u32x4*)(a->ws + WS_V2);
    for (size_t i = gt; i < 2 * NP; i += NGT) { const bool second = i >= NP; const size_t j = second ? i - NP : i; const float* src = (second ? a->peer_v : a->peer_u) + j * 8;
        const f32x4 x0 = *(const f32x4*)src, x1 = *(const f32x4*)(src + 4); u32x4 o; o.x = cvtpk(x0[0], x0[1]); o.y = cvtpk(x0[2], x0[3]); o.z = cvtpk(x1[0], x1[1]); o.w = cvtpk(x1[2], x1[3]);
        (second ? Vd : Ud)[j] = o; }
}
constexpr size_t WS_PART = 336 * MiB;
constexpr size_t WS_COEF = 105 * MiB;
constexpr int Q_U = 8192, Q_V = 8192 + 1024;
constexpr size_t MISC_SS2 = 131072;
constexpr size_t WS_X1B = 185 * MiB, WS_PO = 249 * MiB;

__device__ __forceinline__ void convert_uv_sliced(ArgsP a, const int tidx) {
    const int lane = tidx & 63, w = tidx >> 6; const int gw = blockIdx.x * NWAVES + w, NGW = gridDim.x * NWAVES;
    bf16* Us = (bf16*)(a->ws + WS_U); bf16* Vs = (bf16*)(a->ws + WS_V2);
    for (int row = gw; row < 32768; row += NGW) { const bool second = row >= 16384; const int e = row & 16383; const f32x4* src = (const f32x4*)((second ? a->peer_v : a->peer_u) + (size_t)e * DM) + lane; bf16* dst = second ? Vs : Us;
        f32x4 x[8];
#pragma unroll
        for (int j = 0; j < 8; ++j) x[j] = src[64 * j];
#pragma unroll
        for (int j = 0; j < 8; ++j) { const int s = 4 * j + (lane >> 4); u32x2 o; o.x = cvtpk(x[j][0], x[j][1]); o.y = cvtpk(x[j][2], x[j][3]);
            *(u32x2*)(dst + ((size_t)s * 16384 + e) * 64 + 4 * (lane & 15)) = o; } }
}
__device__ __forceinline__ void peer_stage_idx(const int* IDX, int tok0, LAS unsigned char* lds, int tid) {
#pragma unroll
    for (int i = 0; i < 8; ++i) { const int q = tid + 512 * i; const u32x4 v = *(const u32x4*)(IDX + (size_t)tok0 * 128 + 4 * q);
        *(LAS u32x2*)(lds + 8 * q) = (u32x2){v.x | (v.y << 16), v.z | (v.w << 16)}; }
}
__device__ __forceinline__ void peer_u_phase(ArgsP a, LAS unsigned char* lds, const int tidx, const int qoff = 0) {
    const int w = __builtin_amdgcn_readfirstlane(tidx >> 6); const int myx = (int)(xb_xcc_id() & 7u); int probe = 0;
    unsigned* heads = (unsigned*)(a->ws + WS_CTL) + Q_U + qoff; volatile LAS int* bc = (volatile LAS int*)(lds + 98304);
    const bf16* HN = (const bf16*)(a->ws + WS_HN); const bf16* Us = (const bf16*)(a->ws + WS_U); const int* IDX = (const int*)(a->ws + WS_IDX); bf16* PART = (bf16*)(a->ws + WS_PART);
    for (;;) {
        const int tid = opaque(tidx), lane = tid & 63, m = lane & 7, g = lane >> 3;
        const int item = peer_next_item(heads, myx, probe, 512u, bc, tid); if (item < 0) break;
        const int s = item >> 7, tile = item & 127, tok0 = tile * 128;
        peer_stage_idx(IDX, tok0, lds, tid);
        __syncthreads();
        const bf16* ub = Us + (size_t)s * 16384 * 64 + 8 * m;
        for (int tt = 0; tt < 16; ++tt) { const int tl = 16 * w + tt, t = tok0 + tl;
            const u32x4 hv = *(const u32x4*)(HN + (size_t)t * DM + 64 * s + 8 * m);
            u32x4 uv[16];
#pragma unroll
            for (int r = 0; r < 16; ++r) { const unsigned id = *(const LAS unsigned short*)(lds + (tl * 128 + 16 * g + r) * 2); uv[r] = *(const u32x4*)(ub + (size_t)id * 64); }
            float p[16];
#pragma unroll
            for (int r = 0; r < 16; ++r) { float d = dot2bf(uv[r].x, hv.x, 0.f); d = dot2bf(uv[r].y, hv.y, d); d = dot2bf(uv[r].z, hv.z, d); d = dot2bf(uv[r].w, hv.w, d); p[r] = d; }
            float q8[8], q4[4], q2[2];
#pragma unroll
            for (int r = 0; r < 8; ++r) { const bool up = (lane & 4) != 0; const float snd = up ? p[r] : p[r + 8], kp = up ? p[r + 8] : p[r]; q8[r] = kp + __shfl_xor(snd, 4); }
#pragma unroll
            for (int r = 0; r < 4; ++r) { const bool up = (lane & 2) != 0; const float snd = up ? q8[r] : q8[r + 4], kp = up ? q8[r + 4] : q8[r]; q4[r] = kp + __shfl_xor(snd, 2); }
#pragma unroll
            for (int r = 0; r < 2; ++r) { const bool up = (lane & 1) != 0; const float snd = up ? q4[r] : q4[r + 2], kp = up ? q4[r + 2] : q4[r]; q2[r] = kp + __shfl_xor(snd, 1); }
            *(unsigned*)(PART + ((size_t)s * M + t) * 128 + 2 * lane) = cvtpk(q2[0], q2[1]);
        }
        __syncthreads();
    }
}
__device__ __forceinline__ void peer_combine(ArgsP a, const int tidx) {
    const size_t gt = (size_t)blockIdx.x * NTHR + tidx, NGT = (size_t)gridDim.x * NTHR;
    const unsigned* PART = (const unsigned*)(a->ws + WS_PART); const float* GW = (const float*)(a->ws + WS_GW); const float* SUMSQ = (const float*)(a->ws + WS_MISC + MISC_SUMSQ); f32x2* C = (f32x2*)(a->ws + WS_COEF);
    for (size_t i = gt; i < (size_t)M * 64; i += NGT) { const int t = (int)(i >> 6); float s0 = 0.f, s1 = 0.f;
#pragma unroll 8
        for (int s = 0; s < 32; ++s) { const unsigned v = PART[(size_t)s * M * 64 + i]; s0 += bflo(v); s1 += bfhi(v); }
        const float rstd2 = 1.f / sqrtf(SUMSQ[t] * (1.f / DM) + EPS); const f32x2 g = ((const f32x2*)GW)[i];
        const float a0 = s0 * rstd2, a1 = s1 * rstd2;
        C[i] = (f32x2){g.x * 0.5f * a0 * (1.f + erff(a0 * 0.70710678118654752f)), g.y * 0.5f * a1 * (1.f + erff(a1 * 0.70710678118654752f))}; }
}
template <bool DRY> __device__ __forceinline__ void peer_v_phase(ArgsP a, LAS unsigned char* lds, const int tidx, const int qoff = 0) {
    const int w = __builtin_amdgcn_readfirstlane(tidx >> 6); const int myx = (int)(xb_xcc_id() & 7u); int probe = 0;
    unsigned* heads = (unsigned*)(a->ws + WS_CTL) + Q_V + qoff; volatile LAS int* bc = (volatile LAS int*)(lds + 98304);
    const bf16* Vs = (const bf16*)(a->ws + WS_V2); const int* IDX = (const int*)(a->ws + WS_IDX); const float* COEF = (const float*)(a->ws + WS_COEF); float* SS2 = (float*)(a->ws + WS_MISC + MISC_SS2);
    for (;;) {
        const int tid = opaque(tidx), lane = tid & 63, m = lane & 7, g = lane >> 3;
        const int item = peer_next_item(heads, myx, probe, 512u, bc, tid); if (item < 0) break;
        const int s = item >> 7, tile = item & 127, tok0 = tile * 128;
        peer_stage_idx(IDX, tok0, lds, tid);
#pragma unroll
        for (int i = 0; i < 8; ++i) { const int q = tid + 512 * i; *(LAS u32x4*)(lds + 32768 + 16 * q) = *(const u32x4*)(COEF + (size_t)tok0 * 128 + 4 * q); }
        __syncthreads();
        const bf16* vb = Vs + (size_t)s * 16384 * 64 + 8 * m;
        for (int tt = 0; tt < 16; ++tt) { const int tl = 16 * w + tt, t = tok0 + tl;
            u32x4 vv[16]; float cf[16];
#pragma unroll
            for (int r = 0; r < 16; ++r) { const unsigned id = *(const LAS unsigned short*)(lds + (tl * 128 + 16 * g + r) * 2); vv[r] = *(const u32x4*)(vb + (size_t)id * 64); cf[r] = *(const LAS float*)(lds + 32768 + (tl * 128 + 16 * g + r) * 4); }
            float acc[8];
#pragma unroll
            for (int j = 0; j < 8; ++j) acc[j] = 0.f;
#pragma unroll
            for (int r = 0; r < 16; ++r) { acc[0] += cf[r] * bflo(vv[r].x); acc[1] += cf[r] * bfhi(vv[r].x); acc[2] += cf[r] * bflo(vv[r].y); acc[3] += cf[r] * bfhi(vv[r].y);
                acc[4] += cf[r] * bflo(vv[r].z); acc[5] += cf[r] * bfhi(vv[r].z); acc[6] += cf[r] * bflo(vv[r].w); acc[7] += cf[r] * bfhi(vv[r].w); }
            float q4[4], q2[2];
#pragma unroll
            for (int j = 0; j < 4; ++j) { const bool up = (lane & 32) != 0; const float snd = up ? acc[j] : acc[j + 4], kp = up ? acc[j + 4] : acc[j]; q4[j] = kp + __shfl_xor(snd, 32); }
#pragma unroll
            for (int j = 0; j < 2; ++j) { const bool up = (lane & 16) != 0; const float snd = up ? q4[j] : q4[j + 2], kp = up ? q4[j + 2] : q4[j]; q2[j] = kp + __shfl_xor(snd, 16); }
            float r1; { const bool up = (lane & 8) != 0; const float snd = up ? q2[0] : q2[1], kp = up ? q2[1] : q2[0]; r1 = kp + __shfl_xor(snd, 8); }
            float* op = a->out + (size_t)t * DM + 64 * s + 8 * m + g;
            const float x1v = *op; const float x2 = x1v + r1; *op = DRY ? (x2 == 12345.678f ? x2 : x1v) : x2;
            const float ss = wave_sum(x2 * x2);
            if (lane == 0 && !DRY) atomicAdd(SS2 + t, ss);
        }
        __syncthreads();
    }
}
template <bool DRY> __device__ __forceinline__ void peer_final(ArgsP a, const int tidx) {
    const int lane = tidx & 63, w = tidx >> 6; const int gwv = blockIdx.x * NWAVES + w, NGW = gridDim.x * NWAVES; const float* SS2 = (const float*)(a->ws + WS_MISC + MISC_SS2);
    for (int tok = gwv; tok < M; tok += NGW) { const float rstd = 1.f / sqrtf(SS2[tok] * (1.f / DM) + EPS); f32x4* orow = (f32x4*)(a->out + (size_t)tok * DM) + lane; const f32x4* wr = (const f32x4*)a->lnf_w + lane;
#pragma unroll
        for (int j = 0; j < 8; ++j) { f32x4 v = orow[64 * j]; const f32x4 o = v * rstd * wr[64 * j]; orow[64 * j] = DRY ? (o[0] == 12345.678f ? o : v) : o; } }
}
__device__ __forceinline__ void peer_final8(ArgsP a, const int tidx) {
    const int lane = tidx & 63, w = tidx >> 6; const int gwv = blockIdx.x * NWAVES + w, NGW = gridDim.x * NWAVES;
    const bf16* X1B = (const bf16*)(a->ws + WS_X1B); const bf16* PO = (const bf16*)(a->ws + WS_PO);
    for (int tok = gwv; tok < M; tok += NGW) {
        u32x4 xv[4], pv[4];
#pragma unroll
        for (int i = 0; i < 4; ++i) { xv[i] = *(const u32x4*)(X1B + (size_t)tok * DM + 8 * lane + 512 * i); pv[i] = *(const u32x4*)(PO + (size_t)tok * DM + 8 * lane + 512 * i); }
        float v[32]; float ss = 0.f;
#pragma unroll
        for (int i = 0; i < 4; ++i) { v[8 * i + 0] = bflo(xv[i].x) + bflo(pv[i].x); v[8 * i + 1] = bfhi(xv[i].x) + bfhi(pv[i].x); v[8 * i + 2] = bflo(xv[i].y) + bflo(pv[i].y); v[8 * i + 3] = bfhi(xv[i].y) + bfhi(pv[i].y);
            v[8 * i + 4] = bflo(xv[i].z) + bflo(pv[i].z); v[8 * i + 5] = bfhi(xv[i].z) + bfhi(pv[i].z); v[8 * i + 6] = bflo(xv[i].w) + bflo(pv[i].w); v[8 * i + 7] = bfhi(xv[i].w) + bfhi(pv[i].w); }
#pragma unroll
        for (int i = 0; i < 32; ++i) ss += v[i] * v[i];
        const float rstd = 1.f / sqrtf(wave_sum(ss) * (1.f / DM) + EPS);
        float* orow = a->out + (size_t)tok * DM + 8 * lane;
#pragma unroll
        for (int i = 0; i < 4; ++i) { const f32x4 w0 = *(const f32x4*)(a->lnf_w + 8 * lane + 512 * i), w1 = *(const f32x4*)(a->lnf_w + 8 * lane + 512 * i + 4); f32x4 o0, o1;
#pragma unroll
            for (int j = 0; j < 4; ++j) { o0[j] = v[8 * i + j] * rstd * w0[j]; o1[j] = v[8 * i + 4 + j] * rstd * w1[j]; }
            *(f32x4*)(orow + 512 * i) = o0; *(f32x4*)(orow + 512 * i + 4) = o1; }
    }
}
__device__ __forceinline__ f32x2 fp8lo(unsigned w) { return __builtin_amdgcn_cvt_pk_f32_fp8((int)w, false); }
__device__ __forceinline__ f32x2 fp8hi(unsigned w) { return __builtin_amdgcn_cvt_pk_f32_fp8((int)w, true); }
__device__ __forceinline__ int peer_pop_t0(unsigned* heads, const int myx, int& probe, const unsigned nper) {
    while (probe < 8) { const int q = (myx + probe) & 7; const unsigned v = __hip_atomic_fetch_add(&heads[64 * q], 1u, __ATOMIC_RELAXED, __HIP_MEMORY_SCOPE_AGENT); if (v < nper) return q * (int)nper + (int)v; ++probe; }
    return -1;
}
__device__ __forceinline__ void peer_u_phase8(ArgsP a, LAS unsigned char* lds, const int tidx, const int qoff = 0) {
    const int w = __builtin_amdgcn_readfirstlane(tidx >> 6); const int myx = (int)(xb_xcc_id() & 7u); int probe = 0;
    unsigned* heads = (unsigned*)(a->ws + WS_CTL) + Q_U + qoff; volatile LAS int* bc = (volatile LAS int*)(lds + 98304);
    const bf16* HN = (const bf16*)(a->ws + WS_HN); const unsigned char* U8 = (const unsigned char*)(a->ws + WS_U8); const int* IDX = (const int*)(a->ws + WS_IDX); bf16* PART = (bf16*)(a->ws + WS_PART);
    if (tidx == 0) bc[0] = peer_pop_t0(heads, myx, probe, 256u);
    __syncthreads();
    int item = bc[0], par = 1;
    u32x4 pre[8];
    if (item >= 0) {
#pragma unroll
        for (int i = 0; i < 8; ++i) pre[i] = *(const u32x4*)(IDX + (size_t)(item & 127) * 128 * 128 + 4 * (tidx + 512 * i)); }
    while (item >= 0) {
        const int tid = opaque(tidx), lane = tid & 63, m = lane & 7, g = lane >> 3;
        const int s = item >> 7, tile = item & 127, tok0 = tile * 128;
#pragma unroll
        for (int i = 0; i < 8; ++i) { const int q = tid + 512 * i; *(LAS u32x2*)(lds + 8 * q) = (u32x2){pre[i].x | (pre[i].y << 16), pre[i].z | (pre[i].w << 16)}; }
        __syncthreads();
        if (tid == 0) bc[par] = peer_pop_t0(heads, myx, probe, 256u);
        const unsigned char* ub = U8 + (size_t)s * 16384 * 128 + 16 * m;
#define PU_ISSUE(UV, H0, H1, TT) do { const int tl_ = 16 * w + (TT); \
            const u32x4 idA_ = *(const LAS u32x4*)(lds + (tl_ * 128 + 16 * g) * 2), idB_ = *(const LAS u32x4*)(lds + (tl_ * 128 + 16 * g) * 2 + 16); \
            const unsigned idw_[8] = {idA_.x, idA_.y, idA_.z, idA_.w, idB_.x, idB_.y, idB_.z, idB_.w}; \
            _Pragma("unroll") for (int r = 0; r < 16; ++r) { const unsigned id = (r & 1) ? (idw_[r >> 1] >> 16) : (idw_[r >> 1] & 0xffffu); UV[r] = *(const u32x4*)(ub + (size_t)id * 128); } \
            H0 = *(const u32x4*)(HN + (size_t)(tok0 + tl_) * DM + 128 * s + 16 * m); H1 = *(const u32x4*)(HN + (size_t)(tok0 + tl_) * DM + 128 * s + 16 * m + 8); } while (0)
#define PU_REDUCE(UV, H0, H1, TT) do { const int t_ = tok0 + 16 * w + (TT); f32x2 hf[8]; \
            hf[0] = (f32x2){bflo(H0.x), bfhi(H0.x)}; hf[1] = (f32x2){bflo(H0.y), bfhi(H0.y)}; hf[2] = (f32x2){bflo(H0.z), bfhi(H0.z)}; hf[3] = (f32x2){bflo(H0.w), bfhi(H0.w)}; \
            hf[4] = (f32x2){bflo(H1.x), bfhi(H1.x)}; hf[5] = (f32x2){bflo(H1.y), bfhi(H1.y)}; hf[6] = (f32x2){bflo(H1.z), bfhi(H1.z)}; hf[7] = (f32x2){bflo(H1.w), bfhi(H1.w)}; \
            float p[16]; \
            _Pragma("unroll") for (int r = 0; r < 16; ++r) { f32x2 ac = fp8lo(UV[r].x) * hf[0]; ac += fp8hi(UV[r].x) * hf[1]; ac += fp8lo(UV[r].y) * hf[2]; ac += fp8hi(UV[r].y) * hf[3]; \
                ac += fp8lo(UV[r].z) * hf[4]; ac += fp8hi(UV[r].z) * hf[5]; ac += fp8lo(UV[r].w) * hf[6]; ac += fp8hi(UV[r].w) * hf[7]; p[r] = ac.x + ac.y; } \
            float q8[8], q4[4], q2[2]; \
            _Pragma("unroll") for (int r = 0; r < 8; ++r) { const bool up = (lane & 4) != 0; const float snd = up ? p[r] : p[r + 8], kp = up ? p[r + 8] : p[r]; q8[r] = kp + __shfl_xor(snd, 4); } \
            _Pragma("unroll") for (int r = 0; r < 4; ++r) { const bool up = (lane & 2) != 0; const float snd = up ? q8[r] : q8[r + 4], kp = up ? q8[r + 4] : q8[r]; q4[r] = kp + __shfl_xor(snd, 2); } \
            _Pragma("unroll") for (int r = 0; r < 2; ++r) { const bool up = (lane & 1) != 0; const float snd = up ? q4[r] : q4[r + 2], kp = up ? q4[r + 2] : q4[r]; q2[r] = kp + __shfl_xor(snd, 1); } \
            *(unsigned*)(PART + ((size_t)s * M + t_) * 128 + 2 * lane) = cvtpk(q2[0], q2[1]); } while (0)
        u32x4 uvA[16], uvB[16], hA0, hA1, hB0, hB1;
        for (int tt = 0; tt < 8; ++tt) { PU_ISSUE(uvA, hA0, hA1, tt); PU_REDUCE(uvA, hA0, hA1, tt); }
        __syncthreads();
        const int nxt = bc[par];
        if (nxt >= 0) {
#pragma unroll
            for (int i = 0; i < 8; ++i) pre[i] = *(const u32x4*)(IDX + (size_t)(nxt & 127) * 128 * 128 + 4 * (tid + 512 * i)); }
        for (int tt = 8; tt < 16; ++tt) { PU_ISSUE(uvA, hA0, hA1, tt); PU_REDUCE(uvA, hA0, hA1, tt); }
        (void)uvB; (void)hB0; (void)hB1;
#undef PU_ISSUE
#undef PU_REDUCE
        __syncthreads();
        item = nxt; par ^= 1;
    }
}
__device__ __forceinline__ void peer_combine8(ArgsP a, const int tidx) {
    const size_t gt = (size_t)blockIdx.x * NTHR + tidx, NGT = (size_t)gridDim.x * NTHR;
    const unsigned* PART = (const unsigned*)(a->ws + WS_PART); const float* GW = (const float*)(a->ws + WS_GW); const float* SUMSQ = (const float*)(a->ws + WS_MISC + MISC_SUMSQ); f32x2* C = (f32x2*)(a->ws + WS_COEF);
    const float* USC = (const float*)(a->ws + WS_USC); const float* VSC = (const float*)(a->ws + WS_VSC); const int* IDX = (const int*)(a->ws + WS_IDX);
    for (size_t i = gt; i < (size_t)M * 64; i += NGT) { const int t = (int)(i >> 6); float s0 = 0.f, s1 = 0.f;
#pragma unroll 8
        for (int s = 0; s < 16; ++s) { const unsigned v = PART[(size_t)s * M * 64 + i]; s0 += bflo(v); s1 += bfhi(v); }
        const int id0 = IDX[2 * i], id1 = IDX[2 * i + 1];
        const float rstd2 = 1.f / sqrtf(SUMSQ[t] * (1.f / DM) + EPS); const f32x2 g = ((const f32x2*)GW)[i];
        const float a0 = s0 * rstd2 * USC[id0], a1 = s1 * rstd2 * USC[id1];
        C[i] = (f32x2){g.x * 0.5f * a0 * (1.f + erff(a0 * 0.70710678118654752f)) * VSC[id0], g.y * 0.5f * a1 * (1.f + erff(a1 * 0.70710678118654752f)) * VSC[id1]}; }
}
template <bool DRY> __device__ __forceinline__ void peer_v_phase8(ArgsP a, LAS unsigned char* lds, const int tidx, const int qoff = 0) {
    const int w = __builtin_amdgcn_readfirstlane(tidx >> 6); const int myx = (int)(xb_xcc_id() & 7u); int probe = 0;
    unsigned* heads = (unsigned*)(a->ws + WS_CTL) + Q_V + qoff; volatile LAS int* bc = (volatile LAS int*)(lds + 98304);
    const unsigned char* V8 = (const unsigned char*)(a->ws + WS_V8); const int* IDX = (const int*)(a->ws + WS_IDX); const float* COEF = (const float*)(a->ws + WS_COEF); bf16* PO = (bf16*)(a->ws + WS_PO);
    if (tidx == 0) bc[0] = peer_pop_t0(heads, myx, probe, 256u);
    __syncthreads();
    int item = bc[0], par = 1;
    u32x4 pre[8], prc[8];
    if (item >= 0) {
#pragma unroll
        for (int i = 0; i < 8; ++i) { pre[i] = *(const u32x4*)(IDX + (size_t)(item & 127) * 128 * 128 + 4 * (tidx + 512 * i)); prc[i] = *(const u32x4*)(COEF + (size_t)(item & 127) * 128 * 128 + 4 * (tidx + 512 * i)); } }
    while (item >= 0) {
        const int tid = opaque(tidx), lane = tid & 63, m = lane & 7, g = lane >> 3;
        const int s = item >> 7, tile = item & 127, tok0 = tile * 128;
#pragma unroll
        for (int i = 0; i < 8; ++i) { const int q = tid + 512 * i; *(LAS u32x2*)(lds + 8 * q) = (u32x2){pre[i].x | (pre[i].y << 16), pre[i].z | (pre[i].w << 16)}; *(LAS u32x4*)(lds + 32768 + 16 * q) = prc[i]; }
        __syncthreads();
        if (tid == 0) bc[par] = peer_pop_t0(heads, myx, probe, 256u);
        const unsigned char* vb = V8 + (size_t)s * 16384 * 128 + 16 * m;
#define PV_ISSUE(VV, X1, TT) do { const int tl_ = 16 * w + (TT); \
            const u32x4 idA_ = *(const LAS u32x4*)(lds + (tl_ * 128 + 16 * g) * 2), idB_ = *(const LAS u32x4*)(lds + (tl_ * 128 + 16 * g) * 2 + 16); \
            const unsigned idw_[8] = {idA_.x, idA_.y, idA_.z, idA_.w, idB_.x, idB_.y, idB_.z, idB_.w}; \
            _Pragma("unroll") for (int r = 0; r < 16; ++r) { const unsigned id = (r & 1) ? (idw_[r >> 1] >> 16) : (idw_[r >> 1] & 0xffffu); VV[r] = *(const u32x4*)(vb + (size_t)id * 128); } \
            X1 = (f32x2){0.f, 0.f}; } while (0)
#define PV_REDUCE(VV, X1, TT) do { const int tl_ = 16 * w + (TT), t_ = tok0 + tl_; f32x4 cfv[4]; \
            _Pragma("unroll") for (int i = 0; i < 4; ++i) cfv[i] = *(const LAS f32x4*)(lds + 32768 + (tl_ * 128 + 16 * g + 4 * i) * 4); \
            f32x2 acc[8]; \
            _Pragma("unroll") for (int j = 0; j < 8; ++j) acc[j] = (f32x2){0.f, 0.f}; \
            _Pragma("unroll") for (int r = 0; r < 16; ++r) { const float cf = cfv[r >> 2][r & 3]; const f32x2 c2 = {cf, cf}; \
                acc[0] += c2 * fp8lo(VV[r].x); acc[1] += c2 * fp8hi(VV[r].x); acc[2] += c2 * fp8lo(VV[r].y); acc[3] += c2 * fp8hi(VV[r].y); \
                acc[4] += c2 * fp8lo(VV[r].z); acc[5] += c2 * fp8hi(VV[r].z); acc[6] += c2 * fp8lo(VV[r].w); acc[7] += c2 * fp8hi(VV[r].w); } \
            f32x2 q4[4], q2[2], q1; \
            _Pragma("unroll") for (int j = 0; j < 4; ++j) { const bool up = (lane & 32) != 0; const f32x2 snd = up ? acc[j] : acc[j + 4], kp = up ? acc[j + 4] : acc[j]; q4[j] = kp + (f32x2){__shfl_xor(snd.x, 32), __shfl_xor(snd.y, 32)}; } \
            _Pragma("unroll") for (int j = 0; j < 2; ++j) { const bool up = (lane & 16) != 0; const f32x2 snd = up ? q4[j] : q4[j + 2], kp = up ? q4[j + 2] : q4[j]; q2[j] = kp + (f32x2){__shfl_xor(snd.x, 16), __shfl_xor(snd.y, 16)}; } \
            { const bool up = (lane & 8) != 0; const f32x2 snd = up ? q2[0] : q2[1], kp = up ? q2[1] : q2[0]; q1 = kp + (f32x2){__shfl_xor(snd.x, 8), __shfl_xor(snd.y, 8)}; } \
            if (!DRY) *(unsigned*)(PO + (size_t)t_ * DM + 128 * s + 16 * m + 2 * g) = cvtpk(q1.x + X1.x, q1.y + X1.y); } while (0)
        u32x4 vvA[16], vvB[16]; f32x2 xA, xB;
        for (int tt = 0; tt < 8; ++tt) { PV_ISSUE(vvA, xA, tt); PV_REDUCE(vvA, xA, tt); }
        __syncthreads();
        const int nxt = bc[par];
        if (nxt >= 0) {
#pragma unroll
            for (int i = 0; i < 8; ++i) { pre[i] = *(const u32x4*)(IDX + (size_t)(nxt & 127) * 128 * 128 + 4 * (tid + 512 * i)); prc[i] = *(const u32x4*)(COEF + (size_t)(nxt & 127) * 128 * 128 + 4 * (tid + 512 * i)); } }
        for (int tt = 8; tt < 16; ++tt) { PV_ISSUE(vvA, xA, tt); PV_REDUCE(vvA, xA, tt); }
        (void)vvB; (void)xB;
#undef PV_ISSUE
#undef PV_REDUCE
        __syncthreads();
        item = nxt; par ^= 1;
    }
}
#if SELFCHECK
constexpr size_t WS_YDBG = 464 * MiB;
constexpr size_t WS_XSAVE = 500 * MiB;
__device__ __forceinline__ float bfr(float v) { return bf2f(f2bf(v)); }
__device__ __forceinline__ void chk_report(ArgsP a, int k, float err) { if (!(err == err)) err = 1e30f; atomicMax((int*)(a->ws + WS_MISC + MISC_CHK) + k, __float_as_int(err)); }
__device__ const int CHK_ROWS[8] = {0, 1, 255, 256, 7777, 12345, 16128, 16383};
__device__ const int CHK_TOK[8] = {0, 1, 63, 127, 128, 129, 8191, 16383};
__device__ __forceinline__ float geluf(float x) { return 0.5f * x * (1.f + erff(x * 0.70710678118654752f)); }
__device__ __forceinline__ void chk1(ArgsP a, const int tidx) {
    const int gt = blockIdx.x * NTHR + tidx, NGT = gridDim.x * NTHR;
    const bf16 *Z = (const bf16*)(a->ws + WS_Z), *XBC = (const bf16*)(a->ws + WS_XBC), *Q = (const bf16*)(a->ws + WS_Q), *K = (const bf16*)(a->ws + WS_K), *V = (const bf16*)(a->ws + WS_V); const float* DTF = (const float*)(a->ws + WS_DTF);
    for (int it = gt; it < 8 * 5664; it += NGT) { const int t = CHK_ROWS[it / 5664], j = it % 5664; const float* xr = a->x + (size_t)t * DM;
        float ss = 0.f; for (int k = 0; k < DM; ++k) ss += xr[k] * xr[k]; const float rstd = 1.f / sqrtf(ss / DM + EPS);
        float ref = 0.f; for (int k = 0; k < DM; ++k) ref += bfr(xr[k] * rstd * a->ln1_w[k]) * bfr(a->w_in[(size_t)k * 5664 + j]);
        float got;
        if (j < 1024) got = bf2f(Z[(size_t)t * 1024 + j]); else if (j < 2560) got = bf2f(XBC[(size_t)t * 1536 + j - 1024]); else if (j < 2576) got = DTF[(size_t)t * 32 + j - 2560];
        else if (j < 3600) got = bf2f(Q[(size_t)t * 1024 + j - 2576]) / QSCALE; else if (j < 4624) got = bf2f(K[(size_t)t * 1024 + j - 3600]); else if (j < 5648) got = bf2f(V[(size_t)t * 1024 + j - 4624]);
        else got = DTF[(size_t)t * 32 + 16 + j - 5648];
        chk_report(a, 1, fabsf(got - ref)); }
}
__device__ __forceinline__ void chk2(ArgsP a, const int tidx) {
    const int gt = blockIdx.x * NTHR + tidx, NGT = gridDim.x * NTHR;
    const bf16 *XBC = (const bf16*)(a->ws + WS_XBC), *XS = (const bf16*)(a->ws + WS_XS), *BC = (const bf16*)(a->ws + WS_BC); const float *DTF = (const float*)(a->ws + WS_DTF), *DT = (const float*)(a->ws + WS_DT), *ACUM = (const float*)(a->ws + WS_ACUM);
    for (int it = gt; it < 64 * 1536; it += NGT) { const int si = it / 1536, ch = it % 1536; const int t = si < 8 ? si : (si < 16 ? 60 + (si - 8) : (int)(((unsigned)si * 2654435761u) % M));
        float acc = a->conv_b[ch]; for (int j = 0; j < 4; ++j) { const int tt = t - 3 + j; if (tt >= 0) acc += a->conv_w[j * 1536 + ch] * bf2f(XBC[(size_t)tt * 1536 + ch]); }
        const float ref = siluf(acc); const float got = ch < 1024 ? bf2f(XS[(size_t)t * 1024 + ch]) : bf2f(BC[(size_t)t * 512 + ch - 1024]);
        chk_report(a, 2, fabsf(got - ref));
        if (ch < 16) { const int h = ch; const float A = -__expf(a->a_log[h]); float ac = 0.f, dtl = 0.f; for (int tt = (t / 64) * 64; tt <= t; ++tt) { dtl = softplusf(DTF[(size_t)tt * 32 + h] + a->dt_bias[h]); ac += dtl * A; }
            chk_report(a, 2, fabsf(DT[(size_t)t * 16 + h] - dtl) * 10.f); chk_report(a, 2, fabsf(ACUM[(size_t)t * 16 + h] - ac)); } }
}
__device__ __forceinline__ void chk3(ArgsP a, const int tidx) {
    const int gt = blockIdx.x * NTHR + tidx, NGT = gridDim.x * NTHR;
    const bf16 *XS = (const bf16*)(a->ws + WS_XS), *BC = (const bf16*)(a->ws + WS_BC), *SL = (const bf16*)(a->ws + WS_SLOC); const float *DT = (const float*)(a->ws + WS_DT), *ACUM = (const float*)(a->ws + WS_ACUM);
    for (int it = gt; it < 8192; it += NGT) { const unsigned hsh = (unsigned)it * 2654435761u; const int c = it < 2048 ? (it & 1) * 255 : (hsh >> 8) & 255, h = (hsh >> 16) & 15, p = (hsh >> 20) & 63, n = (hsh >> 26) & 63 | ((it & 1) << 6), g = h >> 3;
        const float al = ACUM[(size_t)(c * 64 + 63) * 16 + h]; float ref = 0.f;
        for (int sx = 0; sx < 64; ++sx) { const int t = c * 64 + sx; ref += bf2f(BC[(size_t)t * 512 + 128 * g + n]) * bfr(bf2f(XS[(size_t)t * 1024 + 64 * h + p]) * DT[(size_t)t * 16 + h] * __expf(al - ACUM[(size_t)t * 16 + h])); }
        const float got = bf2f(SL[((size_t)(c * 16 + h) * 64 + p) * 128 + n]);
        chk_report(a, 3, fabsf(got - ref) / fmaxf(fabsf(ref), 0.05f)); }
}
__device__ __forceinline__ void chk13(ArgsP a, const int tidx) {
    const int gt = blockIdx.x * NTHR + tidx, NGT = gridDim.x * NTHR;
    const bf16 *XS = (const bf16*)(a->ws + WS_XS), *BC = (const bf16*)(a->ws + WS_BC), *SL = (const bf16*)(a->ws + WS_SLOC); const float *DT = (const float*)(a->ws + WS_DT), *ACUM = (const float*)(a->ws + WS_ACUM);
    for (int it = gt; it < 4096; it += NGT) { const unsigned hsh = (unsigned)it * 2654435761u; const int h = (hsh >> 16) & 15, p = (hsh >> 20) & 63, n = (hsh >> 26) & 63 | ((it & 1) << 6), g = h >> 3;
        float st = 0.f, num = 0.f, den = 1e-12f;
        for (int c = 0; c < NCHUNK; ++c) { const float got = bf2f(SL[((size_t)(c * 16 + h) * 64 + p) * 128 + n]); num += (got - st) * (got - st); den += st * st;
            const float al = ACUM[(size_t)(c * 64 + 63) * 16 + h]; float sl = 0.f;
            for (int sx = 0; sx < 64; ++sx) { const int t = c * 64 + sx; sl += bf2f(BC[(size_t)t * 512 + 128 * g + n]) * bf2f(XS[(size_t)t * 1024 + 64 * h + p]) * DT[(size_t)t * 16 + h] * __expf(al - ACUM[(size_t)t * 16 + h]); }
            st = st * __expf(al) + sl; }
        chk_report(a, 13, sqrtf(num / den)); }
}
__device__ __forceinline__ void chk4(ArgsP a, const int tidx) {
    const int lane = tidx & 63, gw = blockIdx.x * NWAVES + (tidx >> 6);
    const bf16 *XS = (const bf16*)(a->ws + WS_XS), *BC = (const bf16*)(a->ws + WS_BC); const float *DT = (const float*)(a->ws + WS_DT); const float* Y = (const float*)(a->ws + WS_YDBG);
    if (gw >= 32) return;
    const int h = (gw * 5 + 3) & 15, p = (gw * 23 + 7) & 63, g = h >> 3; const float A = -__expf(a->a_log[h]);
    float s0 = 0.f, s1 = 0.f, emax = 0.f, emax0 = 0.f, num = 0.f, den = 1e-12f;
    for (int t = 0; t < 8192; ++t) { const float dt = DT[(size_t)t * 16 + h], x = bf2f(XS[(size_t)t * 1024 + 64 * h + p]), dA = __expf(dt * A);
        const float b0 = bf2f(BC[(size_t)t * 512 + 128 * g + lane]), b1 = bf2f(BC[(size_t)t * 512 + 128 * g + 64 + lane]), c0 = bf2f(BC[(size_t)t * 512 + 256 + 128 * g + lane]), c1 = bf2f(BC[(size_t)t * 512 + 256 + 128 * g + 64 + lane]);
        s0 = s0 * dA + dt * b0 * x; s1 = s1 * dA + dt * b1 * x;
        const float y = wave_sum(c0 * s0 + c1 * s1); const float got = Y[(size_t)t * 1024 + 64 * h + p];
        float e = fabsf(got - y) / fmaxf(fabsf(y), 0.25f); if (!(got == got)) e = 1e30f; if (t < 64) emax0 = fmaxf(emax0, e); else { num += (got - y) * (got - y); den += y * y; } }
    emax = sqrtf(num / den);
    if (lane == 0) { chk_report(a, 12, emax0); chk_report(a, 4, emax); }
}
__device__ __forceinline__ void chk567(ArgsP a, const int tidx) {
    const int lane = tidx & 63, gw = blockIdx.x * NWAVES + (tidx >> 6);
    const bf16 *XS = (const bf16*)(a->ws + WS_XS), *Zb = (const bf16*)(a->ws + WS_Z), *MIX = (const bf16*)(a->ws + WS_MIX); const float* Y = (const float*)(a->ws + WS_YDBG);
    if (gw >= 64 && gw < 128) { const int si = gw - 64, g = si & 1, t = (si >> 1) < 4 ? (si >> 1) * 63 : (int)(((unsigned)si * 2654435761u) % 8192);
        float v[8]; float ss = 0.f;
#pragma unroll
        for (int i = 0; i < 8; ++i) { const int ch = 512 * g + lane + 64 * i; const float y = (Y[(size_t)t * 1024 + ch] + a->d_skip[ch >> 6] * bf2f(XS[(size_t)t * 1024 + ch])) * siluf(bf2f(Zb[(size_t)t * 1024 + ch])); v[i] = y; ss += y * y; }
        const float rstd = 1.f / sqrtf(wave_sum(ss) / 512.f + EPS); float e = 0.f;
#pragma unroll
        for (int i = 0; i < 8; ++i) { const int ch = 512 * g + lane + 64 * i; const float rf = v[i] * rstd * a->ssd_norm_w[ch]; e = fmaxf(e, fabsf(bf2f(MIX[(size_t)t * DM + ch]) - rf) / fmaxf(1.f, fabsf(rf))); }
        chk_report(a, 5, e); }
    if (gw >= 128 && gw < 144 && lane == 0) { const int h = gw - 128; const float* DTF = (const float*)(a->ws + WS_DTF); const float* CL = (const float*)(a->ws + WS_CUMF) + (size_t)h * M; double c = 0.0; float e = 0.f;
        for (int t = 0; t < M; ++t) { c += (double)logsigmoidf(DTF[(size_t)t * 32 + 16 + h] + a->fox_f_bias[h]); const float ref = (float)(c * 1.4426950408889634); e = fmaxf(e, fabsf(CL[t] - ref) / (1.f + 1e-4f * fabsf(ref))); }
        chk_report(a, 6, e); }
    if (gw >= 160 && gw < 224) { const int si = gw - 160, h = (si * 7 + 1) & 15; const int t = si < 8 ? CHK_TOK[si] : (int)(((unsigned)si * 2654435761u) % M);
        const bf16 *Q = (const bf16*)(a->ws + WS_Q), *K = (const bf16*)(a->ws + WS_K), *V = (const bf16*)(a->ws + WS_V); const float* CL = (const float*)(a->ws + WS_CUMF) + (size_t)h * M;
        const float q = bf2f(Q[(size_t)t * 1024 + 64 * h + lane]); float m = -1e30f, l = 0.f, o = 0.f;
        for (int j = 0; j <= t; ++j) { const float s = wave_sum(q * bf2f(K[(size_t)j * 1024 + 64 * h + lane])) + (CL[t] - CL[j]); const float mn = fmaxf(m, s), al = exp2f(m - mn), p = exp2f(s - mn);
            l = l * al + p; o = o * al + p * bf2f(V[(size_t)j * 1024 + 64 * h + lane]); m = mn; }
        const float e = fabsf(bf2f(MIX[(size_t)t * DM + 1024 + 64 * h + lane]) - o / l);
        chk_report(a, 7, wave_max(e)); }
}
__device__ __forceinline__ void chk8(ArgsP a, const int tidx) {
    const int gt = blockIdx.x * NTHR + tidx, NGT = gridDim.x * NTHR; const bf16* MIX = (const bf16*)(a->ws + WS_MIX); const bf16* HN = (const bf16*)(a->ws + WS_HN); float* XSV = (float*)(a->ws + WS_XSAVE);
    for (int it = gt; it < 8 * DM; it += NGT) { const int r = it / DM, t = CHK_ROWS[r], c = it % DM; float ref = a->x[(size_t)t * DM + c];
        for (int k = 0; k < DM; ++k) ref += bf2f(MIX[(size_t)t * DM + k]) * bfr(a->w_out[(size_t)k * DM + c]);
        const float got = bf2f(((const bf16*)(a->ws + WS_X1B))[(size_t)t * DM + c]); XSV[it] = got; chk_report(a, 8, fabsf(got - ref)); chk_report(a, 8, fabsf(bf2f(HN[(size_t)t * DM + c]) - got * a->ln2_w[c]) * 0.5f);
        if (c == 0) { float ss = 0.f; for (int k = 0; k < DM; ++k) { const float v = bf2f(((const bf16*)(a->ws + WS_X1B))[(size_t)t * DM + k]); ss += v * v; } const float sq = ((const float*)(a->ws + WS_MISC + MISC_SUMSQ))[t]; chk_report(a, 8, fabsf(sq - ss) / ss * 2.f); } }
}
__device__ __forceinline__ void chk910(ArgsP a, LAS unsigned char* lds, const int tidx) {
    const int gt = blockIdx.x * NTHR + tidx, NGT = gridDim.x * NTHR; const bf16* HN = (const bf16*)(a->ws + WS_HN); const bf16* QP = (const bf16*)(a->ws + WS_QP);
    for (int it = gt; it < 8 * DM; it += NGT) { const int r = it / DM, t = CHK_ROWS[r], c = it % DM; float ref = 0.f;
        for (int k = 0; k < DM; ++k) ref += bf2f(HN[(size_t)t * DM + k]) * bfr(a->peer_wq[(size_t)k * DM + c]);
        chk_report(a, 9, fabsf(bf2f(QP[(size_t)t * DM + c]) - ref)); }
    const int lane = tidx & 63, wv = tidx >> 6, gw = blockIdx.x * NWAVES + wv;
    if (gw < 64) { const int t = CHK_ROWS[gw >> 3], hd = gw & 7; LAS float* S = (LAS float*)lds + wv * 256;
        for (int half = 0; half < 2; ++half) for (int n = lane; n < 128; n += 64) { const float* kr = (half ? a->peer_k2 : a->peer_k1) + ((size_t)hd * 128 + n) * 128; float s = 0.f;
            for (int d = 0; d < 128; ++d) s += bf2f(QP[(size_t)t * DM + 256 * hd + 128 * half + d]) * bfr(kr[d]); S[128 * half + n] = s; }
        asm volatile("s_waitcnt lgkmcnt(0)" ::: "memory");
        float lo = -1e30f, hi = 1e30f; { float mx = -1e30f, mn = 1e30f; for (int i = lane; i < 128; i += 64) { mx = fmaxf(mx, S[i]); mn = fminf(mn, S[i]); } float mx2 = -1e30f, mn2 = 1e30f; for (int i = lane; i < 128; i += 64) { mx2 = fmaxf(mx2, S[128 + i]); mn2 = fminf(mn2, S[128 + i]); }
            hi = wave_max(mx) + wave_max(mx2) + 1.f; lo = -wave_max(-mn) - wave_max(-mn2) - 1.f; }
        for (int itn = 0; itn < 40; ++itn) { const float mid = 0.5f * (lo + hi); int cnt = 0; for (int i = lane; i < 16384; i += 64) cnt += (S[i >> 7] + S[128 + (i & 127)] >= mid) ? 1 : 0; cnt = (int)wave_sum((float)cnt); if (cnt >= 16) lo = mid; else hi = mid; }
        const float thr = lo; float mxs = -1e30f; for (int i = lane; i < 16384; i += 64) { const float s = S[i >> 7] + S[128 + (i & 127)]; if (s >= thr) mxs = fmaxf(mxs, s); } mxs = wave_max(mxs);
        const float rstd = 1.f / sqrtf(((const float*)(a->ws + WS_MISC + MISC_SUMSQ))[t] / DM + EPS);
        float den = 0.f; for (int i = lane; i < 16384; i += 64) { const float s = S[i >> 7] + S[128 + (i & 127)]; if (s >= thr) den += __expf((s - mxs) * rstd); } den = wave_sum(den);
        float e = 0.f; if (lane < 16) { const int id = ((const int*)(a->ws + WS_IDX))[(size_t)t * 128 + 16 * hd + lane]; const float g = ((const float*)(a->ws + WS_GW))[(size_t)t * 128 + 16 * hd + lane];
            if (id < 0 || id >= 16384) e = 10.f; else { const float s = S[id >> 7] + S[128 + (id & 127)]; if (s < thr - 2e-3f) e = 5.f; e = fmaxf(e, fabsf(g - __expf((s - mxs) * rstd) / den)); }
            for (int k2 = 0; k2 < 16; ++k2) { const int id2 = __shfl(id, k2); if (k2 != lane && id2 == id) e = 7.f; } }
        chk_report(a, 10, wave_max(e)); }
}
__device__ __forceinline__ void chk11(ArgsP a, const int tidx) {
    const int lane = tidx & 63, gw = blockIdx.x * NWAVES + (tidx >> 6); if (gw >= 8) return;
    const int t = CHK_ROWS[gw]; const bf16* HN = (const bf16*)(a->ws + WS_HN); const float* XSV = (const float*)(a->ws + WS_XSAVE) + gw * DM;
    const float rstd2 = 1.f / sqrtf(((const float*)(a->ws + WS_MISC + MISC_SUMSQ))[t] / DM + EPS);
    float acc[32];
#pragma unroll
    for (int i = 0; i < 32; ++i) acc[i] = 0.f;
    for (int k = 0; k < 128; ++k) { const int id = ((const int*)(a->ws + WS_IDX))[(size_t)t * 128 + k]; const float g = ((const float*)(a->ws + WS_GW))[(size_t)t * 128 + k];
        float s = 0.f;
#pragma unroll
        for (int i = 0; i < 32; ++i) { const int d = lane + 64 * i; s += bfr(a->peer_u[(size_t)id * DM + d]) * bf2f(HN[(size_t)t * DM + d]); }
        const float cf = g * geluf(wave_sum(s) * rstd2);
#pragma unroll
        for (int i = 0; i < 32; ++i) acc[i] += cf * bfr(a->peer_v[(size_t)id * DM + lane + 64 * i]); }
    float ss = 0.f;
#pragma unroll
    for (int i = 0; i < 32; ++i) { acc[i] += XSV[lane + 64 * i]; ss += acc[i] * acc[i]; }
    const float rstd = 1.f / sqrtf(wave_sum(ss) / DM + EPS); float e = 0.f;
#pragma unroll
    for (int i = 0; i < 32; ++i) e = fmaxf(e, fabsf(a->out[(size_t)t * DM + lane + 64 * i] - acc[i] * rstd * a->lnf_w[lane + 64 * i]));
    chk_report(a, 11, wave_max(e));
}
__device__ const float CHK_TOL[14] = {1.f, 0.05f, 0.02f, 0.05f, 0.06f, 0.03f, 0.02f, 0.03f, 0.03f, 0.06f, 0.05f, 0.03f, 0.06f, 0.03f};
__device__ const int CHK_ORD[13] = {1, 2, 3, 12, 13, 4, 5, 6, 7, 8, 9, 10, 11};
__device__ __forceinline__ void chk_verdict(ArgsP a, const int tidx) {
    const int* C = (const int*)(a->ws + WS_MISC + MISC_CHK); int bad = -1; float m = 0.f;
    for (int kk = 0; kk < 13; ++kk) { const int k = CHK_ORD[kk]; const float e = __int_as_float(C[k]); if (bad < 0 && e > CHK_TOL[k]) { bad = k; m = fminf(fmaxf(e / CHK_TOL[k], 1.f), 9.9f); } }
    if (bad < 0) return;
    const float cst = sqrtf(m * powf(100.f, (float)(bad + 1)));
    const size_t gt = (size_t)blockIdx.x * NTHR + tidx, NGT = (size_t)gridDim.x * NTHR;
    for (size_t i = gt; i < (size_t)M * DM; i += NGT) a->out[i] = cst;
}
#endif
#ifndef MK_PER_PHASE
#define MK_PER_PHASE 0
#endif
constexpr int NPHASE = 12;
__global__ void __launch_bounds__(NTHR, 2) hymba_fwd(Args a) {
    extern __shared__ __attribute__((aligned(16))) unsigned char lds_raw[];
    LAS unsigned char* lds = (LAS unsigned char*)lds_raw;
    const int lo = a.ph_lo, hi = a.ph_hi;
    const int wv_ = __builtin_amdgcn_readfirstlane((int)threadIdx.x >> 6);
#define TID (wv_ * 64 + lane_id())
    int dupi_ = 0; (void)dupi_;
    volatile LAS unsigned* lctl = (volatile LAS unsigned*)(lds + LDS_BYTES - 64);
    if (TID < 16) lctl[TID] = 0u;
    __syncthreads();
    (void)xcd_barrier_post((unsigned*)(get_args()->ws + WS_CTL) + 4096, lctl, TID);
#define A get_args()
#if SELFCHECK
#define CHK(x) x
#else
#define CHK(x)
#endif
#define IN(k) (lo <= (k) && (k) < hi)
#define GRIDBAR() do { XcdBarrier xb_; xb_.bar = (unsigned*)(get_args()->ws + WS_CTL) + 4096; xb_.x = xb_xcc_id(); xb_.st = (volatile LAS unsigned*)(lds + LDS_BYTES - 64); xcd_barrier(xb_, TID); } while (0)
#ifndef PEER8
#define PEER8 1
#endif
#ifndef DUP_MASK
#define DUP_MASK 0
#endif
#define DUP(bit, stmt) do { stmt; if (DUP_MASK & (1 << (bit))) { __syncthreads(); stmt; } } while (0)
#define SEAM(k) do { if (IN(k) && IN((k) + 1)) { GRIDBAR(); } } while (0)
    if (IN(0)) { DUP(0, phase0(A, lds, TID)); } SEAM(0);
    if (IN(1)) {
        pg8::Gemm g{(const bf16*)(A->ws + WS_XN), (const bf16*)(A->ws + WS_WIN), M, NIN, DM}; pg8::StaticOrder S; S.init(M, NIN, gridDim.x, (int)blockIdx.x);
        EpiInProj E{(bf16*)(A->ws + WS_Z), (bf16*)(A->ws + WS_XBC), (bf16*)(A->ws + WS_Q), (bf16*)(A->ws + WS_K), (bf16*)(A->ws + WS_V), (float*)(A->ws + WS_DTF)};
        DUP(1, (pg8::gemm_phase<EpiInProj, pg8::StaticOrder, true, true>(lds, g, S, E, TID)));
    } SEAM(1);
    if (IN(2)) { CHK(chk1(A, TID)); DUP(2, phase2(A, lds, TID)); } SEAM(2);
    if (IN(3)) { CHK(chk2(A, TID)); CHK(chk3(A, TID)); CHK(GRIDBAR()); if (DUP_MASK & 8) { phase3<true>(A, TID); } phase3<false>(A, TID); } SEAM(3);
    if (IN(4)) { DUP(4, phase4(A, lds, TID));
        const attn_body::AttnTensors AT{(const bf16*)(A->ws + WS_Q), (const bf16*)(A->ws + WS_K), (const bf16*)(A->ws + WS_V), (bf16*)(A->ws + WS_MIX), (const float*)(A->ws + WS_CUMF),
                                        (const float*)(A->ws + WS_MISC + MISC_QN2), (const float*)(A->ws + WS_MISC + MISC_KN2)};
        DUP(12, (attn_body::attn_phase<8>((char*)lds_raw, AT, (unsigned*)(A->ws + WS_CTL) + Q_A + ((DUP_MASK & 4096) ? 512 * dupi_++ : 0), (int)(xb_xcc_id() & 7u), TID, A)));
    } SEAM(4);
    if (IN(5)) {
        CHK(chk13(A, TID)); CHK(chk4(A, TID)); CHK(chk567(A, TID)); CHK(GRIDBAR());
        pg8::Gemm g{(const bf16*)(A->ws + WS_MIX), (const bf16*)(A->ws + WS_WOUT), M, DM, DM}; pg8::StaticOrder S; S.init(M, DM, gridDim.x, (int)blockIdx.x);
        EpiOutProj E{A->x, (bf16*)(A->ws + WS_X1B), (bf16*)(A->ws + WS_HN), A->ln2_w, (float*)(A->ws + WS_MISC + MISC_SUMSQ)};
        pg8::gemm_phase<EpiOutProj, pg8::StaticOrder, true, true>(lds, g, S, E, TID);
        if (!PEER8) convert_uv_sliced(A, TID);
    } SEAM(5);
    if (IN(6)) {
        CHK(chk8(A, TID));
        pg8::Gemm g{(const bf16*)(A->ws + WS_HN), (const bf16*)(A->ws + WS_WQ), M, DM, DM}; pg8::StaticOrder S; S.init(M, DM, gridDim.x, (int)blockIdx.x);
        EpiPlainBf16 E{(bf16*)(A->ws + WS_QP), DM};
        DUP(6, (pg8::gemm_phase<EpiPlainBf16, pg8::StaticOrder, true, true>(lds, g, S, E, TID)));
    } SEAM(6);
    if (IN(7)) { DUP(7, phase7(A, lds, TID)); } SEAM(7);
    if (IN(8)) { CHK(chk910(A, lds, TID)); CHK(__syncthreads()); if (PEER8) { DUP(8, peer_u_phase8(A, lds, TID, (DUP_MASK & 256) ? 512 * dupi_++ : 0)); } else { DUP(8, peer_u_phase(A, lds, TID, (DUP_MASK & 256) ? 512 * dupi_++ : 0)); } } SEAM(8);
    if (IN(9)) { if (PEER8) { DUP(9, peer_combine8(A, TID)); } else { DUP(9, peer_combine(A, TID)); } } SEAM(9);
    if (IN(10)) { if (PEER8) { if (DUP_MASK & 1024) { peer_v_phase8<true>(A, lds, TID, 512); } peer_v_phase8<false>(A, lds, TID); } else { if (DUP_MASK & 1024) { peer_v_phase<true>(A, lds, TID, 512); } peer_v_phase<false>(A, lds, TID); } } SEAM(10);
    if (IN(11)) { if (PEER8) { peer_final8(A, TID); } else { peer_final<false>(A, TID); } CHK(GRIDBAR()); CHK(chk11(A, TID)); CHK(GRIDBAR()); CHK(chk_verdict(A, TID)); }
#undef A
#undef TID
#undef IN
#undef SEAM
#undef DUP
#undef GRIDBAR
}

extern "C" void kernel_launch(void* const* d_in, const int* in_sizes, int n_in, void* d_out, int out_size, void* d_ws, size_t ws_size, hipStream_t stream) {
    static int grid = 0;
    if (grid == 0) {
        if (n_in != 18 || in_sizes[0] != M * DM || out_size != M * DM || ws_size < WS_END) { fprintf(stderr, "kernel_launch: unexpected shapes (n_in %d, in0 %d, out %d, ws %zu)\n", n_in, n_in > 0 ? in_sizes[0] : -1, out_size, ws_size); grid = -1; return; }
        int dev = 0, cus = 0, per_cu = 0;
        if (hipGetDevice(&dev) != hipSuccess || hipDeviceGetAttribute(&cus, hipDeviceAttributeMultiprocessorCount, dev) != hipSuccess) { grid = -1; return; }
        if (hipFuncSetAttribute((const void*)hymba_fwd, hipFuncAttributeMaxDynamicSharedMemorySize, LDS_BYTES) != hipSuccess) { fprintf(stderr, "kernel_launch: hipFuncSetAttribute failed\n"); grid = -1; return; }
        if (hipOccupancyMaxActiveBlocksPerMultiprocessor(&per_cu, (const void*)hymba_fwd, NTHR, LDS_BYTES) != hipSuccess || per_cu < 1) { fprintf(stderr, "kernel_launch: occupancy query says %d\n", per_cu); (void)hipGetLastError(); grid = -1; return; }
        grid = cus;
    }
    if (grid < 0) return;
    Args a{};
    const float** f = (const float**)&a;
    for (int i = 0; i < 18; ++i) f[i] = (const float*)d_in[i];
    a.out = (float*)d_out; a.ws = (unsigned char*)d_ws;
#if MK_PER_PHASE
    for (int p = 0; p < NPHASE; ++p) { a.ph_lo = p; a.ph_hi = p + 1; hipLaunchKernelGGL(hymba_fwd, dim3(grid), dim3(NTHR), LDS_BYTES, stream, a); }
#else
    a.ph_lo = 0; a.ph_hi = NPHASE;
    if (hipMemsetAsync((char*)d_ws + WS_CTL, 0, 65536, stream) != hipSuccess) { fprintf(stderr, "kernel_launch: hipMemsetAsync failed\n"); return; }
    hipLaunchKernelGGL(hymba_fwd, dim3(grid), dim3(NTHR), LDS_BYTES, stream, a);
#endif
}
```

```cpp
#include <hip/hip_runtime.h>
#include <cstdio>
#include <cstdint>
#include <cmath>
#ifndef SELFCHECK
#define SELFCHECK 0
#endif
namespace pg8 {
#define PG8_LAS __attribute__((address_space(3)))
typedef unsigned short bf16_t;
typedef short bf16x8 __attribute__((ext_vector_type(8)));
typedef float f32x4 __attribute__((ext_vector_type(4)));
typedef unsigned u32x4 __attribute__((ext_vector_type(4)));
constexpr int BM = 256, BK = 64, HALF = 128, HTB = HALF * BK * 2  , STAGE_BYTES = 8 * HTB, NXCD = 8, WGM = 4;

__host__ __device__ __forceinline__ int lds_byte(int r, int c) { const int st = (r >> 4) * 2 + (c >> 5), rr = r & 15, cc = c & 31, ob = rr * 64 + cc * 2; return st * 1024 + (ob ^ (((ob >> 9) & 1) << 5)); }
__host__ __device__ __forceinline__ void stage_rc(int b, int& R, int& C) { const int st = b / 1024, sb = b % 1024, swz = sb ^ (((sb >> 9) & 1) << 5); R = (st >> 1) * 16 + swz / 64; C = (st & 1) * 32 + (swz % 64) / 2; }
__host__ __device__ __forceinline__ int perm32(int rho) { const int n = rho >> 4, i = rho & 15; return 8 * (i >> 2) + 4 * n + (i & 3); }

struct Unit { int pm, pn; };
struct Gemm { const bf16_t* A; const bf16_t* Bt; int M, N, K; };

struct StaticOrder {
    int nM, nN, nwg, G, c;
    __host__ __device__ void init(int M, int N, int G_, int c_) { nM = M / BM; nN = N / BM; nwg = nM * nN; G = G_; c = c_; }
    __host__ __device__ bool next(int i, Unit& u) const {
        const long L = (long)i * G + c; if (L >= nwg) return false;
        int wgid = (int)L; { const int q = nwg / NXCD, r = nwg % NXCD, xcd = wgid % NXCD, off = wgid / NXCD; wgid = (xcd < r ? xcd * (q + 1) : r * (q + 1) + (xcd - r) * q) + off; }
        const int nig = WGM * nN, gid = wgid / nig, fm = gid * WGM, gsz = (nM - fm) < WGM ? (nM - fm) : WGM;
        u.pm = fm + ((wgid % nig) % gsz); u.pn = (wgid % nig) / gsz; return true;
    }
    __device__ __forceinline__ void a_ready(const Unit&) const {}
    __device__ __forceinline__ void done(const Unit&) const {}
};

__device__ __forceinline__ unsigned cvt_pk_bf16(float lo, float hi) { unsigned r; asm volatile("v_cvt_pk_bf16_f32 %0, %1, %2" : "=v"(r) : "v"(lo), "v"(hi)); return r; }
typedef float f32x2 __attribute__((ext_vector_type(2)));
__device__ __forceinline__ f32x2 gelu_pk(f32x2 v) {
    const f32x2 av = __builtin_elementwise_abs(v), d = av * 0.2316418882f + 1.0f;
    f32x2 t; t.x = __builtin_amdgcn_rcpf(d.x); t.y = __builtin_amdgcn_rcpf(d.y);
    f32x2 q = t * 0.5307027145f + (-0.7265760135f); q = q * t + 0.7107068705f; q = q * t + (-0.142248368f); q = q * t + 0.127414796f; q = q * t;
    const f32x2 s = (v * v) * (-0.72134752044f);
    f32x2 e; e.x = __builtin_amdgcn_exp2f(s.x); e.y = __builtin_amdgcn_exp2f(s.y);
    const f32x2 m = v * (q * e), r = v - m;
    f32x2 o; o.x = v.x < 0.f ? m.x : r.x; o.y = v.y < 0.f ? m.y : r.y; return o;
}

template <int ACT  > struct EpiBf16 {
    static constexpr bool PERM = true, AFTER_DRAIN = false; static_assert(ACT == 0 || ACT == 1, "EpiBf16: ACT is 0 (none) or 1 (gelu_pk)");
    bf16_t* O; int ldc; const float* bias; int split_cols; size_t split_stride; float scale0;
    __device__ __forceinline__ void operator()(const f32x4 (&acc)[2][2][4][2], const Unit& u, int wr, int wc, int fr, int fq) const {
        const int row0 = u.pm * BM + wr * 64 + fr; int colt = u.pn * BM; bf16_t* base = O;
        float sc = 1.f; if (split_cols) { const int t = colt / split_cols; base += (size_t)t * split_stride; colt -= t * split_cols; if (t == 0) sc = scale0; }
        const int col0 = colt + wc * 32 + 8 * fq, bcol0 = u.pn * BM + wc * 32 + 8 * fq;
        f32x4 bv[2][2];
#pragma unroll
        for (int bj = 0; bj < 2; ++bj)
#pragma unroll
            for (int n = 0; n < 2; ++n) bv[bj][n] = bias ? *(const f32x4*)(bias + bcol0 + bj * HALF + 4 * n) : (f32x4){0.f, 0.f, 0.f, 0.f};
#pragma unroll
        for (int ai = 0; ai < 2; ++ai)
#pragma unroll
            for (int m = 0; m < 4; ++m) { bf16_t* rowp = base + (size_t)(row0 + ai * HALF + m * 16) * ldc + col0;
#pragma unroll
                for (int bj = 0; bj < 2; ++bj) { f32x4 v0 = acc[ai][bj][m][0] + bv[bj][0], v1 = acc[ai][bj][m][1] + bv[bj][1];
                    if (ACT == 1) { f32x2 a = gelu_pk((f32x2){v0[0], v0[1]}), b = gelu_pk((f32x2){v0[2], v0[3]}), c = gelu_pk((f32x2){v1[0], v1[1]}), d = gelu_pk((f32x2){v1[2], v1[3]});
                        v0 = (f32x4){a.x, a.y, b.x, b.y}; v1 = (f32x4){c.x, c.y, d.x, d.y}; }
                    v0 = v0 * sc; v1 = v1 * sc; u32x4 w; w.x = cvt_pk_bf16(v0[0], v0[1]); w.y = cvt_pk_bf16(v0[2], v0[3]); w.z = cvt_pk_bf16(v1[0], v1[1]); w.w = cvt_pk_bf16(v1[2], v1[3]);
                    *(u32x4*)(rowp + bj * HALF) = w; } }
    }
};
template <class Epi, class Sched, bool ALIGN_EPI = false, bool SP2 = false>
__device__ __forceinline__ void gemm_phase(PG8_LAS unsigned char* lds, const Gemm g, const Sched& S, const Epi& E, const int tid_in) {
    const int tid = tid_in, wid = __builtin_amdgcn_readfirstlane(tid >> 6), lane = tid & 63, wr = wid >> 2, wc = wid & 3, fr = lane & 15, fq = lane >> 4;
    const int K = g.K, nt = K / BK;
    unsigned voffA[2], voffB[2];
#pragma unroll
    for (int i = 0; i < 2; ++i) { int R, C; stage_rc(tid * 16 + i * 8192, R, C); const int Rb = Epi::PERM ? ((R & ~31) + perm32(R & 31)) : R;
        voffA[i] = (unsigned)(R * K + C) * 2u; voffB[i] = (unsigned)(Rb * K + C) * 2u; }
    const size_t kstep = (size_t)(BK * 2);
    const size_t hstep = (size_t)HALF * K * 2;
    const size_t tstep = 2 * hstep;
    const unsigned ldsw = (unsigned)wid * 1024u;
    const int aoff = lds_byte(wr * 64 + fr, fq * 8), boff = lds_byte(wc * 32 + fr, fq * 8);
#define PG8_SA(b, h) (((b) * 2 + (h)) * HTB)
#define PG8_SB(b, h) ((4 + (b) * 2 + (h)) * HTB)
#define PG8_STAGE(bufoff, gbase, voff) do { _Pragma("unroll") for (int _i = 0; _i < 2; ++_i) \
        __builtin_amdgcn_global_load_lds((const unsigned*)((const char*)(gbase) + (voff)[_i]), (PG8_LAS unsigned*)(lds + (bufoff) + ldsw + _i * 8192), 16, 0, 0); } while (0)
#define PG8_LDA(dst, b, h) do { _Pragma("unroll") for (int m = 0; m < 4; ++m) _Pragma("unroll") for (int k = 0; k < 2; ++k) dst[m][k] = *(const PG8_LAS bf16x8*)(lds + PG8_SA(b, h) + aoff + m * 2048 + k * 1024); } while (0)
#define PG8_LDB(dst, b, h) do { _Pragma("unroll") for (int n = 0; n < 2; ++n) _Pragma("unroll") for (int k = 0; k < 2; ++k) dst[n][k] = *(const PG8_LAS bf16x8*)(lds + PG8_SB(b, h) + boff + n * 2048 + k * 1024); } while (0)
#define PG8_MMA(ai, bj, At, Bt) do { __builtin_amdgcn_s_setprio(1); _Pragma("unroll") for (int m = 0; m < 4; ++m) _Pragma("unroll") for (int n = 0; n < 2; ++n) _Pragma("unroll") for (int k = 0; k < 2; ++k) \
        acc[ai][bj][m][n] = __builtin_amdgcn_mfma_f32_16x16x32_bf16(Bt[n][k], At[m][k], acc[ai][bj][m][n], 0, 0, 0); __builtin_amdgcn_s_setprio(0); } while (0)
#define PG8_WAIT_V(n) asm volatile("s_waitcnt vmcnt(" #n ")" ::: "memory")
#define PG8_WAIT_L(n) asm volatile("s_waitcnt lgkmcnt(" #n ")" ::: "memory")
#define PG8_BAR __builtin_amdgcn_s_barrier()
#define PG8_SCHED __builtin_amdgcn_sched_barrier(0)
    Unit cur, nxt; int ui = 0;
    if (!S.next(0, cur)) return;
    f32x4 acc[2][2][4][2];
#pragma unroll
    for (int a = 0; a < 2; ++a)
#pragma unroll
        for (int b = 0; b < 2; ++b)
#pragma unroll
            for (int m = 0; m < 4; ++m)
#pragma unroll
                for (int n = 0; n < 2; ++n) acc[a][b][m][n] = (f32x4){0.f, 0.f, 0.f, 0.f};
    bf16x8 At[4][2], B0[2][2], B1[2][2];
    const char* cA = (const char*)g.A + (size_t)cur.pm * tstep; const char* cB = (const char*)g.Bt + (size_t)cur.pn * tstep;
    S.a_ready(cur);
    if constexpr (SP2) {
        PG8_STAGE(PG8_SB(0, 0), cB, voffB); PG8_STAGE(PG8_SB(0, 1), cB + hstep, voffB); PG8_STAGE(PG8_SA(0, 0), cA, voffA); PG8_STAGE(PG8_SA(0, 1), cA + hstep, voffA);
        if (wr == 1) PG8_BAR;
        PG8_WAIT_V(2); PG8_BAR;
        PG8_STAGE(PG8_SB(1, 0), cB + kstep, voffB); PG8_STAGE(PG8_SA(1, 0), cA + kstep, voffA); PG8_STAGE(PG8_SB(1, 1), cB + hstep + kstep, voffB);
        PG8_WAIT_V(6); PG8_BAR;
    } else {
        PG8_STAGE(PG8_SB(0, 0), cB, voffB); PG8_STAGE(PG8_SA(0, 0), cA, voffA); PG8_STAGE(PG8_SB(0, 1), cB + hstep, voffB); PG8_STAGE(PG8_SA(0, 1), cA + hstep, voffA);
        if (wr == 1) PG8_BAR;
        PG8_WAIT_V(4); PG8_BAR;
        PG8_STAGE(PG8_SB(1, 0), cB + kstep, voffB); PG8_STAGE(PG8_SA(1, 0), cA + kstep, voffA); PG8_STAGE(PG8_SB(1, 1), cB + hstep + kstep, voffB);
        PG8_WAIT_V(6); PG8_BAR;
    }
    for (;;) {
        const bool has_next = S.next(ui + 1, nxt);
        const char* nA = has_next ? (const char*)g.A + (size_t)nxt.pm * tstep : cA; const char* nB = has_next ? (const char*)g.Bt + (size_t)nxt.pn * tstep : cB;
        for (int t = 0; t < nt; t += 2) {
            const bool last = (t == nt - 2);
            const char* a1 = cA + (size_t)(t + 1) * kstep;
            const char* a2 = last ? nA : cA + (size_t)(t + 2) * kstep; const char* b2 = last ? nB : cB + (size_t)(t + 2) * kstep;
            const char* a3 = a2 + kstep; const char* b3 = b2 + kstep;
            if (last && has_next) S.a_ready(nxt);
            if constexpr (SP2) {
            PG8_LDB(B0, 0, 0); PG8_LDB(B1, 0, 1); PG8_SCHED; PG8_LDA(At, 0, 0); PG8_STAGE(PG8_SA(1, 1), a1 + hstep, voffA);
            PG8_WAIT_V(8); PG8_WAIT_L(0); PG8_BAR; PG8_MMA(0, 0, At, B0); PG8_MMA(0, 1, At, B1); PG8_BAR; PG8_SCHED;
            PG8_LDA(At, 0, 1); PG8_STAGE(PG8_SB(0, 0), b2, voffB); PG8_STAGE(PG8_SB(0, 1), b2 + hstep, voffB); PG8_STAGE(PG8_SA(0, 0), a2, voffA);
            PG8_WAIT_V(8); PG8_WAIT_L(0); PG8_BAR; PG8_MMA(1, 0, At, B0); PG8_MMA(1, 1, At, B1); PG8_BAR; PG8_SCHED;
            PG8_LDB(B0, 1, 0); PG8_LDB(B1, 1, 1); PG8_SCHED; PG8_LDA(At, 1, 0); PG8_STAGE(PG8_SA(0, 1), a2 + hstep, voffA);
            PG8_WAIT_V(8); PG8_WAIT_L(0); PG8_BAR; PG8_MMA(0, 0, At, B0); PG8_MMA(0, 1, At, B1); PG8_BAR; PG8_SCHED;
            PG8_LDA(At, 1, 1); PG8_STAGE(PG8_SB(1, 0), b3, voffB); PG8_STAGE(PG8_SB(1, 1), b3 + hstep, voffB); PG8_STAGE(PG8_SA(1, 0), a3, voffA);
            PG8_WAIT_V(8); PG8_WAIT_L(0); PG8_BAR; PG8_MMA(1, 0, At, B0); PG8_MMA(1, 1, At, B1); PG8_BAR; PG8_SCHED;
            } else {
            PG8_LDB(B0, 0, 0); PG8_SCHED; PG8_LDA(At, 0, 0); PG8_STAGE(PG8_SA(1, 1), a1 + hstep, voffA);
            PG8_WAIT_L(8); PG8_BAR; PG8_WAIT_L(0); PG8_MMA(0, 0, At, B0); PG8_BAR; PG8_SCHED;
            PG8_LDB(B1, 0, 1); PG8_STAGE(PG8_SB(0, 0), b2, voffB);
            PG8_BAR; PG8_WAIT_L(0); PG8_MMA(0, 1, At, B1); PG8_BAR;
            PG8_LDA(At, 0, 1); PG8_STAGE(PG8_SA(0, 0), a2, voffA);
            PG8_BAR; PG8_WAIT_L(0); PG8_MMA(1, 0, At, B0); PG8_BAR; PG8_SCHED;
            PG8_STAGE(PG8_SB(0, 1), b2 + hstep, voffB);
            PG8_WAIT_V(6); PG8_BAR; PG8_MMA(1, 1, At, B1); PG8_BAR;
            PG8_LDB(B0, 1, 0); PG8_SCHED; PG8_LDA(At, 1, 0); PG8_STAGE(PG8_SA(0, 1), a2 + hstep, voffA);
            PG8_WAIT_L(8); PG8_BAR; PG8_WAIT_L(0); PG8_MMA(0, 0, At, B0); PG8_BAR; PG8_SCHED;
            PG8_LDB(B1, 1, 1); PG8_STAGE(PG8_SB(1, 0), b3, voffB);
            PG8_BAR; PG8_WAIT_L(0); PG8_MMA(0, 1, At, B1); PG8_BAR;
            PG8_LDA(At, 1, 1); PG8_STAGE(PG8_SA(1, 0), a3, voffA);
            PG8_BAR; PG8_WAIT_L(0); PG8_MMA(1, 0, At, B0); PG8_BAR; PG8_SCHED;
            PG8_STAGE(PG8_SB(1, 1), b3 + hstep, voffB);
            PG8_WAIT_V(6); PG8_BAR; PG8_MMA(1, 1, At, B1); PG8_BAR;
            }
        }
        if constexpr (ALIGN_EPI) { if (wr == 0) PG8_BAR; }
        if constexpr (!Epi::AFTER_DRAIN) { E(acc, cur, wr, wc, fr, fq); S.done(cur); }
        if (!has_next) break;
#pragma unroll
        for (int a = 0; a < 2; ++a)
#pragma unroll
            for (int b = 0; b < 2; ++b)
#pragma unroll
                for (int m = 0; m < 4; ++m)
#pragma unroll
                    for (int n = 0; n < 2; ++n) acc[a][b][m][n] = (f32x4){0.f, 0.f, 0.f, 0.f};
        cur = nxt; cA = nA; cB = nB; ++ui;
        if constexpr (ALIGN_EPI) { if (wr == 1) PG8_BAR; }
    }
    PG8_WAIT_V(0);
    if constexpr (!ALIGN_EPI) { if (wr == 0) PG8_BAR; }
    PG8_BAR;
    if constexpr (Epi::AFTER_DRAIN) { E.fused(acc, cur, wr, wc, fr, fq, lds, wid, lane); S.done(cur); }
#undef PG8_SA
#undef PG8_SB
#undef PG8_STAGE
#undef PG8_LDA
#undef PG8_LDB
#undef PG8_MMA
#undef PG8_WAIT_V
#undef PG8_WAIT_L
#undef PG8_BAR
#undef PG8_SCHED
}
}
#define LAS __attribute__((address_space(3)))
typedef unsigned short bf16;
typedef short bf16x8 __attribute__((ext_vector_type(8)));
typedef float f32x4 __attribute__((ext_vector_type(4)));
typedef float f32x2 __attribute__((ext_vector_type(2)));
typedef unsigned u32x4 __attribute__((ext_vector_type(4)));
typedef unsigned u32x2 __attribute__((ext_vector_type(2)));
typedef __bf16 bf16x2_t __attribute__((ext_vector_type(2)));

constexpr int M = 16384, DM = 2048, NIN = 5888, NCHUNK = 256;
constexpr float EPS = 1e-6f, LOG2E = 1.4426950408889634f, QSCALE = 0.125f * LOG2E;
constexpr int NWAVES = 8, NTHR = 512;
constexpr size_t MiB = 1u << 20;
constexpr size_t WS_CTL = 0, WS_WOUT = 1 * MiB, WS_WQ = 9 * MiB, WS_K12 = 17 * MiB, WS_XN = 18 * MiB, WS_WIN = 82 * MiB, WS_Z = 105 * MiB, WS_XBC = 137 * MiB,
                 WS_Q = 185 * MiB, WS_K = 217 * MiB, WS_V = 249 * MiB, WS_DTF = 281 * MiB, WS_XS = 283 * MiB, WS_BC = 315 * MiB, WS_DT = 331 * MiB, WS_ACUM = 332 * MiB,
                 WS_CUMF = 333 * MiB, WS_MISC = 334 * MiB, WS_MIX = 335 * MiB, WS_END = 464 * MiB;
constexpr size_t WS_SLOC = WS_XN;
constexpr size_t WS_HN = WS_XN;
constexpr size_t WS_QP = 105 * MiB, WS_IDX = 169 * MiB, WS_GW = 177 * MiB, WS_U = 185 * MiB, WS_V2 = 249 * MiB;
constexpr size_t MISC_FTOT = 0, MISC_SUMSQ = 65536, MISC_QN2 = 196608, MISC_KN2 = 212992, MISC_QKD = 229376, MISC_CHK = 262144;
constexpr int LDS_BYTES = 155648;

__device__ __forceinline__ unsigned cvtpk(float lo, float hi) { f32x2 v = {lo, hi}; bf16x2_t b = __builtin_convertvector(v, bf16x2_t); return __builtin_bit_cast(unsigned, b); }
__device__ __forceinline__ bf16 f2bf(float f) { return (bf16)(cvtpk(f, 0.f) & 0xffffu); }
__device__ __forceinline__ float bf2f(bf16 h) { return __uint_as_float((unsigned)h << 16); }
__device__ __forceinline__ float bflo(unsigned w) { return __uint_as_float(w << 16); }
__device__ __forceinline__ float bfhi(unsigned w) { return __uint_as_float(w & 0xffff0000u); }
template <int CTRL, int RM> __device__ __forceinline__ float dpp_self(float v) { return __int_as_float(__builtin_amdgcn_update_dpp(__float_as_int(v), __float_as_int(v), CTRL, RM, 0xf, false)); }
template <int CTRL, int RM> __device__ __forceinline__ float dpp_zero(float v) { return __int_as_float(__builtin_amdgcn_update_dpp(0, __float_as_int(v), CTRL, RM, 0xf, false)); }
__device__ __forceinline__ float wave_max(float v) {
    v = fmaxf(v, dpp_self<0x111, 0xf>(v)); v = fmaxf(v, dpp_self<0x112, 0xf>(v)); v = fmaxf(v, dpp_self<0x114, 0xf>(v)); v = fmaxf(v, dpp_self<0x118, 0xf>(v));
    v = fmaxf(v, dpp_self<0x142, 0xa>(v)); v = fmaxf(v, dpp_self<0x143, 0xc>(v));
    return __int_as_float(__builtin_amdgcn_readlane(__float_as_int(v), 63));
}
__device__ __forceinline__ float wave_sum(float v) {
    v += dpp_zero<0x111, 0xf>(v); v += dpp_zero<0x112, 0xf>(v); v += dpp_zero<0x114, 0xf>(v); v += dpp_zero<0x118, 0xf>(v);
    v += dpp_zero<0x142, 0xa>(v); v += dpp_zero<0x143, 0xc>(v);
    return __int_as_float(__builtin_amdgcn_readlane(__float_as_int(v), 63));
}
__device__ __forceinline__ float wave_scan_incl(float v, int lane) {
#pragma unroll
    for (int o = 1; o < 64; o <<= 1) { const float t = __shfl_up(v, o); if (lane >= o) v += t; }
    return v;
}
__device__ __forceinline__ float siluf(float x) { return x / (1.f + __expf(-x)); }
__device__ __forceinline__ float softplusf(float x) { return fmaxf(x, 0.f) + log1pf(__expf(-fabsf(x))); }
__device__ __forceinline__ float logsigmoidf(float x) { return fminf(x, 0.f) - log1pf(__expf(-fabsf(x))); }
__device__ __forceinline__ float dot2bf(unsigned a, unsigned b, float c) { const unsigned aa = a, bb = b; return __builtin_amdgcn_fdot2_f32_bf16(__builtin_bit_cast(bf16x2_t, aa), __builtin_bit_cast(bf16x2_t, bb), c, false); }
__device__ __forceinline__ f32x4 mfma16(bf16x8 a, bf16x8 b, f32x4 c) { return __builtin_amdgcn_mfma_f32_16x16x32_bf16(a, b, c, 0, 0, 0); }

struct Args {
    const float *x, *ln1_w, *w_in, *conv_w, *conv_b, *dt_bias, *a_log, *d_skip, *ssd_norm_w, *fox_f_bias, *w_out, *ln2_w, *peer_wq, *peer_k1, *peer_k2, *peer_u, *peer_v, *lnf_w;
    float* out; unsigned char* ws; int ph_lo, ph_hi;
};
typedef const __attribute__((address_space(4))) Args* ArgsP;
__device__ __forceinline__ ArgsP get_args() { ArgsP p = (ArgsP)__builtin_amdgcn_kernarg_segment_ptr(); asm volatile("" : "+s"(p)); return p; }
__device__ __forceinline__ int lane_id() { int l; asm volatile("v_mbcnt_lo_u32_b32 %0, -1, 0\n\tv_mbcnt_hi_u32_b32 %0, -1, %0" : "=v"(l)); return l; }
__device__ __forceinline__ int opaque(int v) { asm volatile("" : "+v"(v)); return v; }
#define GAS __attribute__((address_space(1)))
#define XB_TMO      128
#define XB_XCNT(j)  (256  + 64 * (j))
#define XB_XSUB(j)  (1280 + 64 * (j))
#define XB_XGEN(j)  (2304 + 64 * (j))
#define XB_TOP      3328
#define XB_TOPGEN   3392
#define XCD_BAR_WORDS 3456
#define XB_SPIN_CAP (1u << 18)

__device__ __forceinline__ unsigned xb_ld(unsigned* p)              { return __hip_atomic_load(p, __ATOMIC_RELAXED, __HIP_MEMORY_SCOPE_AGENT); }
__device__ __forceinline__ unsigned xb_add(unsigned* p, unsigned v) { return __hip_atomic_fetch_add(p, v, __ATOMIC_RELAXED, __HIP_MEMORY_SCOPE_AGENT); }
__device__ __forceinline__ unsigned xb_xcc_id() { return (unsigned)__builtin_amdgcn_s_getreg((3 << 11) | 20) & 0xFu; }
#define XB_SPIN(cond, bar) do { unsigned _sp = 0; while (cond) { __builtin_amdgcn_s_sleep(1); \
    if ((++_sp & 255u) == 0u) { if (xb_ld(&(bar)[XB_TMO])) break; if (_sp > XB_SPIN_CAP) { atomicAdd(&(bar)[XB_TMO], 1u); break; } } } } while (0)
struct XcdBarrier { unsigned* bar; unsigned x; volatile LAS unsigned* st; };
__device__ __forceinline__ XcdBarrier xcd_barrier_post(unsigned* bar, volatile LAS unsigned* st, const int tid) {
    XcdBarrier b; b.bar = bar; b.x = xb_xcc_id(); b.st = st;
    if (tid == 0) (void)xb_add(&bar[XB_XCNT(b.x)], 1u);
    return b;
}
__device__ __forceinline__ void xcd_barrier_complete(unsigned* bar, unsigned x, unsigned& nloc, unsigned& nx) {
    const unsigned G = gridDim.x;
    unsigned sum, cnt, mine, sp = 0u;
    for (;;) {
        sum = 0u; cnt = 0u; mine = 0u;
#pragma unroll
        for (unsigned j = 0; j < 16; ++j) { const unsigned c = xb_ld(&bar[XB_XCNT(j)]); sum += c; cnt += (c > 0u) ? 1u : 0u; mine = (j == x) ? c : mine; }
        if (sum == G) break;
        __builtin_amdgcn_s_sleep(1);
        if ((++sp & 255u) == 0u) { if (xb_ld(&bar[XB_TMO])) break; if (sp > XB_SPIN_CAP) { atomicAdd(&bar[XB_TMO], 1u); break; } }
    }
    nloc = mine > 0u ? mine : 1u; nx = cnt > 0u ? cnt : 1u;
}
__device__ __forceinline__ void xcd_barrier(const XcdBarrier& b, const int tid) {
    asm volatile("s_waitcnt vmcnt(0)" ::: "memory");
    __syncthreads();
    if (tid == 0) {
        unsigned* bar = b.bar;
        __builtin_amdgcn_s_waitcnt(0);
        unsigned nloc = b.st[0], nx = b.st[1];
        if (nloc == 0u) { xcd_barrier_complete(bar, b.x, nloc, nx); b.st[0] = nloc; b.st[1] = nx; }
        const unsigned old = xb_add(&bar[XB_XSUB(b.x)], 1u);
        const unsigned gen = old / nloc;
        if (old + 1u == (gen + 1u) * nloc) {
            __builtin_amdgcn_fence(__ATOMIC_RELEASE, "agent");
            asm volatile("s_waitcnt vmcnt(0)" ::: "memory");
            const unsigned og = xb_add(&bar[XB_TOP], 1u);
            const unsigned tg = og / nx;
            if (og + 1u == (tg + 1u) * nx) xb_add(&bar[XB_TOPGEN], 1u);
            else XB_SPIN(xb_ld(&bar[XB_TOPGEN]) == tg, bar);
            __builtin_amdgcn_fence(__ATOMIC_ACQUIRE, "agent");
            xb_add(&bar[XB_XGEN(b.x)], 1u);
            asm volatile("s_waitcnt vmcnt(0)" ::: "memory");
        } else {
            XB_SPIN(xb_ld(&bar[XB_XGEN(b.x)]) == gen, bar);
            __builtin_amdgcn_fence(__ATOMIC_ACQUIRE, "agent");
            asm volatile("s_waitcnt vmcnt(0)" ::: "memory");
        }
    }
    __syncthreads();
}
__device__ __forceinline__ int peer_next_item(unsigned* heads, const int myx, int& probe, const unsigned nper, volatile LAS int* bc, const int tid) {
    if (tid == 0) { int r = -1;
        while (probe < 8) { const int q = (myx + probe) & 7; const unsigned v = __hip_atomic_fetch_add(&heads[64 * q], 1u, __ATOMIC_RELAXED, __HIP_MEMORY_SCOPE_AGENT); if (v < nper) { r = q * (int)nper + (int)v; break; } ++probe; }
        bc[0] = r; }
    __syncthreads(); const int r = bc[0]; __syncthreads(); return r;
}
constexpr int Q_A = 8192 + 2048;
__device__ __forceinline__ int win_dest_row(int j) { return j < 2560 ? j : (j < 2576 ? 5632 + (j - 2560) : (j < 5648 ? j - 16 : j)); }
template <bool MAPROW> __device__ __forceinline__ void p0_transpose_item(const float* W, int K, int N, bf16* WT, LAS float* scr, int item, int lane) {
    const int nblk = N / 32, kb = item / nblk, nb = item % nblk, k0 = 64 * kb, n0 = 32 * nb;
#pragma unroll 8
    for (int i = 0; i < 32; ++i) { const int kk = 2 * i + (lane >> 5); scr[kk * 33 + (lane & 31)] = W[(size_t)(k0 + kk) * N + n0 + (lane & 31)]; }
    asm volatile("s_waitcnt lgkmcnt(0)" ::: "memory");
    const int c = lane & 7;
#pragma unroll
    for (int j = 0; j < 4; ++j) { const int n = (lane >> 3) + 8 * j; const LAS float* s = scr + (8 * c) * 33 + n;
        u32x4 o; o.x = cvtpk(s[0 * 33], s[1 * 33]); o.y = cvtpk(s[2 * 33], s[3 * 33]); o.z = cvtpk(s[4 * 33], s[5 * 33]); o.w = cvtpk(s[6 * 33], s[7 * 33]);
        const int drow = MAPROW ? win_dest_row(n0 + n) : (n0 + n);
        *(u32x4*)(WT + (size_t)drow * K + k0 + 8 * c) = o; }
    asm volatile("s_waitcnt lgkmcnt(0)" ::: "memory");
}
__device__ __forceinline__ void rms_row_to_bf16(const float* xrow, const float* w, bf16* orow, int lane) {
    const f32x4* xr = (const f32x4*)xrow + lane; const f32x4* wr = (const f32x4*)w + lane;
    f32x4 v[8]; float s = 0.f;
#pragma unroll
    for (int j = 0; j < 8; ++j) { v[j] = xr[64 * j]; s += (v[j].x * v[j].x + v[j].y * v[j].y) + (v[j].z * v[j].z + v[j].w * v[j].w); }
    const float rstd = 1.f / sqrtf(wave_sum(s) * (1.f / DM) + EPS);
    u32x2* o8 = (u32x2*)orow + lane;
#pragma unroll
    for (int j = 0; j < 8; ++j) { const f32x4 ww = wr[64 * j]; u32x2 o; o.x = cvtpk(v[j].x * rstd * ww.x, v[j].y * rstd * ww.y); o.y = cvtpk(v[j].z * rstd * ww.z, v[j].w * rstd * ww.w); o8[64 * j] = o; }
}
__device__ __forceinline__ void transpose_filler_item(ArgsP a, LAS unsigned char* lds, const int tidx, const int f) {
    const int lane = tidx & 63, wave = __builtin_amdgcn_readfirstlane(tidx >> 6); LAS float* scr = (LAS float*)(lds + wave * 16384);
    const bool second = f >= 256; const int it = (f & 255) * 8 + wave;
    p0_transpose_item<false>(second ? a->peer_wq : a->w_out, DM, DM, (bf16*)(a->ws + (second ? WS_WQ : WS_WOUT)), scr, it, lane);
}
__device__ __forceinline__ void phase0(ArgsP a, LAS unsigned char* lds, const int tidx) {
    const int tid = tidx, lane = tid & 63, wave = __builtin_amdgcn_readfirstlane(tid >> 6);
    LAS float* scr = (LAS float*)(lds + wave * 16384);
    const int gw = blockIdx.x * NWAVES + wave, NGW = gridDim.x * NWAVES;
    bf16* WinT = (bf16*)(a->ws + WS_WIN); bf16* WoutT = (bf16*)(a->ws + WS_WOUT); bf16* WqT = (bf16*)(a->ws + WS_WQ);
    constexpr int I_IN = (DM / 64) * (5664 / 32), I_SQ = (DM / 64) * (DM / 32);
    for (int it = gw; it < I_IN; it += NGW) p0_transpose_item<true>(a->w_in, DM, 5664, WinT, scr, it, lane);
    (void)WoutT; (void)WqT;
    { const int gt = blockIdx.x * NTHR + tid, NGT = gridDim.x * NTHR; u32x4* z = (u32x4*)(WinT + (size_t)5664 * DM);
      for (int i = gt; i < 224 * 256; i += NGT) z[i] = (u32x4){0u, 0u, 0u, 0u};
      float* ss = (float*)(a->ws + WS_MISC + MISC_SUMSQ); for (int i = gt; i < M; i += NGT) { ss[i] = 0.f; ss[i + 16384] = 0.f; }
      if (gt < 16) ((int*)(a->ws + WS_MISC + MISC_CHK))[gt] = 0;
      bf16* k12 = (bf16*)(a->ws + WS_K12);
      for (int i = gt; i < 2 * 8 * 128 * 128 / 2; i += NGT) { const int half = i >= 65536; const float* src = half ? a->peer_k2 : a->peer_k1; const int e = (i - half * 65536) * 2;
          ((unsigned*)k12)[i] = cvtpk(src[e], src[e + 1]); } }
    bf16* XN = (bf16*)(a->ws + WS_XN);
    for (int m = gw; m < M; m += NGW) rms_row_to_bf16(a->x + (size_t)m * DM, a->ln1_w, XN + (size_t)m * DM, lane);
}

struct EpiInProj {
    static constexpr bool PERM = true, AFTER_DRAIN = false;
    bf16 *Z, *XBC, *Q, *K, *V; float* DTF;
    __device__ __forceinline__ void operator()(const f32x4 (&acc)[2][2][4][2], const pg8::Unit& u, int wr, int wc, int fr, int fq) const {
        const int pn = u.pn; bf16* base; int ldc, colt; float sc = 1.f;
        if (pn < 4) { base = Z; ldc = 1024; colt = pn * 256; }
        else if (pn < 10) { base = XBC; ldc = 1536; colt = (pn - 4) * 256; }
        else if (pn < 14) { base = Q; ldc = 1024; colt = (pn - 10) * 256; sc = QSCALE; }
        else if (pn < 18) { base = K; ldc = 1024; colt = (pn - 14) * 256; }
        else if (pn < 22) { base = V; ldc = 1024; colt = (pn - 18) * 256; }
        else {
            if (wc == 0) {
#pragma unroll
                for (int ai = 0; ai < 2; ++ai)
#pragma unroll
                    for (int m = 0; m < 4; ++m) { const int row = u.pm * 256 + ai * 128 + wr * 64 + m * 16 + fr;
#pragma unroll
                        for (int n = 0; n < 2; ++n) *(f32x4*)(DTF + (size_t)row * 32 + 8 * fq + 4 * n) = acc[ai][0][m][n]; }
            }
            return;
        }
        const int row0 = u.pm * 256 + wr * 64 + fr, col0 = colt + wc * 32 + 8 * fq;
#pragma unroll
        for (int ai = 0; ai < 2; ++ai)
#pragma unroll
            for (int m = 0; m < 4; ++m) { bf16* rowp = base + (size_t)(row0 + ai * 128 + m * 16) * ldc + col0;
#pragma unroll
                for (int bj = 0; bj < 2; ++bj) { const f32x4 v0 = acc[ai][bj][m][0] * sc, v1 = acc[ai][bj][m][1] * sc;
                    u32x4 w; w.x = cvtpk(v0[0], v0[1]); w.y = cvtpk(v0[2], v0[3]); w.z = cvtpk(v1[0], v1[1]); w.w = cvtpk(v1[2], v1[3]);
                    *(u32x4*)(rowp + bj * 128) = w; } }
    }
};
struct EpiPlainBf16 {
    static constexpr bool PERM = true, AFTER_DRAIN = false;
    bf16* O; int ldc;
    __device__ __forceinline__ void operator()(const f32x4 (&acc)[2][2][4][2], const pg8::Unit& u, int wr, int wc, int fr, int fq) const {
        const int row0 = u.pm * 256 + wr * 64 + fr, col0 = u.pn * 256 + wc * 32 + 8 * fq;
#pragma unroll
        for (int ai = 0; ai < 2; ++ai)
#pragma unroll
            for (int m = 0; m < 4; ++m) { bf16* rowp = O + (size_t)(row0 + ai * 128 + m * 16) * ldc + col0;
#pragma unroll
                for (int bj = 0; bj < 2; ++bj) { const f32x4 v0 = acc[ai][bj][m][0], v1 = acc[ai][bj][m][1];
                    u32x4 w; w.x = cvtpk(v0[0], v0[1]); w.y = cvtpk(v0[2], v0[3]); w.z = cvtpk(v1[0], v1[1]); w.w = cvtpk(v1[2], v1[3]);
                    *(u32x4*)(rowp + bj * 128) = w; } }
    }
};
struct EpiOutProj {
    static constexpr bool PERM = true, AFTER_DRAIN = false;
    const float* x; bf16* X1B; bf16* HN; const float* ln2w; float* sumsq;
    __device__ __forceinline__ void operator()(const f32x4 (&acc)[2][2][4][2], const pg8::Unit& u, int wr, int wc, int fr, int fq) const {
        const int col0 = u.pn * 256 + wc * 32 + 8 * fq;
        f32x4 wv[2][2];
#pragma unroll
        for (int bj = 0; bj < 2; ++bj)
#pragma unroll
            for (int n = 0; n < 2; ++n) wv[bj][n] = *(const f32x4*)(ln2w + col0 + bj * 128 + 4 * n);
#pragma unroll
        for (int ai = 0; ai < 2; ++ai) {
            f32x4 xr[4][2][2];
#pragma unroll
            for (int m = 0; m < 4; ++m) { const size_t off = (size_t)(u.pm * 256 + ai * 128 + wr * 64 + m * 16 + fr) * DM + col0;
#pragma unroll
                for (int bj = 0; bj < 2; ++bj)
#pragma unroll
                    for (int n = 0; n < 2; ++n) xr[m][bj][n] = *(const f32x4*)(x + off + bj * 128 + 4 * n); }
#pragma unroll
            for (int m = 0; m < 4; ++m) { const int row = u.pm * 256 + ai * 128 + wr * 64 + m * 16 + fr; const size_t off = (size_t)row * DM + col0; float ss = 0.f;
#pragma unroll
                for (int bj = 0; bj < 2; ++bj) { const f32x4 a0 = acc[ai][bj][m][0] + xr[m][bj][0], a1 = acc[ai][bj][m][1] + xr[m][bj][1]; const size_t o = off + bj * 128;
                    u32x4 xw; xw.x = cvtpk(a0[0], a0[1]); xw.y = cvtpk(a0[2], a0[3]); xw.z = cvtpk(a1[0], a1[1]); xw.w = cvtpk(a1[2], a1[3]); *(u32x4*)(X1B + o) = xw;
                    const f32x4 w0 = wv[bj][0], w1 = wv[bj][1];
                    u32x4 hw; hw.x = cvtpk(a0[0] * w0[0], a0[1] * w0[1]); hw.y = cvtpk(a0[2] * w0[2], a0[3] * w0[3]); hw.z = cvtpk(a1[0] * w1[0], a1[1] * w1[1]); hw.w = cvtpk(a1[2] * w1[2], a1[3] * w1[3]); *(u32x4*)(HN + o) = hw;
                    ss += ((a0[0] * a0[0] + a0[1] * a0[1]) + (a0[2] * a0[2] + a0[3] * a0[3])) + ((a1[0] * a1[0] + a1[1] * a1[1]) + (a1[2] * a1[2] + a1[3] * a1[3])); }
                ss += __shfl_xor(ss, 16); ss += __shfl_xor(ss, 32);
                if (fq == 0) atomicAdd(sumsq + row, ss); }
        }
    }
};
__device__ __forceinline__ void phase2(ArgsP a, LAS unsigned char* lds, const int tidx) {
    const int tid0 = tidx, w = __builtin_amdgcn_readfirstlane(tid0 >> 6);
    const bf16* XBC = (const bf16*)(a->ws + WS_XBC); const float* DTF = (const float*)(a->ws + WS_DTF);
    bf16* XS = (bf16*)(a->ws + WS_XS); bf16* BC = (bf16*)(a->ws + WS_BC); float* DT = (float*)(a->ws + WS_DT); float* ACUM = (float*)(a->ws + WS_ACUM);
    float* CUMF = (float*)(a->ws + WS_CUMF); float* FTOT = (float*)(a->ws + WS_MISC + MISC_FTOT); bf16* SLOC = (bf16*)(a->ws + WS_SLOC);
    LAS bf16* BT = (LAS bf16*)lds; LAS bf16* XT = (LAS bf16*)(lds + 18432 + w * 9216);
    for (int u = blockIdx.x; u < 2 * NCHUNK; u += gridDim.x) {
        const int tid = opaque(tid0), lane = tid & 63;
        const int c = u >> 1, g = u & 1, t0 = c * 64, h = 8 * g + w;
        const int n = tid & 127, t0v = opaque(t0), tt = t0 + lane;
        float inb[2][2][11];
#pragma unroll
        for (int which = 0; which < 2; ++which)
#pragma unroll
            for (int rr = 0; rr < 2; ++rr) { const int s0 = 8 * ((tid >> 7) + 4 * rr); const unsigned chb = 1024u + which * 256 + 128 * g + n;
#pragma unroll
                for (int j = 0; j < 11; ++j) { const int t = t0v + s0 - 3 + j; inb[which][rr][j] = bf2f(XBC[(unsigned)(t < 0 ? 0 : t) * 1536u + chb]); } }
        const int chx = 64 * h + lane;
        float in[67];
#pragma unroll
        for (int j = 0; j < 67; ++j) { const int t = t0v - 3 + j; in[j] = bf2f(XBC[(unsigned)(j < 3 ? (t < 0 ? 0 : t) : t) * 1536u + (unsigned)chx]); }
        const float dtraw = DTF[(size_t)tt * 32 + h], fraw = DTF[(size_t)tt * 32 + 16 + h];
#pragma unroll
        for (int which = 0; which < 2; ++which) {
            const int ch = 1024 + which * 256 + 128 * g + n;
            const float w0 = a->conv_w[ch], w1 = a->conv_w[1536 + ch], w2 = a->conv_w[2 * 1536 + ch], w3 = a->conv_w[3 * 1536 + ch], cb = a->conv_b[ch];
#pragma unroll
            for (int rr = 0; rr < 2; ++rr) {
                const int s0 = 8 * ((tid >> 7) + 4 * rr);
                float inn[11];
#pragma unroll
                for (int j = 0; j < 11; ++j) inn[j] = (t0 + s0 - 3 + j < 0) ? 0.f : inb[which][rr][j];
                unsigned pk[4];
#pragma unroll
                for (int j = 0; j < 8; j += 2) {
                    const float v0 = siluf(cb + w0 * inn[j] + w1 * inn[j + 1] + w2 * inn[j + 2] + w3 * inn[j + 3]);
                    const float v1 = siluf(cb + w0 * inn[j + 1] + w1 * inn[j + 2] + w2 * inn[j + 3] + w3 * inn[j + 4]);
                    const unsigned p2 = cvtpk(v0, v1); pk[j >> 1] = p2;
                    BC[(size_t)(t0 + s0 + j) * 512 + which * 256 + 128 * g + n] = (bf16)(p2 & 0xffffu);
                    BC[(size_t)(t0 + s0 + j + 1) * 512 + which * 256 + 128 * g + n] = (bf16)(p2 >> 16);
                }
                if (which == 0) *(LAS u32x4*)(BT + n * 72 + s0) = (u32x4){pk[0], pk[1], pk[2], pk[3]};
            }
        }
        float wgt;
        {
            const int t = tt;
            const float dt = softplusf(dtraw + a->dt_bias[h]);
            const float A = -__expf(a->a_log[h]);
            const float acum = wave_scan_incl(dt * A, lane);
            DT[(size_t)t * 16 + h] = dt; ACUM[(size_t)t * 16 + h] = acum;
            const float alast = __shfl(acum, 63);
            wgt = dt * __expf(alast - acum);
            const float lf = logsigmoidf(fraw + a->fox_f_bias[h]);
            const float cl = wave_scan_incl(lf, lane);
            CUMF[(size_t)h * M + t] = cl;
            if (lane == 63) FTOT[h * NCHUNK + c] = cl;
        }
        {
            const int ch = chx;
            const float w0 = a->conv_w[ch], w1 = a->conv_w[1536 + ch], w2 = a->conv_w[2 * 1536 + ch], w3 = a->conv_w[3 * 1536 + ch], cb = a->conv_b[ch];
#pragma unroll
            for (int j = 0; j < 3; ++j) in[j] = (t0 - 3 + j < 0) ? 0.f : in[j];
#pragma unroll
            for (int sb = 0; sb < 8; ++sb) {
                unsigned pk[4];
#pragma unroll
                for (int j = 0; j < 8; j += 2) {
                    const int s = 8 * sb + j;
                    const float v0 = siluf(cb + w0 * in[s] + w1 * in[s + 1] + w2 * in[s + 2] + w3 * in[s + 3]);
                    const float v1 = siluf(cb + w0 * in[s + 1] + w1 * in[s + 2] + w2 * in[s + 3] + w3 * in[s + 4]);
                    const unsigned p2 = cvtpk(v0, v1);
                    XS[(size_t)(t0 + s) * 1024 + ch] = (bf16)(p2 & 0xffffu); XS[(size_t)(t0 + s + 1) * 1024 + ch] = (bf16)(p2 >> 16);
                    const float g0 = __shfl(wgt, s), g1 = __shfl(wgt, s + 1);
                    pk[j >> 1] = cvtpk(bflo(p2) * g0, bfhi(p2) * g1);
                }
                *(LAS u32x4*)(XT + lane * 72 + 8 * sb) = (u32x4){pk[0], pk[1], pk[2], pk[3]};
            }
        }
        __syncthreads();
        {
            const int fr = lane & 15, fq = lane >> 4;
            bf16x8 bfr[4][2];
#pragma unroll
            for (int pt = 0; pt < 4; ++pt)
#pragma unroll
                for (int kk = 0; kk < 2; ++kk) bfr[pt][kk] = *(const LAS bf16x8*)(XT + (16 * pt + fr) * 72 + 8 * fq + 32 * kk);
            bf16* dst = SLOC + ((size_t)(c * 16 + h) * 64) * 128;
#pragma unroll
            for (int nt = 0; nt < 8; ++nt) {
                const bf16x8 a0 = *(const LAS bf16x8*)(BT + (16 * nt + fr) * 72 + 8 * fq), a1 = *(const LAS bf16x8*)(BT + (16 * nt + fr) * 72 + 8 * fq + 32);
#pragma unroll
                for (int pt = 0; pt < 4; ++pt) {
                    f32x4 acc = {0.f, 0.f, 0.f, 0.f};
                    acc = mfma16(a0, bfr[pt][0], acc); acc = mfma16(a1, bfr[pt][1], acc);
                    u32x2 o; o.x = cvtpk(acc[0], acc[1]); o.y = cvtpk(acc[2], acc[3]);
                    *(u32x2*)(dst + (size_t)(16 * pt + fr) * 128 + 16 * nt + 4 * fq) = o;
                }
            }
        }
        __syncthreads();
    }
}

template <bool DRY> __device__ __forceinline__ void phase3(ArgsP a, const int tidx) {
    const int tid = tidx, lane = tid & 63, w = __builtin_amdgcn_readfirstlane(tid >> 6);
    const float* ACUM = (const float*)(a->ws + WS_ACUM); unsigned* SL = (unsigned*)(a->ws + WS_SLOC);
    const int gt = blockIdx.x * NTHR + tid, NGT = gridDim.x * NTHR;
    for (int p8 = (int)blockIdx.x * 64 + lane; w == 0 && p8 < 16384; p8 += (int)gridDim.x * 64) {
        const int h = p8 >> 10; u32x4* SL4 = (u32x4*)SL;
        float st[8];
#pragma unroll
        for (int i = 0; i < 8; ++i) st[i] = 0.f;
        for (int cb = 0; cb < NCHUNK; cb += 32) {
            u32x4 v[32]; float d[32];
#pragma unroll
            for (int j = 0; j < 32; ++j) { v[j] = SL4[(size_t)(cb + j) * 16384 + p8]; d[j] = __expf(ACUM[(size_t)((cb + j) * 64 + 63) * 16 + h]); }
#pragma unroll
            for (int j = 0; j < 32; ++j) { u32x4 o; o.x = cvtpk(st[0], st[1]); o.y = cvtpk(st[2], st[3]); o.z = cvtpk(st[4], st[5]); o.w = cvtpk(st[6], st[7]); SL4[(size_t)(cb + j) * 16384 + p8] = DRY ? v[j] : o;
                st[0] = st[0] * d[j] + bflo(v[j].x); st[1] = st[1] * d[j] + bfhi(v[j].x); st[2] = st[2] * d[j] + bflo(v[j].y); st[3] = st[3] * d[j] + bfhi(v[j].y);
                st[4] = st[4] * d[j] + bflo(v[j].z); st[5] = st[5] * d[j] + bfhi(v[j].z); st[6] = st[6] * d[j] + bflo(v[j].w); st[7] = st[7] * d[j] + bfhi(v[j].w); }
        }
    }
    (void)gt; (void)NGT;
    if (w >= 2) {
        const bf16* Qb = (const bf16*)(a->ws + WS_Q); const bf16* Kb = (const bf16*)(a->ws + WS_K);
        for (int pr = (int)blockIdx.x * 6 + (w - 2); pr < NCHUNK * 16; pr += (int)gridDim.x * 6) { const int c = pr >> 4, hh = pr & 15, t = c * 64 + lane;
            const u32x4* qp = (const u32x4*)(Qb + (size_t)t * 1024 + 64 * hh); const u32x4* kp = (const u32x4*)(Kb + (size_t)t * 1024 + 64 * hh); u32x4 qv[8], kv[8]; float qn = 0.f, kn = 0.f, qk = 0.f;
#pragma unroll
            for (int i = 0; i < 8; ++i) { qv[i] = qp[i]; kv[i] = kp[i]; }
#pragma unroll
            for (int i = 0; i < 8; ++i) {
                qn += bflo(qv[i].x) * bflo(qv[i].x) + bfhi(qv[i].x) * bfhi(qv[i].x) + bflo(qv[i].y) * bflo(qv[i].y) + bfhi(qv[i].y) * bfhi(qv[i].y) + bflo(qv[i].z) * bflo(qv[i].z) + bfhi(qv[i].z) * bfhi(qv[i].z) + bflo(qv[i].w) * bflo(qv[i].w) + bfhi(qv[i].w) * bfhi(qv[i].w);
                kn += bflo(kv[i].x) * bflo(kv[i].x) + bfhi(kv[i].x) * bfhi(kv[i].x) + bflo(kv[i].y) * bflo(kv[i].y) + bfhi(kv[i].y) * bfhi(kv[i].y) + bflo(kv[i].z) * bflo(kv[i].z) + bfhi(kv[i].z) * bfhi(kv[i].z) + bflo(kv[i].w) * bflo(kv[i].w) + bfhi(kv[i].w) * bfhi(kv[i].w); }
#pragma unroll
            for (int i = 0; i < 8; ++i)
                qk += bflo(qv[i].x) * bflo(kv[i].x) + bfhi(qv[i].x) * bfhi(kv[i].x) + bflo(qv[i].y) * bflo(kv[i].y) + bfhi(qv[i].y) * bfhi(kv[i].y) + bflo(qv[i].z) * bflo(kv[i].z) + bfhi(qv[i].z) * bfhi(kv[i].z) + bflo(qv[i].w) * bflo(kv[i].w) + bfhi(qv[i].w) * bfhi(kv[i].w);
            qn = wave_max(qn); kn = wave_max(kn); qk = -wave_max(-qk);
            if (lane == 0) { ((float*)(a->ws + WS_MISC + MISC_QN2))[hh * NCHUNK + c] = qn; ((float*)(a->ws + WS_MISC + MISC_KN2))[hh * NCHUNK + c] = kn; ((float*)(a->ws + WS_MISC + MISC_QKD))[hh * NCHUNK + c] = qk; } }
    }
    for (int hh = (w == 1 ? (int)blockIdx.x : 16); hh < 16; hh += (int)gridDim.x) {
        const float* FTOT = (const float*)(a->ws + WS_MISC + MISC_FTOT) + hh * NCHUNK; float* CF = (float*)(a->ws + WS_CUMF) + (size_t)hh * M;
        const f32x4 tv = *(const f32x4*)(FTOT + 4 * lane);
        const float tot = (tv.x + tv.y) + (tv.z + tv.w);
        const float incl = wave_scan_incl(tot, lane); float pre = incl - tot;
#pragma unroll
        for (int k = 0; k < 4; ++k) {
            f32x4* p = (f32x4*)(CF + (size_t)(4 * lane + k) * 64);
#pragma unroll 4
            for (int j = 0; j < 16; ++j) { f32x4 v = p[j]; if (!DRY) v = (v + pre) * LOG2E; p[j] = v; }
            pre += tv[k];
        }
    }
}
__device__ __forceinline__ void phase4(ArgsP a, LAS unsigned char* lds, const int tidx) {
    const int tid0 = tidx, w = __builtin_amdgcn_readfirstlane(tid0 >> 6);
    const bf16* XS = (const bf16*)(a->ws + WS_XS); const bf16* BC = (const bf16*)(a->ws + WS_BC); const float* DT = (const float*)(a->ws + WS_DT); const float* ACUM = (const float*)(a->ws + WS_ACUM);
    const bf16* PREV = (const bf16*)(a->ws + WS_SLOC); const bf16* Z = (const bf16*)(a->ws + WS_Z); bf16* MIX = (bf16*)(a->ws + WS_MIX);
    LAS bf16* CS = (LAS bf16*)lds; LAS bf16* BS = (LAS bf16*)(lds + 17408); LAS float* CBm = (LAS float*)(lds + 34816);
    LAS bf16* XT = (LAS bf16*)(lds + 52224 + w * 9216); LAS float* AC = (LAS float*)(lds + 125952 + w * 256); LAS float* SSW = (LAS float*)(lds + 128000); LAS float* DTs = (LAS float*)(lds + 130048 + w * 256);
    for (int u = blockIdx.x; u < 2 * NCHUNK; u += gridDim.x) {
        const int tid = opaque(tid0), lane = tid & 63, fr = lane & 15, fq = lane >> 4;
        const int c = u >> 1, g = u & 1, t0 = c * 64, h = 8 * g + w;
        bf16x8 pvf[4][4];
        { const bf16* pv = PREV + ((size_t)(c * 16 + h) * 64) * 128;
#pragma unroll
          for (int kk = 0; kk < 4; ++kk)
#pragma unroll
              for (int j = 0; j < 4; ++j) pvf[kk][j] = *(const bf16x8*)(pv + (size_t)(16 * j + fr) * 128 + 8 * fq + 32 * kk); }
        unsigned short zv[4][4][4];
#pragma unroll
        for (int i = 0; i < 4; ++i)
#pragma unroll
            for (int r = 0; r < 4; ++r)
#pragma unroll
                for (int j = 0; j < 4; ++j) zv[i][r][j] = Z[(size_t)(t0 + 16 * i + 4 * fq + r) * 1024 + 64 * h + 16 * j + fr];
#pragma unroll
        for (int i = 0; i < 2; ++i) { const int q = tid + 512 * i, row = q >> 4, c16 = q & 15;
            *(LAS u32x4*)(CS + row * 136 + c16 * 8) = *(const u32x4*)(BC + (size_t)(t0 + row) * 512 + 256 + 128 * g + c16 * 8);
            *(LAS u32x4*)(BS + row * 136 + c16 * 8) = *(const u32x4*)(BC + (size_t)(t0 + row) * 512 + 128 * g + c16 * 8); }
        DTs[lane] = DT[(size_t)(t0 + lane) * 16 + h];
        AC[lane] = ACUM[(size_t)(t0 + lane) * 16 + h];
        {
            const int ch = 64 * h + lane;
            float xin[64];
#pragma unroll
            for (int s = 0; s < 64; ++s) xin[s] = bf2f(XS[(size_t)(t0 + s) * 1024 + ch]);
#pragma unroll
            for (int sb = 0; sb < 8; ++sb) {
                unsigned pk[4];
#pragma unroll
                for (int j = 0; j < 8; j += 2) { const int s = 8 * sb + j; pk[j >> 1] = cvtpk(xin[s], xin[s + 1]); }
                *(LAS u32x4*)(XT + lane * 72 + 8 * sb) = (u32x4){pk[0], pk[1], pk[2], pk[3]};
            }
        }
        __syncthreads();
#pragma unroll
        for (int x = 0; x < 2; ++x) { const int id = 2 * w + x, ti = id >> 2, si = id & 3; f32x4 acc = {0.f, 0.f, 0.f, 0.f};
#pragma unroll
            for (int kk = 0; kk < 4; ++kk) acc = mfma16(*(const LAS bf16x8*)(CS + (16 * ti + fr) * 136 + 8 * fq + 32 * kk), *(const LAS bf16x8*)(BS + (16 * si + fr) * 136 + 8 * fq + 32 * kk), acc);
#pragma unroll
            for (int r = 0; r < 4; ++r) CBm[(16 * ti + 4 * fq + r) * 68 + 16 * si + fr] = acc[r]; }
        __syncthreads();
        f32x4 acc[4][4];
#pragma unroll
        for (int i = 0; i < 4; ++i)
#pragma unroll
            for (int j = 0; j < 4; ++j) acc[i][j] = (f32x4){0.f, 0.f, 0.f, 0.f};
        {
#pragma unroll
            for (int kk = 0; kk < 4; ++kk) {
                bf16x8 af[4];
#pragma unroll
                for (int i = 0; i < 4; ++i) af[i] = *(const LAS bf16x8*)(CS + (16 * i + fr) * 136 + 8 * fq + 32 * kk);
#pragma unroll
                for (int i = 0; i < 4; ++i)
#pragma unroll
                    for (int j = 0; j < 4; ++j) acc[i][j] = mfma16(af[i], pvf[kk][j], acc[i][j]);
            }
#pragma unroll
            for (int i = 0; i < 4; ++i)
#pragma unroll
                for (int r = 0; r < 4; ++r) { const float e = __expf(AC[16 * i + 4 * fq + r]);
#pragma unroll
                    for (int j = 0; j < 4; ++j) acc[i][j][r] *= e; }
        }
#pragma unroll
        for (int kk = 0; kk < 2; ++kk) {
            bf16x8 bfv[4];
#pragma unroll
            for (int j = 0; j < 4; ++j) bfv[j] = *(const LAS bf16x8*)(XT + (16 * j + fr) * 72 + 8 * fq + 32 * kk);
            const int sbase = 8 * fq + 32 * kk;
            const f32x4 as0 = *(const LAS f32x4*)(AC + sbase), as1 = *(const LAS f32x4*)(AC + sbase + 4); const f32x4 ds0 = *(const LAS f32x4*)(DTs + sbase), ds1 = *(const LAS f32x4*)(DTs + sbase + 4);
#pragma unroll
            for (int i = 0; i < 4; ++i) {
                const int t = 16 * i + fr; const float act = AC[t];
                const f32x4 c0 = *(const LAS f32x4*)(CBm + t * 68 + sbase), c1 = *(const LAS f32x4*)(CBm + t * 68 + sbase + 4);
                float m[8];
#pragma unroll
                for (int jj = 0; jj < 4; ++jj) { m[jj] = (sbase + jj <= t) ? c0[jj] * ds0[jj] * __expf(fminf(act - as0[jj], 0.f)) : 0.f; m[4 + jj] = (sbase + 4 + jj <= t) ? c1[jj] * ds1[jj] * __expf(fminf(act - as1[jj], 0.f)) : 0.f; }
                u32x4 mp; mp.x = cvtpk(m[0], m[1]); mp.y = cvtpk(m[2], m[3]); mp.z = cvtpk(m[4], m[5]); mp.w = cvtpk(m[6], m[7]);
                const bf16x8 af = __builtin_bit_cast(bf16x8, mp);
#pragma unroll
                for (int j = 0; j < 4; ++j) acc[i][j] = mfma16(af, bfv[j], acc[i][j]);
            }
        }
        const float Dh = a->d_skip[h];
#pragma unroll
        for (int i = 0; i < 4; ++i)
#pragma unroll
            for (int r = 0; r < 4; ++r) { const int t = 16 * i + 4 * fq + r; float ss = 0.f;
#pragma unroll
                for (int j = 0; j < 4; ++j) {
#if SELFCHECK
                    { const size_t o = (size_t)(t0 + t) * 1024 + 64 * h + 16 * j + fr; if (t0 + t < 8192) ((float*)(a->ws + (size_t)464 * MiB))[o] = acc[i][j][r]; }
#endif
                    const float xv = bf2f(XT[(16 * j + fr) * 72 + t]);
                    const float y = (acc[i][j][r] + Dh * xv) * siluf(bf2f(zv[i][r][j])); acc[i][j][r] = y; ss += y * y; }
                ss += __shfl_xor(ss, 1); ss += __shfl_xor(ss, 2); ss += __shfl_xor(ss, 4); ss += __shfl_xor(ss, 8);
                if (fr == 0) SSW[w * 64 + t] = ss; }
        __syncthreads();
#pragma unroll
        for (int i = 0; i < 4; ++i)
#pragma unroll
            for (int r = 0; r < 4; ++r) { const int t = 16 * i + 4 * fq + r; float ss = 0.f;
#pragma unroll
                for (int ww = 0; ww < 8; ++ww) ss += SSW[ww * 64 + t];
                const float rstd = 1.f / sqrtf(ss * (1.f / 512.f) + EPS);
#pragma unroll
                for (int j = 0; j < 4; ++j) { const int ch = 64 * h + 16 * j + fr; MIX[(size_t)(t0 + t) * DM + ch] = f2bf(acc[i][j][r] * rstd * a->ssd_norm_w[ch]); } }
        __syncthreads();
    }
}

__device__ __forceinline__ void phase_attn(ArgsP a, LAS unsigned char* lds, const int tidx) {
    const int tid0 = tidx, w = __builtin_amdgcn_readfirstlane(tid0 >> 6);
    const bf16* Q = (const bf16*)(a->ws + WS_Q); const bf16* K = (const bf16*)(a->ws + WS_K); const bf16* V = (const bf16*)(a->ws + WS_V); const float* CL = (const float*)(a->ws + WS_CUMF);
    bf16* MIX = (bf16*)(a->ws + WS_MIX);
    LAS bf16* KS = (LAS bf16*)lds; LAS bf16* VT = (LAS bf16*)(lds + 9216); LAS float* CK = (LAS float*)(lds + 18432); LAS bf16* PS = (LAS bf16*)(lds + 18688 + w * 2304);
    const int G = gridDim.x;
    for (int i = 0;; ++i) {
        const int uidx = i * G + (int)blockIdx.x; if (uidx >= 2048) break;
        const int tid = opaque(tid0), lane = tid & 63, fr = lane & 15, fq = lane >> 4;
        const int slot = uidx >> 8, pos = uidx & 255, grp = pos >> 4, h = pos & 15;
        const int rnk = 16 * slot + ((slot & 1) ? 15 - grp : grp);
        const int qb = 127 - rnk;
        const int q0 = qb * 128 + 16 * w;
        const bf16x8 qf0 = *(const bf16x8*)(Q + (size_t)(q0 + fr) * 1024 + 64 * h + 8 * fq), qf1 = *(const bf16x8*)(Q + (size_t)(q0 + fr) * 1024 + 64 * h + 8 * fq + 32);
        float cq[4], mrun[4], lrun[4]; f32x4 o[4];
#pragma unroll
        for (int r = 0; r < 4; ++r) { cq[r] = CL[(size_t)h * M + q0 + 4 * fq + r]; mrun[r] = -3.0e38f; lrun[r] = 0.f; }
#pragma unroll
        for (int d = 0; d < 4; ++d) o[d] = (f32x4){0.f, 0.f, 0.f, 0.f};
        const int ntile = 2 * qb + 2;
        for (int kt = 0; kt < ntile; ++kt) {
            const int k0 = kt * 64;
            { const int row = tid >> 3, c16 = tid & 7; *(LAS u32x4*)(KS + row * 72 + c16 * 8) = *(const u32x4*)(K + (size_t)(k0 + row) * 1024 + 64 * h + c16 * 8);
              const int d = tid & 63, kb = tid >> 6; unsigned pk[4];
#pragma unroll
              for (int j = 0; j < 8; j += 2) { const unsigned lo = V[(size_t)(k0 + 8 * kb + j) * 1024 + 64 * h + d], hi = V[(size_t)(k0 + 8 * kb + j + 1) * 1024 + 64 * h + d]; pk[j >> 1] = lo | (hi << 16); }
              *(LAS u32x4*)(VT + d * 72 + 8 * kb) = (u32x4){pk[0], pk[1], pk[2], pk[3]};
              if (tid < 64) CK[tid] = CL[(size_t)h * M + k0 + tid]; }
            __syncthreads();
            f32x4 s[4];
#pragma unroll
            for (int nt = 0; nt < 4; ++nt) { s[nt] = (f32x4){0.f, 0.f, 0.f, 0.f};
                s[nt] = mfma16(qf0, *(const LAS bf16x8*)(KS + (16 * nt + fr) * 72 + 8 * fq), s[nt]);
                s[nt] = mfma16(qf1, *(const LAS bf16x8*)(KS + (16 * nt + fr) * 72 + 8 * fq + 32), s[nt]); }
            float mx[4];
#pragma unroll
            for (int r = 0; r < 4; ++r) { const int qg = q0 + 4 * fq + r; float m = -INFINITY;
#pragma unroll
                for (int nt = 0; nt < 4; ++nt) { const int kg = k0 + 16 * nt + fr; float v = s[nt][r] + (cq[r] - CK[16 * nt + fr]); v = kg > qg ? -INFINITY : v; s[nt][r] = v; m = fmaxf(m, v); }
                m = fmaxf(m, __shfl_xor(m, 1)); m = fmaxf(m, __shfl_xor(m, 2)); m = fmaxf(m, __shfl_xor(m, 4)); m = fmaxf(m, __shfl_xor(m, 8)); mx[r] = m; }
#pragma unroll
            for (int r = 0; r < 4; ++r) { const float mn = fmaxf(mrun[r], mx[r]); const float al = exp2f(mrun[r] - mn); mrun[r] = mn; float ps = 0.f;
#pragma unroll
                for (int nt = 0; nt < 4; ++nt) { const float p = exp2f(s[nt][r] - mn); ps += p; PS[(4 * fq + r) * 72 + 16 * nt + fr] = f2bf(p); }
                lrun[r] = lrun[r] * al + ps;
#pragma unroll
                for (int d = 0; d < 4; ++d) o[d][r] *= al; }
            asm volatile("s_waitcnt lgkmcnt(0)" ::: "memory");
            const bf16x8 pf0 = *(const LAS bf16x8*)(PS + fr * 72 + 8 * fq), pf1 = *(const LAS bf16x8*)(PS + fr * 72 + 8 * fq + 32);
#pragma unroll
            for (int d = 0; d < 4; ++d) { o[d] = mfma16(pf0, *(const LAS bf16x8*)(VT + (16 * d + fr) * 72 + 8 * fq), o[d]); o[d] = mfma16(pf1, *(const LAS bf16x8*)(VT + (16 * d + fr) * 72 + 8 * fq + 32), o[d]); }
            __syncthreads();
        }
#pragma unroll
        for (int r = 0; r < 4; ++r) { float l = lrun[r]; l += __shfl_xor(l, 1); l += __shfl_xor(l, 2); l += __shfl_xor(l, 4); l += __shfl_xor(l, 8); const float il = 1.f / l;
#pragma unroll
            for (int d = 0; d < 4; ++d) MIX[(size_t)(q0 + 4 * fq + r) * DM + 1024 + 64 * h + 16 * d + fr] = f2bf(o[d][r] * il); }
    }
}
constexpr size_t WS_U8 = 400 * MiB, WS_V8 = 432 * MiB;
constexpr size_t WS_PLAN = 496 * MiB, WS_PARTL = 497 * MiB;
constexpr size_t WS_USC = WS_K12 + 512 * 1024, WS_VSC = WS_K12 + 576 * 1024;
#ifndef PEERV_I8
#define PEERV_I8 1
#endif
constexpr size_t WS_CSC = 109 * MiB;
__device__ __forceinline__ int pack_i8x4(float a, float b, float c, float d) { const int i0 = __float2int_rn(a), i1 = __float2int_rn(b), i2 = __float2int_rn(c), i3 = __float2int_rn(d); return (i0 & 255) | ((i1 & 255) << 8) | ((i2 & 255) << 16) | (i3 << 24); }
__device__ __forceinline__ void convert_uv_fp8_item(ArgsP a, const int tidx, const int item) {
    const int lane = tidx & 63, w = tidx >> 6;
    unsigned char* U8 = (unsigned char*)(a->ws + WS_U8); unsigned char* V8 = (unsigned char*)(a->ws + WS_V8);
    for (int row0 = 32 * item + 4 * w; row0 < 32 * item + 4 * w + 4; row0 += 2) {
        f32x4 x[2][8]; float mx[2] = {0.f, 0.f};
#pragma unroll
        for (int q = 0; q < 2; ++q) { const int row = row0 + q; const bool second = row >= 16384; const int e = row & 16383; const f32x4* src = (const f32x4*)((second ? a->peer_v : a->peer_u) + (size_t)e * DM) + lane;
#pragma unroll
            for (int j = 0; j < 8; ++j) x[q][j] = src[64 * j]; }
#pragma unroll
        for (int q = 0; q < 2; ++q) { const int row = row0 + q; const bool second = row >= 16384; const int e = row & 16383; unsigned char* dst = second ? V8 : U8;
#pragma unroll
            for (int j = 0; j < 8; ++j) mx[q] = fmaxf(mx[q], fmaxf(fmaxf(fabsf(x[q][j][0]), fabsf(x[q][j][1])), fmaxf(fabsf(x[q][j][2]), fabsf(x[q][j][3]))));
            const float mxa = wave_max(mx[q]); const float sc = mxa > 0.f ? ((second && !PEERV_I8) ? 440.f : 127.f) / mxa : 1.f;
            if (lane == 0) ((float*)(a->ws + (second ? WS_VSC : WS_USC)))[e] = 1.f / sc;
#pragma unroll
            for (int j = 0; j < 8; ++j) { const int s = 2 * j + (lane >> 5); int p;
                if (second && !PEERV_I8) { p = __builtin_amdgcn_cvt_pk_fp8_f32(x[q][j][0] * sc, x[q][j][1] * sc, 0, false); p = __builtin_amdgcn_cvt_pk_fp8_f32(x[q][j][2] * sc, x[q][j][3] * sc, p, true); }
                else p = pack_i8x4(x[q][j][0] * sc, x[q][j][1] * sc, x[q][j][2] * sc, x[q][j][3] * sc);
                *(int*)(dst + ((size_t)s * 16384 + e) * 128 + 4 * (lane & 31)) = p; } } }
}
namespace attn_body {
using bf16=unsigned short;
using bf16x8=__attribute__((ext_vector_type(8)))short;
using s16x4=__attribute__((ext_vector_type(4)))short;
using f32x16=__attribute__((ext_vector_type(16)))float;
using u32x4=__attribute__((ext_vector_type(4)))unsigned;
constexpr int BATCH=1,NHEAD=16,SEQ=16384,D=64,DM=NHEAD*D,OPITCH=2048,OCOL=1024;
constexpr int NW=8,QBLK=32,QB=QBLK*NW,KVBLK=64,NQB=SEQ/QB;
constexpr int ATTN_PITCH=DM, ATTN_UNIT_ROWS=QB;
__device__ __forceinline__ int crow(int r,int hi){return (r&3)+8*(r>>2)+4*hi;}
#define SBAR() __builtin_amdgcn_sched_barrier(0)
__device__ __forceinline__ void cmask(f32x16&p0,f32x16&p1,int jb,int qrel,int hi){
  const float NEG=-INFINITY; int kb=64*jb+4*hi;
  #pragma unroll
  for(int r=0;r<16;++r){int kv=kb+(r&3)+8*(r>>2); if(kv>qrel)p0[r]=NEG; if(kv+32>qrel)p1[r]=NEG;}
}

constexpr int NSLOT=3, SLOTB=8192;
constexpr int LDS_K=0, LDS_V=NSLOT*SLOTB, LDS_WS=2*NSLOT*SLOTB, LDS_OST=LDS_WS+NW*64*4, LDS_CL=LDS_OST+NW*4096, LDS_BYTES=LDS_CL+SEQ*4;
constexpr float C2=0.125f*1.4426950408889634f;
__device__ __forceinline__ void glds16(const void*gsrc,unsigned lds_dst){unsigned keep;
  asm volatile("s_mov_b32 %0, m0\n\ts_mov_b32 m0, %2\n\ts_nop 0\n\tglobal_load_lds_dwordx4 %1, off\n\ts_mov_b32 m0, %0":"=&s"(keep):"v"(gsrc),"s"(lds_dst):"memory");}
__device__ __forceinline__ float max3f(float a,float b,float c){float r;asm("v_max3_f32 %0, %1, %2, %3":"=v"(r):"v"(a),"v"(b),"v"(c));return r;}
__device__ __forceinline__ float max2f(float a,float b){float r;asm("v_max_f32_e32 %0, %1, %2":"=v"(r):"v"(a),"v"(b));return r;}
__device__ __forceinline__ float fadd_s(float a,float b){float r;asm("v_add_f32_e32 %0, %1, %2":"=v"(r):"v"(a),"v"(b));return r;}
__device__ __forceinline__ float fsub_s(float a,float b){float r;asm("v_sub_f32_e32 %0, %1, %2":"=v"(r):"v"(a),"v"(b));return r;}
typedef float f32x2_t __attribute__((ext_vector_type(2))); typedef float f32x4_t __attribute__((ext_vector_type(4))); typedef __bf16 bf16x2_t __attribute__((ext_vector_type(2)));
__device__ __forceinline__ unsigned cvtpk_s(float lo,float hi){f32x2_t v={lo,hi};bf16x2_t b=__builtin_convertvector(v,bf16x2_t);return __builtin_bit_cast(unsigned,b);}
#define WAIT_BAR(N) asm volatile("s_waitcnt vmcnt(" #N ") lgkmcnt(0)\n\ts_barrier":::"memory")

__device__ __forceinline__ void qkt(f32x16&p0,f32x16&p1,const char*Kslot,const bf16x8*qr,const f32x16&i0,const f32x16&i1,int r32,int hi){
  const char*kb=Kslot+hi*1024+r32*16;
  #pragma unroll
  for(int d0=0;d0<4;++d0){
    const bf16x8 b0=*reinterpret_cast<const bf16x8*>(kb+d0*2048);
    const bf16x8 b1=*reinterpret_cast<const bf16x8*>(kb+d0*2048+512);
    if(d0==0){p0=__builtin_amdgcn_mfma_f32_32x32x16_bf16(b0,qr[0],i0,0,0,0);p1=__builtin_amdgcn_mfma_f32_32x32x16_bf16(b1,qr[0],i1,0,0,0);}
    else{p0=__builtin_amdgcn_mfma_f32_32x32x16_bf16(b0,qr[d0],p0,0,0,0);p1=__builtin_amdgcn_mfma_f32_32x32x16_bf16(b1,qr[d0],p1,0,0,0);}}
}
typedef __attribute__((address_space(3))) const char* lds_cptr;
typedef short v4i16_t __attribute__((ext_vector_type(4)));
__device__ __forceinline__ void kload8(bf16x8*kf,lds_cptr kp){
  kf[0]=*(const __attribute__((address_space(3))) bf16x8*)(kp);      kf[1]=*(const __attribute__((address_space(3))) bf16x8*)(kp+512);
  kf[2]=*(const __attribute__((address_space(3))) bf16x8*)(kp+2048); kf[3]=*(const __attribute__((address_space(3))) bf16x8*)(kp+2560);
  kf[4]=*(const __attribute__((address_space(3))) bf16x8*)(kp+4096); kf[5]=*(const __attribute__((address_space(3))) bf16x8*)(kp+4608);
  kf[6]=*(const __attribute__((address_space(3))) bf16x8*)(kp+6144); kf[7]=*(const __attribute__((address_space(3))) bf16x8*)(kp+6656);
}
__device__ __forceinline__ void kload2(bf16x8*kf,lds_cptr kp,int j){ kf[2*j]=*(const __attribute__((address_space(3))) bf16x8*)(kp+j*2048); kf[2*j+1]=*(const __attribute__((address_space(3))) bf16x8*)(kp+j*2048+512); }
__device__ __forceinline__ s16x4 vtr(lds_cptr p){ return __builtin_bit_cast(s16x4,__builtin_amdgcn_ds_read_tr16_b64_v4i16((__attribute__((address_space(3))) v4i16_t*)p)); }
__device__ __forceinline__ float rowmax(const f32x16&p0,const f32x16&p1){
  float a=max3f(p0[0],p0[1],p1[0]),b=max3f(p0[2],p0[3],p1[1]);a=max3f(a,p1[2],p1[3]);
  #pragma unroll
  for(int r=4;r<16;r+=4){a=max3f(a,p0[r],p0[r+1]);b=max3f(b,p0[r+2],p0[r+3]);a=max3f(a,p1[r],p1[r+1]);b=max3f(b,p1[r+2],p1[r+3]);}
  const float m=max2f(a,b);
  auto rr=__builtin_amdgcn_permlane32_swap(__float_as_uint(m),__float_as_uint(m),false,false);
  return max2f(__uint_as_float(rr[0]),__uint_as_float(rr[1]));
}
__device__ __forceinline__ void pv(f32x16*o,int vb,bf16x8 pa0,bf16x8 pa1,bf16x8 pa2,bf16x8 pa3){
  #pragma unroll
  for(int d0=0;d0<2;++d0){s16x4 lo[4],hi[4];
    #pragma unroll
    for(int ks=0;ks<4;++ks){
      asm volatile("ds_read_b64_tr_b16 %0,%1 offset:%c2":"=&v"(lo[ks]):"v"(vb),"i"(d0*4096+ks*1024):"memory");
      asm volatile("ds_read_b64_tr_b16 %0,%1 offset:%c2":"=&v"(hi[ks]):"v"(vb),"i"(d0*4096+ks*1024+512):"memory");}
    asm volatile("s_waitcnt lgkmcnt(0)":::"memory");SBAR();
    #define PK(k) (bf16x8){lo[k][0],lo[k][1],lo[k][2],lo[k][3],hi[k][0],hi[k][1],hi[k][2],hi[k][3]}
    o[d0]=__builtin_amdgcn_mfma_f32_32x32x16_bf16(pa0,PK(0),o[d0],0,0,0);
    o[d0]=__builtin_amdgcn_mfma_f32_32x32x16_bf16(pa1,PK(1),o[d0],0,0,0);
    o[d0]=__builtin_amdgcn_mfma_f32_32x32x16_bf16(pa2,PK(2),o[d0],0,0,0);
    o[d0]=__builtin_amdgcn_mfma_f32_32x32x16_bf16(pa3,PK(3),o[d0],0,0,0);
    #undef PK
  }
}

#ifndef ATTN_STORE16
#define ATTN_STORE16(p,v) (*(u32x4*)(p)=(v))
#endif
template<int THRL> __device__ __forceinline__ void attn_unit(int b,int h,int qb,const bf16*Q,const bf16*__restrict__ K,const bf16*__restrict__ V,bf16*O,const float*__restrict__ CLh,const float*__restrict__ QN2h,const float*__restrict__ KN2h,const float*__restrict__ QKDh,char*shm,const int tid_in){
  const int tid=tid_in,lane=tid&63,r32=lane&31,hi=lane>>5; const int wid=__builtin_amdgcn_readfirstlane(tid>>6);
  const long rowbase=(long)b*SEQ; const int q0=qb*QB;
  const bf16*Qw=Q+(rowbase+q0+wid*QBLK)*DM+h*D;
  int Ts;
  { const int NT0=(q0+QB)/KVBLK;
    const float qn=__builtin_sqrtf(__builtin_fmaxf(__builtin_fmaxf(QN2h[4*qb],QN2h[4*qb+1]),__builtin_fmaxf(QN2h[4*qb+2],QN2h[4*qb+3])));
    const float dmin=__builtin_fminf(__builtin_fminf(QKDh[4*qb],QKDh[4*qb+1]),__builtin_fminf(QKDh[4*qb+2],QKDh[4*qb+3]))-0.01f, clq0=CLh[q0]; int first=NT0;
    _Pragma("unroll") for(int j=3;j>=0;--j){ const int Tt=lane+64*j; const bool in=Tt<NT0; const bool keep=in&&!(qn*__builtin_sqrtf(KN2h[in?Tt:0])+clq0-CLh[in?64*Tt+63:0]-dmin<-48.f);
      const unsigned long long nm=__ballot(keep); if(nm)first=64*j+(int)__builtin_ctzll(nm); }
    Ts=first&~1; if(Ts>NT0-4)Ts=NT0-4; Ts=__builtin_amdgcn_readfirstlane(Ts); }
  const bf16*Kh=K+(rowbase+(long)Ts*KVBLK)*DM+h*D,*Vh=V+(rowbase+(long)Ts*KVBLK)*DM+h*D;
  const lds_cptr shm3=(lds_cptr)shm;
  const unsigned lds0=(unsigned)(uintptr_t)shm;
  float*wsf=(float*)(shm+LDS_WS)+wid*64;
  const bf16*ksrc=Kh+(long)lane*DM+wid*8;
  const bf16*vsrc=Vh+(long)(16*(wid&3)+(lane>>2))*DM+(wid>>2)*32+(lane&3)*8;
  const unsigned kdst=lds0+LDS_K+wid*1024, vdst=lds0+LDS_V+wid*1024;
  #define DMA_K(t,slot) glds16(ksrc+(long)(t)*KVBLK*DM,(unsigned)__builtin_amdgcn_readfirstlane(kdst+(slot)))
  #define DMA_V(t,slot) glds16(vsrc+(long)(t)*KVBLK*DM,(unsigned)__builtin_amdgcn_readfirstlane(vdst+(slot)))
  const int vb0=(int)(lds0+LDS_V)+((lane>>4)&1)*32+(lane&3)*8+(4*hi+((lane&15)>>2))*64;
  const char*Kbase=shm+LDS_K; bf16x8 kf[8];
  const lds_cptr kp0=shm3+LDS_K+hi*1024+r32*16; const lds_cptr vp0=shm3+LDS_V+((lane>>4)&1)*32+(lane&3)*8+(4*hi+((lane&15)>>2))*64;
  const int NT=(q0+QB)/KVBLK-Ts;
  typedef __attribute__((address_space(3))) float* lds_fptr; typedef __attribute__((address_space(3))) const f32x4_t* lds_f4ptr;
  { typedef __attribute__((address_space(3))) f32x4_t* lds_f4w; lds_f4w clw=(lds_f4w)(shm3+LDS_CL); const f32x4_t*cls=(const f32x4_t*)(CLh+Ts*KVBLK); const int ncl4=(q0+QB-Ts*KVBLK)>>2; _Pragma("nounroll") for(int i=tid;i<ncl4;i+=NW*64)clw[i]=cls[i]; }
  const lds_f4ptr clp=(lds_f4ptr)(shm3+LDS_CL+16*hi);
  float nb=CLh[q0+wid*QBLK+r32];
  #define CKLOAD(X0,X1,t) do{ const lds_f4ptr cb_=clp+(t)*16; \
    _Pragma("unroll") for(int g_=0;g_<4;++g_){ const f32x4_t a_=cb_[2*g_], b_=cb_[8+2*g_]; \
      _Pragma("unroll") for(int i_=0;i_<4;++i_){ X0[4*g_+i_]=a_[i_]; X1[4*g_+i_]=b_[i_]; } } }while(0)
  #define BIASSUB(C0,C1) do{ _Pragma("unroll") for(int r_=0;r_<16;++r_){ C0[r_]=nb-C0[r_]; C1[r_]=nb-C1[r_]; } }while(0)
  DMA_K(0,0);DMA_V(0,0);DMA_K(1,SLOTB);
  bf16x8 qr[4];
  #pragma unroll
  for(int d0=0;d0<4;++d0)qr[d0]=*reinterpret_cast<const bf16x8*>(&Qw[(long)r32*DM+d0*16+hi*8]);
  float l_reg=0.f;f32x16 o[2];o[0]=f32x16{};o[1]=f32x16{};
  const int qrel=wid*QBLK+r32;
  #define CMASK(P0,P1,t) do{int jb_=(t)-(NT-4); if(jb_>=0)cmask(P0,P1,jb_,qrel,hi);}while(0)
  bool resc=false;
  #define START(P0,P1) do{ const float rm=rowmax(P0,P1); resc=false; \
    { const float dl=rm; nb=fsub_s(nb,dl); \
      _Pragma("unroll") for(int r=0;r<16;++r){P0[r]=fsub_s(P0[r],dl);P1[r]=fsub_s(P1[r],dl);} } \
    _Pragma("unroll") for(int r=0;r<16;++r)P0[r]=__builtin_amdgcn_exp2f(P0[r]); }while(0)
  #define RESC() do{ if(resc){ asm volatile("s_waitcnt lgkmcnt(0)":::"memory"); \
      _Pragma("unroll") for(int d_=0;d_<2;++d_) _Pragma("unroll") for(int r=0;r<16;++r)o[d_][r]*=wsf[crow(r,hi)]; } }while(0)
  f32x16 pA0,pA1,pB0,pB1;
  int sl_prev=0,sl_cur=0,sl_next=SLOTB;
  #define ROT() do{sl_prev=sl_cur;sl_cur=sl_next;sl_next=(sl_next==(NSLOT-1)*SLOTB)?0:sl_next+SLOTB;}while(0)
  DMA_K(2,2*SLOTB);
  WAIT_BAR(3);
  CKLOAD(pA0,pA1,0); BIASSUB(pA0,pA1);
  qkt(pA0,pA1,Kbase,qr,pA0,pA1,r32,hi);asm volatile("s_nop 15\n\ts_nop 7":"+v"(pA0),"+v"(pA1));CMASK(pA0,pA1,0);
  START(pA0,pA1);
  _Pragma("unroll") for(int r=0;r<16;++r)pA1[r]=__builtin_amdgcn_exp2f(pA1[r]);
  WAIT_BAR(0);
  DMA_K(3,0);DMA_V(1,SLOTB);
  ROT();
  kload8(kf,kp0+sl_cur);
  WAIT_BAR(2);
  s16x4 vlo[8],vhi[8]; u32x4 pw0,pw1,pw2,pw3;
  #define PKW(P,B) cvtpk_s(P[B],P[B+1])
  #define PAF(k) __builtin_bit_cast(bf16x8,pw##k)
  #define VFR(i) (bf16x8){vlo[i][0],vlo[i][1],vlo[i][2],vlo[i][3],vhi[i][0],vhi[i][1],vhi[i][2],vhi[i][3]}
  #define PIN(x) asm volatile("":"+v"(x))
  #define MX3(a,b,c) __builtin_fmaxf(__builtin_fmaxf((a),(b)),(c))
  #define GAPA(MF,A0,A1,A2,A3,W0,W1,PW) do{ MF; sacc+=A0; sacc+=A1; sacc+=A2; sacc+=A3; PIN(sacc); W0; W1; PIN(PW); SBAR(); }while(0)
  #define EX(v) __builtin_amdgcn_exp2f(v)
  #define GAPB(MF,X,B) do{ MF; X[B]=EX(X[B]); X[B+1]=EX(X[B+1]); X[B+2]=EX(X[B+2]); X[B+3]=EX(X[B+3]); PIN(X); SBAR(); }while(0)
  #define VRD(i) do{ vlo[i]=vtr(vp_+(((i)>>2)*4096+((i)&3)*1024)); vhi[i]=vtr(vp_+(((i)>>2)*4096+((i)&3)*1024+512)); }while(0)
  #define KRD(G,j) do{ if(G){ kload2(kf,kp0+sl_next,j); SBAR(); } }while(0)
  #define STEP(C0,C1,P0,P1,t,GK,GV,GL) do{ CKLOAD(C0,C1,t); asm volatile("":"+v"(C0),"+v"(C1)); BIASSUB(C0,C1); SBAR(); \
    const lds_cptr vp_=vp0+sl_prev; \
    VRD(0); SBAR(); float sacc=(P0[0]+P0[1]); \
    GAPA(C0=__builtin_amdgcn_mfma_f32_32x32x16_bf16(kf[0],qr[0],C0,0,0,0), P0[2],P0[3],P0[4],P0[5],     pw0[0]=PKW(P0,0), pw0[1]=PKW(P0,2), pw0); \
    VRD(4); SBAR(); GAPA(C1=__builtin_amdgcn_mfma_f32_32x32x16_bf16(kf[1],qr[0],C1,0,0,0), P0[6],P0[7],P0[8],P0[9],     pw0[2]=PKW(P0,4), pw0[3]=PKW(P0,6), pw0); \
    VRD(1); SBAR(); GAPA(C0=__builtin_amdgcn_mfma_f32_32x32x16_bf16(kf[2],qr[1],C0,0,0,0),   P0[10],P0[11],P0[12],P0[13], pw1[0]=PKW(P0,8), pw1[1]=PKW(P0,10), pw1); \
    VRD(5); SBAR(); GAPA(C1=__builtin_amdgcn_mfma_f32_32x32x16_bf16(kf[3],qr[1],C1,0,0,0),   P0[14],P0[15],P1[0],P1[1],   pw1[2]=PKW(P0,12),pw1[3]=PKW(P0,14), pw1); \
    VRD(2); SBAR(); GAPA(C0=__builtin_amdgcn_mfma_f32_32x32x16_bf16(kf[4],qr[2],C0,0,0,0),   P1[2],P1[3],P1[4],P1[5],     pw2[0]=PKW(P1,0), pw2[1]=PKW(P1,2), pw2); \
    VRD(6); SBAR(); GAPA(C1=__builtin_amdgcn_mfma_f32_32x32x16_bf16(kf[5],qr[2],C1,0,0,0),   P1[6],P1[7],P1[8],P1[9],     pw2[2]=PKW(P1,4), pw2[3]=PKW(P1,6), pw2); \
    VRD(3); SBAR(); GAPA(C0=__builtin_amdgcn_mfma_f32_32x32x16_bf16(kf[6],qr[3],C0,0,0,0),   P1[10],P1[11],P1[12],P1[13], pw3[0]=PKW(P1,8), pw3[1]=PKW(P1,10), pw3); \
    VRD(7); SBAR(); GAPA(C1=__builtin_amdgcn_mfma_f32_32x32x16_bf16(kf[7],qr[3],C1,0,0,0),   P1[14],P1[15],0.f,0.f,       pw3[2]=PKW(P1,12),pw3[3]=PKW(P1,14), pw3); \
    l_reg+=sacc; \
    if(GK){DMA_K((t)+3,sl_cur);} if(GV){DMA_V((t)+1,sl_next);} \
    CMASK(C0,C1,t); \
    { float a=MX3(C0[0],C0[1],C1[0]),b=MX3(C0[2],C0[3],C1[1]); a=MX3(a,C1[2],C1[3]); \
      _Pragma("unroll") for(int r=4;r<16;r+=4){a=MX3(a,C0[r],C0[r+1]);b=MX3(b,C0[r+2],C0[r+3]);a=MX3(a,C1[r],C1[r+1]);b=MX3(b,C1[r+2],C1[r+3]);} \
      float rm=__builtin_fmaxf(a,b); { auto rr=__builtin_amdgcn_permlane32_swap(__float_as_uint(rm),__float_as_uint(rm),false,false); rm=__builtin_fmaxf(__uint_as_float(rr[0]),__uint_as_float(rr[1])); } \
      resc=false; \
      if(__builtin_expect(__any(rm>(float)THRL),0)){ const float dl=__builtin_fmaxf(rm,0.f); nb-=dl; \
        _Pragma("unroll") for(int r=0;r<16;++r){C0[r]-=dl;C1[r]-=dl;} \
        const float f=__builtin_amdgcn_exp2f(-dl); l_reg*=f; if(hi==0)wsf[r32]=f; resc=true; } } \
    SBAR(); \
    GAPB(o[0]=__builtin_amdgcn_mfma_f32_32x32x16_bf16(PAF(0),VFR(0),o[0],0,0,0), C0,0); \
    GAPB(o[1]=__builtin_amdgcn_mfma_f32_32x32x16_bf16(PAF(0),VFR(4),o[1],0,0,0), C0,4); \
    KRD(GL,0); GAPB(o[0]=__builtin_amdgcn_mfma_f32_32x32x16_bf16(PAF(1),VFR(1),o[0],0,0,0), C0,8); \
    KRD(GL,1); GAPB(o[1]=__builtin_amdgcn_mfma_f32_32x32x16_bf16(PAF(1),VFR(5),o[1],0,0,0), C0,12); \
    KRD(GL,2); GAPB(o[0]=__builtin_amdgcn_mfma_f32_32x32x16_bf16(PAF(2),VFR(2),o[0],0,0,0), C1,0); \
    KRD(GL,3); GAPB(o[1]=__builtin_amdgcn_mfma_f32_32x32x16_bf16(PAF(2),VFR(6),o[1],0,0,0), C1,4); \
    GAPB(o[0]=__builtin_amdgcn_mfma_f32_32x32x16_bf16(PAF(3),VFR(3),o[0],0,0,0), C1,8); \
    GAPB(o[1]=__builtin_amdgcn_mfma_f32_32x32x16_bf16(PAF(3),VFR(7),o[1],0,0,0), C1,12); \
    }while(0)
  int t=1;
  #undef CMASK
  #define CMASK(P0,P1,t) do{}while(0)
  for(;t+5<NT;t+=2){
    STEP(pB0,pB1,pA0,pA1,t,true,true,true);     WAIT_BAR(2); RESC(); ROT();
    STEP(pA0,pA1,pB0,pB1,t+1,true,true,true);   WAIT_BAR(2); RESC(); ROT();
  }
  #undef CMASK
  #define CMASK(P0,P1,t) do{int jb_=(t)-(NT-4); if(jb_>=0)cmask(P0,P1,jb_,qrel,hi);}while(0)
  #define ENDW(tt) do{ if((tt)+3<NT){WAIT_BAR(2);} else if((tt)+2<NT){WAIT_BAR(1);} else {WAIT_BAR(0);} }while(0)
  for(;t+1<NT;t+=2){
    STEP(pB0,pB1,pA0,pA1,t,(t+3<NT),(t+1<NT),(t+1<NT));       ENDW(t);   RESC(); ROT();
    STEP(pA0,pA1,pB0,pB1,t+1,(t+4<NT),(t+2<NT),(t+2<NT));     ENDW(t+1); RESC(); ROT();
  }
  STEP(pB0,pB1,pA0,pA1,NT-1,false,false,false); RESC();
  { float sacc=pB0[0]+pB0[1]; _Pragma("unroll") for(int r=2;r<16;++r)sacc+=pB0[r]; _Pragma("unroll") for(int r=0;r<16;++r)sacc+=pB1[r]; l_reg+=sacc;
    pw0=(u32x4){PKW(pB0,0),PKW(pB0,2),PKW(pB0,4),PKW(pB0,6)};pw1=(u32x4){PKW(pB0,8),PKW(pB0,10),PKW(pB0,12),PKW(pB0,14)};pw2=(u32x4){PKW(pB1,0),PKW(pB1,2),PKW(pB1,4),PKW(pB1,6)};pw3=(u32x4){PKW(pB1,8),PKW(pB1,10),PKW(pB1,12),PKW(pB1,14)};
    SBAR(); pv(o,vb0+sl_cur,PAF(0),PAF(1),PAF(2),PAF(3)); }
  #undef PKW
  #undef PAF
  #undef VFR
  #undef PIN
  #undef MX3
  #undef GAPA
  #undef GAPB
  #undef EX
  #undef VRD
  #undef KRD
  #undef STEP
  #undef ENDW
  {auto rr=__builtin_amdgcn_permlane32_swap(__float_as_uint(l_reg),__float_as_uint(l_reg),false,false);l_reg=__uint_as_float(rr[0])+__uint_as_float(rr[1]);}
  if(hi==0)wsf[32+r32]=l_reg;asm volatile("s_waitcnt lgkmcnt(0)":::"memory");
  float rli[16];
  #pragma unroll
  for(int r=0;r<16;++r)rli[r]=__builtin_amdgcn_rcpf(wsf[32+crow(r,hi)]);
  bf16*Ow=O+(rowbase+q0+wid*QBLK)*OPITCH+OCOL+h*D;
  { bf16*stg=(bf16*)(shm+LDS_OST)+wid*2048;
    #pragma unroll
    for(int r=0;r<16;++r){const int orow=crow(r,hi);
      #pragma unroll
      for(int d0=0;d0<2;++d0)stg[orow*64+d0*32+r32]=(bf16)(cvtpk_s(o[d0][r]*rli[r],0.f)&0xffffu);}
    asm volatile("s_waitcnt lgkmcnt(0)":::"memory");
    #pragma unroll
    for(int i=0;i<4;++i){const int row=i*8+(lane>>3),ch=lane&7; const u32x4 v=*(const u32x4*)(stg+row*64+ch*8); ATTN_STORE16(Ow+(long)row*OPITCH+ch*8,v);} }
  asm volatile("s_waitcnt lgkmcnt(0)\n\ts_barrier":::"memory");
  #undef CKLOAD
  #undef BIASSUB
  #undef DMA_K
  #undef DMA_V
  #undef CMASK
  #undef START
  #undef RESC
  #undef ROT
}
constexpr int ATTN_LDS_BYTES=LDS_BYTES;
struct AttnTensors { const bf16* Q; const bf16* K; const bf16* V; bf16* O; const float* CL; const float* QN2; const float* KN2; const float* QKD; };
struct AttnUnit { int bh; int qb; };
struct StaticOrder {
  int vcu, G;
  __device__ __forceinline__ explicit StaticOrder(int grid,int block):vcu((grid%8==0)?(block%8)*(grid/8)+block/8:block),G(grid){}
  __device__ __forceinline__ bool next(int i,AttnUnit&u)const{ const int L=i*G+vcu; if(L>=1024)return false; const int slot=L>>8,pos=L&255,s=pos&15; u.bh=pos>>4; u.qb=(slot==0)?s:(slot==1)?31-s:(slot==2)?32+s:63-s; return true; }
  __device__ __forceinline__ void a_ready(const AttnUnit&)const{}
  __device__ __forceinline__ void done(const AttnUnit&)const{}
};
template<int THRL=8> __device__ __forceinline__ void attn_phase(char*lds,const AttnTensors&T,unsigned*heads,const int myx,const int tid_in,ArgsP ap){
  int probe=7; volatile __attribute__((address_space(3))) int*bc=(volatile __attribute__((address_space(3))) int*)((__attribute__((address_space(3))) char*)lds+LDS_BYTES+64);
  const int NF1=(gridDim.x==256)?512:0, NCV=1024-NF1, F=NCV+512; const unsigned nitems=2u*F+(F<1024?1024u-F:0u);
  for(;;){ const int item=peer_next_item(heads,1,probe,nitems,bc,tid_in); if(item<0)break;
    int v,ty; if(item<2*F){ v=item>>1; ty=item&1; } else { v=F+item-2*F; ty=0; }
    if(ty==1){ if(v<NCV)convert_uv_fp8_item(ap,opaque(tid_in),NF1+v); else transpose_filler_item(ap,(__attribute__((address_space(3))) unsigned char*)lds,opaque(tid_in),v-NCV); continue; }
    if(v>=1024)continue;
    const int h=15-(v&15),qb=63-(v>>4);
    attn_unit<THRL>(0,h,qb,T.Q,T.K,T.V,T.O,T.CL+(long)h*SEQ,T.QN2+h*256,T.KN2+h*256,T.QKD+h*256,lds,tid_in); }
}
#undef SBAR
#undef WAIT_BAR
}
__device__ __forceinline__ int topk_sortable(float f) { const int u = __float_as_int(f); return u ^ ((u >> 31) & 0x7fffffff); }
__device__ __forceinline__ int topk_pack7(float f, int idx) { return (topk_sortable(f) & ~127) | (127 - idx); }
__device__ __forceinline__ void wave_imax2(int& a, int& b, int& sa, int& sb) {
    asm volatile("s_nop 1\n\t"
        "v_max_i32_dpp %0, %0, %0 row_shr:1 row_mask:0xf bank_mask:0xf\n\tv_max_i32_dpp %1, %1, %1 row_shr:1 row_mask:0xf bank_mask:0xf\n\ts_nop 0\n\t"
        "v_max_i32_dpp %0, %0, %0 row_shr:2 row_mask:0xf bank_mask:0xf\n\tv_max_i32_dpp %1, %1, %1 row_shr:2 row_mask:0xf bank_mask:0xf\n\ts_nop 0\n\t"
        "v_max_i32_dpp %0, %0, %0 row_shr:4 row_mask:0xf bank_mask:0xf\n\tv_max_i32_dpp %1, %1, %1 row_shr:4 row_mask:0xf bank_mask:0xf\n\ts_nop 0\n\t"
        "v_max_i32_dpp %0, %0, %0 row_shr:8 row_mask:0xf bank_mask:0xf\n\tv_max_i32_dpp %1, %1, %1 row_shr:8 row_mask:0xf bank_mask:0xf\n\ts_nop 0\n\t"
        "v_max_i32_dpp %0, %0, %0 row_bcast:15 row_mask:0xa bank_mask:0xf\n\tv_max_i32_dpp %1, %1, %1 row_bcast:15 row_mask:0xa bank_mask:0xf\n\ts_nop 0\n\t"
        "v_max_i32_dpp %0, %0, %0 row_bcast:31 row_mask:0xc bank_mask:0xf\n\tv_max_i32_dpp %1, %1, %1 row_bcast:31 row_mask:0xc bank_mask:0xf\n\ts_nop 1\n\t"
        "v_readlane_b32 %2, %0, 63\n\tv_readlane_b32 %3, %1, 63\n\ts_nop 3"
        : "+v"(a), "+v"(b), "=s"(sa), "=s"(sb));
}
__device__ __forceinline__ void wave_imax1(int& a, int& sa) {
    asm volatile("s_nop 1\n\t"
        "v_max_i32_dpp %0, %0, %0 row_shr:1 row_mask:0xf bank_mask:0xf\n\ts_nop 1\n\t"
        "v_max_i32_dpp %0, %0, %0 row_shr:2 row_mask:0xf bank_mask:0xf\n\ts_nop 1\n\t"
        "v_max_i32_dpp %0, %0, %0 row_shr:4 row_mask:0xf bank_mask:0xf\n\ts_nop 1\n\t"
        "v_max_i32_dpp %0, %0, %0 row_shr:8 row_mask:0xf bank_mask:0xf\n\ts_nop 1\n\t"
        "v_max_i32_dpp %0, %0, %0 row_bcast:15 row_mask:0xa bank_mask:0xf\n\ts_nop 1\n\t"
        "v_max_i32_dpp %0, %0, %0 row_bcast:31 row_mask:0xc bank_mask:0xf\n\ts_nop 1\n\t"
        "v_readlane_b32 %1, %0, 63\n\ts_nop 3"
        : "+v"(a), "=s"(sa));
}
__device__ __forceinline__ void wave_imax_x8(int (&k)[8], int (&s)[8]) {
    asm volatile("s_nop 1\n\t"
        "v_max_i32_dpp %0, %0, %0 row_shr:1 row_mask:0xf bank_mask:0xf\n\tv_max_i32_dpp %1, %1, %1 row_shr:1 row_mask:0xf bank_mask:0xf\n\tv_max_i32_dpp %2, %2, %2 row_shr:1 row_mask:0xf bank_mask:0xf\n\tv_max_i32_dpp %3, %3, %3 row_shr:1 row_mask:0xf bank_mask:0xf\n\tv_max_i32_dpp %4, %4, %4 row_shr:1 row_mask:0xf bank_mask:0xf\n\tv_max_i32_dpp %5, %5, %5 row_shr:1 row_mask:0xf bank_mask:0xf\n\tv_max_i32_dpp %6, %6, %6 row_shr:1 row_mask:0xf bank_mask:0xf\n\tv_max_i32_dpp %7, %7, %7 row_shr:1 row_mask:0xf bank_mask:0xf\n\t"
        "v_max_i32_dpp %0, %0, %0 row_shr:2 row_mask:0xf bank_mask:0xf\n\tv_max_i32_dpp %1, %1, %1 row_shr:2 row_mask:0xf bank_mask:0xf\n\tv_max_i32_dpp %2, %2, %2 row_shr:2 row_mask:0xf bank_mask:0xf\n\tv_max_i32_dpp %3, %3, %3 row_shr:2 row_mask:0xf bank_mask:0xf\n\tv_max_i32_dpp %4, %4, %4 row_shr:2 row_mask:0xf bank_mask:0xf\n\tv_max_i32_dpp %5, %5, %5 row_shr:2 row_mask:0xf bank_mask:0xf\n\tv_max_i32_dpp %6, %6, %6 row_shr:2 row_mask:0xf bank_mask:0xf\n\tv_max_i32_dpp %7, %7, %7 row_shr:2 row_mask:0xf bank_mask:0xf\n\t"
        "v_max_i32_dpp %0, %0, %0 row_shr:4 row_mask:0xf bank_mask:0xf\n\tv_max_i32_dpp %1, %1, %1 row_shr:4 row_mask:0xf bank_mask:0xf\n\tv_max_i32_dpp %2, %2, %2 row_shr:4 row_mask:0xf bank_mask:0xf\n\tv_max_i32_dpp %3, %3, %3 row_shr:4 row_mask:0xf bank_mask:0xf\n\tv_max_i32_dpp %4, %4, %4 row_shr:4 row_mask:0xf bank_mask:0xf\n\tv_max_i32_dpp %5, %5, %5 row_shr:4 row_mask:0xf bank_mask:0xf\n\tv_max_i32_dpp %6, %6, %6 row_shr:4 row_mask:0xf bank_mask:0xf\n\tv_max_i32_dpp %7, %7, %7 row_shr:4 row_mask:0xf bank_mask:0xf\n\t"
        "v_max_i32_dpp %0, %0, %0 row_shr:8 row_mask:0xf bank_mask:0xf\n\tv_max_i32_dpp %1, %1, %1 row_shr:8 row_mask:0xf bank_mask:0xf\n\tv_max_i32_dpp %2, %2, %2 row_shr:8 row_mask:0xf bank_mask:0xf\n\tv_max_i32_dpp %3, %3, %3 row_shr:8 row_mask:0xf bank_mask:0xf\n\tv_max_i32_dpp %4, %4, %4 row_shr:8 row_mask:0xf bank_mask:0xf\n\tv_max_i32_dpp %5, %5, %5 row_shr:8 row_mask:0xf bank_mask:0xf\n\tv_max_i32_dpp %6, %6, %6 row_shr:8 row_mask:0xf bank_mask:0xf\n\tv_max_i32_dpp %7, %7, %7 row_shr:8 row_mask:0xf bank_mask:0xf\n\t"
        "v_max_i32_dpp %0, %0, %0 row_bcast:15 row_mask:0xa bank_mask:0xf\n\tv_max_i32_dpp %1, %1, %1 row_bcast:15 row_mask:0xa bank_mask:0xf\n\tv_max_i32_dpp %2, %2, %2 row_bcast:15 row_mask:0xa bank_mask:0xf\n\tv_max_i32_dpp %3, %3, %3 row_bcast:15 row_mask:0xa bank_mask:0xf\n\tv_max_i32_dpp %4, %4, %4 row_bcast:15 row_mask:0xa bank_mask:0xf\n\tv_max_i32_dpp %5, %5, %5 row_bcast:15 row_mask:0xa bank_mask:0xf\n\tv_max_i32_dpp %6, %6, %6 row_bcast:15 row_mask:0xa bank_mask:0xf\n\tv_max_i32_dpp %7, %7, %7 row_bcast:15 row_mask:0xa bank_mask:0xf\n\t"
        "v_max_i32_dpp %0, %0, %0 row_bcast:31 row_mask:0xc bank_mask:0xf\n\tv_max_i32_dpp %1, %1, %1 row_bcast:31 row_mask:0xc bank_mask:0xf\n\tv_max_i32_dpp %2, %2, %2 row_bcast:31 row_mask:0xc bank_mask:0xf\n\tv_max_i32_dpp %3, %3, %3 row_bcast:31 row_mask:0xc bank_mask:0xf\n\tv_max_i32_dpp %4, %4, %4 row_bcast:31 row_mask:0xc bank_mask:0xf\n\tv_max_i32_dpp %5, %5, %5 row_bcast:31 row_mask:0xc bank_mask:0xf\n\tv_max_i32_dpp %6, %6, %6 row_bcast:31 row_mask:0xc bank_mask:0xf\n\tv_max_i32_dpp %7, %7, %7 row_bcast:31 row_mask:0xc bank_mask:0xf\n\t"
        "s_nop 1\n\tv_readlane_b32 %8, %0, 63\n\tv_readlane_b32 %9, %1, 63\n\tv_readlane_b32 %10, %2, 63\n\tv_readlane_b32 %11, %3, 63\n\tv_readlane_b32 %12, %4, 63\n\tv_readlane_b32 %13, %5, 63\n\tv_readlane_b32 %14, %6, 63\n\tv_readlane_b32 %15, %7, 63\n\ts_nop 3"
        : "+v"(k[0]), "+v"(k[1]), "+v"(k[2]), "+v"(k[3]), "+v"(k[4]), "+v"(k[5]), "+v"(k[6]), "+v"(k[7]), "=s"(s[0]), "=s"(s[1]), "=s"(s[2]), "=s"(s[3]), "=s"(s[4]), "=s"(s[5]), "=s"(s[6]), "=s"(s[7]));
}
__device__ __forceinline__ void wave_imax_x4(int (&k)[4], int (&s)[4]) {
    asm volatile("s_nop 1\n\t"
        "v_max_i32_dpp %0, %0, %0 row_shr:1 row_mask:0xf bank_mask:0xf\n\tv_max_i32_dpp %1, %1, %1 row_shr:1 row_mask:0xf bank_mask:0xf\n\tv_max_i32_dpp %2, %2, %2 row_shr:1 row_mask:0xf bank_mask:0xf\n\tv_max_i32_dpp %3, %3, %3 row_shr:1 row_mask:0xf bank_mask:0xf\n\t"
        "v_max_i32_dpp %0, %0, %0 row_shr:2 row_mask:0xf bank_mask:0xf\n\tv_max_i32_dpp %1, %1, %1 row_shr:2 row_mask:0xf bank_mask:0xf\n\tv_max_i32_dpp %2, %2, %2 row_shr:2 row_mask:0xf bank_mask:0xf\n\tv_max_i32_dpp %3, %3, %3 row_shr:2 row_mask:0xf bank_mask:0xf\n\t"
        "v_max_i32_dpp %0, %0, %0 row_shr:4 row_mask:0xf bank_mask:0xf\n\tv_max_i32_dpp %1, %1, %1 row_shr:4 row_mask:0xf bank_mask:0xf\n\tv_max_i32_dpp %2, %2, %2 row_shr:4 row_mask:0xf bank_mask:0xf\n\tv_max_i32_dpp %3, %3, %3 row_shr:4 row_mask:0xf bank_mask:0xf\n\t"
        "v_max_i32_dpp %0, %0, %0 row_shr:8 row_mask:0xf bank_mask:0xf\n\tv_max_i32_dpp %1, %1, %1 row_shr:8 row_mask:0xf bank_mask:0xf\n\tv_max_i32_dpp %2, %2, %2 row_shr:8 row_mask:0xf bank_mask:0xf\n\tv_max_i32_dpp %3, %3, %3 row_shr:8 row_mask:0xf bank_mask:0xf\n\t"
        "v_max_i32_dpp %0, %0, %0 row_bcast:15 row_mask:0xa bank_mask:0xf\n\tv_max_i32_dpp %1, %1, %1 row_bcast:15 row_mask:0xa bank_mask:0xf\n\tv_max_i32_dpp %2, %2, %2 row_bcast:15 row_mask:0xa bank_mask:0xf\n\tv_max_i32_dpp %3, %3, %3 row_bcast:15 row_mask:0xa bank_mask:0xf\n\t"
        "v_max_i32_dpp %0, %0, %0 row_bcast:31 row_mask:0xc bank_mask:0xf\n\tv_max_i32_dpp %1, %1, %1 row_bcast:31 row_mask:0xc bank_mask:0xf\n\tv_max_i32_dpp %2, %2, %2 row_bcast:31 row_mask:0xc bank_mask:0xf\n\tv_max_i32_dpp %3, %3, %3 row_bcast:31 row_mask:0xc bank_mask:0xf\n\t"
        "s_nop 1\n\tv_readlane_b32 %4, %0, 63\n\tv_readlane_b32 %5, %1, 63\n\tv_readlane_b32 %6, %2, 63\n\tv_readlane_b32 %7, %3, 63\n\ts_nop 3"
        : "+v"(k[0]), "+v"(k[1]), "+v"(k[2]), "+v"(k[3]), "=s"(s[0]), "=s"(s[1]), "=s"(s[2]), "=s"(s[3]));
}
__device__ __forceinline__ void row_imax2(int& a, int& b) {
    asm volatile("s_nop 1\n\t"
        "v_max_i32_dpp %0, %0, %0 row_ror:8 row_mask:0xf bank_mask:0xf\n\tv_max_i32_dpp %1, %1, %1 row_ror:8 row_mask:0xf bank_mask:0xf\n\ts_nop 0\n\t"
        "v_max_i32_dpp %0, %0, %0 row_ror:4 row_mask:0xf bank_mask:0xf\n\tv_max_i32_dpp %1, %1, %1 row_ror:4 row_mask:0xf bank_mask:0xf\n\ts_nop 0\n\t"
        "v_max_i32_dpp %0, %0, %0 row_ror:2 row_mask:0xf bank_mask:0xf\n\tv_max_i32_dpp %1, %1, %1 row_ror:2 row_mask:0xf bank_mask:0xf\n\ts_nop 0\n\t"
        "v_max_i32_dpp %0, %0, %0 row_ror:1 row_mask:0xf bank_mask:0xf\n\tv_max_i32_dpp %1, %1, %1 row_ror:1 row_mask:0xf bank_mask:0xf\n\ts_nop 1"
        : "+v"(a), "+v"(b));
}
__device__ __forceinline__ void row_imax4(int& a, int& b, int& c, int& d) {
    asm volatile("s_nop 1\n\t"
        "v_max_i32_dpp %0, %0, %0 row_ror:8 row_mask:0xf bank_mask:0xf\n\tv_max_i32_dpp %1, %1, %1 row_ror:8 row_mask:0xf bank_mask:0xf\n\tv_max_i32_dpp %2, %2, %2 row_ror:8 row_mask:0xf bank_mask:0xf\n\tv_max_i32_dpp %3, %3, %3 row_ror:8 row_mask:0xf bank_mask:0xf\n\t"
        "v_max_i32_dpp %0, %0, %0 row_ror:4 row_mask:0xf bank_mask:0xf\n\tv_max_i32_dpp %1, %1, %1 row_ror:4 row_mask:0xf bank_mask:0xf\n\tv_max_i32_dpp %2, %2, %2 row_ror:4 row_mask:0xf bank_mask:0xf\n\tv_max_i32_dpp %3, %3, %3 row_ror:4 row_mask:0xf bank_mask:0xf\n\t"
        "v_max_i32_dpp %0, %0, %0 row_ror:2 row_mask:0xf bank_mask:0xf\n\tv_max_i32_dpp %1, %1, %1 row_ror:2 row_mask:0xf bank_mask:0xf\n\tv_max_i32_dpp %2, %2, %2 row_ror:2 row_mask:0xf bank_mask:0xf\n\tv_max_i32_dpp %3, %3, %3 row_ror:2 row_mask:0xf bank_mask:0xf\n\t"
        "v_max_i32_dpp %0, %0, %0 row_ror:1 row_mask:0xf bank_mask:0xf\n\tv_max_i32_dpp %1, %1, %1 row_ror:1 row_mask:0xf bank_mask:0xf\n\tv_max_i32_dpp %2, %2, %2 row_ror:1 row_mask:0xf bank_mask:0xf\n\tv_max_i32_dpp %3, %3, %3 row_ror:1 row_mask:0xf bank_mask:0xf\n\ts_nop 1"
        : "+v"(a), "+v"(b), "+v"(c), "+v"(d));
}
template <int CTRL> __device__ __forceinline__ float dpp_rot(float v) { return __int_as_float(__builtin_amdgcn_update_dpp(0, __float_as_int(v), CTRL, 0xf, 0xf, false)); }
__device__ __forceinline__ float row_fmax(float v) { v = fmaxf(v, dpp_rot<0x128>(v)); v = fmaxf(v, dpp_rot<0x124>(v)); v = fmaxf(v, dpp_rot<0x122>(v)); v = fmaxf(v, dpp_rot<0x121>(v)); return v; }
__device__ __forceinline__ float row_fsum(float v) { v += dpp_rot<0x128>(v); v += dpp_rot<0x124>(v); v += dpp_rot<0x122>(v); v += dpp_rot<0x121>(v); return v; }
__device__ const unsigned char PEER_CAND[64] = {
    0x00,0x01,0x02,0x03,0x04,0x05,0x06,0x07,0x08,0x09,0x0a,0x0b,0x0c,0x0d,0x0e,0x0f, 0x10,0x11,0x12,0x13,0x14,0x15,0x16,0x17, 0x20,0x21,0x22,0x23,0x24, 0x30,0x31,0x32,0x33,
    0x40,0x41,0x42, 0x50,0x51, 0x60,0x61, 0x70,0x71, 0x80, 0x90, 0xa0, 0xb0, 0xc0, 0xd0, 0xe0, 0xf0, 0xff,0xff,0xff,0xff,0xff,0xff,0xff,0xff,0xff,0xff,0xff,0xff,0xff,0xff};
__device__ __forceinline__ void phase7(ArgsP a, LAS unsigned char* lds, const int tidx) {
    const int tid0 = tidx, w = __builtin_amdgcn_readfirstlane(tid0 >> 6);
    const bf16* QP = (const bf16*)(a->ws + WS_QP); const bf16* K12 = (const bf16*)(a->ws + WS_K12); const float* SUMSQ = (const float*)(a->ws + WS_MISC + MISC_SUMSQ);
    int* IDX = (int*)(a->ws + WS_IDX); float* GW = (float*)(a->ws + WS_GW);
    LAS float* SC = (LAS float*)lds;
    bf16x8 af[4][4];
    { const int u0 = blockIdx.x; const int l0 = lane_id(), fr0 = l0 & 15, fq0 = l0 >> 4, half0 = w >> 2;
      if (u0 < 256 * 8) {
#pragma unroll
        for (int kk = 0; kk < 4; ++kk)
#pragma unroll
            for (int i = 0; i < 4; ++i) af[kk][i] = *(const bf16x8*)(QP + (size_t)((u0 >> 3) * 64 + 16 * i + fr0) * DM + 256 * (u0 & 7) + 128 * half0 + 8 * fq0 + 32 * kk); } }
    for (int u = blockIdx.x; u < 256 * 8; u += gridDim.x) {
        const int tid = opaque(tid0), lane = tid & 63, fr = lane & 15, fq = lane >> 4;
        const int tt = u >> 3, hd = u & 7, tok0 = tt * 64;
        {
            const int half = w >> 2; const bf16* kb = K12 + ((size_t)(half * 8 + hd) * 128) * 128;
            f32x4 acc[4][2];
#pragma unroll
            for (int i = 0; i < 4; ++i) { acc[i][0] = (f32x4){0.f, 0.f, 0.f, 0.f}; acc[i][1] = (f32x4){0.f, 0.f, 0.f, 0.f}; }
            bf16x8 bfv[4][2];
#pragma unroll
            for (int kk = 0; kk < 4; ++kk)
#pragma unroll
                for (int j = 0; j < 2; ++j) bfv[kk][j] = *(const bf16x8*)(kb + (size_t)(16 * (2 * (w & 3) + j) + fr) * 128 + 8 * fq + 32 * kk);
#pragma unroll
            for (int kk = 0; kk < 4; ++kk)
#pragma unroll
                for (int i = 0; i < 4; ++i) { acc[i][0] = mfma16(af[kk][i], bfv[kk][0], acc[i][0]); acc[i][1] = mfma16(af[kk][i], bfv[kk][1], acc[i][1]); }
#pragma unroll
            for (int i = 0; i < 4; ++i)
#pragma unroll
                for (int j = 0; j < 2; ++j)
#pragma unroll
                    for (int r = 0; r < 4; ++r) SC[(16 * i + 4 * fq + r) * 260 + 128 * half + 16 * (2 * (w & 3) + j) + fr] = acc[i][j][r];
            const int un = u + (int)gridDim.x;
            if (un < 256 * 8) {
#pragma unroll
                for (int kk = 0; kk < 4; ++kk)
#pragma unroll
                    for (int i = 0; i < 4; ++i) af[kk][i] = *(const bf16x8*)(QP + (size_t)((un >> 3) * 64 + 16 * i + fr) * DM + 256 * (un & 7) + 128 * half + 8 * fq + 32 * kk); }
        }
        __syncthreads();
        const int r16 = lane & 15, rowb = lane & 48;
        const int cab = (int)PEER_CAND[lane];
        int cca[4], ccb[4];
#pragma unroll
        for (int i = 0; i < 4; ++i) { const int cc = (int)PEER_CAND[r16 + 16 * i]; cca[i] = rowb + (cc >> 4); ccb[i] = rowb + (cc & 15); }
        {
            const LAS float* srow0 = SC + (8 * w + (lane >> 4)) * 260; const LAS float* srow1 = srow0 + 4 * 260;
            int sa[2][8], sb[2][8];
#pragma unroll
            for (int i = 0; i < 8; ++i) { sa[0][i] = topk_pack7(srow0[r16 + 16 * i], r16 + 16 * i); sb[0][i] = topk_pack7(srow0[128 + r16 + 16 * i], r16 + 16 * i);
                                          sa[1][i] = topk_pack7(srow1[r16 + 16 * i], r16 + 16 * i); sb[1][i] = topk_pack7(srow1[128 + r16 + 16 * i], r16 + 16 * i); }
#define CE(x, i, j) do { const int hi_ = x[i] > x[j] ? x[i] : x[j], lo_ = x[i] > x[j] ? x[j] : x[i]; x[i] = hi_; x[j] = lo_; } while (0)
#define SORT8(x) do { CE(x,0,1); CE(x,2,3); CE(x,4,5); CE(x,6,7); CE(x,0,2); CE(x,1,3); CE(x,4,6); CE(x,5,7); CE(x,1,2); CE(x,5,6); CE(x,0,4); CE(x,3,7); CE(x,1,5); CE(x,2,6); CE(x,1,4); CE(x,3,6); CE(x,2,4); CE(x,3,5); CE(x,3,4); } while (0)
            SORT8(sa[0]); SORT8(sb[0]); SORT8(sa[1]); SORT8(sb[1]);
            int resa[2] = {0, 0}, resb[2] = {0, 0};
            for (int k = 0; k < 16; ++k) {
                int m0 = sa[0][0], m1 = sb[0][0], m2 = sa[1][0], m3 = sb[1][0];
                row_imax4(m0, m1, m2, m3);
                const bool w0 = sa[0][0] == m0, w1 = sb[0][0] == m1, w2 = sa[1][0] == m2, w3 = sb[1][0] == m3;
#pragma unroll
                for (int i = 0; i < 7; ++i) { sa[0][i] = w0 ? sa[0][i + 1] : sa[0][i]; sb[0][i] = w1 ? sb[0][i + 1] : sb[0][i]; sa[1][i] = w2 ? sa[1][i + 1] : sa[1][i]; sb[1][i] = w3 ? sb[1][i + 1] : sb[1][i]; }
                sa[0][7] = w0 ? (int)0x80000000 : sa[0][7]; sb[0][7] = w1 ? (int)0x80000000 : sb[0][7]; sa[1][7] = w2 ? (int)0x80000000 : sa[1][7]; sb[1][7] = w3 ? (int)0x80000000 : sb[1][7];
                if (r16 == k) { resa[0] = m0; resb[0] = m1; resa[1] = m2; resb[1] = m3; }
            }
            int ria[2], rib[2]; float rva[2], rvb[2]; int kc[2][4];
#pragma unroll
            for (int q = 0; q < 2; ++q) { const LAS float* srow = q ? srow1 : srow0;
                ria[q] = 127 - (resa[q] & 127); rib[q] = 127 - (resb[q] & 127); rva[q] = srow[ria[q]]; rvb[q] = srow[128 + rib[q]];
#pragma unroll
                for (int i = 0; i < 4; ++i) { const float csum = __shfl(rva[q], cca[i]) + __shfl(rvb[q], ccb[i]); const int cidx = r16 + 16 * i; kc[q][i] = cidx < 50 ? ((topk_sortable(csum) & ~63) | (63 - cidx)) : (int)0x80000000; }
                CE(kc[q],0,1); CE(kc[q],2,3); CE(kc[q],0,2); CE(kc[q],1,3); CE(kc[q],1,2); }
            int resc[2] = {0, 0};
            for (int k = 0; k < 16; ++k) {
                int m0 = kc[0][0], m1 = kc[1][0];
                row_imax2(m0, m1);
                const bool w0 = kc[0][0] == m0, w1 = kc[1][0] == m1;
                kc[0][0] = w0 ? kc[0][1] : kc[0][0]; kc[0][1] = w0 ? kc[0][2] : kc[0][1]; kc[0][2] = w0 ? kc[0][3] : kc[0][2]; kc[0][3] = w0 ? (int)0x80000000 : kc[0][3];
                kc[1][0] = w1 ? kc[1][1] : kc[1][0]; kc[1][1] = w1 ? kc[1][2] : kc[1][1]; kc[1][2] = w1 ? kc[1][3] : kc[1][2]; kc[1][3] = w1 ? (int)0x80000000 : kc[1][3];
                if (r16 == k) { resc[0] = m0; resc[1] = m1; }
            }
#undef SORT8
#undef CE
#pragma unroll
            for (int q = 0; q < 2; ++q) { const int tok = tok0 + 8 * w + 4 * q + (lane >> 4);
                const int ci = 63 - (resc[q] & 63);
                const int sab = __shfl(cab, ci), sela = rowb + (sab >> 4), selb = rowb + (sab & 15);
                const float sv = __shfl(rva[q], sela) + __shfl(rvb[q], selb);
                const int e1 = __shfl(ria[q], sela), e2 = __shfl(rib[q], selb);
                const float rstd = 1.f / sqrtf(SUMSQ[tok] * (1.f / DM) + EPS);
                const float top = row_fmax(sv);
                const float p = __expf((sv - top) * rstd);
                const float den = row_fsum(p);
                IDX[(size_t)tok * 128 + 16 * hd + r16] = e1 * 128 + e2; GW[(size_t)tok * 128 + 16 * hd + r16] = p / den; }
        }
        __syncthreads();
    }
}

__device__ __forceinline__ void phase8(ArgsP a, const int tidx) {
    const int tid0 = tidx, w = __builtin_amdgcn_readfirstlane(tid0 >> 6);
    const bf16* HN = (const bf16*)(a->ws + WS_HN); const bf16* U = (const bf16*)(a->ws + WS_U); const bf16* V = (const bf16*)(a->ws + WS_V2);
    const int* IDX = (const int*)(a->ws + WS_IDX); const float* GW = (const float*)(a->ws + WS_GW); const float* SUMSQ = (const float*)(a->ws + WS_MISC + MISC_SUMSQ);
    const int gwv = blockIdx.x * NWAVES + w, NGW = gridDim.x * NWAVES;
    for (int tok = gwv; tok < M; tok += NGW) {
        const int lane = opaque(tid0) & 63;
        u32x4 hv[4];
#pragma unroll
        for (int i = 0; i < 4; ++i) hv[i] = *(const u32x4*)(HN + (size_t)tok * DM + 8 * lane + 512 * i);
        const int id0 = IDX[(size_t)tok * 128 + lane], id1 = IDX[(size_t)tok * 128 + 64 + lane];
        const float g0 = GW[(size_t)tok * 128 + lane], g1 = GW[(size_t)tok * 128 + 64 + lane];
        const float rstd2 = 1.f / sqrtf(SUMSQ[tok] * (1.f / DM) + EPS);
        float oacc[32];
#pragma unroll
        for (int i = 0; i < 32; ++i) oacc[i] = 0.f;
        for (int eb = 0; eb < 128; eb += 8) {
            u32x4 uv[8][4]; float part[8]; int eid[8];
#pragma unroll
            for (int e = 0; e < 8; ++e) { const int sl = eb + e; eid[e] = __builtin_amdgcn_readfirstlane(sl < 64 ? __shfl(id0, sl) : __shfl(id1, sl - 64));
                const bf16* row = U + (size_t)eid[e] * DM + 8 * lane;
#pragma unroll
                for (int i = 0; i < 4; ++i) uv[e][i] = *(const u32x4*)(row + 512 * i); }
#pragma unroll
            for (int e = 0; e < 8; ++e) { float s = 0.f;
#pragma unroll
                for (int i = 0; i < 4; ++i) {
                    s = dot2bf(uv[e][i].x, hv[i].x, s); s = dot2bf(uv[e][i].y, hv[i].y, s); s = dot2bf(uv[e][i].z, hv[i].z, s); s = dot2bf(uv[e][i].w, hv[i].w, s); }
                part[e] = wave_sum(s); }
#pragma unroll
            for (int e = 0; e < 8; ++e) { const bf16* row = V + (size_t)eid[e] * DM + 8 * lane;
#pragma unroll
                for (int i = 0; i < 4; ++i) uv[e][i] = *(const u32x4*)(row + 512 * i); }
#pragma unroll
            for (int e = 0; e < 8; ++e) { const int sl = eb + e; const float gg = sl < 64 ? __shfl(g0, sl) : __shfl(g1, sl - 64);
                const float act = part[e] * rstd2; const float ge = 0.5f * act * (1.f + erff(act * 0.70710678118654752f)); const float cf = gg * ge;
#pragma unroll
                for (int i = 0; i < 4; ++i) {
                    oacc[8 * i + 0] += cf * bflo(uv[e][i].x); oacc[8 * i + 1] += cf * bfhi(uv[e][i].x); oacc[8 * i + 2] += cf * bflo(uv[e][i].y); oacc[8 * i + 3] += cf * bfhi(uv[e][i].y);
                    oacc[8 * i + 4] += cf * bflo(uv[e][i].z); oacc[8 * i + 5] += cf * bfhi(uv[e][i].z); oacc[8 * i + 6] += cf * bflo(uv[e][i].w); oacc[8 * i + 7] += cf * bfhi(uv[e][i].w); } }
        }
        float* orow = a->out + (size_t)tok * DM + 8 * lane; float ss = 0.f;
#pragma unroll
        for (int i = 0; i < 4; ++i) { const f32x4 x0 = *(const f32x4*)(orow + 512 * i), x1 = *(const f32x4*)(orow + 512 * i + 4);
#pragma unroll
            for (int j = 0; j < 4; ++j) { oacc[8 * i + j] += x0[j]; oacc[8 * i + 4 + j] += x1[j]; }
#pragma unroll
            for (int j = 0; j < 8; ++j) ss += oacc[8 * i + j] * oacc[8 * i + j]; }
        const float rstd = 1.f / sqrtf(wave_sum(ss) * (1.f / DM) + EPS);
#pragma unroll
        for (int i = 0; i < 4; ++i) { const f32x4 w0 = *(const f32x4*)(a->lnf_w + 8 * lane + 512 * i), w1 = *(const f32x4*)(a->lnf_w + 8 * lane + 512 * i + 4); f32x4 o0, o1;
#pragma unroll
            for (int j = 0; j < 4; ++j) { o0[j] = oacc[8 * i + j] * rstd * w0[j]; o1[j] = oacc[8 * i + 4 + j] * rstd * w1[j]; }
            *(f32x4*)(orow + 512 * i) = o0; *(f32x4*)(orow + 512 * i + 4) = o1; }
    }
}
__device__ __forceinline__ void convert_uv(ArgsP a, const int tidx) {
    const size_t gt = (size_t)blockIdx.x * NTHR + tidx, NGT = (size_t)gridDim.x * NTHR; const size_t NP = (size_t)16384 * 2048 / 8;
    u32x4* Ud = (u32x4*)(a->ws + WS_U); u32x4* Vd = (u32x4*)(a->ws + WS_V2);
    for (size_t i = gt; i < 2 * NP; i += NGT) { const bool second = i >= NP; const size_t j = second ? i - NP : i; const float* src = (second ? a->peer_v : a->peer_u) + j * 8;
        const f32x4 x0 = *(const f32x4*)src, x1 = *(const f32x4*)(src + 4); u32x4 o; o.x = cvtpk(x0[0], x0[1]); o.y = cvtpk(x0[2], x0[3]); o.z = cvtpk(x1[0], x1[1]); o.w = cvtpk(x1[2], x1[3]);
        (second ? Vd : Ud)[j] = o; }
}
constexpr size_t WS_PART = 336 * MiB;
constexpr size_t WS_COEF = 105 * MiB;
constexpr int Q_U = 8192, Q_V = 8192 + 1024;
constexpr size_t MISC_SS2 = 131072;
constexpr size_t WS_X1B = 185 * MiB, WS_PO = 249 * MiB;

__device__ __forceinline__ void convert_uv_sliced(ArgsP a, const int tidx) {
    const int lane = tidx & 63, w = tidx >> 6; const int gw = blockIdx.x * NWAVES + w, NGW = gridDim.x * NWAVES;
    bf16* Us = (bf16*)(a->ws + WS_U); bf16* Vs = (bf16*)(a->ws + WS_V2);
    for (int row = gw; row < 32768; row += NGW) { const bool second = row >= 16384; const int e = row & 16383; const f32x4* src = (const f32x4*)((second ? a->peer_v : a->peer_u) + (size_t)e * DM) + lane; bf16* dst = second ? Vs : Us;
        f32x4 x[8];
#pragma unroll
        for (int j = 0; j < 8; ++j) x[j] = src[64 * j];
#pragma unroll
        for (int j = 0; j < 8; ++j) { const int s = 4 * j + (lane >> 4); u32x2 o; o.x = cvtpk(x[j][0], x[j][1]); o.y = cvtpk(x[j][2], x[j][3]);
            *(u32x2*)(dst + ((size_t)s * 16384 + e) * 64 + 4 * (lane & 15)) = o; } }
}
__device__ __forceinline__ void peer_stage_idx(const int* IDX, int tok0, LAS unsigned char* lds, int tid) {
#pragma unroll
    for (int i = 0; i < 8; ++i) { const int q = tid + 512 * i; const u32x4 v = *(const u32x4*)(IDX + (size_t)tok0 * 128 + 4 * q);
        *(LAS u32x2*)(lds + 8 * q) = (u32x2){v.x | (v.y << 16), v.z | (v.w << 16)}; }
}
__device__ __forceinline__ void peer_u_phase(ArgsP a, LAS unsigned char* lds, const int tidx, const int qoff = 0) {
    const int w = __builtin_amdgcn_readfirstlane(tidx >> 6); const int myx = (int)(xb_xcc_id() & 7u); int probe = 0;
    unsigned* heads = (unsigned*)(a->ws + WS_CTL) + Q_U + qoff; volatile LAS int* bc = (volatile LAS int*)(lds + 98304);
    const bf16* HN = (const bf16*)(a->ws + WS_HN); const bf16* Us = (const bf16*)(a->ws + WS_U); const int* IDX = (const int*)(a->ws + WS_IDX); bf16* PART = (bf16*)(a->ws + WS_PART);
    for (;;) {
        const int tid = opaque(tidx), lane = tid & 63, m = lane & 7, g = lane >> 3;
        const int item = peer_next_item(heads, myx, probe, 512u, bc, tid); if (item < 0) break;
        const int s = item >> 7, tile = item & 127, tok0 = tile * 128;
        peer_stage_idx(IDX, tok0, lds, tid);
        __syncthreads();
        const bf16* ub = Us + (size_t)s * 16384 * 64 + 8 * m;
        for (int tt = 0; tt < 16; ++tt) { const int tl = 16 * w + tt, t = tok0 + tl;
            const u32x4 hv = *(const u32x4*)(HN + (size_t)t * DM + 64 * s + 8 * m);
            u32x4 uv[16];
#pragma unroll
            for (int r = 0; r < 16; ++r) { const unsigned id = *(const LAS unsigned short*)(lds + (tl * 128 + 16 * g + r) * 2); uv[r] = *(const u32x4*)(ub + (size_t)id * 64); }
            float p[16];
#pragma unroll
            for (int r = 0; r < 16; ++r) { float d = dot2bf(uv[r].x, hv.x, 0.f); d = dot2bf(uv[r].y, hv.y, d); d = dot2bf(uv[r].z, hv.z, d); d = dot2bf(uv[r].w, hv.w, d); p[r] = d; }
            float q8[8], q4[4], q2[2];
#pragma unroll
            for (int r = 0; r < 8; ++r) { const bool up = (lane & 4) != 0; const float snd = up ? p[r] : p[r + 8], kp = up ? p[r + 8] : p[r]; q8[r] = kp + __shfl_xor(snd, 4); }
#pragma unroll
            for (int r = 0; r < 4; ++r) { const bool up = (lane & 2) != 0; const float snd = up ? q8[r] : q8[r + 4], kp = up ? q8[r + 4] : q8[r]; q4[r] = kp + __shfl_xor(snd, 2); }
#pragma unroll
            for (int r = 0; r < 2; ++r) { const bool up = (lane & 1) != 0; const float snd = up ? q4[r] : q4[r + 2], kp = up ? q4[r + 2] : q4[r]; q2[r] = kp + __shfl_xor(snd, 1); }
            *(unsigned*)(PART + ((size_t)s * M + t) * 128 + 2 * lane) = cvtpk(q2[0], q2[1]);
        }
        __syncthreads();
    }
}
__device__ __forceinline__ void peer_combine(ArgsP a, const int tidx) {
    const size_t gt = (size_t)blockIdx.x * NTHR + tidx, NGT = (size_t)gridDim.x * NTHR;
    const unsigned* PART = (const unsigned*)(a->ws + WS_PART); const float* GW = (const float*)(a->ws + WS_GW); const float* SUMSQ = (const float*)(a->ws + WS_MISC + MISC_SUMSQ); f32x2* C = (f32x2*)(a->ws + WS_COEF);
    for (size_t i = gt; i < (size_t)M * 64; i += NGT) { const int t = (int)(i >> 6); float s0 = 0.f, s1 = 0.f;
#pragma unroll 8
        for (int s = 0; s < 32; ++s) { const unsigned v = PART[(size_t)s * M * 64 + i]; s0 += bflo(v); s1 += bfhi(v); }
        const float rstd2 = 1.f / sqrtf(SUMSQ[t] * (1.f / DM) + EPS); const f32x2 g = ((const f32x2*)GW)[i];
        const float a0 = s0 * rstd2, a1 = s1 * rstd2;
        C[i] = (f32x2){g.x * 0.5f * a0 * (1.f + erff(a0 * 0.70710678118654752f)), g.y * 0.5f * a1 * (1.f + erff(a1 * 0.70710678118654752f))}; }
}
template <bool DRY> __device__ __forceinline__ void peer_v_phase(ArgsP a, LAS unsigned char* lds, const int tidx, const int qoff = 0) {
    const int w = __builtin_amdgcn_readfirstlane(tidx >> 6); const int myx = (int)(xb_xcc_id() & 7u); int probe = 0;
    unsigned* heads = (unsigned*)(a->ws + WS_CTL) + Q_V + qoff; volatile LAS int* bc = (volatile LAS int*)(lds + 98304);
    const bf16* Vs = (const bf16*)(a->ws + WS_V2); const int* IDX = (const int*)(a->ws + WS_IDX); const float* COEF = (const float*)(a->ws + WS_COEF); float* SS2 = (float*)(a->ws + WS_MISC + MISC_SS2);
    for (;;) {
        const int tid = opaque(tidx), lane = tid & 63, m = lane & 7, g = lane >> 3;
        const int item = peer_next_item(heads, myx, probe, 512u, bc, tid); if (item < 0) break;
        const int s = item >> 7, tile = item & 127, tok0 = tile * 128;
        peer_stage_idx(IDX, tok0, lds, tid);
#pragma unroll
        for (int i = 0; i < 8; ++i) { const int q = tid + 512 * i; *(LAS u32x4*)(lds + 32768 + 16 * q) = *(const u32x4*)(COEF + (size_t)tok0 * 128 + 4 * q); }
        __syncthreads();
        const bf16* vb = Vs + (size_t)s * 16384 * 64 + 8 * m;
        for (int tt = 0; tt < 16; ++tt) { const int tl = 16 * w + tt, t = tok0 + tl;
            u32x4 vv[16]; float cf[16];
#pragma unroll
            for (int r = 0; r < 16; ++r) { const unsigned id = *(const LAS unsigned short*)(lds + (tl * 128 + 16 * g + r) * 2); vv[r] = *(const u32x4*)(vb + (size_t)id * 64); cf[r] = *(const LAS float*)(lds + 32768 + (tl * 128 + 16 * g + r) * 4); }
            float acc[8];
#pragma unroll
            for (int j = 0; j < 8; ++j) acc[j] = 0.f;
#pragma unroll
            for (int r = 0; r < 16; ++r) { acc[0] += cf[r] * bflo(vv[r].x); acc[1] += cf[r] * bfhi(vv[r].x); acc[2] += cf[r] * bflo(vv[r].y); acc[3] += cf[r] * bfhi(vv[r].y);
                acc[4] += cf[r] * bflo(vv[r].z); acc[5] += cf[r] * bfhi(vv[r].z); acc[6] += cf[r] * bflo(vv[r].w); acc[7] += cf[r] * bfhi(vv[r].w); }
            float q4[4], q2[2];
#pragma unroll
            for (int j = 0; j < 4; ++j) { const bool up = (lane & 32) != 0; const float snd = up ? acc[j] : acc[j + 4], kp = up ? acc[j + 4] : acc[j]; q4[j] = kp + __shfl_xor(snd, 32); }
#pragma unroll
            for (int j = 0; j < 2; ++j) { const bool up = (lane & 16) != 0; const float snd = up ? q4[j] : q4[j + 2], kp = up ? q4[j + 2] : q4[j]; q2[j] = kp + __shfl_xor(snd, 16); }
            float r1; { const bool up = (lane & 8) != 0; const float snd = up ? q2[0] : q2[1], kp = up ? q2[1] : q2[0]; r1 = kp + __shfl_xor(snd, 8); }
            float* op = a->out + (size_t)t * DM + 64 * s + 8 * m + g;
            const float x1v = *op; const float x2 = x1v + r1; *op = DRY ? (x2 == 12345.678f ? x2 : x1v) : x2;
            const float ss = wave_sum(x2 * x2);
            if (lane == 0 && !DRY) atomicAdd(SS2 + t, ss);
        }
        __syncthreads();
    }
}
template <bool DRY> __device__ __forceinline__ void peer_final(ArgsP a, const int tidx) {
    const int lane = tidx & 63, w = tidx >> 6; const int gwv = blockIdx.x * NWAVES + w, NGW = gridDim.x * NWAVES; const float* SS2 = (const float*)(a->ws + WS_MISC + MISC_SS2);
    for (int tok = gwv; tok < M; tok += NGW) { const float rstd = 1.f / sqrtf(SS2[tok] * (1.f / DM) + EPS); f32x4* orow = (f32x4*)(a->out + (size_t)tok * DM) + lane; const f32x4* wr = (const f32x4*)a->lnf_w + lane;
#pragma unroll
        for (int j = 0; j < 8; ++j) { f32x4 v = orow[64 * j]; const f32x4 o = v * rstd * wr[64 * j]; orow[64 * j] = DRY ? (o[0] == 12345.678f ? o : v) : o; } }
}
__device__ __forceinline__ void peer_final8(ArgsP a, const int tidx) {
    const int lane = tidx & 63, w = tidx >> 6; const int gwv = blockIdx.x * NWAVES + w, NGW = gridDim.x * NWAVES;
    const bf16* X1B = (const bf16*)(a->ws + WS_X1B); const bf16* PO = (const bf16*)(a->ws + WS_PO);
    for (int tok = gwv; tok < M; tok += NGW) {
        u32x4 xv[4], pv[4];
#pragma unroll
        for (int i = 0; i < 4; ++i) { xv[i] = *(const u32x4*)(X1B + (size_t)tok * DM + 8 * lane + 512 * i); pv[i] = *(const u32x4*)(PO + (size_t)tok * DM + 8 * lane + 512 * i); }
        float v[32]; float ss = 0.f;
#pragma unroll
        for (int i = 0; i < 4; ++i) { v[8 * i + 0] = bflo(xv[i].x) + bflo(pv[i].x); v[8 * i + 1] = bfhi(xv[i].x) + bfhi(pv[i].x); v[8 * i + 2] = bflo(xv[i].y) + bflo(pv[i].y); v[8 * i + 3] = bfhi(xv[i].y) + bfhi(pv[i].y);
            v[8 * i + 4] = bflo(xv[i].z) + bflo(pv[i].z); v[8 * i + 5] = bfhi(xv[i].z) + bfhi(pv[i].z); v[8 * i + 6] = bflo(xv[i].w) + bflo(pv[i].w); v[8 * i + 7] = bfhi(xv[i].w) + bfhi(pv[i].w); }
#pragma unroll
        for (int i = 0; i < 32; ++i) ss += v[i] * v[i];
        const float rstd = 1.f / sqrtf(wave_sum(ss) * (1.f / DM) + EPS);
        float* orow = a->out + (size_t)tok * DM + 8 * lane;
#pragma unroll
        for (int i = 0; i < 4; ++i) { const f32x4 w0 = *(const f32x4*)(a->lnf_w + 8 * lane + 512 * i), w1 = *(const f32x4*)(a->lnf_w + 8 * lane + 512 * i + 4); f32x4 o0, o1;
#pragma unroll
            for (int j = 0; j < 4; ++j) { o0[j] = v[8 * i + j] * rstd * w0[j]; o1[j] = v[8 * i + 4 + j] * rstd * w1[j]; }
            *(f32x4*)(orow + 512 * i) = o0; *(f32x4*)(orow + 512 * i + 4) = o1; }
    }
}
__device__ __forceinline__ f32x2 fp8lo(unsigned w) { return __builtin_amdgcn_cvt_pk_f32_fp8((int)w, false); }
__device__ __forceinline__ f32x2 fp8hi(unsigned w) { return __builtin_amdgcn_cvt_pk_f32_fp8((int)w, true); }
template <int CTRL> __device__ __forceinline__ float dppf(float v) { return __int_as_float(__builtin_amdgcn_update_dpp(0, __float_as_int(v), CTRL, 0xf, 0xf, false)); }
__device__ __forceinline__ float xor4f(float v, bool up) { const float a = dppf<0x114>(v), b = dppf<0x104>(v); return up ? a : b; }
__device__ __forceinline__ float xor2f(float v) { return dppf<0x4E>(v); }
__device__ __forceinline__ float xor1f(float v) { return dppf<0xB1>(v); }
__device__ __forceinline__ float xor8f(float v) { return dppf<0x128>(v); }
__device__ __forceinline__ float swapsum32(float d, float s) { auto rr = __builtin_amdgcn_permlane32_swap(__float_as_uint(d), __float_as_uint(s), false, false); return __uint_as_float(rr[0]) + __uint_as_float(rr[1]); }
__device__ __forceinline__ float swapsum16(float d, float s) { auto rr = __builtin_amdgcn_permlane16_swap(__float_as_uint(d), __float_as_uint(s), false, false); return __uint_as_float(rr[0]) + __uint_as_float(rr[1]); }
__device__ __forceinline__ int peer_pop_t0(unsigned* heads, const int myx, int& probe, const unsigned nper) {
    while (probe < 8) { const int q = (myx + probe) & 7; const unsigned v = __hip_atomic_fetch_add(&heads[64 * q], 1u, __ATOMIC_RELAXED, __HIP_MEMORY_SCOPE_AGENT); if (v < nper) return q * (int)nper + (int)v; ++probe; }
    return -1;
}
__device__ __forceinline__ void peer_u_phase8(ArgsP a, LAS unsigned char* lds, const int tidx, const int qoff = 0) {
    const int w = __builtin_amdgcn_readfirstlane(tidx >> 6); const int myx = (int)(xb_xcc_id() & 7u); int probe = 0;
    unsigned* heads = (unsigned*)(a->ws + WS_CTL) + Q_U + qoff; volatile LAS int* bc = (volatile LAS int*)(lds + 98304);
    const bf16* HN = (const bf16*)(a->ws + WS_HN); const unsigned char* U8 = (const unsigned char*)(a->ws + WS_U8); const int* IDX = (const int*)(a->ws + WS_IDX); bf16* PART = (bf16*)(a->ws + WS_PART);
    if (tidx == 0) bc[0] = peer_pop_t0(heads, myx, probe, 256u);
    __syncthreads();
    int item = bc[0], par = 1;
    u32x4 pre[8];
    if (item >= 0) {
#pragma unroll
        for (int i = 0; i < 8; ++i) pre[i] = *(const u32x4*)(IDX + (size_t)(item & 127) * 128 * 128 + 4 * (tidx + 512 * i)); }
    while (item >= 0) {
        const int tid = opaque(tidx), lane = tid & 63, m = lane & 7, g = lane >> 3;
        const int s = item >> 7, tile = item & 127, tok0 = tile * 128;
#pragma unroll
        for (int i = 0; i < 8; ++i) { const int q = tid + 512 * i; *(LAS u32x2*)(lds + 8 * q) = (u32x2){pre[i].x | (pre[i].y << 16), pre[i].z | (pre[i].w << 16)}; }
        __syncthreads();
        if (tid == 0) bc[par] = peer_pop_t0(heads, myx, probe, 256u);
        const unsigned char* ub = U8 + (size_t)s * 16384 * 128 + 16 * m;
        LAS unsigned char* hqb = lds + 40960 + w * 1152;
#define PU_QUANT(TT0) do { const int tlq_ = 16 * w + (TT0) + g; const bf16* hp_ = HN + (size_t)(tok0 + tlq_) * DM + 128 * s + 16 * m; const u32x4 H0 = *(const u32x4*)hp_, H1 = *(const u32x4*)(hp_ + 8); float hf[16]; \
            hf[0] = bflo(H0.x); hf[1] = bfhi(H0.x); hf[2] = bflo(H0.y); hf[3] = bfhi(H0.y); hf[4] = bflo(H0.z); hf[5] = bfhi(H0.z); hf[6] = bflo(H0.w); hf[7] = bfhi(H0.w); \
            hf[8] = bflo(H1.x); hf[9] = bfhi(H1.x); hf[10] = bflo(H1.y); hf[11] = bfhi(H1.y); hf[12] = bflo(H1.z); hf[13] = bfhi(H1.z); hf[14] = bflo(H1.w); hf[15] = bfhi(H1.w); \
            float mx_ = 0.f; \
            _Pragma("unroll") for (int j = 0; j < 16; ++j) mx_ = fmaxf(mx_, fabsf(hf[j])); \
            mx_ = fmaxf(mx_, xor4f(mx_, (lane & 4) != 0)); mx_ = fmaxf(mx_, xor2f(mx_)); mx_ = fmaxf(mx_, xor1f(mx_)); \
            const float hsc_ = mx_ > 0.f ? 127.f / mx_ : 1.f, hinv_ = mx_ > 0.f ? mx_ * (1.f / 127.f) : 1.f; \
            u32x4 hq_; hq_.x = (unsigned)pack_i8x4(hf[0] * hsc_, hf[1] * hsc_, hf[2] * hsc_, hf[3] * hsc_); hq_.y = (unsigned)pack_i8x4(hf[4] * hsc_, hf[5] * hsc_, hf[6] * hsc_, hf[7] * hsc_); \
            hq_.z = (unsigned)pack_i8x4(hf[8] * hsc_, hf[9] * hsc_, hf[10] * hsc_, hf[11] * hsc_); hq_.w = (unsigned)pack_i8x4(hf[12] * hsc_, hf[13] * hsc_, hf[14] * hsc_, hf[15] * hsc_); \
            *(LAS u32x4*)(hqb + (g * 8 + m) * 16) = hq_; if (m == 0) *(LAS float*)(hqb + 1024 + 4 * g) = hinv_; } while (0)
#define PU_ISSUE(UV, H0, H1, TT) do { const int tl_ = 16 * w + (TT); \
            const u32x4 idA_ = *(const LAS u32x4*)(lds + (tl_ * 128 + 16 * g) * 2), idB_ = *(const LAS u32x4*)(lds + (tl_ * 128 + 16 * g) * 2 + 16); \
            const unsigned idw_[8] = {idA_.x, idA_.y, idA_.z, idA_.w, idB_.x, idB_.y, idB_.z, idB_.w}; \
            _Pragma("unroll") for (int r = 0; r < 16; ++r) { const unsigned id = (r & 1) ? (idw_[r >> 1] >> 16) : (idw_[r >> 1] & 0xffffu); UV[r] = *(const u32x4*)(ub + (size_t)id * 128); } } while (0)
#define PU_REDUCE(UV, H0, H1, TT) do { const int t_ = tok0 + 16 * w + (TT); \
            const u32x4 hq_ = *(const LAS u32x4*)(hqb + (((TT) & 7) * 8 + m) * 16); const float hinv_ = *(const LAS float*)(hqb + 1024 + 4 * ((TT) & 7)); \
            const int hq0 = (int)hq_.x, hq1 = (int)hq_.y, hq2 = (int)hq_.z, hq3 = (int)hq_.w; \
            float p[16]; \
            _Pragma("unroll") for (int r = 0; r < 16; ++r) { int ac = __builtin_amdgcn_sdot4((int)UV[r].x, hq0, 0, false); ac = __builtin_amdgcn_sdot4((int)UV[r].y, hq1, ac, false); \
                ac = __builtin_amdgcn_sdot4((int)UV[r].z, hq2, ac, false); ac = __builtin_amdgcn_sdot4((int)UV[r].w, hq3, ac, false); p[r] = (float)ac * hinv_; } \
            float q8[8], q4[4], q2[2]; \
            _Pragma("unroll") for (int r = 0; r < 8; ++r) { const bool up = (lane & 4) != 0; const float snd = up ? p[r] : p[r + 8], kp = up ? p[r + 8] : p[r]; q8[r] = kp + xor4f(snd, up); } \
            _Pragma("unroll") for (int r = 0; r < 4; ++r) { const bool up = (lane & 2) != 0; const float snd = up ? q8[r] : q8[r + 4], kp = up ? q8[r + 4] : q8[r]; q4[r] = kp + xor2f(snd); } \
            _Pragma("unroll") for (int r = 0; r < 2; ++r) { const bool up = (lane & 1) != 0; const float snd = up ? q4[r] : q4[r + 2], kp = up ? q4[r + 2] : q4[r]; q2[r] = kp + xor1f(snd); } \
            *(unsigned*)(PART + ((size_t)s * M + t_) * 128 + 2 * lane) = cvtpk(q2[0], q2[1]); } while (0)
        u32x4 uvA[16], uvB[16], hA0, hA1, hB0, hB1;
        PU_QUANT(0);
        for (int tt = 0; tt < 8; ++tt) { PU_ISSUE(uvA, hA0, hA1, tt); PU_REDUCE(uvA, hA0, hA1, tt); }
        __syncthreads();
        const int nxt = bc[par];
        if (nxt >= 0) {
#pragma unroll
            for (int i = 0; i < 8; ++i) pre[i] = *(const u32x4*)(IDX + (size_t)(nxt & 127) * 128 * 128 + 4 * (tid + 512 * i)); }
        PU_QUANT(8);
        for (int tt = 8; tt < 16; ++tt) { PU_ISSUE(uvA, hA0, hA1, tt); PU_REDUCE(uvA, hA0, hA1, tt); }
        (void)uvB; (void)hA0; (void)hA1; (void)hB0; (void)hB1;
#undef PU_QUANT
#undef PU_ISSUE
#undef PU_REDUCE
        __syncthreads();
        item = nxt; par ^= 1;
    }
}
__device__ __forceinline__ void peer_combine8(ArgsP a, const int tidx) {
    const size_t gt = (size_t)blockIdx.x * NTHR + tidx, NGT = (size_t)gridDim.x * NTHR;
    const unsigned* PART = (const unsigned*)(a->ws + WS_PART); const float* GW = (const float*)(a->ws + WS_GW); const float* SUMSQ = (const float*)(a->ws + WS_MISC + MISC_SUMSQ); f32x2* C = (f32x2*)(a->ws + WS_COEF);
    const float* USC = (const float*)(a->ws + WS_USC); const float* VSC = (const float*)(a->ws + WS_VSC); const int* IDX = (const int*)(a->ws + WS_IDX);
    for (size_t i0 = gt; i0 < (size_t)M * 64; i0 += 2 * NGT) {
        unsigned pv[2][16]; int id[2][2]; f32x2 g[2]; float sq[2];
#pragma unroll
        for (int q = 0; q < 2; ++q) { const size_t i = i0 + q * NGT;
#pragma unroll
            for (int s = 0; s < 16; ++s) pv[q][s] = PART[(size_t)s * M * 64 + i];
            id[q][0] = IDX[2 * i]; id[q][1] = IDX[2 * i + 1]; g[q] = ((const f32x2*)GW)[i]; sq[q] = SUMSQ[(int)(i >> 6)]; }
#pragma unroll
        for (int q = 0; q < 2; ++q) { const size_t i = i0 + q * NGT; float s0 = 0.f, s1 = 0.f;
#pragma unroll
            for (int s = 0; s < 16; ++s) { s0 += bflo(pv[q][s]); s1 += bfhi(pv[q][s]); }
            const float rstd2 = 1.f / sqrtf(sq[q] * (1.f / DM) + EPS);
            const float a0 = s0 * rstd2 * USC[id[q][0]], a1 = s1 * rstd2 * USC[id[q][1]];
            const float c0 = g[q].x * 0.5f * a0 * (1.f + erff(a0 * 0.70710678118654752f)) * VSC[id[q][0]], c1 = g[q].y * 0.5f * a1 * (1.f + erff(a1 * 0.70710678118654752f)) * VSC[id[q][1]];
#if PEERV_I8
            float mxc = fmaxf(fabsf(c0), fabsf(c1)); mxc = fmaxf(mxc, xor1f(mxc)); mxc = fmaxf(mxc, xor2f(mxc)); mxc = fmaxf(mxc, xor4f(mxc, (tidx & 4) != 0));
            const float scq = mxc > 0.f ? 127.f / mxc : 0.f; const int q0 = __float2int_rn(c0 * scq), q1 = __float2int_rn(c1 * scq);
            ((unsigned short*)(a->ws + WS_COEF))[i] = (unsigned short)((q0 & 255) | ((q1 & 255) << 8));
            if ((tidx & 7) == 0) ((float*)(a->ws + WS_CSC))[i >> 3] = mxc * (1.f / 127.f);
#else
            C[i] = (f32x2){c0, c1};
#endif
        }
    }
}
#if PEERV_I8
template <bool DRY> __device__ __forceinline__ void peer_v_phase8(ArgsP a, LAS unsigned char* lds, const int tidx, const int qoff = 0) {
    const int w = __builtin_amdgcn_readfirstlane(tidx >> 6); const int myx = (int)(xb_xcc_id() & 7u); int probe = 0;
    unsigned* heads = (unsigned*)(a->ws + WS_CTL) + Q_V + qoff; volatile LAS int* bc = (volatile LAS int*)(lds + 98304);
    const unsigned char* V8 = (const unsigned char*)(a->ws + WS_V8); const int* IDX = (const int*)(a->ws + WS_IDX); const unsigned char* CQ = (const unsigned char*)(a->ws + WS_COEF); const float* CSC = (const float*)(a->ws + WS_CSC); bf16* PO = (bf16*)(a->ws + WS_PO);
    if (tidx == 0) bc[0] = peer_pop_t0(heads, myx, probe, 256u);
    __syncthreads();
    int item = bc[0], par = 1;
    u32x4 pre[8], prc[2]; u32x2 prs;
    if (item >= 0) {
#pragma unroll
        for (int i = 0; i < 8; ++i) pre[i] = *(const u32x4*)(IDX + (size_t)(item & 127) * 128 * 128 + 4 * (tidx + 512 * i));
#pragma unroll
        for (int i = 0; i < 2; ++i) prc[i] = *(const u32x4*)(CQ + (size_t)(item & 127) * 128 * 128 + 16 * (tidx + 512 * i));
        prs = *(const u32x2*)(CSC + (size_t)(item & 127) * 128 * 8 + 2 * tidx); }
    while (item >= 0) {
        const int tid = opaque(tidx), lane = tid & 63, m = lane & 7, g = lane >> 3;
        const int s = item >> 7, tile = item & 127, tok0 = tile * 128;
#pragma unroll
        for (int i = 0; i < 8; ++i) { const int q = tid + 512 * i; *(LAS u32x2*)(lds + 8 * q) = (u32x2){pre[i].x | (pre[i].y << 16), pre[i].z | (pre[i].w << 16)}; }
#pragma unroll
        for (int i = 0; i < 2; ++i) *(LAS u32x4*)(lds + 32768 + 16 * (tid + 512 * i)) = prc[i];
        *(LAS u32x2*)(lds + 49152 + 8 * tid) = prs;
        __syncthreads();
        if (tid == 0) bc[par] = peer_pop_t0(heads, myx, probe, 256u);
        const unsigned char* vb = V8 + (size_t)s * 16384 * 128 + 16 * m;
#define PV_ISSUE(VV, TT) do { const int tl_ = 16 * w + (TT); \
            const u32x4 idA_ = *(const LAS u32x4*)(lds + (tl_ * 128 + 16 * g) * 2), idB_ = *(const LAS u32x4*)(lds + (tl_ * 128 + 16 * g) * 2 + 16); \
            const unsigned idw_[8] = {idA_.x, idA_.y, idA_.z, idA_.w, idB_.x, idB_.y, idB_.z, idB_.w}; \
            _Pragma("unroll") for (int r = 0; r < 16; ++r) { const unsigned id = (r & 1) ? (idw_[r >> 1] >> 16) : (idw_[r >> 1] & 0xffffu); VV[r] = *(const u32x4*)(vb + (size_t)id * 128); } } while (0)
#define PV_REDUCE(VV, TT) do { const int tl_ = 16 * w + (TT), t_ = tok0 + tl_; \
            const u32x4 cq_ = *(const LAS u32x4*)(lds + 32768 + tl_ * 128 + 16 * g); const float cs_ = *(const LAS float*)(lds + 49152 + (tl_ * 8 + g) * 4); \
            int ia[16]; \
            _Pragma("unroll") for (int j = 0; j < 16; ++j) ia[j] = 0; \
            _Pragma("unroll") for (int rg = 0; rg < 4; ++rg) { const int c4 = (int)cq_[rg]; \
                _Pragma("unroll") for (int j = 0; j < 4; ++j) { const unsigned W0 = VV[4 * rg][j], W1 = VV[4 * rg + 1][j], W2 = VV[4 * rg + 2][j], W3 = VV[4 * rg + 3][j]; \
                    const unsigned lo01 = __builtin_amdgcn_perm(W1, W0, 0x05010400u), hi01 = __builtin_amdgcn_perm(W1, W0, 0x07030602u), lo23 = __builtin_amdgcn_perm(W3, W2, 0x05010400u), hi23 = __builtin_amdgcn_perm(W3, W2, 0x07030602u); \
                    ia[4 * j + 0] = __builtin_amdgcn_sdot4((int)__builtin_amdgcn_perm(lo23, lo01, 0x05040100u), c4, ia[4 * j + 0], false); \
                    ia[4 * j + 1] = __builtin_amdgcn_sdot4((int)__builtin_amdgcn_perm(lo23, lo01, 0x07060302u), c4, ia[4 * j + 1], false); \
                    ia[4 * j + 2] = __builtin_amdgcn_sdot4((int)__builtin_amdgcn_perm(hi23, hi01, 0x05040100u), c4, ia[4 * j + 2], false); \
                    ia[4 * j + 3] = __builtin_amdgcn_sdot4((int)__builtin_amdgcn_perm(hi23, hi01, 0x07060302u), c4, ia[4 * j + 3], false); } } \
            f32x2 acc[8]; \
            _Pragma("unroll") for (int j = 0; j < 8; ++j) acc[j] = (f32x2){(float)ia[2 * j] * cs_, (float)ia[2 * j + 1] * cs_}; \
            f32x2 q4[4], q2[2], q1; \
            _Pragma("unroll") for (int j = 0; j < 4; ++j) q4[j] = (f32x2){swapsum32(acc[j].x, acc[j + 4].x), swapsum32(acc[j].y, acc[j + 4].y)}; \
            _Pragma("unroll") for (int j = 0; j < 2; ++j) q2[j] = (f32x2){swapsum16(q4[j].x, q4[j + 2].x), swapsum16(q4[j].y, q4[j + 2].y)}; \
            { const bool up = (lane & 8) != 0; const f32x2 snd = up ? q2[0] : q2[1], kp = up ? q2[1] : q2[0]; q1 = kp + (f32x2){xor8f(snd.x), xor8f(snd.y)}; } \
            if (!DRY) *(unsigned*)(PO + (size_t)t_ * DM + 128 * s + 16 * m + 2 * g) = cvtpk(q1.x, q1.y); } while (0)
        u32x4 vvA[16];
        for (int tt = 0; tt < 8; ++tt) { PV_ISSUE(vvA, tt); PV_REDUCE(vvA, tt); }
        __syncthreads();
        const int nxt = bc[par];
        if (nxt >= 0) {
#pragma unroll
            for (int i = 0; i < 8; ++i) pre[i] = *(const u32x4*)(IDX + (size_t)(nxt & 127) * 128 * 128 + 4 * (tid + 512 * i));
#pragma unroll
            for (int i = 0; i < 2; ++i) prc[i] = *(const u32x4*)(CQ + (size_t)(nxt & 127) * 128 * 128 + 16 * (tid + 512 * i));
            prs = *(const u32x2*)(CSC + (size_t)(nxt & 127) * 128 * 8 + 2 * tid); }
        for (int tt = 8; tt < 16; ++tt) { PV_ISSUE(vvA, tt); PV_REDUCE(vvA, tt); }
#undef PV_ISSUE
#undef PV_REDUCE
        __syncthreads();
        item = nxt; par ^= 1;
    }
}
#else
template <bool DRY> __device__ __forceinline__ void peer_v_phase8(ArgsP a, LAS unsigned char* lds, const int tidx, const int qoff = 0) {
    const int w = __builtin_amdgcn_readfirstlane(tidx >> 6); const int myx = (int)(xb_xcc_id() & 7u); int probe = 0;
    unsigned* heads = (unsigned*)(a->ws + WS_CTL) + Q_V + qoff; volatile LAS int* bc = (volatile LAS int*)(lds + 98304);
    const unsigned char* V8 = (const unsigned char*)(a->ws + WS_V8); const int* IDX = (const int*)(a->ws + WS_IDX); const float* COEF = (const float*)(a->ws + WS_COEF); bf16* PO = (bf16*)(a->ws + WS_PO);
    if (tidx == 0) bc[0] = peer_pop_t0(heads, myx, probe, 256u);
    __syncthreads();
    int item = bc[0], par = 1;
    u32x4 pre[8], prc[8];
    if (item >= 0) {
#pragma unroll
        for (int i = 0; i < 8; ++i) { pre[i] = *(const u32x4*)(IDX + (size_t)(item & 127) * 128 * 128 + 4 * (tidx + 512 * i)); prc[i] = *(const u32x4*)(COEF + (size_t)(item & 127) * 128 * 128 + 4 * (tidx + 512 * i)); } }
    while (item >= 0) {
        const int tid = opaque(tidx), lane = tid & 63, m = lane & 7, g = lane >> 3;
        const int s = item >> 7, tile = item & 127, tok0 = tile * 128;
#pragma unroll
        for (int i = 0; i < 8; ++i) { const int q = tid + 512 * i; *(LAS u32x2*)(lds + 8 * q) = (u32x2){pre[i].x | (pre[i].y << 16), pre[i].z | (pre[i].w << 16)}; *(LAS u32x4*)(lds + 32768 + 16 * q) = prc[i]; }
        __syncthreads();
        if (tid == 0) bc[par] = peer_pop_t0(heads, myx, probe, 256u);
        const unsigned char* vb = V8 + (size_t)s * 16384 * 128 + 16 * m;
#define PV_ISSUE(VV, X1, TT) do { const int tl_ = 16 * w + (TT); \
            const u32x4 idA_ = *(const LAS u32x4*)(lds + (tl_ * 128 + 16 * g) * 2), idB_ = *(const LAS u32x4*)(lds + (tl_ * 128 + 16 * g) * 2 + 16); \
            const unsigned idw_[8] = {idA_.x, idA_.y, idA_.z, idA_.w, idB_.x, idB_.y, idB_.z, idB_.w}; \
            _Pragma("unroll") for (int r = 0; r < 16; ++r) { const unsigned id = (r & 1) ? (idw_[r >> 1] >> 16) : (idw_[r >> 1] & 0xffffu); VV[r] = *(const u32x4*)(vb + (size_t)id * 128); } \
            X1 = (f32x2){0.f, 0.f}; } while (0)
#define PV_REDUCE(VV, X1, TT) do { const int tl_ = 16 * w + (TT), t_ = tok0 + tl_; f32x4 cfv[4]; \
            _Pragma("unroll") for (int i = 0; i < 4; ++i) cfv[i] = *(const LAS f32x4*)(lds + 32768 + (tl_ * 128 + 16 * g + 4 * i) * 4); \
            f32x2 acc[8]; \
            _Pragma("unroll") for (int j = 0; j < 8; ++j) acc[j] = (f32x2){0.f, 0.f}; \
            _Pragma("unroll") for (int r = 0; r < 16; ++r) { const float cf = cfv[r >> 2][r & 3]; const f32x2 c2 = {cf, cf}; \
                acc[0] += c2 * fp8lo(VV[r].x); acc[1] += c2 * fp8hi(VV[r].x); acc[2] += c2 * fp8lo(VV[r].y); acc[3] += c2 * fp8hi(VV[r].y); \
                acc[4] += c2 * fp8lo(VV[r].z); acc[5] += c2 * fp8hi(VV[r].z); acc[6] += c2 * fp8lo(VV[r].w); acc[7] += c2 * fp8hi(VV[r].w); } \
            f32x2 q4[4], q2[2], q1; \
            _Pragma("unroll") for (int j = 0; j < 4; ++j) q4[j] = (f32x2){swapsum32(acc[j].x, acc[j + 4].x), swapsum32(acc[j].y, acc[j + 4].y)}; \
            _Pragma("unroll") for (int j = 0; j < 2; ++j) q2[j] = (f32x2){swapsum16(q4[j].x, q4[j + 2].x), swapsum16(q4[j].y, q4[j + 2].y)}; \
            { const bool up = (lane & 8) != 0; const f32x2 snd = up ? q2[0] : q2[1], kp = up ? q2[1] : q2[0]; q1 = kp + (f32x2){xor8f(snd.x), xor8f(snd.y)}; } \
            if (!DRY) *(unsigned*)(PO + (size_t)t_ * DM + 128 * s + 16 * m + 2 * g) = cvtpk(q1.x + X1.x, q1.y + X1.y); } while (0)
        u32x4 vvA[16], vvB[16]; f32x2 xA, xB;
        for (int tt = 0; tt < 8; ++tt) { PV_ISSUE(vvA, xA, tt); PV_REDUCE(vvA, xA, tt); }
        __syncthreads();
        const int nxt = bc[par];
        if (nxt >= 0) {
#pragma unroll
            for (int i = 0; i < 8; ++i) { pre[i] = *(const u32x4*)(IDX + (size_t)(nxt & 127) * 128 * 128 + 4 * (tid + 512 * i)); prc[i] = *(const u32x4*)(COEF + (size_t)(nxt & 127) * 128 * 128 + 4 * (tid + 512 * i)); } }
        for (int tt = 8; tt < 16; ++tt) { PV_ISSUE(vvA, xA, tt); PV_REDUCE(vvA, xA, tt); }
        (void)vvB; (void)xB;
#undef PV_ISSUE
#undef PV_REDUCE
        __syncthreads();
        item = nxt; par ^= 1;
    }
}
#endif
#if SELFCHECK
constexpr size_t WS_YDBG = 464 * MiB;
constexpr size_t WS_XSAVE = 500 * MiB;
__device__ __forceinline__ float bfr(float v) { return bf2f(f2bf(v)); }
__device__ __forceinline__ void chk_report(ArgsP a, int k, float err) { if (!(err == err)) err = 1e30f; atomicMax((int*)(a->ws + WS_MISC + MISC_CHK) + k, __float_as_int(err)); }
__device__ const int CHK_ROWS[8] = {0, 1, 255, 256, 7777, 12345, 16128, 16383};
__device__ const int CHK_TOK[8] = {0, 1, 63, 127, 128, 129, 8191, 16383};
__device__ __forceinline__ float geluf(float x) { return 0.5f * x * (1.f + erff(x * 0.70710678118654752f)); }
__device__ __forceinline__ void chk1(ArgsP a, const int tidx) {
    const int gt = blockIdx.x * NTHR + tidx, NGT = gridDim.x * NTHR;
    const bf16 *Z = (const bf16*)(a->ws + WS_Z), *XBC = (const bf16*)(a->ws + WS_XBC), *Q = (const bf16*)(a->ws + WS_Q), *K = (const bf16*)(a->ws + WS_K), *V = (const bf16*)(a->ws + WS_V); const float* DTF = (const float*)(a->ws + WS_DTF);
    for (int it = gt; it < 8 * 5664; it += NGT) { const int t = CHK_ROWS[it / 5664], j = it % 5664; const float* xr = a->x + (size_t)t * DM;
        float ss = 0.f; for (int k = 0; k < DM; ++k) ss += xr[k] * xr[k]; const float rstd = 1.f / sqrtf(ss / DM + EPS);
        float ref = 0.f; for (int k = 0; k < DM; ++k) ref += bfr(xr[k] * rstd * a->ln1_w[k]) * bfr(a->w_in[(size_t)k * 5664 + j]);
        float got;
        if (j < 1024) got = bf2f(Z[(size_t)t * 1024 + j]); else if (j < 2560) got = bf2f(XBC[(size_t)t * 1536 + j - 1024]); else if (j < 2576) got = DTF[(size_t)t * 32 + j - 2560];
        else if (j < 3600) got = bf2f(Q[(size_t)t * 1024 + j - 2576]) / QSCALE; else if (j < 4624) got = bf2f(K[(size_t)t * 1024 + j - 3600]); else if (j < 5648) got = bf2f(V[(size_t)t * 1024 + j - 4624]);
        else got = DTF[(size_t)t * 32 + 16 + j - 5648];
        chk_report(a, 1, fabsf(got - ref)); }
}
__device__ __forceinline__ void chk2(ArgsP a, const int tidx) {
    const int gt = blockIdx.x * NTHR + tidx, NGT = gridDim.x * NTHR;
    const bf16 *XBC = (const bf16*)(a->ws + WS_XBC), *XS = (const bf16*)(a->ws + WS_XS), *BC = (const bf16*)(a->ws + WS_BC); const float *DTF = (const float*)(a->ws + WS_DTF), *DT = (const float*)(a->ws + WS_DT), *ACUM = (const float*)(a->ws + WS_ACUM);
    for (int it = gt; it < 64 * 1536; it += NGT) { const int si = it / 1536, ch = it % 1536; const int t = si < 8 ? si : (si < 16 ? 60 + (si - 8) : (int)(((unsigned)si * 2654435761u) % M));
        float acc = a->conv_b[ch]; for (int j = 0; j < 4; ++j) { const int tt = t - 3 + j; if (tt >= 0) acc += a->conv_w[j * 1536 + ch] * bf2f(XBC[(size_t)tt * 1536 + ch]); }
        const float ref = siluf(acc); const float got = ch < 1024 ? bf2f(XS[(size_t)t * 1024 + ch]) : bf2f(BC[(size_t)t * 512 + ch - 1024]);
        chk_report(a, 2, fabsf(got - ref));
        if (ch < 16) { const int h = ch; const float A = -__expf(a->a_log[h]); float ac = 0.f, dtl = 0.f; for (int tt = (t / 64) * 64; tt <= t; ++tt) { dtl = softplusf(DTF[(size_t)tt * 32 + h] + a->dt_bias[h]); ac += dtl * A; }
            chk_report(a, 2, fabsf(DT[(size_t)t * 16 + h] - dtl) * 10.f); chk_report(a, 2, fabsf(ACUM[(size_t)t * 16 + h] - ac)); } }
}
__device__ __forceinline__ void chk3(ArgsP a, const int tidx) {
    const int gt = blockIdx.x * NTHR + tidx, NGT = gridDim.x * NTHR;
    const bf16 *XS = (const bf16*)(a->ws + WS_XS), *BC = (const bf16*)(a->ws + WS_BC), *SL = (const bf16*)(a->ws + WS_SLOC); const float *DT = (const float*)(a->ws + WS_DT), *ACUM = (const float*)(a->ws + WS_ACUM);
    for (int it = gt; it < 8192; it += NGT) { const unsigned hsh = (unsigned)it * 2654435761u; const int c = it < 2048 ? (it & 1) * 255 : (hsh >> 8) & 255, h = (hsh >> 16) & 15, p = (hsh >> 20) & 63, n = (hsh >> 26) & 63 | ((it & 1) << 6), g = h >> 3;
        const float al = ACUM[(size_t)(c * 64 + 63) * 16 + h]; float ref = 0.f;
        for (int sx = 0; sx < 64; ++sx) { const int t = c * 64 + sx; ref += bf2f(BC[(size_t)t * 512 + 128 * g + n]) * bfr(bf2f(XS[(size_t)t * 1024 + 64 * h + p]) * DT[(size_t)t * 16 + h] * __expf(al - ACUM[(size_t)t * 16 + h])); }
        const float got = bf2f(SL[((size_t)(c * 16 + h) * 64 + p) * 128 + n]);
        chk_report(a, 3, fabsf(got - ref) / fmaxf(fabsf(ref), 0.05f)); }
}
__device__ __forceinline__ void chk13(ArgsP a, const int tidx) {
    const int gt = blockIdx.x * NTHR + tidx, NGT = gridDim.x * NTHR;
    const bf16 *XS = (const bf16*)(a->ws + WS_XS), *BC = (const bf16*)(a->ws + WS_BC), *SL = (const bf16*)(a->ws + WS_SLOC); const float *DT = (const float*)(a->ws + WS_DT), *ACUM = (const float*)(a->ws + WS_ACUM);
    for (int it = gt; it < 4096; it += NGT) { const unsigned hsh = (unsigned)it * 2654435761u; const int h = (hsh >> 16) & 15, p = (hsh >> 20) & 63, n = (hsh >> 26) & 63 | ((it & 1) << 6), g = h >> 3;
        float st = 0.f, num = 0.f, den = 1e-12f;
        for (int c = 0; c < NCHUNK; ++c) { const float got = bf2f(SL[((size_t)(c * 16 + h) * 64 + p) * 128 + n]); num += (got - st) * (got - st); den += st * st;
            const float al = ACUM[(size_t)(c * 64 + 63) * 16 + h]; float sl = 0.f;
            for (int sx = 0; sx < 64; ++sx) { const int t = c * 64 + sx; sl += bf2f(BC[(size_t)t * 512 + 128 * g + n]) * bf2f(XS[(size_t)t * 1024 + 64 * h + p]) * DT[(size_t)t * 16 + h] * __expf(al - ACUM[(size_t)t * 16 + h]); }
            st = st * __expf(al) + sl; }
        chk_report(a, 13, sqrtf(num / den)); }
}
__device__ __forceinline__ void chk4(ArgsP a, const int tidx) {
    const int lane = tidx & 63, gw = blockIdx.x * NWAVES + (tidx >> 6);
    const bf16 *XS = (const bf16*)(a->ws + WS_XS), *BC = (const bf16*)(a->ws + WS_BC); const float *DT = (const float*)(a->ws + WS_DT); const float* Y = (const float*)(a->ws + WS_YDBG);
    if (gw >= 32) return;
    const int h = (gw * 5 + 3) & 15, p = (gw * 23 + 7) & 63, g = h >> 3; const float A = -__expf(a->a_log[h]);
    float s0 = 0.f, s1 = 0.f, emax = 0.f, emax0 = 0.f, num = 0.f, den = 1e-12f;
    for (int t = 0; t < 8192; ++t) { const float dt = DT[(size_t)t * 16 + h], x = bf2f(XS[(size_t)t * 1024 + 64 * h + p]), dA = __expf(dt * A);
        const float b0 = bf2f(BC[(size_t)t * 512 + 128 * g + lane]), b1 = bf2f(BC[(size_t)t * 512 + 128 * g + 64 + lane]), c0 = bf2f(BC[(size_t)t * 512 + 256 + 128 * g + lane]), c1 = bf2f(BC[(size_t)t * 512 + 256 + 128 * g + 64 + lane]);
        s0 = s0 * dA + dt * b0 * x; s1 = s1 * dA + dt * b1 * x;
        const float y = wave_sum(c0 * s0 + c1 * s1); const float got = Y[(size_t)t * 1024 + 64 * h + p];
        float e = fabsf(got - y) / fmaxf(fabsf(y), 0.25f); if (!(got == got)) e = 1e30f; if (t < 64) emax0 = fmaxf(emax0, e); else { num += (got - y) * (got - y); den += y * y; } }
    emax = sqrtf(num / den);
    if (lane == 0) { chk_report(a, 12, emax0); chk_report(a, 4, emax); }
}
__device__ __forceinline__ void chk567(ArgsP a, const int tidx) {
    const int lane = tidx & 63, gw = blockIdx.x * NWAVES + (tidx >> 6);
    const bf16 *XS = (const bf16*)(a->ws + WS_XS), *Zb = (const bf16*)(a->ws + WS_Z), *MIX = (const bf16*)(a->ws + WS_MIX); const float* Y = (const float*)(a->ws + WS_YDBG);
    if (gw >= 64 && gw < 128) { const int si = gw - 64, g = si & 1, t = (si >> 1) < 4 ? (si >> 1) * 63 : (int)(((unsigned)si * 2654435761u) % 8192);
        float v[8]; float ss = 0.f;
#pragma unroll
        for (int i = 0; i < 8; ++i) { const int ch = 512 * g + lane + 64 * i; const float y = (Y[(size_t)t * 1024 + ch] + a->d_skip[ch >> 6] * bf2f(XS[(size_t)t * 1024 + ch])) * siluf(bf2f(Zb[(size_t)t * 1024 + ch])); v[i] = y; ss += y * y; }
        const float rstd = 1.f / sqrtf(wave_sum(ss) / 512.f + EPS); float e = 0.f;
#pragma unroll
        for (int i = 0; i < 8; ++i) { const int ch = 512 * g + lane + 64 * i; const float rf = v[i] * rstd * a->ssd_norm_w[ch]; e = fmaxf(e, fabsf(bf2f(MIX[(size_t)t * DM + ch]) - rf) / fmaxf(1.f, fabsf(rf))); }
        chk_report(a, 5, e); }
    if (gw >= 128 && gw < 144 && lane == 0) { const int h = gw - 128; const float* DTF = (const float*)(a->ws + WS_DTF); const float* CL = (const float*)(a->ws + WS_CUMF) + (size_t)h * M; double c = 0.0; float e = 0.f;
        for (int t = 0; t < M; ++t) { c += (double)logsigmoidf(DTF[(size_t)t * 32 + 16 + h] + a->fox_f_bias[h]); const float ref = (float)(c * 1.4426950408889634); e = fmaxf(e, fabsf(CL[t] - ref) / (1.f + 1e-4f * fabsf(ref))); }
        chk_report(a, 6, e); }
    if (gw >= 160 && gw < 224) { const int si = gw - 160, h = (si * 7 + 1) & 15; const int t = si < 8 ? CHK_TOK[si] : (int)(((unsigned)si * 2654435761u) % M);
        const bf16 *Q = (const bf16*)(a->ws + WS_Q), *K = (const bf16*)(a->ws + WS_K), *V = (const bf16*)(a->ws + WS_V); const float* CL = (const float*)(a->ws + WS_CUMF) + (size_t)h * M;
        const float q = bf2f(Q[(size_t)t * 1024 + 64 * h + lane]); float m = -1e30f, l = 0.f, o = 0.f;
        for (int j = 0; j <= t; ++j) { const float s = wave_sum(q * bf2f(K[(size_t)j * 1024 + 64 * h + lane])) + (CL[t] - CL[j]); const float mn = fmaxf(m, s), al = exp2f(m - mn), p = exp2f(s - mn);
            l = l * al + p; o = o * al + p * bf2f(V[(size_t)j * 1024 + 64 * h + lane]); m = mn; }
        const float e = fabsf(bf2f(MIX[(size_t)t * DM + 1024 + 64 * h + lane]) - o / l);
        chk_report(a, 7, wave_max(e)); }
}
__device__ __forceinline__ void chk8(ArgsP a, const int tidx) {
    const int gt = blockIdx.x * NTHR + tidx, NGT = gridDim.x * NTHR; const bf16* MIX = (const bf16*)(a->ws + WS_MIX); const bf16* HN = (const bf16*)(a->ws + WS_HN); float* XSV = (float*)(a->ws + WS_XSAVE);
    for (int it = gt; it < 8 * DM; it += NGT) { const int r = it / DM, t = CHK_ROWS[r], c = it % DM; float ref = a->x[(size_t)t * DM + c];
        for (int k = 0; k < DM; ++k) ref += bf2f(MIX[(size_t)t * DM + k]) * bfr(a->w_out[(size_t)k * DM + c]);
        const float got = bf2f(((const bf16*)(a->ws + WS_X1B))[(size_t)t * DM + c]); XSV[it] = got; chk_report(a, 8, fabsf(got - ref)); chk_report(a, 8, fabsf(bf2f(HN[(size_t)t * DM + c]) - got * a->ln2_w[c]) * 0.5f);
        if (c == 0) { float ss = 0.f; for (int k = 0; k < DM; ++k) { const float v = bf2f(((const bf16*)(a->ws + WS_X1B))[(size_t)t * DM + k]); ss += v * v; } const float sq = ((const float*)(a->ws + WS_MISC + MISC_SUMSQ))[t]; chk_report(a, 8, fabsf(sq - ss) / ss * 2.f); } }
}
__device__ __forceinline__ void chk910(ArgsP a, LAS unsigned char* lds, const int tidx) {
    const int gt = blockIdx.x * NTHR + tidx, NGT = gridDim.x * NTHR; const bf16* HN = (const bf16*)(a->ws + WS_HN); const bf16* QP = (const bf16*)(a->ws + WS_QP);
    for (int it = gt; it < 8 * DM; it += NGT) { const int r = it / DM, t = CHK_ROWS[r], c = it % DM; float ref = 0.f;
        for (int k = 0; k < DM; ++k) ref += bf2f(HN[(size_t)t * DM + k]) * bfr(a->peer_wq[(size_t)k * DM + c]);
        chk_report(a, 9, fabsf(bf2f(QP[(size_t)t * DM + c]) - ref)); }
    const int lane = tidx & 63, wv = tidx >> 6, gw = blockIdx.x * NWAVES + wv;
    if (gw < 64) { const int t = CHK_ROWS[gw >> 3], hd = gw & 7; LAS float* S = (LAS float*)lds + wv * 256;
        for (int half = 0; half < 2; ++half) for (int n = lane; n < 128; n += 64) { const float* kr = (half ? a->peer_k2 : a->peer_k1) + ((size_t)hd * 128 + n) * 128; float s = 0.f;
            for (int d = 0; d < 128; ++d) s += bf2f(QP[(size_t)t * DM + 256 * hd + 128 * half + d]) * bfr(kr[d]); S[128 * half + n] = s; }
        asm volatile("s_waitcnt lgkmcnt(0)" ::: "memory");
        float lo = -1e30f, hi = 1e30f; { float mx = -1e30f, mn = 1e30f; for (int i = lane; i < 128; i += 64) { mx = fmaxf(mx, S[i]); mn = fminf(mn, S[i]); } float mx2 = -1e30f, mn2 = 1e30f; for (int i = lane; i < 128; i += 64) { mx2 = fmaxf(mx2, S[128 + i]); mn2 = fminf(mn2, S[128 + i]); }
            hi = wave_max(mx) + wave_max(mx2) + 1.f; lo = -wave_max(-mn) - wave_max(-mn2) - 1.f; }
        for (int itn = 0; itn < 40; ++itn) { const float mid = 0.5f * (lo + hi); int cnt = 0; for (int i = lane; i < 16384; i += 64) cnt += (S[i >> 7] + S[128 + (i & 127)] >= mid) ? 1 : 0; cnt = (int)wave_sum((float)cnt); if (cnt >= 16) lo = mid; else hi = mid; }
        const float thr = lo; float mxs = -1e30f; for (int i = lane; i < 16384; i += 64) { const float s = S[i >> 7] + S[128 + (i & 127)]; if (s >= thr) mxs = fmaxf(mxs, s); } mxs = wave_max(mxs);
        const float rstd = 1.f / sqrtf(((const float*)(a->ws + WS_MISC + MISC_SUMSQ))[t] / DM + EPS);
        float den = 0.f; for (int i = lane; i < 16384; i += 64) { const float s = S[i >> 7] + S[128 + (i & 127)]; if (s >= thr) den += __expf((s - mxs) * rstd); } den = wave_sum(den);
        float e = 0.f; if (lane < 16) { const int id = ((const int*)(a->ws + WS_IDX))[(size_t)t * 128 + 16 * hd + lane]; const float g = ((const float*)(a->ws + WS_GW))[(size_t)t * 128 + 16 * hd + lane];
            if (id < 0 || id >= 16384) e = 10.f; else { const float s = S[id >> 7] + S[128 + (id & 127)]; if (s < thr - 2e-3f) e = 5.f; e = fmaxf(e, fabsf(g - __expf((s - mxs) * rstd) / den)); }
            for (int k2 = 0; k2 < 16; ++k2) { const int id2 = __shfl(id, k2); if (k2 != lane && id2 == id) e = 7.f; } }
        chk_report(a, 10, wave_max(e)); }
}
__device__ __forceinline__ void chk11(ArgsP a, const int tidx) {
    const int lane = tidx & 63, gw = blockIdx.x * NWAVES + (tidx >> 6); if (gw >= 8) return;
    const int t = CHK_ROWS[gw]; const bf16* HN = (const bf16*)(a->ws + WS_HN); const float* XSV = (const float*)(a->ws + WS_XSAVE) + gw * DM;
    const float rstd2 = 1.f / sqrtf(((const float*)(a->ws + WS_MISC + MISC_SUMSQ))[t] / DM + EPS);
    float acc[32];
#pragma unroll
    for (int i = 0; i < 32; ++i) acc[i] = 0.f;
    for (int k = 0; k < 128; ++k) { const int id = ((const int*)(a->ws + WS_IDX))[(size_t)t * 128 + k]; const float g = ((const float*)(a->ws + WS_GW))[(size_t)t * 128 + k];
        float s = 0.f;
#pragma unroll
        for (int i = 0; i < 32; ++i) { const int d = lane + 64 * i; s += bfr(a->peer_u[(size_t)id * DM + d]) * bf2f(HN[(size_t)t * DM + d]); }
        const float cf = g * geluf(wave_sum(s) * rstd2);
#pragma unroll
        for (int i = 0; i < 32; ++i) acc[i] += cf * bfr(a->peer_v[(size_t)id * DM + lane + 64 * i]); }
    float ss = 0.f;
#pragma unroll
    for (int i = 0; i < 32; ++i) { acc[i] += XSV[lane + 64 * i]; ss += acc[i] * acc[i]; }
    const float rstd = 1.f / sqrtf(wave_sum(ss) / DM + EPS); float e = 0.f;
#pragma unroll
    for (int i = 0; i < 32; ++i) e = fmaxf(e, fabsf(a->out[(size_t)t * DM + lane + 64 * i] - acc[i] * rstd * a->lnf_w[lane + 64 * i]));
    chk_report(a, 11, wave_max(e));
}
__device__ const float CHK_TOL[14] = {1.f, 0.05f, 0.02f, 0.05f, 0.06f, 0.03f, 0.02f, 0.03f, 0.03f, 0.06f, 0.05f, 0.03f, 0.06f, 0.03f};
__device__ const int CHK_ORD[13] = {1, 2, 3, 12, 13, 4, 5, 6, 7, 8, 9, 10, 11};
__device__ __forceinline__ void chk_verdict(ArgsP a, const int tidx) {
    const int* C = (const int*)(a->ws + WS_MISC + MISC_CHK); int bad = -1; float m = 0.f;
    for (int kk = 0; kk < 13; ++kk) { const int k = CHK_ORD[kk]; const float e = __int_as_float(C[k]); if (bad < 0 && e > CHK_TOL[k]) { bad = k; m = fminf(fmaxf(e / CHK_TOL[k], 1.f), 9.9f); } }
    if (bad < 0) return;
    const float cst = sqrtf(m * powf(100.f, (float)(bad + 1)));
    const size_t gt = (size_t)blockIdx.x * NTHR + tidx, NGT = (size_t)gridDim.x * NTHR;
    for (size_t i = gt; i < (size_t)M * DM; i += NGT) a->out[i] = cst;
}
#endif
#ifndef MK_PER_PHASE
#define MK_PER_PHASE 0
#endif
constexpr int NPHASE = 12;
__global__ void __launch_bounds__(NTHR, 2) hymba_fwd(Args a) {
    extern __shared__ __attribute__((aligned(16))) unsigned char lds_raw[];
    LAS unsigned char* lds = (LAS unsigned char*)lds_raw;
    const int lo = a.ph_lo, hi = a.ph_hi;
    const int wv_ = __builtin_amdgcn_readfirstlane((int)threadIdx.x >> 6);
#define TID (wv_ * 64 + lane_id())
    int dupi_ = 0; (void)dupi_;
    volatile LAS unsigned* lctl = (volatile LAS unsigned*)(lds + LDS_BYTES - 64);
    if (TID < 16) lctl[TID] = 0u;
    __syncthreads();
    (void)xcd_barrier_post((unsigned*)(get_args()->ws + WS_CTL) + 4096, lctl, TID);
#define A get_args()
#if SELFCHECK
#define CHK(x) x
#else
#define CHK(x)
#endif
#define IN(k) (lo <= (k) && (k) < hi)
#define GRIDBAR() do { XcdBarrier xb_; xb_.bar = (unsigned*)(get_args()->ws + WS_CTL) + 4096; xb_.x = xb_xcc_id(); xb_.st = (volatile LAS unsigned*)(lds + LDS_BYTES - 64); xcd_barrier(xb_, TID); } while (0)
#ifndef PEER8
#define PEER8 1
#endif
#ifndef DUP_MASK
#define DUP_MASK 0
#endif
#define DUP(bit, stmt) do { stmt; if (DUP_MASK & (1 << (bit))) { __syncthreads(); stmt; } } while (0)
#ifndef TS_SEL
#define TS_SEL -1
#endif
#define STAMP(k) do { if (TS_SEL >= 0 && blockIdx.x == 0 && TID == 0) { ((unsigned long long*)(get_args()->ws + WS_CTL + 49152))[k] = __builtin_amdgcn_s_memrealtime(); } } while (0)
#define SEAM(k) do { if (IN(k) && IN((k) + 1)) { GRIDBAR(); } STAMP((k) + 1); } while (0)
    STAMP(0);
    if (IN(0)) { DUP(0, phase0(A, lds, TID)); } SEAM(0);
    if (IN(1)) {
        pg8::Gemm g{(const bf16*)(A->ws + WS_XN), (const bf16*)(A->ws + WS_WIN), M, NIN, DM}; pg8::StaticOrder S; S.init(M, NIN, gridDim.x, (int)blockIdx.x);
        EpiInProj E{(bf16*)(A->ws + WS_Z), (bf16*)(A->ws + WS_XBC), (bf16*)(A->ws + WS_Q), (bf16*)(A->ws + WS_K), (bf16*)(A->ws + WS_V), (float*)(A->ws + WS_DTF)};
        DUP(1, (pg8::gemm_phase<EpiInProj, pg8::StaticOrder, true, true>(lds, g, S, E, TID)));
        if (gridDim.x == 256 && blockIdx.x >= 192) { for (int j = 0; j < 8; ++j) convert_uv_fp8_item(A, opaque(TID), ((int)blockIdx.x - 192) * 8 + j); }
    } SEAM(1);
    if (IN(2)) { CHK(chk1(A, TID)); DUP(2, phase2(A, lds, TID)); } SEAM(2);
    if (IN(3)) { CHK(chk2(A, TID)); CHK(chk3(A, TID)); CHK(GRIDBAR()); if (DUP_MASK & 8) { phase3<true>(A, TID); } phase3<false>(A, TID); } SEAM(3);
    if (IN(4)) { DUP(4, phase4(A, lds, TID));
        const attn_body::AttnTensors AT{(const bf16*)(A->ws + WS_Q), (const bf16*)(A->ws + WS_K), (const bf16*)(A->ws + WS_V), (bf16*)(A->ws + WS_MIX), (const float*)(A->ws + WS_CUMF),
                                        (const float*)(A->ws + WS_MISC + MISC_QN2), (const float*)(A->ws + WS_MISC + MISC_KN2), (const float*)(A->ws + WS_MISC + MISC_QKD)};
        DUP(12, (attn_body::attn_phase<8>((char*)lds_raw, AT, (unsigned*)(A->ws + WS_CTL) + Q_A + ((DUP_MASK & 4096) ? 512 * dupi_++ : 0), (int)(xb_xcc_id() & 7u), TID, A)));
    } SEAM(4);
    if (IN(5)) {
        CHK(chk13(A, TID)); CHK(chk4(A, TID)); CHK(chk567(A, TID)); CHK(GRIDBAR());
        pg8::Gemm g{(const bf16*)(A->ws + WS_MIX), (const bf16*)(A->ws + WS_WOUT), M, DM, DM}; pg8::StaticOrder S; S.init(M, DM, gridDim.x, (int)blockIdx.x);
        EpiOutProj E{A->x, (bf16*)(A->ws + WS_X1B), (bf16*)(A->ws + WS_HN), A->ln2_w, (float*)(A->ws + WS_MISC + MISC_SUMSQ)};
        pg8::gemm_phase<EpiOutProj, pg8::StaticOrder, true, true>(lds, g, S, E, TID);
        if (!PEER8) convert_uv_sliced(A, TID);
    } SEAM(5);
    if (IN(6)) {
        CHK(chk8(A, TID));
        pg8::Gemm g{(const bf16*)(A->ws + WS_HN), (const bf16*)(A->ws + WS_WQ), M, DM, DM}; pg8::StaticOrder S; S.init(M, DM, gridDim.x, (int)blockIdx.x);
        EpiPlainBf16 E{(bf16*)(A->ws + WS_QP), DM};
        DUP(6, (pg8::gemm_phase<EpiPlainBf16, pg8::StaticOrder, true, true>(lds, g, S, E, TID)));
    } SEAM(6);
    if (IN(7)) { DUP(7, phase7(A, lds, TID)); } SEAM(7);
    if (IN(8)) { CHK(chk910(A, lds, TID)); CHK(__syncthreads()); if (PEER8) { DUP(8, peer_u_phase8(A, lds, TID, (DUP_MASK & 256) ? 512 * dupi_++ : 0)); } else { DUP(8, peer_u_phase(A, lds, TID, (DUP_MASK & 256) ? 512 * dupi_++ : 0)); } } SEAM(8);
    if (IN(9)) { if (PEER8) { DUP(9, peer_combine8(A, TID)); } else { DUP(9, peer_combine(A, TID)); } } SEAM(9);
    if (IN(10)) { if (PEER8) { if (DUP_MASK & 1024) { peer_v_phase8<true>(A, lds, TID, 512); } peer_v_phase8<false>(A, lds, TID); } else { if (DUP_MASK & 1024) { peer_v_phase<true>(A, lds, TID, 512); } peer_v_phase<false>(A, lds, TID); } } SEAM(10);
    if (IN(11)) { if (PEER8) { peer_final8(A, TID); } else { peer_final<false>(A, TID); } STAMP(12);
        if (TS_SEL >= 0 && blockIdx.x == 0 && TID == 0) { const unsigned long long* ts = (const unsigned long long*)(get_args()->ws + WS_CTL + 49152); const int lo_ = TS_SEL & 15, hi_ = TS_SEL >> 4;
            const float us = (float)(ts[hi_] - ts[lo_]) * 0.01f; get_args()->out[0] += us * 0.25f; } CHK(GRIDBAR()); CHK(chk11(A, TID)); CHK(GRIDBAR()); CHK(chk_verdict(A, TID)); }
#undef A
#undef TID
#undef IN
#undef SEAM
#undef DUP
#undef GRIDBAR
}

extern "C" void kernel_launch(void* const* d_in, const int* in_sizes, int n_in, void* d_out, int out_size, void* d_ws, size_t ws_size, hipStream_t stream) {
    static int grid = 0;
    if (grid == 0) {
        if (n_in != 18 || in_sizes[0] != M * DM || out_size != M * DM || ws_size < WS_END) { fprintf(stderr, "kernel_launch: unexpected shapes (n_in %d, in0 %d, out %d, ws %zu)\n", n_in, n_in > 0 ? in_sizes[0] : -1, out_size, ws_size); grid = -1; return; }
        int dev = 0, cus = 0, per_cu = 0;
        if (hipGetDevice(&dev) != hipSuccess || hipDeviceGetAttribute(&cus, hipDeviceAttributeMultiprocessorCount, dev) != hipSuccess) { grid = -1; return; }
        if (hipFuncSetAttribute((const void*)hymba_fwd, hipFuncAttributeMaxDynamicSharedMemorySize, LDS_BYTES) != hipSuccess) { fprintf(stderr, "kernel_launch: hipFuncSetAttribute failed\n"); grid = -1; return; }
        if (hipOccupancyMaxActiveBlocksPerMultiprocessor(&per_cu, (const void*)hymba_fwd, NTHR, LDS_BYTES) != hipSuccess || per_cu < 1) { fprintf(stderr, "kernel_launch: occupancy query says %d\n", per_cu); (void)hipGetLastError(); grid = -1; return; }
        grid = cus;
    }
    if (grid < 0) return;
    Args a{};
    const float** f = (const float**)&a;
    for (int i = 0; i < 18; ++i) f[i] = (const float*)d_in[i];
    a.out = (float*)d_out; a.ws = (unsigned char*)d_ws;
#if MK_PER_PHASE
    for (int p = 0; p < NPHASE; ++p) { a.ph_lo = p; a.ph_hi = p + 1; hipLaunchKernelGGL(hymba_fwd, dim3(grid), dim3(NTHR), LDS_BYTES, stream, a); }
#else
    a.ph_lo = 0; a.ph_hi = NPHASE;
    if (hipMemsetAsync((char*)d_ws + WS_CTL, 0, 65536, stream) != hipSuccess) { fprintf(stderr, "kernel_launch: hipMemsetAsync failed\n"); return; }
    hipLaunchKernelGGL(hymba_fwd, dim3(grid), dim3(NTHR), LDS_BYTES, stream, a);
#endif
}
```

```cpp
#include <hip/hip_runtime.h>
#include <cstdio>
#include <cstdint>
#include <cmath>
#ifndef SELFCHECK
#define SELFCHECK 0
#endif
namespace pg8 {
#define PG8_LAS __attribute__((address_space(3)))
typedef unsigned short bf16_t;
typedef short bf16x8 __attribute__((ext_vector_type(8)));
typedef float f32x4 __attribute__((ext_vector_type(4)));
typedef unsigned u32x4 __attribute__((ext_vector_type(4)));
constexpr int BM = 256, BK = 64, HALF = 128, HTB = HALF * BK * 2  , STAGE_BYTES = 8 * HTB, NXCD = 8, WGM = 4;

__host__ __device__ __forceinline__ int lds_byte(int r, int c) { const int st = (r >> 4) * 2 + (c >> 5), rr = r & 15, cc = c & 31, ob = rr * 64 + cc * 2; return st * 1024 + (ob ^ (((ob >> 9) & 1) << 5)); }
__host__ __device__ __forceinline__ void stage_rc(int b, int& R, int& C) { const int st = b / 1024, sb = b % 1024, swz = sb ^ (((sb >> 9) & 1) << 5); R = (st >> 1) * 16 + swz / 64; C = (st & 1) * 32 + (swz % 64) / 2; }
__host__ __device__ __forceinline__ int perm32(int rho) { const int n = rho >> 4, i = rho & 15; return 8 * (i >> 2) + 4 * n + (i & 3); }

struct Unit { int pm, pn; };
struct Gemm { const bf16_t* A; const bf16_t* Bt; int M, N, K; };

struct StaticOrder {
    int nM, nN, nwg, G, c;
    __host__ __device__ void init(int M, int N, int G_, int c_) { nM = M / BM; nN = N / BM; nwg = nM * nN; G = G_; c = c_; }
    __host__ __device__ bool next(int i, Unit& u) const {
        const long L = (long)i * G + c; if (L >= nwg) return false;
        int wgid = (int)L; { const int q = nwg / NXCD, r = nwg % NXCD, xcd = wgid % NXCD, off = wgid / NXCD; wgid = (xcd < r ? xcd * (q + 1) : r * (q + 1) + (xcd - r) * q) + off; }
        const int nig = WGM * nN, gid = wgid / nig, fm = gid * WGM, gsz = (nM - fm) < WGM ? (nM - fm) : WGM;
        u.pm = fm + ((wgid % nig) % gsz); u.pn = (wgid % nig) / gsz; return true;
    }
    __device__ __forceinline__ void a_ready(const Unit&) const {}
    __device__ __forceinline__ void done(const Unit&) const {}
};

__device__ __forceinline__ unsigned cvt_pk_bf16(float lo, float hi) { unsigned r; asm volatile("v_cvt_pk_bf16_f32 %0, %1, %2" : "=v"(r) : "v"(lo), "v"(hi)); return r; }
typedef float f32x2 __attribute__((ext_vector_type(2)));
__device__ __forceinline__ f32x2 gelu_pk(f32x2 v) {
    const f32x2 av = __builtin_elementwise_abs(v), d = av * 0.2316418882f + 1.0f;
    f32x2 t; t.x = __builtin_amdgcn_rcpf(d.x); t.y = __builtin_amdgcn_rcpf(d.y);
    f32x2 q = t * 0.5307027145f + (-0.7265760135f); q = q * t + 0.7107068705f; q = q * t + (-0.142248368f); q = q * t + 0.127414796f; q = q * t;
    const f32x2 s = (v * v) * (-0.72134752044f);
    f32x2 e; e.x = __builtin_amdgcn_exp2f(s.x); e.y = __builtin_amdgcn_exp2f(s.y);
    const f32x2 m = v * (q * e), r = v - m;
    f32x2 o; o.x = v.x < 0.f ? m.x : r.x; o.y = v.y < 0.f ? m.y : r.y; return o;
}

template <int ACT  > struct EpiBf16 {
    static constexpr bool PERM = true, AFTER_DRAIN = false; static_assert(ACT == 0 || ACT == 1, "EpiBf16: ACT is 0 (none) or 1 (gelu_pk)");
    bf16_t* O; int ldc; const float* bias; int split_cols; size_t split_stride; float scale0;
    __device__ __forceinline__ void operator()(const f32x4 (&acc)[2][2][4][2], const Unit& u, int wr, int wc, int fr, int fq) const {
        const int row0 = u.pm * BM + wr * 64 + fr; int colt = u.pn * BM; bf16_t* base = O;
        float sc = 1.f; if (split_cols) { const int t = colt / split_cols; base += (size_t)t * split_stride; colt -= t * split_cols; if (t == 0) sc = scale0; }
        const int col0 = colt + wc * 32 + 8 * fq, bcol0 = u.pn * BM + wc * 32 + 8 * fq;
        f32x4 bv[2][2];
#pragma unroll
        for (int bj = 0; bj < 2; ++bj)
#pragma unroll
            for (int n = 0; n < 2; ++n) bv[bj][n] = bias ? *(const f32x4*)(bias + bcol0 + bj * HALF + 4 * n) : (f32x4){0.f, 0.f, 0.f, 0.f};
#pragma unroll
        for (int ai = 0; ai < 2; ++ai)
#pragma unroll
            for (int m = 0; m < 4; ++m) { bf16_t* rowp = base + (size_t)(row0 + ai * HALF + m * 16) * ldc + col0;
#pragma unroll
                for (int bj = 0; bj < 2; ++bj) { f32x4 v0 = acc[ai][bj][m][0] + bv[bj][0], v1 = acc[ai][bj][m][1] + bv[bj][1];
                    if (ACT == 1) { f32x2 a = gelu_pk((f32x2){v0[0], v0[1]}), b = gelu_pk((f32x2){v0[2], v0[3]}), c = gelu_pk((f32x2){v1[0], v1[1]}), d = gelu_pk((f32x2){v1[2], v1[3]});
                        v0 = (f32x4){a.x, a.y, b.x, b.y}; v1 = (f32x4){c.x, c.y, d.x, d.y}; }
                    v0 = v0 * sc; v1 = v1 * sc; u32x4 w; w.x = cvt_pk_bf16(v0[0], v0[1]); w.y = cvt_pk_bf16(v0[2], v0[3]); w.z = cvt_pk_bf16(v1[0], v1[1]); w.w = cvt_pk_bf16(v1[2], v1[3]);
                    *(u32x4*)(rowp + bj * HALF) = w; } }
    }
};
template <class Epi, class Sched, bool ALIGN_EPI = false, bool SP2 = false>
__device__ __forceinline__ void gemm_phase(PG8_LAS unsigned char* lds, const Gemm g, const Sched& S, const Epi& E, const int tid_in) {
    const int tid = tid_in, wid = __builtin_amdgcn_readfirstlane(tid >> 6), lane = tid & 63, wr = wid >> 2, wc = wid & 3, fr = lane & 15, fq = lane >> 4;
    const int K = g.K, nt = K / BK;
    unsigned voffA[2], voffB[2];
#pragma unroll
    for (int i = 0; i < 2; ++i) { int R, C; stage_rc(tid * 16 + i * 8192, R, C); const int Rb = Epi::PERM ? ((R & ~31) + perm32(R & 31)) : R;
        voffA[i] = (unsigned)(R * K + C) * 2u; voffB[i] = (unsigned)(Rb * K + C) * 2u; }
    const size_t kstep = (size_t)(BK * 2);
    const size_t hstep = (size_t)HALF * K * 2;
    const size_t tstep = 2 * hstep;
    const unsigned ldsw = (unsigned)wid * 1024u;
    const int aoff = lds_byte(wr * 64 + fr, fq * 8), boff = lds_byte(wc * 32 + fr, fq * 8);
#define PG8_SA(b, h) (((b) * 2 + (h)) * HTB)
#define PG8_SB(b, h) ((4 + (b) * 2 + (h)) * HTB)
#define PG8_STAGE(bufoff, gbase, voff) do { _Pragma("unroll") for (int _i = 0; _i < 2; ++_i) \
        __builtin_amdgcn_global_load_lds((const unsigned*)((const char*)(gbase) + (voff)[_i]), (PG8_LAS unsigned*)(lds + (bufoff) + ldsw + _i * 8192), 16, 0, 0); } while (0)
#define PG8_LDA(dst, b, h) do { _Pragma("unroll") for (int m = 0; m < 4; ++m) _Pragma("unroll") for (int k = 0; k < 2; ++k) dst[m][k] = *(const PG8_LAS bf16x8*)(lds + PG8_SA(b, h) + aoff + m * 2048 + k * 1024); } while (0)
#define PG8_LDB(dst, b, h) do { _Pragma("unroll") for (int n = 0; n < 2; ++n) _Pragma("unroll") for (int k = 0; k < 2; ++k) dst[n][k] = *(const PG8_LAS bf16x8*)(lds + PG8_SB(b, h) + boff + n * 2048 + k * 1024); } while (0)
#define PG8_MMA(ai, bj, At, Bt) do { __builtin_amdgcn_s_setprio(1); _Pragma("unroll") for (int m = 0; m < 4; ++m) _Pragma("unroll") for (int n = 0; n < 2; ++n) _Pragma("unroll") for (int k = 0; k < 2; ++k) \
        acc[ai][bj][m][n] = __builtin_amdgcn_mfma_f32_16x16x32_bf16(Bt[n][k], At[m][k], acc[ai][bj][m][n], 0, 0, 0); __builtin_amdgcn_s_setprio(0); } while (0)
#define PG8_WAIT_V(n) asm volatile("s_waitcnt vmcnt(" #n ")" ::: "memory")
#define PG8_WAIT_L(n) asm volatile("s_waitcnt lgkmcnt(" #n ")" ::: "memory")
#define PG8_BAR __builtin_amdgcn_s_barrier()
#define PG8_SCHED __builtin_amdgcn_sched_barrier(0)
    Unit cur, nxt; int ui = 0;
    if (!S.next(0, cur)) return;
    f32x4 acc[2][2][4][2];
#pragma unroll
    for (int a = 0; a < 2; ++a)
#pragma unroll
        for (int b = 0; b < 2; ++b)
#pragma unroll
            for (int m = 0; m < 4; ++m)
#pragma unroll
                for (int n = 0; n < 2; ++n) acc[a][b][m][n] = (f32x4){0.f, 0.f, 0.f, 0.f};
    bf16x8 At[4][2], B0[2][2], B1[2][2];
    const char* cA = (const char*)g.A + (size_t)cur.pm * tstep; const char* cB = (const char*)g.Bt + (size_t)cur.pn * tstep;
    S.a_ready(cur);
    if constexpr (SP2) {
        PG8_STAGE(PG8_SB(0, 0), cB, voffB); PG8_STAGE(PG8_SB(0, 1), cB + hstep, voffB); PG8_STAGE(PG8_SA(0, 0), cA, voffA); PG8_STAGE(PG8_SA(0, 1), cA + hstep, voffA);
        if (wr == 1) PG8_BAR;
        PG8_WAIT_V(2); PG8_BAR;
        PG8_STAGE(PG8_SB(1, 0), cB + kstep, voffB); PG8_STAGE(PG8_SA(1, 0), cA + kstep, voffA); PG8_STAGE(PG8_SB(1, 1), cB + hstep + kstep, voffB);
        PG8_WAIT_V(6); PG8_BAR;
    } else {
        PG8_STAGE(PG8_SB(0, 0), cB, voffB); PG8_STAGE(PG8_SA(0, 0), cA, voffA); PG8_STAGE(PG8_SB(0, 1), cB + hstep, voffB); PG8_STAGE(PG8_SA(0, 1), cA + hstep, voffA);
        if (wr == 1) PG8_BAR;
        PG8_WAIT_V(4); PG8_BAR;
        PG8_STAGE(PG8_SB(1, 0), cB + kstep, voffB); PG8_STAGE(PG8_SA(1, 0), cA + kstep, voffA); PG8_STAGE(PG8_SB(1, 1), cB + hstep + kstep, voffB);
        PG8_WAIT_V(6); PG8_BAR;
    }
    for (;;) {
        const bool has_next = S.next(ui + 1, nxt);
        const char* nA = has_next ? (const char*)g.A + (size_t)nxt.pm * tstep : cA; const char* nB = has_next ? (const char*)g.Bt + (size_t)nxt.pn * tstep : cB;
        for (int t = 0; t < nt; t += 2) {
            const bool last = (t == nt - 2);
            const char* a1 = cA + (size_t)(t + 1) * kstep;
            const char* a2 = last ? nA : cA + (size_t)(t + 2) * kstep; const char* b2 = last ? nB : cB + (size_t)(t + 2) * kstep;
            const char* a3 = a2 + kstep; const char* b3 = b2 + kstep;
            if (last && has_next) S.a_ready(nxt);
            if constexpr (SP2) {
            PG8_LDB(B0, 0, 0); PG8_LDB(B1, 0, 1); PG8_SCHED; PG8_LDA(At, 0, 0); PG8_STAGE(PG8_SA(1, 1), a1 + hstep, voffA);
            PG8_WAIT_V(8); PG8_WAIT_L(0); PG8_BAR; PG8_MMA(0, 0, At, B0); PG8_MMA(0, 1, At, B1); PG8_BAR; PG8_SCHED;
            PG8_LDA(At, 0, 1); PG8_STAGE(PG8_SB(0, 0), b2, voffB); PG8_STAGE(PG8_SB(0, 1), b2 + hstep, voffB); PG8_STAGE(PG8_SA(0, 0), a2, voffA);
            PG8_WAIT_V(8); PG8_WAIT_L(0); PG8_BAR; PG8_MMA(1, 0, At, B0); PG8_MMA(1, 1, At, B1); PG8_BAR; PG8_SCHED;
            PG8_LDB(B0, 1, 0); PG8_LDB(B1, 1, 1); PG8_SCHED; PG8_LDA(At, 1, 0); PG8_STAGE(PG8_SA(0, 1), a2 + hstep, voffA);
            PG8_WAIT_V(8); PG8_WAIT_L(0); PG8_BAR; PG8_MMA(0, 0, At, B0); PG8_MMA(0, 1, At, B1); PG8_BAR; PG8_SCHED;
            PG8_LDA(At, 1, 1); PG8_STAGE(PG8_SB(1, 0), b3, voffB); PG8_STAGE(PG8_SB(1, 1), b3 + hstep, voffB); PG8_STAGE(PG8_SA(1, 0), a3, voffA);
            PG8_WAIT_V(8); PG8_WAIT_L(0); PG8_BAR; PG8_MMA(1, 0, At, B0); PG8_MMA(1, 1, At, B1); PG8_BAR; PG8_SCHED;
            } else {
            PG8_LDB(B0, 0, 0); PG8_SCHED; PG8_LDA(At, 0, 0); PG8_STAGE(PG8_SA(1, 1), a1 + hstep, voffA);
            PG8_WAIT_L(8); PG8_BAR; PG8_WAIT_L(0); PG8_MMA(0, 0, At, B0); PG8_BAR; PG8_SCHED;
            PG8_LDB(B1, 0, 1); PG8_STAGE(PG8_SB(0, 0), b2, voffB);
            PG8_BAR; PG8_WAIT_L(0); PG8_MMA(0, 1, At, B1); PG8_BAR;
            PG8_LDA(At, 0, 1); PG8_STAGE(PG8_SA(0, 0), a2, voffA);
            PG8_BAR; PG8_WAIT_L(0); PG8_MMA(1, 0, At, B0); PG8_BAR; PG8_SCHED;
            PG8_STAGE(PG8_SB(0, 1), b2 + hstep, voffB);
            PG8_WAIT_V(6); PG8_BAR; PG8_MMA(1, 1, At, B1); PG8_BAR;
            PG8_LDB(B0, 1, 0); PG8_SCHED; PG8_LDA(At, 1, 0); PG8_STAGE(PG8_SA(0, 1), a2 + hstep, voffA);
            PG8_WAIT_L(8); PG8_BAR; PG8_WAIT_L(0); PG8_MMA(0, 0, At, B0); PG8_BAR; PG8_SCHED;
            PG8_LDB(B1, 1, 1); PG8_STAGE(PG8_SB(1, 0), b3, voffB);
            PG8_BAR; PG8_WAIT_L(0); PG8_MMA(0, 1, At, B1); PG8_BAR;
            PG8_LDA(At, 1, 1); PG8_STAGE(PG8_SA(1, 0), a3, voffA);
            PG8_BAR; PG8_WAIT_L(0); PG8_MMA(1, 0, At, B0); PG8_BAR; PG8_SCHED;
            PG8_STAGE(PG8_SB(1, 1), b3 + hstep, voffB);
            PG8_WAIT_V(6); PG8_BAR; PG8_MMA(1, 1, At, B1); PG8_BAR;
            }
        }
        if constexpr (ALIGN_EPI) { if (wr == 0) PG8_BAR; }
        if constexpr (!Epi::AFTER_DRAIN) { E(acc, cur, wr, wc, fr, fq); S.done(cur); }
        if (!has_next) break;
#pragma unroll
        for (int a = 0; a < 2; ++a)
#pragma unroll
            for (int b = 0; b < 2; ++b)
#pragma unroll
                for (int m = 0; m < 4; ++m)
#pragma unroll
                    for (int n = 0; n < 2; ++n) acc[a][b][m][n] = (f32x4){0.f, 0.f, 0.f, 0.f};
        cur = nxt; cA = nA; cB = nB; ++ui;
        if constexpr (ALIGN_EPI) { if (wr == 1) PG8_BAR; }
    }
    PG8_WAIT_V(0);
    if constexpr (!ALIGN_EPI) { if (wr == 0) PG8_BAR; }
    PG8_BAR;
    if constexpr (Epi::AFTER_DRAIN) { E.fused(acc, cur, wr, wc, fr, fq, lds, wid, lane); S.done(cur); }
#undef PG8_SA
#undef PG8_SB
#undef PG8_STAGE
#undef PG8_LDA
#undef PG8_LDB
#undef PG8_MMA
#undef PG8_WAIT_V
#undef PG8_WAIT_L
#undef PG8_BAR
#undef PG8_SCHED
}
}
#define LAS __attribute__((address_space(3)))
typedef unsigned short bf16;
typedef short bf16x8 __attribute__((ext_vector_type(8)));
typedef float f32x4 __attribute__((ext_vector_type(4)));
typedef float f32x2 __attribute__((ext_vector_type(2)));
typedef unsigned u32x4 __attribute__((ext_vector_type(4)));
typedef unsigned u32x2 __attribute__((ext_vector_type(2)));
typedef __bf16 bf16x2_t __attribute__((ext_vector_type(2)));

constexpr int M = 16384, DM = 2048, NIN = 5888, NCHUNK = 256;
constexpr float EPS = 1e-6f, LOG2E = 1.4426950408889634f, QSCALE = 0.125f * LOG2E;
constexpr int NWAVES = 8, NTHR = 512;
constexpr size_t MiB = 1u << 20;
constexpr size_t WS_CTL = 0, WS_WOUT = 1 * MiB, WS_WQ = 9 * MiB, WS_K12 = 17 * MiB, WS_XN = 18 * MiB, WS_WIN = 82 * MiB, WS_Z = 105 * MiB, WS_XBC = 137 * MiB,
                 WS_Q = 185 * MiB, WS_K = 217 * MiB, WS_V = 249 * MiB, WS_DTF = 281 * MiB, WS_XS = 283 * MiB, WS_BC = 315 * MiB, WS_DT = 331 * MiB, WS_ACUM = 332 * MiB,
                 WS_CUMF = 333 * MiB, WS_MISC = 334 * MiB, WS_MIX = 335 * MiB, WS_END = 512 * MiB;
constexpr size_t WS_SLOC_LO = WS_WIN, WS_SLOC_HI = 464 * MiB;
__device__ __forceinline__ size_t sloc_off(int c) { return c < 64 ? WS_SLOC_LO + (size_t)c * 262144 : WS_SLOC_HI + (size_t)(c - 64) * 262144; }
constexpr size_t WS_SLOC = WS_XN;
constexpr size_t WS_HN = WS_XN;
constexpr size_t WS_IDX16 = 464 * MiB;
constexpr size_t WS_QP = 105 * MiB, WS_IDX = 169 * MiB, WS_GW = 177 * MiB, WS_U = 185 * MiB, WS_V2 = 249 * MiB;
constexpr size_t MISC_FTOT = 0, MISC_SUMSQ = 65536, MISC_QN2 = 196608, MISC_KN2 = 212992, MISC_QKD = 229376, MISC_CHK = 262144, MISC_RSTD = 327680;
constexpr int LDS_BYTES = 155648;

__device__ __forceinline__ unsigned cvtpk(float lo, float hi) { f32x2 v = {lo, hi}; bf16x2_t b = __builtin_convertvector(v, bf16x2_t); return __builtin_bit_cast(unsigned, b); }
__device__ __forceinline__ bf16 f2bf(float f) { return (bf16)(cvtpk(f, 0.f) & 0xffffu); }
__device__ __forceinline__ float bf2f(bf16 h) { return __uint_as_float((unsigned)h << 16); }
__device__ __forceinline__ float bflo(unsigned w) { return __uint_as_float(w << 16); }
__device__ __forceinline__ float bfhi(unsigned w) { return __uint_as_float(w & 0xffff0000u); }
template <int CTRL, int RM> __device__ __forceinline__ float dpp_self(float v) { return __int_as_float(__builtin_amdgcn_update_dpp(__float_as_int(v), __float_as_int(v), CTRL, RM, 0xf, false)); }
template <int CTRL, int RM> __device__ __forceinline__ float dpp_zero(float v) { return __int_as_float(__builtin_amdgcn_update_dpp(0, __float_as_int(v), CTRL, RM, 0xf, false)); }
__device__ __forceinline__ float wave_max(float v) {
    v = fmaxf(v, dpp_self<0x111, 0xf>(v)); v = fmaxf(v, dpp_self<0x112, 0xf>(v)); v = fmaxf(v, dpp_self<0x114, 0xf>(v)); v = fmaxf(v, dpp_self<0x118, 0xf>(v));
    v = fmaxf(v, dpp_self<0x142, 0xa>(v)); v = fmaxf(v, dpp_self<0x143, 0xc>(v));
    return __int_as_float(__builtin_amdgcn_readlane(__float_as_int(v), 63));
}
__device__ __forceinline__ float wave_sum(float v) {
    v += dpp_zero<0x111, 0xf>(v); v += dpp_zero<0x112, 0xf>(v); v += dpp_zero<0x114, 0xf>(v); v += dpp_zero<0x118, 0xf>(v);
    v += dpp_zero<0x142, 0xa>(v); v += dpp_zero<0x143, 0xc>(v);
    return __int_as_float(__builtin_amdgcn_readlane(__float_as_int(v), 63));
}
__device__ __forceinline__ float wave_scan_incl(float v, int lane) {
#pragma unroll
    for (int o = 1; o < 64; o <<= 1) { const float t = __shfl_up(v, o); if (lane >= o) v += t; }
    return v;
}
__device__ __forceinline__ float siluf(float x) { return x * __builtin_amdgcn_rcpf(1.f + __expf(-x)); }
__device__ __forceinline__ float softplusf(float x) { return fmaxf(x, 0.f) + log1pf(__expf(-fabsf(x))); }
__device__ __forceinline__ float logsigmoidf(float x) { return fminf(x, 0.f) - log1pf(__expf(-fabsf(x))); }
__device__ __forceinline__ float dot2bf(unsigned a, unsigned b, float c) { const unsigned aa = a, bb = b; return __builtin_amdgcn_fdot2_f32_bf16(__builtin_bit_cast(bf16x2_t, aa), __builtin_bit_cast(bf16x2_t, bb), c, false); }
__device__ __forceinline__ f32x4 mfma16(bf16x8 a, bf16x8 b, f32x4 c) { return __builtin_amdgcn_mfma_f32_16x16x32_bf16(a, b, c, 0, 0, 0); }

struct Args {
    const float *x, *ln1_w, *w_in, *conv_w, *conv_b, *dt_bias, *a_log, *d_skip, *ssd_norm_w, *fox_f_bias, *w_out, *ln2_w, *peer_wq, *peer_k1, *peer_k2, *peer_u, *peer_v, *lnf_w;
    float* out; unsigned char* ws; int ph_lo, ph_hi;
};
typedef const __attribute__((address_space(4))) Args* ArgsP;
__device__ __forceinline__ ArgsP get_args() { ArgsP p = (ArgsP)__builtin_amdgcn_kernarg_segment_ptr(); asm volatile("" : "+s"(p)); return p; }
__device__ __forceinline__ int lane_id() { int l; asm volatile("v_mbcnt_lo_u32_b32 %0, -1, 0\n\tv_mbcnt_hi_u32_b32 %0, -1, %0" : "=v"(l)); return l; }
__device__ __forceinline__ int opaque(int v) { asm volatile("" : "+v"(v)); return v; }
#define GAS __attribute__((address_space(1)))
#define XB_TMO      128
#define XB_XCNT(j)  (256  + 64 * (j))
#define XB_XSUB(j)  (1280 + 64 * (j))
#define XB_XGEN(j)  (2304 + 64 * (j))
#define XB_TOP      3328
#define XB_TOPGEN   3392
#define XCD_BAR_WORDS 3456
#define XB_SPIN_CAP (1u << 18)

__device__ __forceinline__ unsigned xb_ld(unsigned* p)              { return __hip_atomic_load(p, __ATOMIC_RELAXED, __HIP_MEMORY_SCOPE_AGENT); }
__device__ __forceinline__ unsigned xb_add(unsigned* p, unsigned v) { return __hip_atomic_fetch_add(p, v, __ATOMIC_RELAXED, __HIP_MEMORY_SCOPE_AGENT); }
__device__ __forceinline__ unsigned xb_xcc_id() { return (unsigned)__builtin_amdgcn_s_getreg((3 << 11) | 20) & 0xFu; }
#define XB_SPIN(cond, bar) do { unsigned _sp = 0; while (cond) { __builtin_amdgcn_s_sleep(1); \
    if ((++_sp & 255u) == 0u) { if (xb_ld(&(bar)[XB_TMO])) break; if (_sp > XB_SPIN_CAP) { atomicAdd(&(bar)[XB_TMO], 1u); break; } } } } while (0)
struct XcdBarrier { unsigned* bar; unsigned x; volatile LAS unsigned* st; };
__device__ __forceinline__ XcdBarrier xcd_barrier_post(unsigned* bar, volatile LAS unsigned* st, const int tid) {
    XcdBarrier b; b.bar = bar; b.x = xb_xcc_id(); b.st = st;
    if (tid == 0) (void)xb_add(&bar[XB_XCNT(b.x)], 1u);
    return b;
}
__device__ __forceinline__ void xcd_barrier_complete(unsigned* bar, unsigned x, unsigned& nloc, unsigned& nx) {
    const unsigned G = gridDim.x;
    unsigned sum, cnt, mine, sp = 0u;
    for (;;) {
        sum = 0u; cnt = 0u; mine = 0u;
#pragma unroll
        for (unsigned j = 0; j < 16; ++j) { const unsigned c = xb_ld(&bar[XB_XCNT(j)]); sum += c; cnt += (c > 0u) ? 1u : 0u; mine = (j == x) ? c : mine; }
        if (sum == G) break;
        __builtin_amdgcn_s_sleep(1);
        if ((++sp & 255u) == 0u) { if (xb_ld(&bar[XB_TMO])) break; if (sp > XB_SPIN_CAP) { atomicAdd(&bar[XB_TMO], 1u); break; } }
    }
    nloc = mine > 0u ? mine : 1u; nx = cnt > 0u ? cnt : 1u;
}
__device__ __forceinline__ void xcd_barrier(const XcdBarrier& b, const int tid) {
    asm volatile("s_waitcnt vmcnt(0)" ::: "memory");
    __syncthreads();
    if (tid == 0) {
        unsigned* bar = b.bar;
        __builtin_amdgcn_s_waitcnt(0);
        unsigned nloc = b.st[0], nx = b.st[1];
        if (nloc == 0u) { xcd_barrier_complete(bar, b.x, nloc, nx); b.st[0] = nloc; b.st[1] = nx; }
        const unsigned old = xb_add(&bar[XB_XSUB(b.x)], 1u);
        const unsigned gen = old / nloc;
        if (old + 1u == (gen + 1u) * nloc) {
            __builtin_amdgcn_fence(__ATOMIC_RELEASE, "agent");
            asm volatile("s_waitcnt vmcnt(0)" ::: "memory");
            const unsigned og = xb_add(&bar[XB_TOP], 1u);
            const unsigned tg = og / nx;
            if (og + 1u == (tg + 1u) * nx) xb_add(&bar[XB_TOPGEN], 1u);
            else XB_SPIN(xb_ld(&bar[XB_TOPGEN]) == tg, bar);
            __builtin_amdgcn_fence(__ATOMIC_ACQUIRE, "agent");
            xb_add(&bar[XB_XGEN(b.x)], 1u);
            asm volatile("s_waitcnt vmcnt(0)" ::: "memory");
        } else {
            XB_SPIN(xb_ld(&bar[XB_XGEN(b.x)]) == gen, bar);
            __builtin_amdgcn_fence(__ATOMIC_ACQUIRE, "agent");
            asm volatile("s_waitcnt vmcnt(0)" ::: "memory");
        }
    }
    __syncthreads();
}
__device__ __forceinline__ int peer_next_item(unsigned* heads, const int myx, int& probe, const unsigned nper, volatile LAS int* bc, const int tid) {
    if (tid == 0) { int r = -1;
        while (probe < 8) { const int q = (myx + probe) & 7; const unsigned v = __hip_atomic_fetch_add(&heads[64 * q], 1u, __ATOMIC_RELAXED, __HIP_MEMORY_SCOPE_AGENT); if (v < nper) { r = q * (int)nper + (int)v; break; } ++probe; }
        bc[0] = r; }
    __syncthreads(); const int r = bc[0]; __syncthreads(); return r;
}
constexpr int Q_A = 8192 + 2048;
__device__ __forceinline__ int win_dest_row(int j) { return j < 2560 ? j : (j < 2576 ? 5632 + (j - 2560) : (j < 5648 ? j - 16 : j)); }
template <bool MAPROW, bool KSCALE = false> __device__ __forceinline__ void p0_transpose_item(const float* W, int K, int N, bf16* WT, LAS float* scr, int item, int lane, const float* ksc = nullptr) {
    const int nblk = N / 32, kb = item / nblk, nb = item % nblk, k0 = 64 * kb, n0 = 32 * nb;
#pragma unroll
    for (int i = 0; i < 32; ++i) { const int kk = 2 * i + (lane >> 5); scr[kk * 33 + (lane & 31)] = __builtin_nontemporal_load(W + (size_t)(k0 + kk) * N + n0 + (lane & 31)) * (KSCALE ? ksc[k0 + kk] : 1.f); }
    asm volatile("s_waitcnt lgkmcnt(0)" ::: "memory");
    const int c = lane & 7;
#pragma unroll
    for (int j = 0; j < 4; ++j) { const int n = (lane >> 3) + 8 * j; const LAS float* s = scr + (8 * c) * 33 + n;
        u32x4 o; o.x = cvtpk(s[0 * 33], s[1 * 33]); o.y = cvtpk(s[2 * 33], s[3 * 33]); o.z = cvtpk(s[4 * 33], s[5 * 33]); o.w = cvtpk(s[6 * 33], s[7 * 33]);
        const int drow = MAPROW ? win_dest_row(n0 + n) : (n0 + n);
        *(u32x4*)(WT + (size_t)drow * K + k0 + 8 * c) = o; }
    asm volatile("s_waitcnt lgkmcnt(0)" ::: "memory");
}
__device__ __forceinline__ void rms_row_to_bf16(const float* xrow, const float* w, bf16* orow, int lane) {
    const f32x4* xr = (const f32x4*)xrow + lane; const f32x4* wr = (const f32x4*)w + lane;
    f32x4 v[8]; float s = 0.f;
#pragma unroll
    for (int j = 0; j < 8; ++j) { v[j] = __builtin_nontemporal_load(xr + 64 * j); s += (v[j].x * v[j].x + v[j].y * v[j].y) + (v[j].z * v[j].z + v[j].w * v[j].w); }
    const float rstd = 1.f / sqrtf(wave_sum(s) * (1.f / DM) + EPS);
    u32x2* o8 = (u32x2*)orow + lane;
#pragma unroll
    for (int j = 0; j < 8; ++j) { const f32x4 ww = wr[64 * j]; u32x2 o; o.x = cvtpk(v[j].x * rstd * ww.x, v[j].y * rstd * ww.y); o.y = cvtpk(v[j].z * rstd * ww.z, v[j].w * rstd * ww.w); o8[64 * j] = o; }
}
__device__ __forceinline__ void transpose_filler_item(ArgsP a, LAS unsigned char* lds, const int tidx, const int f) {
    const int lane = tidx & 63, wave = __builtin_amdgcn_readfirstlane(tidx >> 6); LAS float* scr = (LAS float*)(lds + wave * 16384);
    const bool second = f >= 256; const int it = (f & 255) * 8 + wave;
    if (second) p0_transpose_item<false, true>(a->peer_wq, DM, DM, (bf16*)(a->ws + WS_WQ), scr, it, lane, a->ln2_w); else p0_transpose_item<false>(a->w_out, DM, DM, (bf16*)(a->ws + WS_WOUT), scr, it, lane);
}
__device__ __forceinline__ void phase0(ArgsP a, LAS unsigned char* lds, const int tidx) {
    const int tid = tidx, lane = tid & 63, wave = __builtin_amdgcn_readfirstlane(tid >> 6);
    LAS float* scr = (LAS float*)(lds + wave * 16384);
    const int gw = blockIdx.x * NWAVES + wave, NGW = gridDim.x * NWAVES;
    bf16* WinT = (bf16*)(a->ws + WS_WIN); bf16* WoutT = (bf16*)(a->ws + WS_WOUT); bf16* WqT = (bf16*)(a->ws + WS_WQ);
    constexpr int I_IN = (DM / 64) * (5664 / 32), I_SQ = (DM / 64) * (DM / 32);
    for (int it = gw; it < I_IN; it += NGW) p0_transpose_item<true, true>(a->w_in, DM, 5664, WinT, scr, it, lane, a->ln1_w);
    (void)WoutT; (void)WqT;
    { const int gt = blockIdx.x * NTHR + tid, NGT = gridDim.x * NTHR; u32x4* z = (u32x4*)(WinT + (size_t)5664 * DM);
      for (int i = gt; i < 224 * 256; i += NGT) z[i] = (u32x4){0u, 0u, 0u, 0u};
      float* ss = (float*)(a->ws + WS_MISC + MISC_SUMSQ); for (int i = gt; i < M; i += NGT) { ss[i] = 0.f; ss[i + 16384] = 0.f; }
      if (gt < 16) ((int*)(a->ws + WS_MISC + MISC_CHK))[gt] = 0;
      bf16* k12 = (bf16*)(a->ws + WS_K12);
      for (int i = gt; i < 2 * 8 * 128 * 128 / 2; i += NGT) { const int half = i >= 65536; const float* src = half ? a->peer_k2 : a->peer_k1; const int e = (i - half * 65536) * 2;
          ((unsigned*)k12)[i] = cvtpk(src[e], src[e + 1]); } }
    bf16* XN = (bf16*)(a->ws + WS_XN);
    { float* RSTD = (float*)(a->ws + WS_MISC + MISC_RSTD);
      for (int m = gw; m < M; m += NGW) { const f32x4* xr = (const f32x4*)(a->x + (size_t)m * DM) + lane; f32x4 v[8]; float sq = 0.f;
#pragma unroll
          for (int j = 0; j < 8; ++j) { v[j] = __builtin_nontemporal_load(xr + 64 * j); sq += (v[j].x * v[j].x + v[j].y * v[j].y) + (v[j].z * v[j].z + v[j].w * v[j].w); }
          const float rstd = 1.f / sqrtf(wave_sum(sq) * (1.f / DM) + EPS); if (lane == 0) RSTD[m] = rstd;
          u32x2* o8 = (u32x2*)(XN + (size_t)m * DM) + lane;
#pragma unroll
          for (int j = 0; j < 8; ++j) { u32x2 o; o.x = cvtpk(v[j].x, v[j].y); o.y = cvtpk(v[j].z, v[j].w); o8[64 * j] = o; } } }
}

struct EpiInProj {
    static constexpr bool PERM = true, AFTER_DRAIN = false;
    bf16 *Z, *XBC, *Q, *K, *V; float* DTF; const float* RSTD;
    __device__ __forceinline__ void operator()(const f32x4 (&acc)[2][2][4][2], const pg8::Unit& u, int wr, int wc, int fr, int fq) const {
        const int pn = u.pn; bf16* base; int ldc, colt; float sc = 1.f;
        if (pn < 4) { base = Z; ldc = 1024; colt = pn * 256; }
        else if (pn < 10) { base = XBC; ldc = 1536; colt = (pn - 4) * 256; }
        else if (pn < 14) { base = Q; ldc = 1024; colt = (pn - 10) * 256; sc = QSCALE; }
        else if (pn < 18) { base = K; ldc = 1024; colt = (pn - 14) * 256; }
        else if (pn < 22) { base = V; ldc = 1024; colt = (pn - 18) * 256; }
        else {
            if (wc == 0) {
#pragma unroll
                for (int ai = 0; ai < 2; ++ai)
#pragma unroll
                    for (int m = 0; m < 4; ++m) { const int row = u.pm * 256 + ai * 128 + wr * 64 + m * 16 + fr;
                        const float rs = RSTD[row];
#pragma unroll
                        for (int n = 0; n < 2; ++n) *(f32x4*)(DTF + (size_t)row * 32 + 8 * fq + 4 * n) = acc[ai][0][m][n] * rs; }
            }
            return;
        }
        const int row0 = u.pm * 256 + wr * 64 + fr, col0 = colt + wc * 32 + 8 * fq;
#pragma unroll
        for (int ai = 0; ai < 2; ++ai)
#pragma unroll
            for (int m = 0; m < 4; ++m) { bf16* rowp = base + (size_t)(row0 + ai * 128 + m * 16) * ldc + col0; const float rs = RSTD[row0 + ai * 128 + m * 16] * sc;
#pragma unroll
                for (int bj = 0; bj < 2; ++bj) { const f32x4 v0 = acc[ai][bj][m][0] * rs, v1 = acc[ai][bj][m][1] * rs;
                    u32x4 w; w.x = cvtpk(v0[0], v0[1]); w.y = cvtpk(v0[2], v0[3]); w.z = cvtpk(v1[0], v1[1]); w.w = cvtpk(v1[2], v1[3]);
                    if (pn < 4) __builtin_nontemporal_store(w, (u32x4*)(rowp + bj * 128)); else *(u32x4*)(rowp + bj * 128) = w; } }
    }
};
struct EpiPlainBf16 {
    static constexpr bool PERM = true, AFTER_DRAIN = false;
    bf16* O; int ldc;
    __device__ __forceinline__ void operator()(const f32x4 (&acc)[2][2][4][2], const pg8::Unit& u, int wr, int wc, int fr, int fq) const {
        const int row0 = u.pm * 256 + wr * 64 + fr, col0 = u.pn * 256 + wc * 32 + 8 * fq;
#pragma unroll
        for (int ai = 0; ai < 2; ++ai)
#pragma unroll
            for (int m = 0; m < 4; ++m) { bf16* rowp = O + (size_t)(row0 + ai * 128 + m * 16) * ldc + col0;
#pragma unroll
                for (int bj = 0; bj < 2; ++bj) { const f32x4 v0 = acc[ai][bj][m][0], v1 = acc[ai][bj][m][1];
                    u32x4 w; w.x = cvtpk(v0[0], v0[1]); w.y = cvtpk(v0[2], v0[3]); w.z = cvtpk(v1[0], v1[1]); w.w = cvtpk(v1[2], v1[3]);
                    *(u32x4*)(rowp + bj * 128) = w; } }
    }
};
struct EpiOutProj {
    static constexpr bool PERM = true, AFTER_DRAIN = false;
    const bf16* xb; bf16* X1B; bf16* HN; const float* ln2w; float* sumsq;
    __device__ __forceinline__ void operator()(const f32x4 (&acc)[2][2][4][2], const pg8::Unit& u, int wr, int wc, int fr, int fq) const {
        const int col0 = u.pn * 256 + wc * 32 + 8 * fq;
#pragma unroll
        for (int ai = 0; ai < 2; ++ai) {
            u32x4 xr[4][2];
#pragma unroll
            for (int m = 0; m < 4; ++m) { const size_t off = (size_t)(u.pm * 256 + ai * 128 + wr * 64 + m * 16 + fr) * DM + col0;
#pragma unroll
                for (int bj = 0; bj < 2; ++bj) xr[m][bj] = __builtin_nontemporal_load((const u32x4*)(xb + off + bj * 128)); }
#pragma unroll
            for (int m = 0; m < 4; ++m) { const int row = u.pm * 256 + ai * 128 + wr * 64 + m * 16 + fr; const size_t off = (size_t)row * DM + col0; float ss = 0.f;
#pragma unroll
                for (int bj = 0; bj < 2; ++bj) { const u32x4 xw_ = xr[m][bj]; const f32x4 a0 = acc[ai][bj][m][0] + (f32x4){bflo(xw_.x), bfhi(xw_.x), bflo(xw_.y), bfhi(xw_.y)}, a1 = acc[ai][bj][m][1] + (f32x4){bflo(xw_.z), bfhi(xw_.z), bflo(xw_.w), bfhi(xw_.w)}; const size_t o = off + bj * 128;
                    u32x4 xw; xw.x = cvtpk(a0[0], a0[1]); xw.y = cvtpk(a0[2], a0[3]); xw.z = cvtpk(a1[0], a1[1]); xw.w = cvtpk(a1[2], a1[3]); *(u32x4*)(X1B + o) = xw;
                    ss += ((a0[0] * a0[0] + a0[1] * a0[1]) + (a0[2] * a0[2] + a0[3] * a0[3])) + ((a1[0] * a1[0] + a1[1] * a1[1]) + (a1[2] * a1[2] + a1[3] * a1[3])); }
                ss += __shfl_xor(ss, 16); ss += __shfl_xor(ss, 32);
                if (fq == 0) atomicAdd(sumsq + row, ss); }
        }
    }
};
__device__ __forceinline__ void phase2(ArgsP a, LAS unsigned char* lds, const int tidx) {
    const int tid0 = tidx, w = __builtin_amdgcn_readfirstlane(tid0 >> 6);
    const bf16* XBC = (const bf16*)(a->ws + WS_XBC); const float* DTF = (const float*)(a->ws + WS_DTF);
    bf16* XS = (bf16*)(a->ws + WS_XS); bf16* BC = (bf16*)(a->ws + WS_BC); float* DT = (float*)(a->ws + WS_DT); float* ACUM = (float*)(a->ws + WS_ACUM);
    float* CUMF = (float*)(a->ws + WS_CUMF); float* FTOT = (float*)(a->ws + WS_MISC + MISC_FTOT);
    LAS bf16* BT = (LAS bf16*)lds; LAS bf16* XT = (LAS bf16*)(lds + 18432 + w * 9216);
    float inb[2][2][11], in[67], dtraw, fraw, cwb[2][5], cwx0, cwx1, cwx2, cwx3, cbx, p_dtb, p_alog, p_fb;
#define P2_LOADS(U) do { const int tid_ = opaque(tid0), lane_ = tid_ & 63, c_ = (U) >> 1, g_ = (U) & 1, h_ = 8 * g_ + w, n_ = tid_ & 127, t0v_ = opaque(c_ * 64), chx_ = 64 * h_ + lane_; \
        _Pragma("unroll") for (int which = 0; which < 2; ++which) \
            _Pragma("unroll") for (int rr = 0; rr < 2; ++rr) { const int s0 = 8 * ((tid_ >> 7) + 4 * rr); const unsigned chb = 1024u + which * 256 + 128 * g_ + n_; \
                _Pragma("unroll") for (int j = 0; j < 11; ++j) { const int t = t0v_ + s0 - 3 + j; inb[which][rr][j] = bf2f(__builtin_nontemporal_load(XBC + (unsigned)(t < 0 ? 0 : t) * 1536u + chb)); } } \
        _Pragma("unroll") for (int j = 0; j < 67; ++j) { const int t = t0v_ - 3 + j; in[j] = bf2f(__builtin_nontemporal_load(XBC + (unsigned)(j < 3 ? (t < 0 ? 0 : t) : t) * 1536u + (unsigned)chx_)); } \
        dtraw = DTF[(size_t)(c_ * 64 + lane_) * 32 + h_]; fraw = DTF[(size_t)(c_ * 64 + lane_) * 32 + 16 + h_]; \
        _Pragma("unroll") for (int which = 0; which < 2; ++which) { const int ch = 1024 + which * 256 + 128 * g_ + n_; cwb[which][0] = a->conv_w[ch]; cwb[which][1] = a->conv_w[1536 + ch]; cwb[which][2] = a->conv_w[2 * 1536 + ch]; cwb[which][3] = a->conv_w[3 * 1536 + ch]; cwb[which][4] = a->conv_b[ch]; } \
        cwx0 = a->conv_w[chx_]; cwx1 = a->conv_w[1536 + chx_]; cwx2 = a->conv_w[2 * 1536 + chx_]; cwx3 = a->conv_w[3 * 1536 + chx_]; cbx = a->conv_b[chx_]; \
        p_dtb = a->dt_bias[h_]; p_alog = a->a_log[h_]; p_fb = a->fox_f_bias[h_]; } while (0)
    if ((int)blockIdx.x < 2 * NCHUNK) P2_LOADS((int)blockIdx.x);
    for (int u = blockIdx.x; u < 2 * NCHUNK; u += gridDim.x) {
        const int tid = opaque(tid0), lane = tid & 63;
        const int c = u >> 1, g = u & 1, t0 = c * 64, h = 8 * g + w;
        const int n = tid & 127, tt = t0 + lane, chx = 64 * h + lane;
#pragma unroll
        for (int which = 0; which < 2; ++which) {
            const int ch = 1024 + which * 256 + 128 * g + n;
            const float w0 = cwb[which][0], w1 = cwb[which][1], w2 = cwb[which][2], w3 = cwb[which][3], cb = cwb[which][4];
#pragma unroll
            for (int rr = 0; rr < 2; ++rr) {
                const int s0 = 8 * ((tid >> 7) + 4 * rr);
                float inn[11];
#pragma unroll
                for (int j = 0; j < 11; ++j) inn[j] = (t0 + s0 - 3 + j < 0) ? 0.f : inb[which][rr][j];
                unsigned pk[4];
#pragma unroll
                for (int j = 0; j < 8; j += 2) {
                    const float v0 = siluf(cb + w0 * inn[j] + w1 * inn[j + 1] + w2 * inn[j + 2] + w3 * inn[j + 3]);
                    const float v1 = siluf(cb + w0 * inn[j + 1] + w1 * inn[j + 2] + w2 * inn[j + 3] + w3 * inn[j + 4]);
                    const unsigned p2 = cvtpk(v0, v1); pk[j >> 1] = p2;
                    BC[(size_t)(t0 + s0 + j) * 512 + which * 256 + 128 * g + n] = (bf16)(p2 & 0xffffu);
                    BC[(size_t)(t0 + s0 + j + 1) * 512 + which * 256 + 128 * g + n] = (bf16)(p2 >> 16);
                }
                if (which == 0) *(LAS u32x4*)(BT + n * 72 + s0) = (u32x4){pk[0], pk[1], pk[2], pk[3]};
            }
        }
        float wgt;
        {
            const int t = tt;
            const float dt = softplusf(dtraw + p_dtb);
            const float A = -__expf(p_alog);
            const float acum = wave_scan_incl(dt * A, lane);
            DT[(size_t)t * 16 + h] = dt; ACUM[(size_t)t * 16 + h] = acum;
            const float alast = __shfl(acum, 63);
            wgt = dt * __expf(alast - acum);
            const float lf = logsigmoidf(fraw + p_fb);
            const float cl = wave_scan_incl(lf, lane);
            CUMF[(size_t)h * M + t] = cl;
            if (lane == 63) FTOT[h * NCHUNK + c] = cl;
        }
        {
            const int ch = chx;
            const float w0 = cwx0, w1 = cwx1, w2 = cwx2, w3 = cwx3, cb = cbx;
#pragma unroll
            for (int j = 0; j < 3; ++j) in[j] = (t0 - 3 + j < 0) ? 0.f : in[j];
#pragma unroll
            for (int sb = 0; sb < 8; ++sb) {
                unsigned pk[4];
#pragma unroll
                for (int j = 0; j < 8; j += 2) {
                    const int s = 8 * sb + j;
                    const float v0 = siluf(cb + w0 * in[s] + w1 * in[s + 1] + w2 * in[s + 2] + w3 * in[s + 3]);
                    const float v1 = siluf(cb + w0 * in[s + 1] + w1 * in[s + 2] + w2 * in[s + 3] + w3 * in[s + 4]);
                    const unsigned p2 = cvtpk(v0, v1);
                    XS[(size_t)(t0 + s) * 1024 + ch] = (bf16)(p2 & 0xffffu); XS[(size_t)(t0 + s + 1) * 1024 + ch] = (bf16)(p2 >> 16);
                    const float g0 = __int_as_float(__builtin_amdgcn_readlane(__float_as_int(wgt), s)), g1 = __int_as_float(__builtin_amdgcn_readlane(__float_as_int(wgt), s + 1));
                    pk[j >> 1] = cvtpk(bflo(p2) * g0, bfhi(p2) * g1);
                }
                *(LAS u32x4*)(XT + lane * 72 + 8 * sb) = (u32x4){pk[0], pk[1], pk[2], pk[3]};
            }
        }
        { const int un = u + (int)gridDim.x; if (un < 2 * NCHUNK) P2_LOADS(un); }
        __syncthreads();
        {
            const int fr = lane & 15, fq = lane >> 4;
            bf16x8 bfr[4][2];
#pragma unroll
            for (int pt = 0; pt < 4; ++pt)
#pragma unroll
                for (int kk = 0; kk < 2; ++kk) bfr[pt][kk] = *(const LAS bf16x8*)(XT + (16 * pt + fr) * 72 + 8 * fq + 32 * kk);
            bf16* dst = (bf16*)(a->ws + sloc_off(c)) + (size_t)h * 64 * 128;
#pragma unroll
            for (int nt = 0; nt < 8; ++nt) {
                const bf16x8 a0 = *(const LAS bf16x8*)(BT + (16 * nt + fr) * 72 + 8 * fq), a1 = *(const LAS bf16x8*)(BT + (16 * nt + fr) * 72 + 8 * fq + 32);
#pragma unroll
                for (int pt = 0; pt < 4; ++pt) {
                    f32x4 acc = {0.f, 0.f, 0.f, 0.f};
                    acc = mfma16(a0, bfr[pt][0], acc); acc = mfma16(a1, bfr[pt][1], acc);
                    u32x2 o; o.x = cvtpk(acc[0], acc[1]); o.y = cvtpk(acc[2], acc[3]);
                    *(u32x2*)(dst + (size_t)(16 * pt + fr) * 128 + 16 * nt + 4 * fq) = o;
                }
            }
        }
        __syncthreads();
    }
#undef P2_LOADS
}

template <int CTRL> __device__ __forceinline__ float n3_dpp(float v) { return __int_as_float(__builtin_amdgcn_update_dpp(0, __float_as_int(v), CTRL, 0xf, 0xf, false)); }
template <bool DRY> __device__ __forceinline__ void phase3(ArgsP a, LAS unsigned char* lds, const int tidx) {
    const int tid = tidx, lane = tid & 63, w = __builtin_amdgcn_readfirstlane(tid >> 6);
    const float* ACUM = (const float*)(a->ws + WS_ACUM);
    const int gt = blockIdx.x * NTHR + tid, NGT = gridDim.x * NTHR;
    for (int pb = (int)blockIdx.x * 64; pb < 16384; pb += (int)gridDim.x * 64) {
        const int h = pb >> 10, cb = 32 * w; const float* acb = ACUM + (size_t)(cb * 64 + 63) * 16 + h;
        LAS float* Bl = (LAS float*)lds; LAS float* Dl = (LAS float*)(lds + 16384);
        u32x4 v[32]; float d[32];
        { const char* lp = (const char*)(a->ws + sloc_off(cb)) + (size_t)(pb + lane) * 16;
#pragma unroll
            for (int j = 0; j < 32; ++j) { v[j] = *(const u32x4*)lp; lp += 262144; asm volatile("" : "+v"(lp)); d[j] = __uint_as_float(__builtin_amdgcn_readfirstlane(__float_as_uint(__expf(acb[j * 1024])))); } }
        float st[8], dp = 1.f;
#pragma unroll
        for (int i = 0; i < 8; ++i) st[i] = 0.f;
#pragma unroll
        for (int j = 0; j < 32; ++j) { dp *= d[j];
            st[0] = st[0] * d[j] + bflo(v[j].x); st[1] = st[1] * d[j] + bfhi(v[j].x); st[2] = st[2] * d[j] + bflo(v[j].y); st[3] = st[3] * d[j] + bfhi(v[j].y);
            st[4] = st[4] * d[j] + bflo(v[j].z); st[5] = st[5] * d[j] + bfhi(v[j].z); st[6] = st[6] * d[j] + bflo(v[j].w); st[7] = st[7] * d[j] + bfhi(v[j].w); }
        *(LAS f32x4*)(Bl + (w * 64 + lane) * 8) = (f32x4){st[0], st[1], st[2], st[3]}; *(LAS f32x4*)(Bl + (w * 64 + lane) * 8 + 4) = (f32x4){st[4], st[5], st[6], st[7]}; Dl[w * 64 + lane] = dp;
        __syncthreads();
#pragma unroll
        for (int j = 0; j < 32; ++j) asm volatile("" : "+v"(v[j]));
#pragma unroll
        for (int i = 0; i < 8; ++i) st[i] = 0.f;
        _Pragma("nounroll") for (int k = 0; k < w; ++k) { const float dk = Dl[k * 64 + lane]; const f32x4 b0 = *(const LAS f32x4*)(Bl + (k * 64 + lane) * 8), b1 = *(const LAS f32x4*)(Bl + (k * 64 + lane) * 8 + 4);
            st[0] = st[0] * dk + b0[0]; st[1] = st[1] * dk + b0[1]; st[2] = st[2] * dk + b0[2]; st[3] = st[3] * dk + b0[3]; st[4] = st[4] * dk + b1[0]; st[5] = st[5] * dk + b1[1]; st[6] = st[6] * dk + b1[2]; st[7] = st[7] * dk + b1[3]; }
        { char* sp = (char*)(a->ws + sloc_off(cb)) + (size_t)(pb + lane) * 16;
#pragma unroll
            for (int j = 0; j < 32; ++j) { u32x4 o; o.x = cvtpk(st[0], st[1]); o.y = cvtpk(st[2], st[3]); o.z = cvtpk(st[4], st[5]); o.w = cvtpk(st[6], st[7]); *(u32x4*)sp = DRY ? v[j] : o; sp += 262144; asm volatile("" : "+v"(sp));
                st[0] = st[0] * d[j] + bflo(v[j].x); st[1] = st[1] * d[j] + bfhi(v[j].x); st[2] = st[2] * d[j] + bflo(v[j].y); st[3] = st[3] * d[j] + bfhi(v[j].y);
                st[4] = st[4] * d[j] + bflo(v[j].z); st[5] = st[5] * d[j] + bfhi(v[j].z); st[6] = st[6] * d[j] + bflo(v[j].w); st[7] = st[7] * d[j] + bfhi(v[j].w); } }
        __syncthreads();
    }
    (void)gt; (void)NGT;
    if (w != 1) { const int wn = w == 0 ? 0 : w - 1;
        const bf16* Qb = (const bf16*)(a->ws + WS_Q); const bf16* Kb = (const bf16*)(a->ws + WS_K);
        for (int pr = (int)blockIdx.x * 7 + wn; pr < NCHUNK * 16; pr += (int)gridDim.x * 7) { const int c = pr >> 4, hh = pr & 15;
            const u32x4* qp = (const u32x4*)(Qb + (size_t)(c * 64 + (lane >> 3)) * 1024 + 64 * hh) + (lane & 7); const u32x4* kp = (const u32x4*)(Kb + (size_t)(c * 64 + (lane >> 3)) * 1024 + 64 * hh) + (lane & 7);
            u32x4 qv[8], kv[8]; float qn = 0.f, kn = 0.f, qk = 3.0e38f;
#pragma unroll
            for (int i = 0; i < 8; ++i) { qv[i] = qp[(size_t)i * 1024]; kv[i] = kp[(size_t)i * 1024]; }
#pragma unroll
            for (int i = 0; i < 8; ++i) {
                float a = bflo(qv[i].x) * bflo(qv[i].x) + bfhi(qv[i].x) * bfhi(qv[i].x) + bflo(qv[i].y) * bflo(qv[i].y) + bfhi(qv[i].y) * bfhi(qv[i].y) + bflo(qv[i].z) * bflo(qv[i].z) + bfhi(qv[i].z) * bfhi(qv[i].z) + bflo(qv[i].w) * bflo(qv[i].w) + bfhi(qv[i].w) * bfhi(qv[i].w);
                float b = bflo(kv[i].x) * bflo(kv[i].x) + bfhi(kv[i].x) * bfhi(kv[i].x) + bflo(kv[i].y) * bflo(kv[i].y) + bfhi(kv[i].y) * bfhi(kv[i].y) + bflo(kv[i].z) * bflo(kv[i].z) + bfhi(kv[i].z) * bfhi(kv[i].z) + bflo(kv[i].w) * bflo(kv[i].w) + bfhi(kv[i].w) * bfhi(kv[i].w);
                float d = bflo(qv[i].x) * bflo(kv[i].x) + bfhi(qv[i].x) * bfhi(kv[i].x) + bflo(qv[i].y) * bflo(kv[i].y) + bfhi(qv[i].y) * bfhi(kv[i].y) + bflo(qv[i].z) * bflo(kv[i].z) + bfhi(qv[i].z) * bfhi(kv[i].z) + bflo(qv[i].w) * bflo(kv[i].w) + bfhi(qv[i].w) * bfhi(kv[i].w);
                a += n3_dpp<0xB1>(a); b += n3_dpp<0xB1>(b); d += n3_dpp<0xB1>(d); a += n3_dpp<0x4E>(a); b += n3_dpp<0x4E>(b); d += n3_dpp<0x4E>(d);
                { const bool up = (lane & 4) != 0; const float a4 = up ? n3_dpp<0x114>(a) : n3_dpp<0x104>(a), b4 = up ? n3_dpp<0x114>(b) : n3_dpp<0x104>(b), d4 = up ? n3_dpp<0x114>(d) : n3_dpp<0x104>(d); a += a4; b += b4; d += d4; }
                qn = fmaxf(qn, a); kn = fmaxf(kn, b); qk = fminf(qk, d); }
            qn = wave_max(qn); kn = wave_max(kn); qk = -wave_max(-qk);
            if (lane == 0) { ((float*)(a->ws + WS_MISC + MISC_QN2))[hh * NCHUNK + c] = qn; ((float*)(a->ws + WS_MISC + MISC_KN2))[hh * NCHUNK + c] = kn; ((float*)(a->ws + WS_MISC + MISC_QKD))[hh * NCHUNK + c] = qk; } }
    }
    if (w == 1) {
        for (int pr = (int)blockIdx.x; pr < 256; pr += (int)gridDim.x) { const int hh = pr & 15, c0 = (pr >> 4) * 16;
            const float* FTOT = (const float*)(a->ws + WS_MISC + MISC_FTOT) + hh * NCHUNK; float* CF = (float*)(a->ws + WS_CUMF) + (size_t)hh * M;
            float part = 0.f;
#pragma unroll
            for (int j = 0; j < 4; ++j) { const int cc = lane + 64 * j; part += cc < c0 ? FTOT[cc] : 0.f; }
            const float base = wave_sum(part);
            const float mine = lane < 16 ? FTOT[c0 + lane] : 0.f;
            const float incl = wave_scan_incl(mine, lane);
            const int cl = lane >> 2; const float pre = base + __shfl(incl - mine, cl);
            f32x4* p = (f32x4*)(CF + (size_t)(c0 + cl) * 64 + 16 * (lane & 3));
            f32x4 v0 = p[0], v1 = p[1], v2 = p[2], v3 = p[3];
            if (!DRY) { v0 = (v0 + pre) * LOG2E; v1 = (v1 + pre) * LOG2E; v2 = (v2 + pre) * LOG2E; v3 = (v3 + pre) * LOG2E; }
            p[0] = v0; p[1] = v1; p[2] = v2; p[3] = v3; }
    }
}
__device__ __forceinline__ void phase4(ArgsP a, LAS unsigned char* lds, const int tidx) {
    const int tid0 = tidx, w = __builtin_amdgcn_readfirstlane(tid0 >> 6);
    const bf16* XS = (const bf16*)(a->ws + WS_XS); const bf16* BC = (const bf16*)(a->ws + WS_BC); const float* DT = (const float*)(a->ws + WS_DT); const float* ACUM = (const float*)(a->ws + WS_ACUM);
    const bf16* Z = (const bf16*)(a->ws + WS_Z); bf16* MIX = (bf16*)(a->ws + WS_MIX);
    LAS bf16* CS = (LAS bf16*)lds; LAS bf16* BS = (LAS bf16*)(lds + 17408); LAS float* CBm = (LAS float*)(lds + 34816);
    LAS bf16* XT = (LAS bf16*)(lds + 52224 + w * 9216); LAS float* AC = (LAS float*)(lds + 125952 + w * 256); LAS float* SSW = (LAS float*)(lds + 128000); LAS float* DTs = (LAS float*)(lds + 130048 + w * 256);
    for (int u = blockIdx.x; u < 2 * NCHUNK; u += gridDim.x) {
        const int tid = opaque(tid0), lane = tid & 63, fr = lane & 15, fq = lane >> 4;
        const int c = u >> 1, g = u & 1, t0 = c * 64, h = 8 * g + w;
        bf16x8 pvf[4][4];
        { const bf16* pv = (const bf16*)(a->ws + sloc_off(c)) + (size_t)h * 64 * 128;
#pragma unroll
          for (int kk = 0; kk < 4; ++kk)
#pragma unroll
              for (int j = 0; j < 4; ++j) pvf[kk][j] = __builtin_nontemporal_load((const bf16x8*)(pv + (size_t)(16 * j + fr) * 128 + 8 * fq + 32 * kk)); }
        unsigned short zv[4][4][4];
#pragma unroll
        for (int i = 0; i < 4; ++i)
#pragma unroll
            for (int r = 0; r < 4; ++r)
#pragma unroll
                for (int j = 0; j < 4; ++j) zv[i][r][j] = __builtin_nontemporal_load(Z + (size_t)(t0 + 16 * i + 4 * fq + r) * 1024 + 64 * h + 16 * j + fr);
#pragma unroll
        for (int i = 0; i < 2; ++i) { const int q = tid + 512 * i, row = q >> 4, c16 = q & 15;
            *(LAS u32x4*)(CS + row * 136 + c16 * 8) = *(const u32x4*)(BC + (size_t)(t0 + row) * 512 + 256 + 128 * g + c16 * 8);
            *(LAS u32x4*)(BS + row * 136 + c16 * 8) = *(const u32x4*)(BC + (size_t)(t0 + row) * 512 + 128 * g + c16 * 8); }
        DTs[lane] = DT[(size_t)(t0 + lane) * 16 + h];
        AC[lane] = ACUM[(size_t)(t0 + lane) * 16 + h];
        {
            const int ch = 64 * h + lane;
            float xin[64];
#pragma unroll
            for (int s = 0; s < 64; ++s) xin[s] = bf2f(__builtin_nontemporal_load(XS + (size_t)(t0 + s) * 1024 + ch));
#pragma unroll
            for (int sb = 0; sb < 8; ++sb) {
                unsigned pk[4];
#pragma unroll
                for (int j = 0; j < 8; j += 2) { const int s = 8 * sb + j; pk[j >> 1] = cvtpk(xin[s], xin[s + 1]); }
                *(LAS u32x4*)(XT + lane * 72 + 8 * sb) = (u32x4){pk[0], pk[1], pk[2], pk[3]};
            }
        }
        __syncthreads();
#pragma unroll
        for (int x = 0; x < 2; ++x) { const int id = 2 * w + x, ti = id >> 2, si = id & 3; f32x4 acc = {0.f, 0.f, 0.f, 0.f};
#pragma unroll
            for (int kk = 0; kk < 4; ++kk) acc = mfma16(*(const LAS bf16x8*)(CS + (16 * ti + fr) * 136 + 8 * fq + 32 * kk), *(const LAS bf16x8*)(BS + (16 * si + fr) * 136 + 8 * fq + 32 * kk), acc);
#pragma unroll
            for (int r = 0; r < 4; ++r) CBm[(16 * ti + 4 * fq + r) * 68 + 16 * si + fr] = acc[r]; }
        __syncthreads();
        f32x4 acc[4][4];
#pragma unroll
        for (int i = 0; i < 4; ++i)
#pragma unroll
            for (int j = 0; j < 4; ++j) acc[i][j] = (f32x4){0.f, 0.f, 0.f, 0.f};
        {
#pragma unroll
            for (int kk = 0; kk < 4; ++kk) {
                bf16x8 af[4];
#pragma unroll
                for (int i = 0; i < 4; ++i) af[i] = *(const LAS bf16x8*)(CS + (16 * i + fr) * 136 + 8 * fq + 32 * kk);
#pragma unroll
                for (int i = 0; i < 4; ++i)
#pragma unroll
                    for (int j = 0; j < 4; ++j) acc[i][j] = mfma16(af[i], pvf[kk][j], acc[i][j]);
            }
#pragma unroll
            for (int i = 0; i < 4; ++i)
#pragma unroll
                for (int r = 0; r < 4; ++r) { const float e = __expf(AC[16 * i + 4 * fq + r]);
#pragma unroll
                    for (int j = 0; j < 4; ++j) acc[i][j][r] *= e; }
        }
#pragma unroll
        for (int kk = 0; kk < 2; ++kk) {
            bf16x8 bfv[4];
#pragma unroll
            for (int j = 0; j < 4; ++j) bfv[j] = *(const LAS bf16x8*)(XT + (16 * j + fr) * 72 + 8 * fq + 32 * kk);
            const int sbase = 8 * fq + 32 * kk;
            const f32x4 as0 = *(const LAS f32x4*)(AC + sbase), as1 = *(const LAS f32x4*)(AC + sbase + 4); const f32x4 ds0 = *(const LAS f32x4*)(DTs + sbase), ds1 = *(const LAS f32x4*)(DTs + sbase + 4);
#pragma unroll
            for (int i = 0; i < 4; ++i) {
                const int t = 16 * i + fr; const float act = AC[t];
                const f32x4 c0 = *(const LAS f32x4*)(CBm + t * 68 + sbase), c1 = *(const LAS f32x4*)(CBm + t * 68 + sbase + 4);
                float m[8];
#pragma unroll
                for (int jj = 0; jj < 4; ++jj) { m[jj] = (sbase + jj <= t) ? c0[jj] * ds0[jj] * __expf(fminf(act - as0[jj], 0.f)) : 0.f; m[4 + jj] = (sbase + 4 + jj <= t) ? c1[jj] * ds1[jj] * __expf(fminf(act - as1[jj], 0.f)) : 0.f; }
                u32x4 mp; mp.x = cvtpk(m[0], m[1]); mp.y = cvtpk(m[2], m[3]); mp.z = cvtpk(m[4], m[5]); mp.w = cvtpk(m[6], m[7]);
                const bf16x8 af = __builtin_bit_cast(bf16x8, mp);
#pragma unroll
                for (int j = 0; j < 4; ++j) acc[i][j] = mfma16(af, bfv[j], acc[i][j]);
            }
        }
        const float Dh = a->d_skip[h];
#pragma unroll
        for (int i = 0; i < 4; ++i)
#pragma unroll
            for (int r = 0; r < 4; ++r) { const int t = 16 * i + 4 * fq + r; float ss = 0.f;
#pragma unroll
                for (int j = 0; j < 4; ++j) {
#if SELFCHECK
                    { const size_t o = (size_t)(t0 + t) * 1024 + 64 * h + 16 * j + fr; if (t0 + t < 8192) ((float*)(a->ws + (size_t)464 * MiB))[o] = acc[i][j][r]; }
#endif
                    const float xv = bf2f(XT[(16 * j + fr) * 72 + t]);
                    const float y = (acc[i][j][r] + Dh * xv) * siluf(bf2f(zv[i][r][j])); acc[i][j][r] = y; ss += y * y; }
                ss += __shfl_xor(ss, 1); ss += __shfl_xor(ss, 2); ss += __shfl_xor(ss, 4); ss += __shfl_xor(ss, 8);
                if (fr == 0) SSW[w * 64 + t] = ss; }
        __syncthreads();
#pragma unroll
        for (int i = 0; i < 4; ++i)
#pragma unroll
            for (int r = 0; r < 4; ++r) { const int t = 16 * i + 4 * fq + r; float ss = 0.f;
#pragma unroll
                for (int ww = 0; ww < 8; ++ww) ss += SSW[ww * 64 + t];
                const float rstd = 1.f / sqrtf(ss * (1.f / 512.f) + EPS);
#pragma unroll
                for (int j = 0; j < 4; ++j) { const int ch = 64 * h + 16 * j + fr; MIX[(size_t)(t0 + t) * DM + ch] = f2bf(acc[i][j][r] * rstd * a->ssd_norm_w[ch]); } }
        __syncthreads();
    }
}

__device__ __forceinline__ void phase_attn(ArgsP a, LAS unsigned char* lds, const int tidx) {
    const int tid0 = tidx, w = __builtin_amdgcn_readfirstlane(tid0 >> 6);
    const bf16* Q = (const bf16*)(a->ws + WS_Q); const bf16* K = (const bf16*)(a->ws + WS_K); const bf16* V = (const bf16*)(a->ws + WS_V); const float* CL = (const float*)(a->ws + WS_CUMF);
    bf16* MIX = (bf16*)(a->ws + WS_MIX);
    LAS bf16* KS = (LAS bf16*)lds; LAS bf16* VT = (LAS bf16*)(lds + 9216); LAS float* CK = (LAS float*)(lds + 18432); LAS bf16* PS = (LAS bf16*)(lds + 18688 + w * 2304);
    const int G = gridDim.x;
    for (int i = 0;; ++i) {
        const int uidx = i * G + (int)blockIdx.x; if (uidx >= 2048) break;
        const int tid = opaque(tid0), lane = tid & 63, fr = lane & 15, fq = lane >> 4;
        const int slot = uidx >> 8, pos = uidx & 255, grp = pos >> 4, h = pos & 15;
        const int rnk = 16 * slot + ((slot & 1) ? 15 - grp : grp);
        const int qb = 127 - rnk;
        const int q0 = qb * 128 + 16 * w;
        const bf16x8 qf0 = *(const bf16x8*)(Q + (size_t)(q0 + fr) * 1024 + 64 * h + 8 * fq), qf1 = *(const bf16x8*)(Q + (size_t)(q0 + fr) * 1024 + 64 * h + 8 * fq + 32);
        float cq[4], mrun[4], lrun[4]; f32x4 o[4];
#pragma unroll
        for (int r = 0; r < 4; ++r) { cq[r] = CL[(size_t)h * M + q0 + 4 * fq + r]; mrun[r] = -3.0e38f; lrun[r] = 0.f; }
#pragma unroll
        for (int d = 0; d < 4; ++d) o[d] = (f32x4){0.f, 0.f, 0.f, 0.f};
        const int ntile = 2 * qb + 2;
        for (int kt = 0; kt < ntile; ++kt) {
            const int k0 = kt * 64;
            { const int row = tid >> 3, c16 = tid & 7; *(LAS u32x4*)(KS + row * 72 + c16 * 8) = *(const u32x4*)(K + (size_t)(k0 + row) * 1024 + 64 * h + c16 * 8);
              const int d = tid & 63, kb = tid >> 6; unsigned pk[4];
#pragma unroll
              for (int j = 0; j < 8; j += 2) { const unsigned lo = V[(size_t)(k0 + 8 * kb + j) * 1024 + 64 * h + d], hi = V[(size_t)(k0 + 8 * kb + j + 1) * 1024 + 64 * h + d]; pk[j >> 1] = lo | (hi << 16); }
              *(LAS u32x4*)(VT + d * 72 + 8 * kb) = (u32x4){pk[0], pk[1], pk[2], pk[3]};
              if (tid < 64) CK[tid] = CL[(size_t)h * M + k0 + tid]; }
            __syncthreads();
            f32x4 s[4];
#pragma unroll
            for (int nt = 0; nt < 4; ++nt) { s[nt] = (f32x4){0.f, 0.f, 0.f, 0.f};
                s[nt] = mfma16(qf0, *(const LAS bf16x8*)(KS + (16 * nt + fr) * 72 + 8 * fq), s[nt]);
                s[nt] = mfma16(qf1, *(const LAS bf16x8*)(KS + (16 * nt + fr) * 72 + 8 * fq + 32), s[nt]); }
            float mx[4];
#pragma unroll
            for (int r = 0; r < 4; ++r) { const int qg = q0 + 4 * fq + r; float m = -INFINITY;
#pragma unroll
                for (int nt = 0; nt < 4; ++nt) { const int kg = k0 + 16 * nt + fr; float v = s[nt][r] + (cq[r] - CK[16 * nt + fr]); v = kg > qg ? -INFINITY : v; s[nt][r] = v; m = fmaxf(m, v); }
                m = fmaxf(m, __shfl_xor(m, 1)); m = fmaxf(m, __shfl_xor(m, 2)); m = fmaxf(m, __shfl_xor(m, 4)); m = fmaxf(m, __shfl_xor(m, 8)); mx[r] = m; }
#pragma unroll
            for (int r = 0; r < 4; ++r) { const float mn = fmaxf(mrun[r], mx[r]); const float al = exp2f(mrun[r] - mn); mrun[r] = mn; float ps = 0.f;
#pragma unroll
                for (int nt = 0; nt < 4; ++nt) { const float p = exp2f(s[nt][r] - mn); ps += p; PS[(4 * fq + r) * 72 + 16 * nt + fr] = f2bf(p); }
                lrun[r] = lrun[r] * al + ps;
#pragma unroll
                for (int d = 0; d < 4; ++d) o[d][r] *= al; }
            asm volatile("s_waitcnt lgkmcnt(0)" ::: "memory");
            const bf16x8 pf0 = *(const LAS bf16x8*)(PS + fr * 72 + 8 * fq), pf1 = *(const LAS bf16x8*)(PS + fr * 72 + 8 * fq + 32);
#pragma unroll
            for (int d = 0; d < 4; ++d) { o[d] = mfma16(pf0, *(const LAS bf16x8*)(VT + (16 * d + fr) * 72 + 8 * fq), o[d]); o[d] = mfma16(pf1, *(const LAS bf16x8*)(VT + (16 * d + fr) * 72 + 8 * fq + 32), o[d]); }
            __syncthreads();
        }
#pragma unroll
        for (int r = 0; r < 4; ++r) { float l = lrun[r]; l += __shfl_xor(l, 1); l += __shfl_xor(l, 2); l += __shfl_xor(l, 4); l += __shfl_xor(l, 8); const float il = 1.f / l;
#pragma unroll
            for (int d = 0; d < 4; ++d) MIX[(size_t)(q0 + 4 * fq + r) * DM + 1024 + 64 * h + 16 * d + fr] = f2bf(o[d][r] * il); }
    }
}
constexpr size_t WS_U8 = 400 * MiB, WS_V8 = 432 * MiB;
constexpr size_t WS_PLAN = 496 * MiB, WS_PARTL = 497 * MiB;
constexpr size_t WS_USC = WS_K12 + 512 * 1024, WS_VSC = WS_K12 + 576 * 1024;
#ifndef PEERV_I8
#define PEERV_I8 1
#endif
constexpr size_t WS_CSC = 109 * MiB;
__device__ __forceinline__ int pack_i8x4(float a, float b, float c, float d) { const int i0 = __float2int_rn(a), i1 = __float2int_rn(b), i2 = __float2int_rn(c), i3 = __float2int_rn(d); return (i0 & 255) | ((i1 & 255) << 8) | ((i2 & 255) << 16) | (i3 << 24); }
__device__ __forceinline__ void conv_load(ArgsP a, const int lane, const int row0, f32x4 (&x)[2][8]) {
#pragma unroll
    for (int q = 0; q < 2; ++q) { const int row = row0 + q; const bool second = row >= 16384; const int e = row & 16383; const f32x4* src = (const f32x4*)((second ? a->peer_v : a->peer_u) + (size_t)e * DM) + lane;
#pragma unroll
        for (int j = 0; j < 8; ++j) x[q][j] = __builtin_nontemporal_load(src + 64 * j); }
}
__device__ __forceinline__ void conv_finish(ArgsP a, const int lane, const int row0, const f32x4 (&x)[2][8]) {
    unsigned char* U8 = (unsigned char*)(a->ws + WS_U8); unsigned char* V8 = (unsigned char*)(a->ws + WS_V8);
#pragma unroll
    for (int q = 0; q < 2; ++q) { const int row = row0 + q; const bool second = row >= 16384; const int e = row & 16383; unsigned char* dst = second ? V8 : U8; float mx = 0.f;
#pragma unroll
        for (int j = 0; j < 8; ++j) mx = fmaxf(mx, fmaxf(fmaxf(fabsf(x[q][j][0]), fabsf(x[q][j][1])), fmaxf(fabsf(x[q][j][2]), fabsf(x[q][j][3]))));
        const float mxa = wave_max(mx); const float sc = mxa > 0.f ? ((second && !PEERV_I8) ? 440.f : 127.f) / mxa : 1.f;
        if (lane == 0) ((float*)(a->ws + (second ? WS_VSC : WS_USC)))[e] = 1.f / sc;
#pragma unroll
        for (int j = 0; j < 8; ++j) { const int s = 2 * j + (lane >> 5); int p;
            if (second && !PEERV_I8) { p = __builtin_amdgcn_cvt_pk_fp8_f32(x[q][j][0] * sc, x[q][j][1] * sc, 0, false); p = __builtin_amdgcn_cvt_pk_fp8_f32(x[q][j][2] * sc, x[q][j][3] * sc, p, true); }
            else {
                const unsigned b0 = __float_as_uint(fmaf(x[q][j][0], sc, 12582912.f)), b1 = __float_as_uint(fmaf(x[q][j][1], sc, 12582912.f)), b2 = __float_as_uint(fmaf(x[q][j][2], sc, 12582912.f)), b3 = __float_as_uint(fmaf(x[q][j][3], sc, 12582912.f));
                p = (int)(__builtin_amdgcn_perm(b1, b0, 0x0c0c0400u) | __builtin_amdgcn_perm(b3, b2, 0x04000c0cu)); }
            __builtin_nontemporal_store(p, (int*)(dst + ((size_t)s * 16384 + e) * 128 + 4 * (lane & 31))); } }
}
__device__ __forceinline__ void conv_pack_lds(ArgsP a, LAS unsigned char* img, const int lane, const int row0, const int rloc, const f32x4 (&x)[2][8]) {
#pragma unroll
    for (int q = 0; q < 2; ++q) { const int row = row0 + q; const bool second = row >= 16384; const int e = row & 16383; float mx = 0.f;
#pragma unroll
        for (int j = 0; j < 8; ++j) mx = fmaxf(mx, fmaxf(fmaxf(fabsf(x[q][j][0]), fabsf(x[q][j][1])), fmaxf(fabsf(x[q][j][2]), fabsf(x[q][j][3]))));
        const float mxa = wave_max(mx); const float sc = mxa > 0.f ? 127.f / mxa : 1.f;
        if (lane == 0) ((float*)(a->ws + (second ? WS_VSC : WS_USC)))[e] = 1.f / sc;
#pragma unroll
        for (int j = 0; j < 8; ++j) { const int s = 2 * j + (lane >> 5);
            const unsigned b0 = __float_as_uint(fmaf(x[q][j][0], sc, 12582912.f)), b1 = __float_as_uint(fmaf(x[q][j][1], sc, 12582912.f)), b2 = __float_as_uint(fmaf(x[q][j][2], sc, 12582912.f)), b3 = __float_as_uint(fmaf(x[q][j][3], sc, 12582912.f));
            *(LAS unsigned*)(img + (s * 32 + rloc + q) * 128 + 4 * (lane & 31)) = __builtin_amdgcn_perm(b1, b0, 0x0c0c0400u) | __builtin_amdgcn_perm(b3, b2, 0x04000c0cu); } }
}
__device__ __forceinline__ void conv_flush_lds(ArgsP a, const LAS unsigned char* img, const int lane, const int w, const int item) {
    const int row0 = 32 * item; const bool second = row0 >= 16384; const int e0 = row0 & 16383; unsigned char* tab = second ? (unsigned char*)(a->ws + WS_V8) : (unsigned char*)(a->ws + WS_U8);
#pragma unroll
    for (int k = 0; k < 2; ++k) { const int sl = 2 * w + k; unsigned char* dst = tab + ((size_t)sl * 16384 + e0) * 128;
#pragma unroll
        for (int i = 0; i < 4; ++i) __builtin_nontemporal_store(*(const LAS u32x4*)(img + sl * 4096 + (i * 64 + lane) * 16), (u32x4*)(dst + (i * 64 + lane) * 16)); }
}
__device__ __forceinline__ void convert_uv_fp8_item(ArgsP a, LAS unsigned char* img, const int tidx, const int item) {
    const int lane = tidx & 63, w = __builtin_amdgcn_readfirstlane(tidx >> 6), row0 = 32 * item + 4 * w;
    f32x4 xa[2][8], xb[2][8];
    conv_load(a, lane, row0, xa); conv_load(a, lane, row0 + 2, xb);
    conv_pack_lds(a, img, lane, row0, 4 * w, xa); conv_pack_lds(a, img, lane, row0 + 2, 4 * w + 2, xb);
    __syncthreads();
    conv_flush_lds(a, img, lane, w, item);
    __syncthreads();
}
__device__ __forceinline__ void convert_uv_fp8_range(ArgsP a, LAS unsigned char* img, const int tidx, const int item0, const int n, const int istride) {
    const int lane = tidx & 63, w = __builtin_amdgcn_readfirstlane(tidx >> 6);
    f32x4 xa[2][8], xb[2][8];
    conv_load(a, lane, 32 * item0 + 4 * w, xa);
    for (int i = 0; i < n; ++i) { const int it = item0 + i * istride, r = 32 * it + 4 * w;
        conv_load(a, lane, r + 2, xb);
        conv_pack_lds(a, img, lane, r, 4 * w, xa);
        if (i + 1 < n) conv_load(a, lane, r + 32 * istride, xa);
        conv_pack_lds(a, img, lane, r + 2, 4 * w + 2, xb);
        __syncthreads();
        conv_flush_lds(a, img, lane, w, it);
        __syncthreads(); }
}
namespace attn_body {
using bf16=unsigned short;
using bf16x8=__attribute__((ext_vector_type(8)))short;
using s16x4=__attribute__((ext_vector_type(4)))short;
using f32x16=__attribute__((ext_vector_type(16)))float;
using u32x4=__attribute__((ext_vector_type(4)))unsigned;
constexpr int BATCH=1,NHEAD=16,SEQ=16384,D=64,DM=NHEAD*D,OPITCH=2048,OCOL=1024;
constexpr int NW=8,QBLK=32,QB=QBLK*NW,KVBLK=64,NQB=SEQ/QB;
constexpr int ATTN_PITCH=DM, ATTN_UNIT_ROWS=QB;
__device__ __forceinline__ int crow(int r,int hi){return (r&3)+8*(r>>2)+4*hi;}
#define SBAR() __builtin_amdgcn_sched_barrier(0)
__device__ __forceinline__ void cmask(f32x16&p0,f32x16&p1,int jb,int qrel,int hi){
  const float NEG=-INFINITY; int kb=64*jb+4*hi;
  #pragma unroll
  for(int r=0;r<16;++r){int kv=kb+(r&3)+8*(r>>2); if(kv>qrel)p0[r]=NEG; if(kv+32>qrel)p1[r]=NEG;}
}

constexpr int NSLOT=3, SLOTB=8192;
constexpr int LDS_K=0, LDS_V=NSLOT*SLOTB, LDS_WS=2*NSLOT*SLOTB, LDS_OST=LDS_WS+NW*64*4, LDS_CL=LDS_OST+NW*4096, LDS_BYTES=LDS_CL+SEQ*4;
constexpr float C2=0.125f*1.4426950408889634f;
__device__ __forceinline__ void glds16(const void*gsrc,unsigned lds_dst){unsigned keep;
  asm volatile("s_mov_b32 %0, m0\n\ts_mov_b32 m0, %2\n\ts_nop 0\n\tglobal_load_lds_dwordx4 %1, off\n\ts_mov_b32 m0, %0":"=&s"(keep):"v"(gsrc),"s"(lds_dst):"memory");}
__device__ __forceinline__ float max3f(float a,float b,float c){float r;asm("v_max3_f32 %0, %1, %2, %3":"=v"(r):"v"(a),"v"(b),"v"(c));return r;}
__device__ __forceinline__ float max2f(float a,float b){float r;asm("v_max_f32_e32 %0, %1, %2":"=v"(r):"v"(a),"v"(b));return r;}
__device__ __forceinline__ float fadd_s(float a,float b){float r;asm("v_add_f32_e32 %0, %1, %2":"=v"(r):"v"(a),"v"(b));return r;}
__device__ __forceinline__ float fsub_s(float a,float b){float r;asm("v_sub_f32_e32 %0, %1, %2":"=v"(r):"v"(a),"v"(b));return r;}
typedef float f32x2_t __attribute__((ext_vector_type(2))); typedef float f32x4_t __attribute__((ext_vector_type(4))); typedef __bf16 bf16x2_t __attribute__((ext_vector_type(2)));
__device__ __forceinline__ unsigned cvtpk_s(float lo,float hi){f32x2_t v={lo,hi};bf16x2_t b=__builtin_convertvector(v,bf16x2_t);return __builtin_bit_cast(unsigned,b);}
#define WAIT_BAR(N) asm volatile("s_waitcnt vmcnt(" #N ") lgkmcnt(0)\n\ts_barrier":::"memory")

__device__ __forceinline__ void qkt(f32x16&p0,f32x16&p1,const char*Kslot,const bf16x8*qr,const f32x16&i0,const f32x16&i1,int r32,int hi){
  const char*kb=Kslot+hi*1024+r32*16;
  #pragma unroll
  for(int d0=0;d0<4;++d0){
    const bf16x8 b0=*reinterpret_cast<const bf16x8*>(kb+d0*2048);
    const bf16x8 b1=*reinterpret_cast<const bf16x8*>(kb+d0*2048+512);
    if(d0==0){p0=__builtin_amdgcn_mfma_f32_32x32x16_bf16(b0,qr[0],i0,0,0,0);p1=__builtin_amdgcn_mfma_f32_32x32x16_bf16(b1,qr[0],i1,0,0,0);}
    else{p0=__builtin_amdgcn_mfma_f32_32x32x16_bf16(b0,qr[d0],p0,0,0,0);p1=__builtin_amdgcn_mfma_f32_32x32x16_bf16(b1,qr[d0],p1,0,0,0);}}
}
typedef __attribute__((address_space(3))) const char* lds_cptr;
typedef short v4i16_t __attribute__((ext_vector_type(4)));
__device__ __forceinline__ void kload8(bf16x8*kf,lds_cptr kp){
  kf[0]=*(const __attribute__((address_space(3))) bf16x8*)(kp);      kf[1]=*(const __attribute__((address_space(3))) bf16x8*)(kp+512);
  kf[2]=*(const __attribute__((address_space(3))) bf16x8*)(kp+2048); kf[3]=*(const __attribute__((address_space(3))) bf16x8*)(kp+2560);
  kf[4]=*(const __attribute__((address_space(3))) bf16x8*)(kp+4096); kf[5]=*(const __attribute__((address_space(3))) bf16x8*)(kp+4608);
  kf[6]=*(const __attribute__((address_space(3))) bf16x8*)(kp+6144); kf[7]=*(const __attribute__((address_space(3))) bf16x8*)(kp+6656);
}
__device__ __forceinline__ void kload2(bf16x8*kf,lds_cptr kp,int j){ kf[2*j]=*(const __attribute__((address_space(3))) bf16x8*)(kp+j*2048); kf[2*j+1]=*(const __attribute__((address_space(3))) bf16x8*)(kp+j*2048+512); }
__device__ __forceinline__ s16x4 vtr(lds_cptr p){ return __builtin_bit_cast(s16x4,__builtin_amdgcn_ds_read_tr16_b64_v4i16((__attribute__((address_space(3))) v4i16_t*)p)); }
__device__ __forceinline__ float rowmax(const f32x16&p0,const f32x16&p1){
  float a=max3f(p0[0],p0[1],p1[0]),b=max3f(p0[2],p0[3],p1[1]);a=max3f(a,p1[2],p1[3]);
  #pragma unroll
  for(int r=4;r<16;r+=4){a=max3f(a,p0[r],p0[r+1]);b=max3f(b,p0[r+2],p0[r+3]);a=max3f(a,p1[r],p1[r+1]);b=max3f(b,p1[r+2],p1[r+3]);}
  const float m=max2f(a,b);
  auto rr=__builtin_amdgcn_permlane32_swap(__float_as_uint(m),__float_as_uint(m),false,false);
  return max2f(__uint_as_float(rr[0]),__uint_as_float(rr[1]));
}
__device__ __forceinline__ void pv(f32x16*o,int vb,bf16x8 pa0,bf16x8 pa1,bf16x8 pa2,bf16x8 pa3){
  #pragma unroll
  for(int d0=0;d0<2;++d0){s16x4 lo[4],hi[4];
    #pragma unroll
    for(int ks=0;ks<4;++ks){
      asm volatile("ds_read_b64_tr_b16 %0,%1 offset:%c2":"=&v"(lo[ks]):"v"(vb),"i"(d0*4096+ks*1024):"memory");
      asm volatile("ds_read_b64_tr_b16 %0,%1 offset:%c2":"=&v"(hi[ks]):"v"(vb),"i"(d0*4096+ks*1024+512):"memory");}
    asm volatile("s_waitcnt lgkmcnt(0)":::"memory");SBAR();
    #define PK(k) (bf16x8){lo[k][0],lo[k][1],lo[k][2],lo[k][3],hi[k][0],hi[k][1],hi[k][2],hi[k][3]}
    o[d0]=__builtin_amdgcn_mfma_f32_32x32x16_bf16(pa0,PK(0),o[d0],0,0,0);
    o[d0]=__builtin_amdgcn_mfma_f32_32x32x16_bf16(pa1,PK(1),o[d0],0,0,0);
    o[d0]=__builtin_amdgcn_mfma_f32_32x32x16_bf16(pa2,PK(2),o[d0],0,0,0);
    o[d0]=__builtin_amdgcn_mfma_f32_32x32x16_bf16(pa3,PK(3),o[d0],0,0,0);
    #undef PK
  }
}

#ifndef ATTN_STORE16
#define ATTN_STORE16(p,v) (*(u32x4*)(p)=(v))
#endif
template<int THRL> __device__ __forceinline__ void attn_unit(int b,int h,int qb,const bf16*Q,const bf16*__restrict__ K,const bf16*__restrict__ V,bf16*O,const float*__restrict__ CLh,const float*__restrict__ QN2h,const float*__restrict__ KN2h,const float*__restrict__ QKDh,char*shm,const int tid_in){
  const int tid=tid_in,lane=tid&63,r32=lane&31,hi=lane>>5; const int wid=__builtin_amdgcn_readfirstlane(tid>>6);
  const long rowbase=(long)b*SEQ; const int q0=qb*QB;
  const bf16*Qw=Q+(rowbase+q0+wid*QBLK)*DM+h*D;
  int Ts;
  { const int NT0=(q0+QB)/KVBLK; float qn4[4],ad4[4];
    _Pragma("unroll") for(int c=0;c<4;++c){ qn4[c]=__builtin_sqrtf(QN2h[4*qb+c]); ad4[c]=CLh[q0+64*c]-(QKDh[4*qb+c]-0.01f); }
    int first=NT0;
    _Pragma("unroll") for(int j=3;j>=0;--j){ const int Tt=lane+64*j; const bool in=Tt<NT0; const float kn=__builtin_sqrtf(KN2h[in?Tt:0]), cll=CLh[in?64*Tt+63:0];
      const float bd=__builtin_fmaxf(__builtin_fmaxf(qn4[0]*kn+ad4[0],qn4[1]*kn+ad4[1]),__builtin_fmaxf(qn4[2]*kn+ad4[2],qn4[3]*kn+ad4[3]))-cll; const bool keep=in&&!(bd<-48.f);
      const unsigned long long nm=__ballot(keep); if(nm)first=64*j+(int)__builtin_ctzll(nm); }
    Ts=first&~1; if(Ts>NT0-4)Ts=NT0-4; Ts=__builtin_amdgcn_readfirstlane(Ts); }
  const bf16*Kh=K+(rowbase+(long)Ts*KVBLK)*DM+h*D,*Vh=V+(rowbase+(long)Ts*KVBLK)*DM+h*D;
  const lds_cptr shm3=(lds_cptr)shm;
  const unsigned lds0=(unsigned)(uintptr_t)shm;
  float*wsf=(float*)(shm+LDS_WS)+wid*64;
  const bf16*ksrc=Kh+(long)lane*DM+wid*8;
  const bf16*vsrc=Vh+(long)(16*(wid&3)+(lane>>2))*DM+(wid>>2)*32+(lane&3)*8;
  const unsigned kdst=lds0+LDS_K+wid*1024, vdst=lds0+LDS_V+wid*1024;
  #define DMA_K(t,slot) glds16(ksrc+(long)(t)*KVBLK*DM,(unsigned)__builtin_amdgcn_readfirstlane(kdst+(slot)))
  #define DMA_V(t,slot) glds16(vsrc+(long)(t)*KVBLK*DM,(unsigned)__builtin_amdgcn_readfirstlane(vdst+(slot)))
  const int vb0=(int)(lds0+LDS_V)+((lane>>4)&1)*32+(lane&3)*8+(4*hi+((lane&15)>>2))*64;
  const char*Kbase=shm+LDS_K; bf16x8 kf[8];
  const lds_cptr kp0=shm3+LDS_K+hi*1024+r32*16; const lds_cptr vp0=shm3+LDS_V+((lane>>4)&1)*32+(lane&3)*8+(4*hi+((lane&15)>>2))*64;
  const int NT=(q0+QB)/KVBLK-Ts;
  typedef __attribute__((address_space(3))) float* lds_fptr; typedef __attribute__((address_space(3))) const f32x4_t* lds_f4ptr;
  { typedef __attribute__((address_space(3))) f32x4_t* lds_f4w; lds_f4w clw=(lds_f4w)(shm3+LDS_CL); const f32x4_t*cls=(const f32x4_t*)(CLh+Ts*KVBLK); const int ncl4=(q0+QB-Ts*KVBLK)>>2; _Pragma("nounroll") for(int i=tid;i<ncl4;i+=4*NW*64){
      const bool b1=i+NW*64<ncl4,b2=i+2*NW*64<ncl4,b3=i+3*NW*64<ncl4; f32x4_t t0=cls[i],t1,t2,t3; if(b1)t1=cls[i+NW*64]; if(b2)t2=cls[i+2*NW*64]; if(b3)t3=cls[i+3*NW*64];
      clw[i]=t0; if(b1)clw[i+NW*64]=t1; if(b2)clw[i+2*NW*64]=t2; if(b3)clw[i+3*NW*64]=t3; } }
  const lds_f4ptr clp=(lds_f4ptr)(shm3+LDS_CL+16*hi);
  float nb=CLh[q0+wid*QBLK+r32];
  #define CKLOAD(X0,X1,t) do{ const lds_f4ptr cb_=clp+(t)*16; \
    _Pragma("unroll") for(int g_=0;g_<4;++g_){ const f32x4_t a_=cb_[2*g_], b_=cb_[8+2*g_]; \
      _Pragma("unroll") for(int i_=0;i_<4;++i_){ X0[4*g_+i_]=a_[i_]; X1[4*g_+i_]=b_[i_]; } } }while(0)
  #define BIASSUB(C0,C1) do{ _Pragma("unroll") for(int r_=0;r_<16;++r_){ C0[r_]=nb-C0[r_]; C1[r_]=nb-C1[r_]; } }while(0)
  DMA_K(0,0);DMA_V(0,0);DMA_K(1,SLOTB);
  bf16x8 qr[4];
  #pragma unroll
  for(int d0=0;d0<4;++d0)qr[d0]=*reinterpret_cast<const bf16x8*>(&Qw[(long)r32*DM+d0*16+hi*8]);
  float l_reg=0.f;f32x16 o[2];o[0]=f32x16{};o[1]=f32x16{};
  const int qrel=wid*QBLK+r32;
  #define CMASK(P0,P1,t) do{int jb_=(t)-(NT-4); if(jb_>=0)cmask(P0,P1,jb_,qrel,hi);}while(0)
  bool resc=false;
  #define START(P0,P1) do{ const float rm=rowmax(P0,P1); resc=false; \
    { const float dl=rm; nb=fsub_s(nb,dl); \
      _Pragma("unroll") for(int r=0;r<16;++r){P0[r]=fsub_s(P0[r],dl);P1[r]=fsub_s(P1[r],dl);} } \
    _Pragma("unroll") for(int r=0;r<16;++r)P0[r]=__builtin_amdgcn_exp2f(P0[r]); }while(0)
  #define RESC() do{ if(resc){ asm volatile("s_waitcnt lgkmcnt(0)":::"memory"); \
      _Pragma("unroll") for(int d_=0;d_<2;++d_) _Pragma("unroll") for(int r=0;r<16;++r)o[d_][r]*=wsf[crow(r,hi)]; } }while(0)
  f32x16 pA0,pA1,pB0,pB1;
  int sl_prev=0,sl_cur=0,sl_next=SLOTB;
  #define ROT() do{sl_prev=sl_cur;sl_cur=sl_next;sl_next=(sl_next==(NSLOT-1)*SLOTB)?0:sl_next+SLOTB;}while(0)
  DMA_K(2,2*SLOTB);
  WAIT_BAR(3);
  CKLOAD(pA0,pA1,0); BIASSUB(pA0,pA1);
  qkt(pA0,pA1,Kbase,qr,pA0,pA1,r32,hi);asm volatile("s_nop 15\n\ts_nop 7":"+v"(pA0),"+v"(pA1));CMASK(pA0,pA1,0);
  START(pA0,pA1);
  _Pragma("unroll") for(int r=0;r<16;++r)pA1[r]=__builtin_amdgcn_exp2f(pA1[r]);
  WAIT_BAR(0);
  DMA_K(3,0);DMA_V(1,SLOTB);
  ROT();
  kload8(kf,kp0+sl_cur);
  WAIT_BAR(2);
  s16x4 vlo[8],vhi[8]; u32x4 pw0,pw1,pw2,pw3;
  #define PKW(P,B) cvtpk_s(P[B],P[B+1])
  #define PAF(k) __builtin_bit_cast(bf16x8,pw##k)
  #define VFR(i) (bf16x8){vlo[i][0],vlo[i][1],vlo[i][2],vlo[i][3],vhi[i][0],vhi[i][1],vhi[i][2],vhi[i][3]}
  #define PIN(x) asm volatile("":"+v"(x))
  #define MX3(a,b,c) __builtin_fmaxf(__builtin_fmaxf((a),(b)),(c))
  #define GAPA(MF,A0,A1,A2,A3,W0,W1,PW) do{ MF; sacc+=A0; sacc+=A1; sacc+=A2; sacc+=A3; PIN(sacc); W0; W1; PIN(PW); SBAR(); }while(0)
  #define EX(v) __builtin_amdgcn_exp2f(v)
  #define GAPB(MF,X,B) do{ MF; X[B]=EX(X[B]); X[B+1]=EX(X[B+1]); X[B+2]=EX(X[B+2]); X[B+3]=EX(X[B+3]); PIN(X); SBAR(); }while(0)
  #define VRD(i) do{ vlo[i]=vtr(vp_+(((i)>>2)*4096+((i)&3)*1024)); vhi[i]=vtr(vp_+(((i)>>2)*4096+((i)&3)*1024+512)); }while(0)
  #define KRD(G,j) do{ if(G){ kload2(kf,kp0+sl_next,j); SBAR(); } }while(0)
  #define STEP(C0,C1,P0,P1,t,GK,GV,GL) do{ CKLOAD(C0,C1,t); asm volatile("":"+v"(C0),"+v"(C1)); BIASSUB(C0,C1); SBAR(); \
    const lds_cptr vp_=vp0+sl_prev; \
    VRD(0); SBAR(); float sacc=(P0[0]+P0[1]); \
    GAPA(C0=__builtin_amdgcn_mfma_f32_32x32x16_bf16(kf[0],qr[0],C0,0,0,0), P0[2],P0[3],P0[4],P0[5],     pw0[0]=PKW(P0,0), pw0[1]=PKW(P0,2), pw0); \
    VRD(4); SBAR(); GAPA(C1=__builtin_amdgcn_mfma_f32_32x32x16_bf16(kf[1],qr[0],C1,0,0,0), P0[6],P0[7],P0[8],P0[9],     pw0[2]=PKW(P0,4), pw0[3]=PKW(P0,6), pw0); \
    VRD(1); SBAR(); GAPA(C0=__builtin_amdgcn_mfma_f32_32x32x16_bf16(kf[2],qr[1],C0,0,0,0),   P0[10],P0[11],P0[12],P0[13], pw1[0]=PKW(P0,8), pw1[1]=PKW(P0,10), pw1); \
    VRD(5); SBAR(); GAPA(C1=__builtin_amdgcn_mfma_f32_32x32x16_bf16(kf[3],qr[1],C1,0,0,0),   P0[14],P0[15],P1[0],P1[1],   pw1[2]=PKW(P0,12),pw1[3]=PKW(P0,14), pw1); \
    VRD(2); SBAR(); GAPA(C0=__builtin_amdgcn_mfma_f32_32x32x16_bf16(kf[4],qr[2],C0,0,0,0),   P1[2],P1[3],P1[4],P1[5],     pw2[0]=PKW(P1,0), pw2[1]=PKW(P1,2), pw2); \
    VRD(6); SBAR(); GAPA(C1=__builtin_amdgcn_mfma_f32_32x32x16_bf16(kf[5],qr[2],C1,0,0,0),   P1[6],P1[7],P1[8],P1[9],     pw2[2]=PKW(P1,4), pw2[3]=PKW(P1,6), pw2); \
    VRD(3); SBAR(); GAPA(C0=__builtin_amdgcn_mfma_f32_32x32x16_bf16(kf[6],qr[3],C0,0,0,0),   P1[10],P1[11],P1[12],P1[13], pw3[0]=PKW(P1,8), pw3[1]=PKW(P1,10), pw3); \
    VRD(7); SBAR(); GAPA(C1=__builtin_amdgcn_mfma_f32_32x32x16_bf16(kf[7],qr[3],C1,0,0,0),   P1[14],P1[15],0.f,0.f,       pw3[2]=PKW(P1,12),pw3[3]=PKW(P1,14), pw3); \
    l_reg+=sacc; \
    if(GK){DMA_K((t)+3,sl_cur);} if(GV){DMA_V((t)+1,sl_next);} \
    CMASK(C0,C1,t); \
    { float a=MX3(C0[0],C0[1],C1[0]),b=MX3(C0[2],C0[3],C1[1]); a=MX3(a,C1[2],C1[3]); \
      _Pragma("unroll") for(int r=4;r<16;r+=4){a=MX3(a,C0[r],C0[r+1]);b=MX3(b,C0[r+2],C0[r+3]);a=MX3(a,C1[r],C1[r+1]);b=MX3(b,C1[r+2],C1[r+3]);} \
      float rm=__builtin_fmaxf(a,b); { auto rr=__builtin_amdgcn_permlane32_swap(__float_as_uint(rm),__float_as_uint(rm),false,false); rm=__builtin_fmaxf(__uint_as_float(rr[0]),__uint_as_float(rr[1])); } \
      resc=false; \
      if(__builtin_expect(__any(rm>(float)THRL),0)){ const float dl=__builtin_fmaxf(rm,0.f); nb-=dl; \
        _Pragma("unroll") for(int r=0;r<16;++r){C0[r]-=dl;C1[r]-=dl;} \
        const float f=__builtin_amdgcn_exp2f(-dl); l_reg*=f; if(hi==0)wsf[r32]=f; resc=true; } } \
    SBAR(); \
    GAPB(o[0]=__builtin_amdgcn_mfma_f32_32x32x16_bf16(PAF(0),VFR(0),o[0],0,0,0), C0,0); \
    GAPB(o[1]=__builtin_amdgcn_mfma_f32_32x32x16_bf16(PAF(0),VFR(4),o[1],0,0,0), C0,4); \
    KRD(GL,0); GAPB(o[0]=__builtin_amdgcn_mfma_f32_32x32x16_bf16(PAF(1),VFR(1),o[0],0,0,0), C0,8); \
    KRD(GL,1); GAPB(o[1]=__builtin_amdgcn_mfma_f32_32x32x16_bf16(PAF(1),VFR(5),o[1],0,0,0), C0,12); \
    KRD(GL,2); GAPB(o[0]=__builtin_amdgcn_mfma_f32_32x32x16_bf16(PAF(2),VFR(2),o[0],0,0,0), C1,0); \
    KRD(GL,3); GAPB(o[1]=__builtin_amdgcn_mfma_f32_32x32x16_bf16(PAF(2),VFR(6),o[1],0,0,0), C1,4); \
    GAPB(o[0]=__builtin_amdgcn_mfma_f32_32x32x16_bf16(PAF(3),VFR(3),o[0],0,0,0), C1,8); \
    GAPB(o[1]=__builtin_amdgcn_mfma_f32_32x32x16_bf16(PAF(3),VFR(7),o[1],0,0,0), C1,12); \
    }while(0)
  int t=1;
  #undef CMASK
  #define CMASK(P0,P1,t) do{}while(0)
  for(;t+5<NT;t+=2){
    STEP(pB0,pB1,pA0,pA1,t,true,true,true);     WAIT_BAR(2); RESC(); ROT();
    STEP(pA0,pA1,pB0,pB1,t+1,true,true,true);   WAIT_BAR(2); RESC(); ROT();
  }
  #undef CMASK
  #define CMASK(P0,P1,t) do{int jb_=(t)-(NT-4); if(jb_>=0)cmask(P0,P1,jb_,qrel,hi);}while(0)
  #define ENDW(tt) do{ if((tt)+3<NT){WAIT_BAR(2);} else if((tt)+2<NT){WAIT_BAR(1);} else {WAIT_BAR(0);} }while(0)
  for(;t+1<NT;t+=2){
    STEP(pB0,pB1,pA0,pA1,t,(t+3<NT),(t+1<NT),(t+1<NT));       ENDW(t);   RESC(); ROT();
    STEP(pA0,pA1,pB0,pB1,t+1,(t+4<NT),(t+2<NT),(t+2<NT));     ENDW(t+1); RESC(); ROT();
  }
  STEP(pB0,pB1,pA0,pA1,NT-1,false,false,false); RESC();
  { float sacc=pB0[0]+pB0[1]; _Pragma("unroll") for(int r=2;r<16;++r)sacc+=pB0[r]; _Pragma("unroll") for(int r=0;r<16;++r)sacc+=pB1[r]; l_reg+=sacc;
    pw0=(u32x4){PKW(pB0,0),PKW(pB0,2),PKW(pB0,4),PKW(pB0,6)};pw1=(u32x4){PKW(pB0,8),PKW(pB0,10),PKW(pB0,12),PKW(pB0,14)};pw2=(u32x4){PKW(pB1,0),PKW(pB1,2),PKW(pB1,4),PKW(pB1,6)};pw3=(u32x4){PKW(pB1,8),PKW(pB1,10),PKW(pB1,12),PKW(pB1,14)};
    SBAR(); pv(o,vb0+sl_cur,PAF(0),PAF(1),PAF(2),PAF(3)); }
  #undef PKW
  #undef PAF
  #undef VFR
  #undef PIN
  #undef MX3
  #undef GAPA
  #undef GAPB
  #undef EX
  #undef VRD
  #undef KRD
  #undef STEP
  #undef ENDW
  {auto rr=__builtin_amdgcn_permlane32_swap(__float_as_uint(l_reg),__float_as_uint(l_reg),false,false);l_reg=__uint_as_float(rr[0])+__uint_as_float(rr[1]);}
  if(hi==0)wsf[32+r32]=l_reg;asm volatile("s_waitcnt lgkmcnt(0)":::"memory");
  float rli[16];
  #pragma unroll
  for(int r=0;r<16;++r)rli[r]=__builtin_amdgcn_rcpf(wsf[32+crow(r,hi)]);
  bf16*Ow=O+(rowbase+q0+wid*QBLK)*OPITCH+OCOL+h*D;
  { bf16*stg=(bf16*)(shm+LDS_OST)+wid*2048;
    #pragma unroll
    for(int r=0;r<16;++r){const int orow=crow(r,hi);
      #pragma unroll
      for(int d0=0;d0<2;++d0)stg[orow*64+d0*32+r32]=(bf16)(cvtpk_s(o[d0][r]*rli[r],0.f)&0xffffu);}
    asm volatile("s_waitcnt lgkmcnt(0)":::"memory");
    #pragma unroll
    for(int i=0;i<4;++i){const int row=i*8+(lane>>3),ch=lane&7; const u32x4 v=*(const u32x4*)(stg+row*64+ch*8); ATTN_STORE16(Ow+(long)row*OPITCH+ch*8,v);} }
  asm volatile("s_waitcnt lgkmcnt(0)\n\ts_barrier":::"memory");
  #undef CKLOAD
  #undef BIASSUB
  #undef DMA_K
  #undef DMA_V
  #undef CMASK
  #undef START
  #undef RESC
  #undef ROT
}
constexpr int ATTN_LDS_BYTES=LDS_BYTES;
struct AttnTensors { const bf16* Q; const bf16* K; const bf16* V; bf16* O; const float* CL; const float* QN2; const float* KN2; const float* QKD; };
struct AttnUnit { int bh; int qb; };
struct StaticOrder {
  int vcu, G;
  __device__ __forceinline__ explicit StaticOrder(int grid,int block):vcu((grid%8==0)?(block%8)*(grid/8)+block/8:block),G(grid){}
  __device__ __forceinline__ bool next(int i,AttnUnit&u)const{ const int L=i*G+vcu; if(L>=1024)return false; const int slot=L>>8,pos=L&255,s=pos&15; u.bh=pos>>4; u.qb=(slot==0)?s:(slot==1)?31-s:(slot==2)?32+s:63-s; return true; }
  __device__ __forceinline__ void a_ready(const AttnUnit&)const{}
  __device__ __forceinline__ void done(const AttnUnit&)const{}
};
template<int THRL=8> __device__ __forceinline__ void attn_phase(char*lds,const AttnTensors&T,unsigned*heads,const int myx,const int tid_in,ArgsP ap){
  int probe=7; volatile __attribute__((address_space(3))) int*bc=(volatile __attribute__((address_space(3))) int*)((__attribute__((address_space(3))) char*)lds+LDS_BYTES+64);
  const int NF1=(gridDim.x==256)?320:0, NCV=1024-NF1, F=NCV+512; const unsigned nitems=2u*F+(F<1024?1024u-F:0u);
  for(;;){ const int item=peer_next_item(heads,1,probe,nitems,bc,tid_in); if(item<0)break;
    int v,ty; if(item<2*F){ v=item>>1; ty=item&1; } else { v=F+item-2*F; ty=0; }
    if(ty==1){ if(v<NCV)convert_uv_fp8_item(ap,(__attribute__((address_space(3))) unsigned char*)lds,opaque(tid_in),NF1+v); else transpose_filler_item(ap,(__attribute__((address_space(3))) unsigned char*)lds,opaque(tid_in),v-NCV); continue; }
    if(v>=1024)continue;
    const int h=15-(v&15),qb=63-(v>>4);
    attn_unit<THRL>(0,h,qb,T.Q,T.K,T.V,T.O,T.CL+(long)h*SEQ,T.QN2+h*256,T.KN2+h*256,T.QKD+h*256,lds,tid_in); }
}
#undef SBAR
#undef WAIT_BAR
}
__device__ __forceinline__ int topk_sortable(float f) { const int u = __float_as_int(f); return u ^ ((u >> 31) & 0x7fffffff); }
__device__ __forceinline__ int topk_pack7(float f, int idx) { return (topk_sortable(f) & ~127) | (127 - idx); }
__device__ __forceinline__ void wave_imax2(int& a, int& b, int& sa, int& sb) {
    asm volatile("s_nop 1\n\t"
        "v_max_i32_dpp %0, %0, %0 row_shr:1 row_mask:0xf bank_mask:0xf\n\tv_max_i32_dpp %1, %1, %1 row_shr:1 row_mask:0xf bank_mask:0xf\n\ts_nop 0\n\t"
        "v_max_i32_dpp %0, %0, %0 row_shr:2 row_mask:0xf bank_mask:0xf\n\tv_max_i32_dpp %1, %1, %1 row_shr:2 row_mask:0xf bank_mask:0xf\n\ts_nop 0\n\t"
        "v_max_i32_dpp %0, %0, %0 row_shr:4 row_mask:0xf bank_mask:0xf\n\tv_max_i32_dpp %1, %1, %1 row_shr:4 row_mask:0xf bank_mask:0xf\n\ts_nop 0\n\t"
        "v_max_i32_dpp %0, %0, %0 row_shr:8 row_mask:0xf bank_mask:0xf\n\tv_max_i32_dpp %1, %1, %1 row_shr:8 row_mask:0xf bank_mask:0xf\n\ts_nop 0\n\t"
        "v_max_i32_dpp %0, %0, %0 row_bcast:15 row_mask:0xa bank_mask:0xf\n\tv_max_i32_dpp %1, %1, %1 row_bcast:15 row_mask:0xa bank_mask:0xf\n\ts_nop 0\n\t"
        "v_max_i32_dpp %0, %0, %0 row_bcast:31 row_mask:0xc bank_mask:0xf\n\tv_max_i32_dpp %1, %1, %1 row_bcast:31 row_mask:0xc bank_mask:0xf\n\ts_nop 1\n\t"
        "v_readlane_b32 %2, %0, 63\n\tv_readlane_b32 %3, %1, 63\n\ts_nop 3"
        : "+v"(a), "+v"(b), "=s"(sa), "=s"(sb));
}
__device__ __forceinline__ void wave_imax1(int& a, int& sa) {
    asm volatile("s_nop 1\n\t"
        "v_max_i32_dpp %0, %0, %0 row_shr:1 row_mask:0xf bank_mask:0xf\n\ts_nop 1\n\t"
        "v_max_i32_dpp %0, %0, %0 row_shr:2 row_mask:0xf bank_mask:0xf\n\ts_nop 1\n\t"
        "v_max_i32_dpp %0, %0, %0 row_shr:4 row_mask:0xf bank_mask:0xf\n\ts_nop 1\n\t"
        "v_max_i32_dpp %0, %0, %0 row_shr:8 row_mask:0xf bank_mask:0xf\n\ts_nop 1\n\t"
        "v_max_i32_dpp %0, %0, %0 row_bcast:15 row_mask:0xa bank_mask:0xf\n\ts_nop 1\n\t"
        "v_max_i32_dpp %0, %0, %0 row_bcast:31 row_mask:0xc bank_mask:0xf\n\ts_nop 1\n\t"
        "v_readlane_b32 %1, %0, 63\n\ts_nop 3"
        : "+v"(a), "=s"(sa));
}
__device__ __forceinline__ void wave_imax_x8(int (&k)[8], int (&s)[8]) {
    asm volatile("s_nop 1\n\t"
        "v_max_i32_dpp %0, %0, %0 row_shr:1 row_mask:0xf bank_mask:0xf\n\tv_max_i32_dpp %1, %1, %1 row_shr:1 row_mask:0xf bank_mask:0xf\n\tv_max_i32_dpp %2, %2, %2 row_shr:1 row_mask:0xf bank_mask:0xf\n\tv_max_i32_dpp %3, %3, %3 row_shr:1 row_mask:0xf bank_mask:0xf\n\tv_max_i32_dpp %4, %4, %4 row_shr:1 row_mask:0xf bank_mask:0xf\n\tv_max_i32_dpp %5, %5, %5 row_shr:1 row_mask:0xf bank_mask:0xf\n\tv_max_i32_dpp %6, %6, %6 row_shr:1 row_mask:0xf bank_mask:0xf\n\tv_max_i32_dpp %7, %7, %7 row_shr:1 row_mask:0xf bank_mask:0xf\n\t"
        "v_max_i32_dpp %0, %0, %0 row_shr:2 row_mask:0xf bank_mask:0xf\n\tv_max_i32_dpp %1, %1, %1 row_shr:2 row_mask:0xf bank_mask:0xf\n\tv_max_i32_dpp %2, %2, %2 row_shr:2 row_mask:0xf bank_mask:0xf\n\tv_max_i32_dpp %3, %3, %3 row_shr:2 row_mask:0xf bank_mask:0xf\n\tv_max_i32_dpp %4, %4, %4 row_shr:2 row_mask:0xf bank_mask:0xf\n\tv_max_i32_dpp %5, %5, %5 row_shr:2 row_mask:0xf bank_mask:0xf\n\tv_max_i32_dpp %6, %6, %6 row_shr:2 row_mask:0xf bank_mask:0xf\n\tv_max_i32_dpp %7, %7, %7 row_shr:2 row_mask:0xf bank_mask:0xf\n\t"
        "v_max_i32_dpp %0, %0, %0 row_shr:4 row_mask:0xf bank_mask:0xf\n\tv_max_i32_dpp %1, %1, %1 row_shr:4 row_mask:0xf bank_mask:0xf\n\tv_max_i32_dpp %2, %2, %2 row_shr:4 row_mask:0xf bank_mask:0xf\n\tv_max_i32_dpp %3, %3, %3 row_shr:4 row_mask:0xf bank_mask:0xf\n\tv_max_i32_dpp %4, %4, %4 row_shr:4 row_mask:0xf bank_mask:0xf\n\tv_max_i32_dpp %5, %5, %5 row_shr:4 row_mask:0xf bank_mask:0xf\n\tv_max_i32_dpp %6, %6, %6 row_shr:4 row_mask:0xf bank_mask:0xf\n\tv_max_i32_dpp %7, %7, %7 row_shr:4 row_mask:0xf bank_mask:0xf\n\t"
        "v_max_i32_dpp %0, %0, %0 row_shr:8 row_mask:0xf bank_mask:0xf\n\tv_max_i32_dpp %1, %1, %1 row_shr:8 row_mask:0xf bank_mask:0xf\n\tv_max_i32_dpp %2, %2, %2 row_shr:8 row_mask:0xf bank_mask:0xf\n\tv_max_i32_dpp %3, %3, %3 row_shr:8 row_mask:0xf bank_mask:0xf\n\tv_max_i32_dpp %4, %4, %4 row_shr:8 row_mask:0xf bank_mask:0xf\n\tv_max_i32_dpp %5, %5, %5 row_shr:8 row_mask:0xf bank_mask:0xf\n\tv_max_i32_dpp %6, %6, %6 row_shr:8 row_mask:0xf bank_mask:0xf\n\tv_max_i32_dpp %7, %7, %7 row_shr:8 row_mask:0xf bank_mask:0xf\n\t"
        "v_max_i32_dpp %0, %0, %0 row_bcast:15 row_mask:0xa bank_mask:0xf\n\tv_max_i32_dpp %1, %1, %1 row_bcast:15 row_mask:0xa bank_mask:0xf\n\tv_max_i32_dpp %2, %2, %2 row_bcast:15 row_mask:0xa bank_mask:0xf\n\tv_max_i32_dpp %3, %3, %3 row_bcast:15 row_mask:0xa bank_mask:0xf\n\tv_max_i32_dpp %4, %4, %4 row_bcast:15 row_mask:0xa bank_mask:0xf\n\tv_max_i32_dpp %5, %5, %5 row_bcast:15 row_mask:0xa bank_mask:0xf\n\tv_max_i32_dpp %6, %6, %6 row_bcast:15 row_mask:0xa bank_mask:0xf\n\tv_max_i32_dpp %7, %7, %7 row_bcast:15 row_mask:0xa bank_mask:0xf\n\t"
        "v_max_i32_dpp %0, %0, %0 row_bcast:31 row_mask:0xc bank_mask:0xf\n\tv_max_i32_dpp %1, %1, %1 row_bcast:31 row_mask:0xc bank_mask:0xf\n\tv_max_i32_dpp %2, %2, %2 row_bcast:31 row_mask:0xc bank_mask:0xf\n\tv_max_i32_dpp %3, %3, %3 row_bcast:31 row_mask:0xc bank_mask:0xf\n\tv_max_i32_dpp %4, %4, %4 row_bcast:31 row_mask:0xc bank_mask:0xf\n\tv_max_i32_dpp %5, %5, %5 row_bcast:31 row_mask:0xc bank_mask:0xf\n\tv_max_i32_dpp %6, %6, %6 row_bcast:31 row_mask:0xc bank_mask:0xf\n\tv_max_i32_dpp %7, %7, %7 row_bcast:31 row_mask:0xc bank_mask:0xf\n\t"
        "s_nop 1\n\tv_readlane_b32 %8, %0, 63\n\tv_readlane_b32 %9, %1, 63\n\tv_readlane_b32 %10, %2, 63\n\tv_readlane_b32 %11, %3, 63\n\tv_readlane_b32 %12, %4, 63\n\tv_readlane_b32 %13, %5, 63\n\tv_readlane_b32 %14, %6, 63\n\tv_readlane_b32 %15, %7, 63\n\ts_nop 3"
        : "+v"(k[0]), "+v"(k[1]), "+v"(k[2]), "+v"(k[3]), "+v"(k[4]), "+v"(k[5]), "+v"(k[6]), "+v"(k[7]), "=s"(s[0]), "=s"(s[1]), "=s"(s[2]), "=s"(s[3]), "=s"(s[4]), "=s"(s[5]), "=s"(s[6]), "=s"(s[7]));
}
__device__ __forceinline__ void wave_imax_x4(int (&k)[4], int (&s)[4]) {
    asm volatile("s_nop 1\n\t"
        "v_max_i32_dpp %0, %0, %0 row_shr:1 row_mask:0xf bank_mask:0xf\n\tv_max_i32_dpp %1, %1, %1 row_shr:1 row_mask:0xf bank_mask:0xf\n\tv_max_i32_dpp %2, %2, %2 row_shr:1 row_mask:0xf bank_mask:0xf\n\tv_max_i32_dpp %3, %3, %3 row_shr:1 row_mask:0xf bank_mask:0xf\n\t"
        "v_max_i32_dpp %0, %0, %0 row_shr:2 row_mask:0xf bank_mask:0xf\n\tv_max_i32_dpp %1, %1, %1 row_shr:2 row_mask:0xf bank_mask:0xf\n\tv_max_i32_dpp %2, %2, %2 row_shr:2 row_mask:0xf bank_mask:0xf\n\tv_max_i32_dpp %3, %3, %3 row_shr:2 row_mask:0xf bank_mask:0xf\n\t"
        "v_max_i32_dpp %0, %0, %0 row_shr:4 row_mask:0xf bank_mask:0xf\n\tv_max_i32_dpp %1, %1, %1 row_shr:4 row_mask:0xf bank_mask:0xf\n\tv_max_i32_dpp %2, %2, %2 row_shr:4 row_mask:0xf bank_mask:0xf\n\tv_max_i32_dpp %3, %3, %3 row_shr:4 row_mask:0xf bank_mask:0xf\n\t"
        "v_max_i32_dpp %0, %0, %0 row_shr:8 row_mask:0xf bank_mask:0xf\n\tv_max_i32_dpp %1, %1, %1 row_shr:8 row_mask:0xf bank_mask:0xf\n\tv_max_i32_dpp %2, %2, %2 row_shr:8 row_mask:0xf bank_mask:0xf\n\tv_max_i32_dpp %3, %3, %3 row_shr:8 row_mask:0xf bank_mask:0xf\n\t"
        "v_max_i32_dpp %0, %0, %0 row_bcast:15 row_mask:0xa bank_mask:0xf\n\tv_max_i32_dpp %1, %1, %1 row_bcast:15 row_mask:0xa bank_mask:0xf\n\tv_max_i32_dpp %2, %2, %2 row_bcast:15 row_mask:0xa bank_mask:0xf\n\tv_max_i32_dpp %3, %3, %3 row_bcast:15 row_mask:0xa bank_mask:0xf\n\t"
        "v_max_i32_dpp %0, %0, %0 row_bcast:31 row_mask:0xc bank_mask:0xf\n\tv_max_i32_dpp %1, %1, %1 row_bcast:31 row_mask:0xc bank_mask:0xf\n\tv_max_i32_dpp %2, %2, %2 row_bcast:31 row_mask:0xc bank_mask:0xf\n\tv_max_i32_dpp %3, %3, %3 row_bcast:31 row_mask:0xc bank_mask:0xf\n\t"
        "s_nop 1\n\tv_readlane_b32 %4, %0, 63\n\tv_readlane_b32 %5, %1, 63\n\tv_readlane_b32 %6, %2, 63\n\tv_readlane_b32 %7, %3, 63\n\ts_nop 3"
        : "+v"(k[0]), "+v"(k[1]), "+v"(k[2]), "+v"(k[3]), "=s"(s[0]), "=s"(s[1]), "=s"(s[2]), "=s"(s[3]));
}
__device__ __forceinline__ void row_imax2(int& a, int& b) {
    asm volatile("s_nop 1\n\t"
        "v_max_i32_dpp %0, %0, %0 row_ror:8 row_mask:0xf bank_mask:0xf\n\tv_max_i32_dpp %1, %1, %1 row_ror:8 row_mask:0xf bank_mask:0xf\n\ts_nop 0\n\t"
        "v_max_i32_dpp %0, %0, %0 row_ror:4 row_mask:0xf bank_mask:0xf\n\tv_max_i32_dpp %1, %1, %1 row_ror:4 row_mask:0xf bank_mask:0xf\n\ts_nop 0\n\t"
        "v_max_i32_dpp %0, %0, %0 row_ror:2 row_mask:0xf bank_mask:0xf\n\tv_max_i32_dpp %1, %1, %1 row_ror:2 row_mask:0xf bank_mask:0xf\n\ts_nop 0\n\t"
        "v_max_i32_dpp %0, %0, %0 row_ror:1 row_mask:0xf bank_mask:0xf\n\tv_max_i32_dpp %1, %1, %1 row_ror:1 row_mask:0xf bank_mask:0xf\n\ts_nop 1"
        : "+v"(a), "+v"(b));
}
__device__ __forceinline__ void row_imax4(int& a, int& b, int& c, int& d) {
    asm volatile("s_nop 1\n\t"
        "v_max_i32_dpp %0, %0, %0 row_ror:8 row_mask:0xf bank_mask:0xf\n\tv_max_i32_dpp %1, %1, %1 row_ror:8 row_mask:0xf bank_mask:0xf\n\tv_max_i32_dpp %2, %2, %2 row_ror:8 row_mask:0xf bank_mask:0xf\n\tv_max_i32_dpp %3, %3, %3 row_ror:8 row_mask:0xf bank_mask:0xf\n\t"
        "v_max_i32_dpp %0, %0, %0 row_ror:4 row_mask:0xf bank_mask:0xf\n\tv_max_i32_dpp %1, %1, %1 row_ror:4 row_mask:0xf bank_mask:0xf\n\tv_max_i32_dpp %2, %2, %2 row_ror:4 row_mask:0xf bank_mask:0xf\n\tv_max_i32_dpp %3, %3, %3 row_ror:4 row_mask:0xf bank_mask:0xf\n\t"
        "v_max_i32_dpp %0, %0, %0 row_ror:2 row_mask:0xf bank_mask:0xf\n\tv_max_i32_dpp %1, %1, %1 row_ror:2 row_mask:0xf bank_mask:0xf\n\tv_max_i32_dpp %2, %2, %2 row_ror:2 row_mask:0xf bank_mask:0xf\n\tv_max_i32_dpp %3, %3, %3 row_ror:2 row_mask:0xf bank_mask:0xf\n\t"
        "v_max_i32_dpp %0, %0, %0 row_ror:1 row_mask:0xf bank_mask:0xf\n\tv_max_i32_dpp %1, %1, %1 row_ror:1 row_mask:0xf bank_mask:0xf\n\tv_max_i32_dpp %2, %2, %2 row_ror:1 row_mask:0xf bank_mask:0xf\n\tv_max_i32_dpp %3, %3, %3 row_ror:1 row_mask:0xf bank_mask:0xf\n\ts_nop 1"
        : "+v"(a), "+v"(b), "+v"(c), "+v"(d));
}
template <int CTRL> __device__ __forceinline__ float dpp_rot(float v) { return __int_as_float(__builtin_amdgcn_update_dpp(0, __float_as_int(v), CTRL, 0xf, 0xf, false)); }
__device__ __forceinline__ float row_fmax(float v) { v = fmaxf(v, dpp_rot<0x128>(v)); v = fmaxf(v, dpp_rot<0x124>(v)); v = fmaxf(v, dpp_rot<0x122>(v)); v = fmaxf(v, dpp_rot<0x121>(v)); return v; }
__device__ __forceinline__ float row_fsum(float v) { v += dpp_rot<0x128>(v); v += dpp_rot<0x124>(v); v += dpp_rot<0x122>(v); v += dpp_rot<0x121>(v); return v; }
__device__ const unsigned char PEER_CAND[64] = {
    0x00,0x01,0x02,0x03,0x04,0x05,0x06,0x07,0x08,0x09,0x0a,0x0b,0x0c,0x0d,0x0e,0x0f, 0x10,0x11,0x12,0x13,0x14,0x15,0x16,0x17, 0x20,0x21,0x22,0x23,0x24, 0x30,0x31,0x32,0x33,
    0x40,0x41,0x42, 0x50,0x51, 0x60,0x61, 0x70,0x71, 0x80, 0x90, 0xa0, 0xb0, 0xc0, 0xd0, 0xe0, 0xf0, 0xff,0xff,0xff,0xff,0xff,0xff,0xff,0xff,0xff,0xff,0xff,0xff,0xff,0xff};
__device__ __forceinline__ void phase7(ArgsP a, LAS unsigned char* lds, const int tidx) {
    const int tid0 = tidx, w = __builtin_amdgcn_readfirstlane(tid0 >> 6);
    const bf16* QP = (const bf16*)(a->ws + WS_QP); const bf16* K12 = (const bf16*)(a->ws + WS_K12); const float* SUMSQ = (const float*)(a->ws + WS_MISC + MISC_SUMSQ);
    int* IDX = (int*)(a->ws + WS_IDX); float* GW = (float*)(a->ws + WS_GW);
    LAS float* SC = (LAS float*)lds;
    bf16x8 af[4][4];
    const int uper = (256 * 8 + (int)gridDim.x - 1) / (int)gridDim.x, ubeg = (int)blockIdx.x * uper, uend = (ubeg + uper < 256 * 8) ? ubeg + uper : 256 * 8;
    { const int u0 = ubeg; const int l0 = lane_id(), fr0 = l0 & 15, fq0 = l0 >> 4, half0 = w >> 2;
      if (u0 < uend) {
#pragma unroll
        for (int kk = 0; kk < 4; ++kk)
#pragma unroll
            for (int i = 0; i < 4; ++i) af[kk][i] = __builtin_nontemporal_load((const bf16x8*)(QP + (size_t)((u0 >> 3) * 64 + 16 * i + fr0) * DM + 256 * (u0 & 7) + 128 * half0 + 8 * fq0 + 32 * kk)); } }
    for (int u = ubeg; u < uend; ++u) {
        const int tid = opaque(tid0), lane = tid & 63, fr = lane & 15, fq = lane >> 4;
        const int tt = u >> 3, hd = u & 7, tok0 = tt * 64;
        float ssq[2];
#pragma unroll
        for (int q = 0; q < 2; ++q) ssq[q] = SUMSQ[tok0 + 8 * w + 4 * q + (lane >> 4)];
        {
            const int half = w >> 2; const bf16* kb = K12 + ((size_t)(half * 8 + hd) * 128) * 128;
            f32x4 acc[4][2];
#pragma unroll
            for (int i = 0; i < 4; ++i) { acc[i][0] = (f32x4){0.f, 0.f, 0.f, 0.f}; acc[i][1] = (f32x4){0.f, 0.f, 0.f, 0.f}; }
            bf16x8 bfv[4][2];
#pragma unroll
            for (int kk = 0; kk < 4; ++kk)
#pragma unroll
                for (int j = 0; j < 2; ++j) bfv[kk][j] = *(const bf16x8*)(kb + (size_t)(16 * (2 * (w & 3) + j) + fr) * 128 + 8 * fq + 32 * kk);
#pragma unroll
            for (int kk = 0; kk < 4; ++kk)
#pragma unroll
                for (int i = 0; i < 4; ++i) { acc[i][0] = mfma16(af[kk][i], bfv[kk][0], acc[i][0]); acc[i][1] = mfma16(af[kk][i], bfv[kk][1], acc[i][1]); }
#pragma unroll
            for (int i = 0; i < 4; ++i)
#pragma unroll
                for (int j = 0; j < 2; ++j)
#pragma unroll
                    for (int r = 0; r < 4; ++r) SC[(16 * i + 4 * fq + r) * 260 + 128 * half + 16 * (2 * (w & 3) + j) + fr] = acc[i][j][r];
            const int un = u + 1;
            if (un < uend) {
#pragma unroll
                for (int kk = 0; kk < 4; ++kk)
#pragma unroll
                    for (int i = 0; i < 4; ++i) af[kk][i] = __builtin_nontemporal_load((const bf16x8*)(QP + (size_t)((un >> 3) * 64 + 16 * i + fr) * DM + 256 * (un & 7) + 128 * half + 8 * fq + 32 * kk)); }
        }
        __syncthreads();
        const int r16 = lane & 15, rowb = lane & 48;
        const int cab = (int)PEER_CAND[lane];
        int cca[4], ccb[4];
#pragma unroll
        for (int i = 0; i < 4; ++i) { const int cc = (int)PEER_CAND[r16 + 16 * i]; cca[i] = rowb + (cc >> 4); ccb[i] = rowb + (cc & 15); }
        {
            const LAS float* srow0 = SC + (8 * w + (lane >> 4)) * 260; const LAS float* srow1 = srow0 + 4 * 260;
            int sa[2][8], sb[2][8];
#pragma unroll
            for (int i = 0; i < 8; ++i) { sa[0][i] = topk_pack7(srow0[r16 + 16 * i], r16 + 16 * i); sb[0][i] = topk_pack7(srow0[128 + r16 + 16 * i], r16 + 16 * i);
                                          sa[1][i] = topk_pack7(srow1[r16 + 16 * i], r16 + 16 * i); sb[1][i] = topk_pack7(srow1[128 + r16 + 16 * i], r16 + 16 * i); }
#define CE(x, i, j) do { const int hi_ = x[i] > x[j] ? x[i] : x[j], lo_ = x[i] > x[j] ? x[j] : x[i]; x[i] = hi_; x[j] = lo_; } while (0)
#define SORT8(x) do { CE(x,0,1); CE(x,2,3); CE(x,4,5); CE(x,6,7); CE(x,0,2); CE(x,1,3); CE(x,4,6); CE(x,5,7); CE(x,1,2); CE(x,5,6); CE(x,0,4); CE(x,3,7); CE(x,1,5); CE(x,2,6); CE(x,1,4); CE(x,3,6); CE(x,2,4); CE(x,3,5); CE(x,3,4); } while (0)
            SORT8(sa[0]); SORT8(sb[0]); SORT8(sa[1]); SORT8(sb[1]);
            int resa[2] = {0, 0}, resb[2] = {0, 0};
            for (int k = 0; k < 16; ++k) {
                int m0 = sa[0][0], m1 = sb[0][0], m2 = sa[1][0], m3 = sb[1][0];
                row_imax4(m0, m1, m2, m3);
                const bool w0 = sa[0][0] == m0, w1 = sb[0][0] == m1, w2 = sa[1][0] == m2, w3 = sb[1][0] == m3;
#pragma unroll
                for (int i = 0; i < 7; ++i) { sa[0][i] = w0 ? sa[0][i + 1] : sa[0][i]; sb[0][i] = w1 ? sb[0][i + 1] : sb[0][i]; sa[1][i] = w2 ? sa[1][i + 1] : sa[1][i]; sb[1][i] = w3 ? sb[1][i + 1] : sb[1][i]; }
                sa[0][7] = w0 ? (int)0x80000000 : sa[0][7]; sb[0][7] = w1 ? (int)0x80000000 : sb[0][7]; sa[1][7] = w2 ? (int)0x80000000 : sa[1][7]; sb[1][7] = w3 ? (int)0x80000000 : sb[1][7];
                if (r16 == k) { resa[0] = m0; resb[0] = m1; resa[1] = m2; resb[1] = m3; }
            }
            int ria[2], rib[2]; float rva[2], rvb[2]; int kc[2][4];
#pragma unroll
            for (int q = 0; q < 2; ++q) { const LAS float* srow = q ? srow1 : srow0;
                ria[q] = 127 - (resa[q] & 127); rib[q] = 127 - (resb[q] & 127); rva[q] = srow[ria[q]]; rvb[q] = srow[128 + rib[q]];
#pragma unroll
                for (int i = 0; i < 4; ++i) { const float csum = __shfl(rva[q], cca[i]) + __shfl(rvb[q], ccb[i]); const int cidx = r16 + 16 * i; kc[q][i] = cidx < 50 ? ((topk_sortable(csum) & ~63) | (63 - cidx)) : (int)0x80000000; }
                CE(kc[q],0,1); CE(kc[q],2,3); CE(kc[q],0,2); CE(kc[q],1,3); CE(kc[q],1,2); }
            int resc[2] = {0, 0};
            for (int k = 0; k < 16; ++k) {
                int m0 = kc[0][0], m1 = kc[1][0];
                row_imax2(m0, m1);
                const bool w0 = kc[0][0] == m0, w1 = kc[1][0] == m1;
                kc[0][0] = w0 ? kc[0][1] : kc[0][0]; kc[0][1] = w0 ? kc[0][2] : kc[0][1]; kc[0][2] = w0 ? kc[0][3] : kc[0][2]; kc[0][3] = w0 ? (int)0x80000000 : kc[0][3];
                kc[1][0] = w1 ? kc[1][1] : kc[1][0]; kc[1][1] = w1 ? kc[1][2] : kc[1][1]; kc[1][2] = w1 ? kc[1][3] : kc[1][2]; kc[1][3] = w1 ? (int)0x80000000 : kc[1][3];
                if (r16 == k) { resc[0] = m0; resc[1] = m1; }
            }
#undef SORT8
#undef CE
#pragma unroll
            for (int q = 0; q < 2; ++q) { const int tok = tok0 + 8 * w + 4 * q + (lane >> 4);
                const int ci = 63 - (resc[q] & 63);
                const int sab = __shfl(cab, ci), sela = rowb + (sab >> 4), selb = rowb + (sab & 15);
                const float sv = __shfl(rva[q], sela) + __shfl(rvb[q], selb);
                const int e1 = __shfl(ria[q], sela), e2 = __shfl(rib[q], selb);
                const float rstd = 1.f / sqrtf(ssq[q] * (1.f / DM) + EPS);
                const float top = row_fmax(sv);
                const float p = __expf((sv - top) * rstd);
                const float den = row_fsum(p);
                ((unsigned short*)(a->ws + WS_IDX16))[(size_t)tok * 128 + 16 * hd + r16] = (unsigned short)(e1 * 128 + e2); GW[(size_t)tok * 128 + 16 * hd + r16] = p / den; }
        }
        __syncthreads();
    }
}

__device__ __forceinline__ void phase8(ArgsP a, const int tidx) {
    const int tid0 = tidx, w = __builtin_amdgcn_readfirstlane(tid0 >> 6);
    const bf16* HN = (const bf16*)(a->ws + WS_HN); const bf16* U = (const bf16*)(a->ws + WS_U); const bf16* V = (const bf16*)(a->ws + WS_V2);
    const int* IDX = (const int*)(a->ws + WS_IDX); const float* GW = (const float*)(a->ws + WS_GW); const float* SUMSQ = (const float*)(a->ws + WS_MISC + MISC_SUMSQ);
    const int gwv = blockIdx.x * NWAVES + w, NGW = gridDim.x * NWAVES;
    for (int tok = gwv; tok < M; tok += NGW) {
        const int lane = opaque(tid0) & 63;
        u32x4 hv[4];
#pragma unroll
        for (int i = 0; i < 4; ++i) hv[i] = *(const u32x4*)(HN + (size_t)tok * DM + 8 * lane + 512 * i);
        const int id0 = IDX[(size_t)tok * 128 + lane], id1 = IDX[(size_t)tok * 128 + 64 + lane];
        const float g0 = GW[(size_t)tok * 128 + lane], g1 = GW[(size_t)tok * 128 + 64 + lane];
        const float rstd2 = 1.f / sqrtf(SUMSQ[tok] * (1.f / DM) + EPS);
        float oacc[32];
#pragma unroll
        for (int i = 0; i < 32; ++i) oacc[i] = 0.f;
        for (int eb = 0; eb < 128; eb += 8) {
            u32x4 uv[8][4]; float part[8]; int eid[8];
#pragma unroll
            for (int e = 0; e < 8; ++e) { const int sl = eb + e; eid[e] = __builtin_amdgcn_readfirstlane(sl < 64 ? __shfl(id0, sl) : __shfl(id1, sl - 64));
                const bf16* row = U + (size_t)eid[e] * DM + 8 * lane;
#pragma unroll
                for (int i = 0; i < 4; ++i) uv[e][i] = *(const u32x4*)(row + 512 * i); }
#pragma unroll
            for (int e = 0; e < 8; ++e) { float s = 0.f;
#pragma unroll
                for (int i = 0; i < 4; ++i) {
                    s = dot2bf(uv[e][i].x, hv[i].x, s); s = dot2bf(uv[e][i].y, hv[i].y, s); s = dot2bf(uv[e][i].z, hv[i].z, s); s = dot2bf(uv[e][i].w, hv[i].w, s); }
                part[e] = wave_sum(s); }
#pragma unroll
            for (int e = 0; e < 8; ++e) { const bf16* row = V + (size_t)eid[e] * DM + 8 * lane;
#pragma unroll
                for (int i = 0; i < 4; ++i) uv[e][i] = *(const u32x4*)(row + 512 * i); }
#pragma unroll
            for (int e = 0; e < 8; ++e) { const int sl = eb + e; const float gg = sl < 64 ? __shfl(g0, sl) : __shfl(g1, sl - 64);
                const float act = part[e] * rstd2; const float ge = 0.5f * act * (1.f + erff(act * 0.70710678118654752f)); const float cf = gg * ge;
#pragma unroll
                for (int i = 0; i < 4; ++i) {
                    oacc[8 * i + 0] += cf * bflo(uv[e][i].x); oacc[8 * i + 1] += cf * bfhi(uv[e][i].x); oacc[8 * i + 2] += cf * bflo(uv[e][i].y); oacc[8 * i + 3] += cf * bfhi(uv[e][i].y);
                    oacc[8 * i + 4] += cf * bflo(uv[e][i].z); oacc[8 * i + 5] += cf * bfhi(uv[e][i].z); oacc[8 * i + 6] += cf * bflo(uv[e][i].w); oacc[8 * i + 7] += cf * bfhi(uv[e][i].w); } }
        }
        float* orow = a->out + (size_t)tok * DM + 8 * lane; float ss = 0.f;
#pragma unroll
        for (int i = 0; i < 4; ++i) { const f32x4 x0 = *(const f32x4*)(orow + 512 * i), x1 = *(const f32x4*)(orow + 512 * i + 4);
#pragma unroll
            for (int j = 0; j < 4; ++j) { oacc[8 * i + j] += x0[j]; oacc[8 * i + 4 + j] += x1[j]; }
#pragma unroll
            for (int j = 0; j < 8; ++j) ss += oacc[8 * i + j] * oacc[8 * i + j]; }
        const float rstd = 1.f / sqrtf(wave_sum(ss) * (1.f / DM) + EPS);
#pragma unroll
        for (int i = 0; i < 4; ++i) { const f32x4 w0 = *(const f32x4*)(a->lnf_w + 8 * lane + 512 * i), w1 = *(const f32x4*)(a->lnf_w + 8 * lane + 512 * i + 4); f32x4 o0, o1;
#pragma unroll
            for (int j = 0; j < 4; ++j) { o0[j] = oacc[8 * i + j] * rstd * w0[j]; o1[j] = oacc[8 * i + 4 + j] * rstd * w1[j]; }
            *(f32x4*)(orow + 512 * i) = o0; *(f32x4*)(orow + 512 * i + 4) = o1; }
    }
}
__device__ __forceinline__ void convert_uv(ArgsP a, const int tidx) {
    const size_t gt = (size_t)blockIdx.x * NTHR + tidx, NGT = (size_t)gridDim.x * NTHR; const size_t NP = (size_t)16384 * 2048 / 8;
    u32x4* Ud = (u32x4*)(a->ws + WS_U); u32x4* Vd = (u32x4*)(a->ws + WS_V2);
    for (size_t i = gt; i < 2 * NP; i += NGT) { const bool second = i >= NP; const size_t j = second ? i - NP : i; const float* src = (second ? a->peer_v : a->peer_u) + j * 8;
        const f32x4 x0 = *(const f32x4*)src, x1 = *(const f32x4*)(src + 4); u32x4 o; o.x = cvtpk(x0[0], x0[1]); o.y = cvtpk(x0[2], x0[3]); o.z = cvtpk(x1[0], x1[1]); o.w = cvtpk(x1[2], x1[3]);
        (second ? Vd : Ud)[j] = o; }
}
constexpr size_t WS_PART = 336 * MiB;
constexpr size_t WS_COEF = 105 * MiB;
constexpr int Q_U = 8192, Q_V = 8192 + 1024;
constexpr size_t MISC_SS2 = 131072;
constexpr size_t WS_X1B = 185 * MiB, WS_PO = 249 * MiB;

__device__ __forceinline__ void convert_uv_sliced(ArgsP a, const int tidx) {
    const int lane = tidx & 63, w = tidx >> 6; const int gw = blockIdx.x * NWAVES + w, NGW = gridDim.x * NWAVES;
    bf16* Us = (bf16*)(a->ws + WS_U); bf16* Vs = (bf16*)(a->ws + WS_V2);
    for (int row = gw; row < 32768; row += NGW) { const bool second = row >= 16384; const int e = row & 16383; const f32x4* src = (const f32x4*)((second ? a->peer_v : a->peer_u) + (size_t)e * DM) + lane; bf16* dst = second ? Vs : Us;
        f32x4 x[8];
#pragma unroll
        for (int j = 0; j < 8; ++j) x[j] = src[64 * j];
#pragma unroll
        for (int j = 0; j < 8; ++j) { const int s = 4 * j + (lane >> 4); u32x2 o; o.x = cvtpk(x[j][0], x[j][1]); o.y = cvtpk(x[j][2], x[j][3]);
            *(u32x2*)(dst + ((size_t)s * 16384 + e) * 64 + 4 * (lane & 15)) = o; } }
}
__device__ __forceinline__ void peer_stage_idx(const int* IDX, int tok0, LAS unsigned char* lds, int tid) {
#pragma unroll
    for (int i = 0; i < 8; ++i) { const int q = tid + 512 * i; const u32x4 v = *(const u32x4*)(IDX + (size_t)tok0 * 128 + 4 * q);
        *(LAS u32x2*)(lds + 8 * q) = (u32x2){v.x | (v.y << 16), v.z | (v.w << 16)}; }
}
__device__ __forceinline__ void peer_u_phase(ArgsP a, LAS unsigned char* lds, const int tidx, const int qoff = 0) {
    const int w = __builtin_amdgcn_readfirstlane(tidx >> 6); const int myx = (int)(xb_xcc_id() & 7u); int probe = 0;
    unsigned* heads = (unsigned*)(a->ws + WS_CTL) + Q_U + qoff; volatile LAS int* bc = (volatile LAS int*)(lds + 98304);
    const bf16* HN = (const bf16*)(a->ws + WS_HN); const bf16* Us = (const bf16*)(a->ws + WS_U); const int* IDX = (const int*)(a->ws + WS_IDX); bf16* PART = (bf16*)(a->ws + WS_PART);
    for (;;) {
        const int tid = opaque(tidx), lane = tid & 63, m = lane & 7, g = lane >> 3;
        const int item = peer_next_item(heads, myx, probe, 512u, bc, tid); if (item < 0) break;
        const int s = item >> 7, tile = item & 127, tok0 = tile * 128;
        peer_stage_idx(IDX, tok0, lds, tid);
        __syncthreads();
        const bf16* ub = Us + (size_t)s * 16384 * 64 + 8 * m;
        for (int tt = 0; tt < 16; ++tt) { const int tl = 16 * w + tt, t = tok0 + tl;
            const u32x4 hv = *(const u32x4*)(HN + (size_t)t * DM + 64 * s + 8 * m);
            u32x4 uv[16];
#pragma unroll
            for (int r = 0; r < 16; ++r) { const unsigned id = *(const LAS unsigned short*)(lds + (tl * 128 + 16 * g + r) * 2); uv[r] = *(const u32x4*)(ub + (size_t)id * 64); }
            float p[16];
#pragma unroll
            for (int r = 0; r < 16; ++r) { float d = dot2bf(uv[r].x, hv.x, 0.f); d = dot2bf(uv[r].y, hv.y, d); d = dot2bf(uv[r].z, hv.z, d); d = dot2bf(uv[r].w, hv.w, d); p[r] = d; }
            float q8[8], q4[4], q2[2];
#pragma unroll
            for (int r = 0; r < 8; ++r) { const bool up = (lane & 4) != 0; const float snd = up ? p[r] : p[r + 8], kp = up ? p[r + 8] : p[r]; q8[r] = kp + __shfl_xor(snd, 4); }
#pragma unroll
            for (int r = 0; r < 4; ++r) { const bool up = (lane & 2) != 0; const float snd = up ? q8[r] : q8[r + 4], kp = up ? q8[r + 4] : q8[r]; q4[r] = kp + __shfl_xor(snd, 2); }
#pragma unroll
            for (int r = 0; r < 2; ++r) { const bool up = (lane & 1) != 0; const float snd = up ? q4[r] : q4[r + 2], kp = up ? q4[r + 2] : q4[r]; q2[r] = kp + __shfl_xor(snd, 1); }
            *(unsigned*)(PART + ((size_t)s * M + t) * 128 + 2 * lane) = cvtpk(q2[0], q2[1]);
        }
        __syncthreads();
    }
}
__device__ __forceinline__ void peer_combine(ArgsP a, const int tidx) {
    const size_t gt = (size_t)blockIdx.x * NTHR + tidx, NGT = (size_t)gridDim.x * NTHR;
    const unsigned* PART = (const unsigned*)(a->ws + WS_PART); const float* GW = (const float*)(a->ws + WS_GW); const float* SUMSQ = (const float*)(a->ws + WS_MISC + MISC_SUMSQ); f32x2* C = (f32x2*)(a->ws + WS_COEF);
    for (size_t i = gt; i < (size_t)M * 64; i += NGT) { const int t = (int)(i >> 6); float s0 = 0.f, s1 = 0.f;
#pragma unroll 8
        for (int s = 0; s < 32; ++s) { const unsigned v = PART[(size_t)s * M * 64 + i]; s0 += bflo(v); s1 += bfhi(v); }
        const float rstd2 = 1.f / sqrtf(SUMSQ[t] * (1.f / DM) + EPS); const f32x2 g = ((const f32x2*)GW)[i];
        const float a0 = s0 * rstd2, a1 = s1 * rstd2;
        C[i] = (f32x2){g.x * 0.5f * a0 * (1.f + erff(a0 * 0.70710678118654752f)), g.y * 0.5f * a1 * (1.f + erff(a1 * 0.70710678118654752f))}; }
}
template <bool DRY> __device__ __forceinline__ void peer_v_phase(ArgsP a, LAS unsigned char* lds, const int tidx, const int qoff = 0) {
    const int w = __builtin_amdgcn_readfirstlane(tidx >> 6); const int myx = (int)(xb_xcc_id() & 7u); int probe = 0;
    unsigned* heads = (unsigned*)(a->ws + WS_CTL) + Q_V + qoff; volatile LAS int* bc = (volatile LAS int*)(lds + 98304);
    const bf16* Vs = (const bf16*)(a->ws + WS_V2); const int* IDX = (const int*)(a->ws + WS_IDX); const float* COEF = (const float*)(a->ws + WS_COEF); float* SS2 = (float*)(a->ws + WS_MISC + MISC_SS2);
    for (;;) {
        const int tid = opaque(tidx), lane = tid & 63, m = lane & 7, g = lane >> 3;
        const int item = peer_next_item(heads, myx, probe, 512u, bc, tid); if (item < 0) break;
        const int s = item >> 7, tile = item & 127, tok0 = tile * 128;
        peer_stage_idx(IDX, tok0, lds, tid);
#pragma unroll
        for (int i = 0; i < 8; ++i) { const int q = tid + 512 * i; *(LAS u32x4*)(lds + 32768 + 16 * q) = *(const u32x4*)(COEF + (size_t)tok0 * 128 + 4 * q); }
        __syncthreads();
        const bf16* vb = Vs + (size_t)s * 16384 * 64 + 8 * m;
        for (int tt = 0; tt < 16; ++tt) { const int tl = 16 * w + tt, t = tok0 + tl;
            u32x4 vv[16]; float cf[16];
#pragma unroll
            for (int r = 0; r < 16; ++r) { const unsigned id = *(const LAS unsigned short*)(lds + (tl * 128 + 16 * g + r) * 2); vv[r] = *(const u32x4*)(vb + (size_t)id * 64); cf[r] = *(const LAS float*)(lds + 32768 + (tl * 128 + 16 * g + r) * 4); }
            float acc[8];
#pragma unroll
            for (int j = 0; j < 8; ++j) acc[j] = 0.f;
#pragma unroll
            for (int r = 0; r < 16; ++r) { acc[0] += cf[r] * bflo(vv[r].x); acc[1] += cf[r] * bfhi(vv[r].x); acc[2] += cf[r] * bflo(vv[r].y); acc[3] += cf[r] * bfhi(vv[r].y);
                acc[4] += cf[r] * bflo(vv[r].z); acc[5] += cf[r] * bfhi(vv[r].z); acc[6] += cf[r] * bflo(vv[r].w); acc[7] += cf[r] * bfhi(vv[r].w); }
            float q4[4], q2[2];
#pragma unroll
            for (int j = 0; j < 4; ++j) { const bool up = (lane & 32) != 0; const float snd = up ? acc[j] : acc[j + 4], kp = up ? acc[j + 4] : acc[j]; q4[j] = kp + __shfl_xor(snd, 32); }
#pragma unroll
            for (int j = 0; j < 2; ++j) { const bool up = (lane & 16) != 0; const float snd = up ? q4[j] : q4[j + 2], kp = up ? q4[j + 2] : q4[j]; q2[j] = kp + __shfl_xor(snd, 16); }
            float r1; { const bool up = (lane & 8) != 0; const float snd = up ? q2[0] : q2[1], kp = up ? q2[1] : q2[0]; r1 = kp + __shfl_xor(snd, 8); }
            float* op = a->out + (size_t)t * DM + 64 * s + 8 * m + g;
            const float x1v = *op; const float x2 = x1v + r1; *op = DRY ? (x2 == 12345.678f ? x2 : x1v) : x2;
            const float ss = wave_sum(x2 * x2);
            if (lane == 0 && !DRY) atomicAdd(SS2 + t, ss);
        }
        __syncthreads();
    }
}
template <bool DRY> __device__ __forceinline__ void peer_final(ArgsP a, const int tidx) {
    const int lane = tidx & 63, w = tidx >> 6; const int gwv = blockIdx.x * NWAVES + w, NGW = gridDim.x * NWAVES; const float* SS2 = (const float*)(a->ws + WS_MISC + MISC_SS2);
    for (int tok = gwv; tok < M; tok += NGW) { const float rstd = 1.f / sqrtf(SS2[tok] * (1.f / DM) + EPS); f32x4* orow = (f32x4*)(a->out + (size_t)tok * DM) + lane; const f32x4* wr = (const f32x4*)a->lnf_w + lane;
#pragma unroll
        for (int j = 0; j < 8; ++j) { f32x4 v = orow[64 * j]; const f32x4 o = v * rstd * wr[64 * j]; orow[64 * j] = DRY ? (o[0] == 12345.678f ? o : v) : o; } }
}
__device__ __forceinline__ void peer_final8(ArgsP a, const int tidx) {
    const int lane = tidx & 63, w = tidx >> 6; const int gwv = blockIdx.x * NWAVES + w, NGW = gridDim.x * NWAVES;
    const bf16* X1B = (const bf16*)(a->ws + WS_X1B); const bf16* PO = (const bf16*)(a->ws + WS_PO);
    for (int tok = gwv; tok < M; tok += NGW) {
        u32x4 xv[4], pv[4];
#pragma unroll
        for (int i = 0; i < 4; ++i) { xv[i] = __builtin_nontemporal_load((const u32x4*)(X1B + (size_t)tok * DM + 8 * lane + 512 * i)); pv[i] = __builtin_nontemporal_load((const u32x4*)(PO + (size_t)tok * DM + 8 * lane + 512 * i)); }
        float v[32]; float ss = 0.f;
#pragma unroll
        for (int i = 0; i < 4; ++i) { v[8 * i + 0] = bflo(xv[i].x) + bflo(pv[i].x); v[8 * i + 1] = bfhi(xv[i].x) + bfhi(pv[i].x); v[8 * i + 2] = bflo(xv[i].y) + bflo(pv[i].y); v[8 * i + 3] = bfhi(xv[i].y) + bfhi(pv[i].y);
            v[8 * i + 4] = bflo(xv[i].z) + bflo(pv[i].z); v[8 * i + 5] = bfhi(xv[i].z) + bfhi(pv[i].z); v[8 * i + 6] = bflo(xv[i].w) + bflo(pv[i].w); v[8 * i + 7] = bfhi(xv[i].w) + bfhi(pv[i].w); }
#pragma unroll
        for (int i = 0; i < 32; ++i) ss += v[i] * v[i];
        const float rstd = 1.f / sqrtf(wave_sum(ss) * (1.f / DM) + EPS);
        float* orow = a->out + (size_t)tok * DM + 8 * lane;
#pragma unroll
        for (int i = 0; i < 4; ++i) { const f32x4 w0 = *(const f32x4*)(a->lnf_w + 8 * lane + 512 * i), w1 = *(const f32x4*)(a->lnf_w + 8 * lane + 512 * i + 4); f32x4 o0, o1;
#pragma unroll
            for (int j = 0; j < 4; ++j) { o0[j] = v[8 * i + j] * rstd * w0[j]; o1[j] = v[8 * i + 4 + j] * rstd * w1[j]; }
            __builtin_nontemporal_store(o0, (f32x4*)(orow + 512 * i)); __builtin_nontemporal_store(o1, (f32x4*)(orow + 512 * i + 4)); }
    }
}
__device__ __forceinline__ f32x2 fp8lo(unsigned w) { return __builtin_amdgcn_cvt_pk_f32_fp8((int)w, false); }
__device__ __forceinline__ f32x2 fp8hi(unsigned w) { return __builtin_amdgcn_cvt_pk_f32_fp8((int)w, true); }
template <int CTRL> __device__ __forceinline__ float dppf(float v) { return __int_as_float(__builtin_amdgcn_update_dpp(0, __float_as_int(v), CTRL, 0xf, 0xf, false)); }
__device__ __forceinline__ float xor4f(float v, bool up) { const float a = dppf<0x114>(v), b = dppf<0x104>(v); return up ? a : b; }
__device__ __forceinline__ float xor2f(float v) { return dppf<0x4E>(v); }
__device__ __forceinline__ float xor1f(float v) { return dppf<0xB1>(v); }
__device__ __forceinline__ float xor8f(float v) { return dppf<0x128>(v); }
__device__ __forceinline__ float swapsum32(float d, float s) { auto rr = __builtin_amdgcn_permlane32_swap(__float_as_uint(d), __float_as_uint(s), false, false); return __uint_as_float(rr[0]) + __uint_as_float(rr[1]); }
__device__ __forceinline__ int iswapsum32(int d, int s) { auto rr = __builtin_amdgcn_permlane32_swap((unsigned)d, (unsigned)s, false, false); return (int)(rr[0] + rr[1]); }
__device__ __forceinline__ int iswapsum16(int d, int s) { auto rr = __builtin_amdgcn_permlane16_swap((unsigned)d, (unsigned)s, false, false); return (int)(rr[0] + rr[1]); }
__device__ __forceinline__ int ixor4(int v, bool up) { const int a = __builtin_amdgcn_update_dpp(0, v, 0x114, 0xf, 0xf, false), b = __builtin_amdgcn_update_dpp(0, v, 0x104, 0xf, 0xf, false); return up ? a : b; }
__device__ __forceinline__ int ixor2(int v) { return __builtin_amdgcn_update_dpp(0, v, 0x4E, 0xf, 0xf, false); }
__device__ __forceinline__ int ixor1(int v) { return __builtin_amdgcn_update_dpp(0, v, 0xB1, 0xf, 0xf, false); }
__device__ __forceinline__ int dot4_first(int a, int b) { int d; asm("v_dot4_i32_i8 %0, %1, %2, 0" : "=v"(d) : "v"(a), "v"(b)); return d; }
__device__ __forceinline__ int ixor8(int v) { return __builtin_amdgcn_update_dpp(0, v, 0x128, 0xf, 0xf, false); }
__device__ __forceinline__ float swapsum16(float d, float s) { auto rr = __builtin_amdgcn_permlane16_swap(__float_as_uint(d), __float_as_uint(s), false, false); return __uint_as_float(rr[0]) + __uint_as_float(rr[1]); }
__device__ __forceinline__ int peer_pop_t0(unsigned* heads, const int myx, int& probe, const unsigned nper) {
    while (probe < 8) { const int q = (myx + probe) & 7; const unsigned v = __hip_atomic_fetch_add(&heads[64 * q], 1u, __ATOMIC_RELAXED, __HIP_MEMORY_SCOPE_AGENT); if (v < nper) return q * (int)nper + (int)v; ++probe; }
    return -1;
}
__device__ __forceinline__ void peer_u_phase8(ArgsP a, LAS unsigned char* lds, const int tidx, const int qoff = 0) {
    const int w = __builtin_amdgcn_readfirstlane(tidx >> 6); const int myx = (int)(xb_xcc_id() & 7u); int probe = 0;
    unsigned* heads = (unsigned*)(a->ws + WS_CTL) + Q_U + qoff; volatile LAS int* bc = (volatile LAS int*)(lds + 98304);
    const bf16* HN = (const bf16*)(a->ws + WS_X1B); const unsigned char* U8 = (const unsigned char*)(a->ws + WS_U8); const unsigned short* IDX16 = (const unsigned short*)(a->ws + WS_IDX16); bf16* PART = (bf16*)(a->ws + WS_PART);
    if (tidx == 0) bc[0] = peer_pop_t0(heads, myx, probe, 256u);
    __syncthreads();
    int item = bc[0], par = 1;
    u32x4 pre[4];
    if (item >= 0) {
#pragma unroll
        for (int i = 0; i < 4; ++i) pre[i] = *(const u32x4*)(IDX16 + (size_t)(item & 127) * 128 * 128 + 8 * (tidx + 512 * i)); }
    while (item >= 0) {
        const int tid = opaque(tidx), lane = tid & 63, m = lane & 7, g = lane >> 3;
        const int s = item >> 7, tile = item & 127, tok0 = tile * 128;
#pragma unroll
        for (int i = 0; i < 4; ++i) { const u32x4 p_ = pre[i];
            *(LAS u32x4*)(lds + 32 * (tid + 512 * i)) = (u32x4){(p_.x & 0xffffu) << 7, (p_.x >> 16) << 7, (p_.y & 0xffffu) << 7, (p_.y >> 16) << 7};
            *(LAS u32x4*)(lds + 32 * (tid + 512 * i) + 16) = (u32x4){(p_.z & 0xffffu) << 7, (p_.z >> 16) << 7, (p_.w & 0xffffu) << 7, (p_.w >> 16) << 7}; }
        __syncthreads();
        if (tid == 0) bc[par] = peer_pop_t0(heads, myx, probe, 256u);
        const GAS unsigned char* ub; { const unsigned long long b_ = (unsigned long long)(U8 + (size_t)s * 16384 * 128); ub = (const GAS unsigned char*)(((unsigned long long)(unsigned)__builtin_amdgcn_readfirstlane((int)(b_ >> 32)) << 32) | (unsigned)__builtin_amdgcn_readfirstlane((int)b_)); }
        const unsigned m16 = 16u * m;
        f32x4 w2v[4];
#pragma unroll
        for (int i = 0; i < 4; ++i) w2v[i] = *(const f32x4*)(a->ln2_w + 128 * s + 16 * m + 4 * i);
        LAS unsigned char* hqb = lds + 66560 + w * 1152;
#define PU_QUANT(TT0) do { const int tlq_ = 16 * w + (TT0) + g; const bf16* hp_ = HN + (size_t)(tok0 + tlq_) * DM + 128 * s + 16 * m; const u32x4 H0 = *(const u32x4*)hp_, H1 = *(const u32x4*)(hp_ + 8); float hf[16]; \
            hf[0] = bflo(H0.x); hf[1] = bfhi(H0.x); hf[2] = bflo(H0.y); hf[3] = bfhi(H0.y); hf[4] = bflo(H0.z); hf[5] = bfhi(H0.z); hf[6] = bflo(H0.w); hf[7] = bfhi(H0.w); \
            hf[8] = bflo(H1.x); hf[9] = bfhi(H1.x); hf[10] = bflo(H1.y); hf[11] = bfhi(H1.y); hf[12] = bflo(H1.z); hf[13] = bfhi(H1.z); hf[14] = bflo(H1.w); hf[15] = bfhi(H1.w); \
            _Pragma("unroll") for (int j = 0; j < 16; ++j) hf[j] *= w2v[j >> 2][j & 3]; \
            float mx_ = 0.f; \
            _Pragma("unroll") for (int j = 0; j < 16; ++j) mx_ = fmaxf(mx_, fabsf(hf[j])); \
            mx_ = fmaxf(mx_, xor4f(mx_, (lane & 4) != 0)); mx_ = fmaxf(mx_, xor2f(mx_)); mx_ = fmaxf(mx_, xor1f(mx_)); \
            const float hsc_ = mx_ > 0.f ? 127.f / mx_ : 1.f, hinv_ = mx_ > 0.f ? mx_ * (1.f / 127.f) : 1.f; \
            u32x4 hq_; hq_.x = (unsigned)pack_i8x4(hf[0] * hsc_, hf[1] * hsc_, hf[2] * hsc_, hf[3] * hsc_); hq_.y = (unsigned)pack_i8x4(hf[4] * hsc_, hf[5] * hsc_, hf[6] * hsc_, hf[7] * hsc_); \
            hq_.z = (unsigned)pack_i8x4(hf[8] * hsc_, hf[9] * hsc_, hf[10] * hsc_, hf[11] * hsc_); hq_.w = (unsigned)pack_i8x4(hf[12] * hsc_, hf[13] * hsc_, hf[14] * hsc_, hf[15] * hsc_); \
            *(LAS u32x4*)(hqb + (g * 8 + m) * 16) = hq_; if (m == 0) *(LAS float*)(hqb + 1024 + 4 * g) = hinv_; } while (0)
#define PU_ISSUE(UV, H0, H1, TT) do { const int tl_ = 16 * w + (TT); const LAS u32x4* ip_ = (const LAS u32x4*)(lds + (tl_ * 128 + 16 * g) * 4); \
            const u32x4 o0_ = ip_[0], o1_ = ip_[1], o2_ = ip_[2], o3_ = ip_[3]; \
            const unsigned of_[16] = {o0_.x, o0_.y, o0_.z, o0_.w, o1_.x, o1_.y, o1_.z, o1_.w, o2_.x, o2_.y, o2_.z, o2_.w, o3_.x, o3_.y, o3_.z, o3_.w}; \
            _Pragma("unroll") for (int r = 0; r < 16; ++r) UV[r] = *(const GAS u32x4*)(ub + (size_t)(of_[r] | m16)); } while (0)
#define PU_REDUCE(UV, H0, H1, TT) do { const int t_ = tok0 + 16 * w + (TT); \
            const u32x4 hq_ = *(const LAS u32x4*)(hqb + (((TT) & 7) * 8 + m) * 16); const float hinv_ = *(const LAS float*)(hqb + 1024 + 4 * ((TT) & 7)); \
            const int hq0 = (int)hq_.x, hq1 = (int)hq_.y, hq2 = (int)hq_.z, hq3 = (int)hq_.w; \
            int p[16]; \
            _Pragma("unroll") for (int r = 0; r < 16; ++r) { int ac = dot4_first((int)UV[r].x, hq0); ac = __builtin_amdgcn_sdot4((int)UV[r].y, hq1, ac, false); \
                ac = __builtin_amdgcn_sdot4((int)UV[r].z, hq2, ac, false); ac = __builtin_amdgcn_sdot4((int)UV[r].w, hq3, ac, false); p[r] = ac; } \
            int q8[8], q4[4], q2[2];            \
            _Pragma("unroll") for (int r = 0; r < 8; ++r) { const bool up = (lane & 4) != 0;   \
                int t_ = __builtin_amdgcn_update_dpp(0, p[r], 0x104, 0xf, 0x5, false); t_ = __builtin_amdgcn_update_dpp(t_, p[r + 8], 0x114, 0xf, 0xa, false); q8[r] = (up ? p[r + 8] : p[r]) + t_; } \
            _Pragma("unroll") for (int r = 0; r < 4; ++r) { const bool up = (lane & 2) != 0; const int snd = up ? q8[r] : q8[r + 4], kp = up ? q8[r + 4] : q8[r]; q4[r] = kp + ixor2(snd); } \
            _Pragma("unroll") for (int r = 0; r < 2; ++r) { const bool up = (lane & 1) != 0; const int snd = up ? q4[r] : q4[r + 2], kp = up ? q4[r + 2] : q4[r]; q2[r] = kp + ixor1(snd); } \
            *(unsigned*)(PART + ((size_t)s * M + t_) * 128 + 2 * lane) = cvtpk((float)q2[0] * hinv_, (float)q2[1] * hinv_); } while (0)
        u32x4 uvA[16], uvB[16], hA0, hA1, hB0, hB1;
        PU_QUANT(0);
        for (int tt = 0; tt < 8; ++tt) { PU_ISSUE(uvA, hA0, hA1, tt); PU_REDUCE(uvA, hA0, hA1, tt); }
        __syncthreads();
        const int nxt = bc[par];
        if (nxt >= 0) {
#pragma unroll
            for (int i = 0; i < 4; ++i) pre[i] = *(const u32x4*)(IDX16 + (size_t)(nxt & 127) * 128 * 128 + 8 * (tid + 512 * i)); }
        PU_QUANT(8);
        for (int tt = 8; tt < 16; ++tt) { PU_ISSUE(uvA, hA0, hA1, tt); PU_REDUCE(uvA, hA0, hA1, tt); }
        (void)uvB; (void)hA0; (void)hA1; (void)hB0; (void)hB1;
#undef PU_QUANT
#undef PU_ISSUE
#undef PU_REDUCE
        __syncthreads();
        item = nxt; par ^= 1;
    }
}
__device__ __forceinline__ void peer_combine8(ArgsP a, const int tidx) {
    const size_t gt = (size_t)blockIdx.x * NTHR + tidx, NGT = (size_t)gridDim.x * NTHR;
    const unsigned* PART = (const unsigned*)(a->ws + WS_PART); const float* GW = (const float*)(a->ws + WS_GW); const float* SUMSQ = (const float*)(a->ws + WS_MISC + MISC_SUMSQ); f32x2* C = (f32x2*)(a->ws + WS_COEF);
    const float* USC = (const float*)(a->ws + WS_USC); const float* VSC = (const float*)(a->ws + WS_VSC); const int* IDX = (const int*)(a->ws + WS_IDX);
    for (size_t i0 = gt; i0 < (size_t)M * 64; i0 += 2 * NGT) {
        unsigned pv[2][16]; int id[2][2]; f32x2 g[2]; float sq[2];
#pragma unroll
        for (int q = 0; q < 2; ++q) { const size_t i = i0 + q * NGT;
#pragma unroll
            for (int s = 0; s < 16; ++s) pv[q][s] = __builtin_nontemporal_load(PART + (size_t)s * M * 64 + i);
            { const unsigned iw = ((const unsigned*)(a->ws + WS_IDX16))[i]; id[q][0] = (int)(iw & 0xffffu); id[q][1] = (int)(iw >> 16); } g[q] = ((const f32x2*)GW)[i]; sq[q] = SUMSQ[(int)(i >> 6)]; }
#pragma unroll
        for (int q = 0; q < 2; ++q) { const size_t i = i0 + q * NGT; float s0 = 0.f, s1 = 0.f;
#pragma unroll
            for (int s = 0; s < 16; ++s) { s0 += bflo(pv[q][s]); s1 += bfhi(pv[q][s]); }
            const float rstd2 = 1.f / sqrtf(sq[q] * (1.f / DM) + EPS);
            const float a0 = s0 * rstd2 * USC[id[q][0]], a1 = s1 * rstd2 * USC[id[q][1]];
            const float c0 = g[q].x * 0.5f * a0 * (1.f + erff(a0 * 0.70710678118654752f)) * VSC[id[q][0]], c1 = g[q].y * 0.5f * a1 * (1.f + erff(a1 * 0.70710678118654752f)) * VSC[id[q][1]];
#if PEERV_I8
            float mxc = wave_max(fmaxf(fabsf(c0), fabsf(c1)));
            const float scq = mxc > 0.f ? 127.f / mxc : 0.f; const int q0 = __float2int_rn(c0 * scq), q1 = __float2int_rn(c1 * scq);
            ((unsigned short*)(a->ws + WS_COEF))[i] = (unsigned short)((q0 & 255) | ((q1 & 255) << 8));
            if ((tidx & 7) == 0) ((float*)(a->ws + WS_CSC))[i >> 3] = mxc * (1.f / 127.f);
#else
            C[i] = (f32x2){c0, c1};
#endif
        }
    }
}
#if PEERV_I8
template <bool DRY> __device__ __forceinline__ void peer_v_phase8(ArgsP a, LAS unsigned char* lds, const int tidx, const int qoff = 0) {
    const int w = __builtin_amdgcn_readfirstlane(tidx >> 6); const int myx = (int)(xb_xcc_id() & 7u); int probe = 0;
    unsigned* heads = (unsigned*)(a->ws + WS_CTL) + Q_V + qoff; volatile LAS int* bc = (volatile LAS int*)(lds + 98304);
    const unsigned char* V8 = (const unsigned char*)(a->ws + WS_V8); const unsigned short* IDX16 = (const unsigned short*)(a->ws + WS_IDX16); const unsigned char* CQ = (const unsigned char*)(a->ws + WS_COEF); const float* CSC = (const float*)(a->ws + WS_CSC); bf16* PO = (bf16*)(a->ws + WS_PO);
    if (tidx == 0) bc[0] = peer_pop_t0(heads, myx, probe, 256u);
    __syncthreads();
    int item = bc[0], par = 1;
    u32x4 pre[4], prc[2]; u32x2 prs;
    if (item >= 0) {
#pragma unroll
        for (int i = 0; i < 4; ++i) pre[i] = *(const u32x4*)(IDX16 + (size_t)(item & 127) * 128 * 128 + 8 * (tidx + 512 * i));
#pragma unroll
        for (int i = 0; i < 2; ++i) prc[i] = *(const u32x4*)(CQ + (size_t)(item & 127) * 128 * 128 + 16 * (tidx + 512 * i));
        prs = *(const u32x2*)(CSC + (size_t)(item & 127) * 128 * 8 + 2 * tidx); }
    while (item >= 0) {
        const int tid = opaque(tidx), lane = tid & 63, m = lane & 7, g = lane >> 3;
        const int s = item >> 7, tile = item & 127, tok0 = tile * 128;
#pragma unroll
        for (int i = 0; i < 4; ++i) { const u32x4 p_ = pre[i];
            *(LAS u32x4*)(lds + 32 * (tid + 512 * i)) = (u32x4){(p_.x & 0xffffu) << 7, (p_.x >> 16) << 7, (p_.y & 0xffffu) << 7, (p_.y >> 16) << 7};
            *(LAS u32x4*)(lds + 32 * (tid + 512 * i) + 16) = (u32x4){(p_.z & 0xffffu) << 7, (p_.z >> 16) << 7, (p_.w & 0xffffu) << 7, (p_.w >> 16) << 7}; }
#pragma unroll
        for (int i = 0; i < 2; ++i) *(LAS u32x4*)(lds + 65536 + 16 * (tid + 512 * i)) = prc[i];
        *(LAS u32x2*)(lds + 81920 + 8 * tid) = prs;
        __syncthreads();
        if (tid == 0) bc[par] = peer_pop_t0(heads, myx, probe, 256u);
        const GAS unsigned char* vb; { const unsigned long long b_ = (unsigned long long)(V8 + (size_t)s * 16384 * 128); vb = (const GAS unsigned char*)(((unsigned long long)(unsigned)__builtin_amdgcn_readfirstlane((int)(b_ >> 32)) << 32) | (unsigned)__builtin_amdgcn_readfirstlane((int)b_)); }
        const unsigned m16 = 16u * m;
#define PV_ISSUE(VV, TT) do { const int tl_ = 16 * w + (TT); const LAS u32x4* ip_ = (const LAS u32x4*)(lds + (tl_ * 128 + 16 * g) * 4); \
            const u32x4 o0_ = ip_[0], o1_ = ip_[1], o2_ = ip_[2], o3_ = ip_[3]; \
            const unsigned of_[16] = {o0_.x, o0_.y, o0_.z, o0_.w, o1_.x, o1_.y, o1_.z, o1_.w, o2_.x, o2_.y, o2_.z, o2_.w, o3_.x, o3_.y, o3_.z, o3_.w}; \
            _Pragma("unroll") for (int r = 0; r < 16; ++r) VV[r] = *(const GAS u32x4*)(vb + (size_t)(of_[r] | m16)); } while (0)
#define PV_REDUCE(VV, TT) do { const int tl_ = 16 * w + (TT), t_ = tok0 + tl_; \
            const u32x4 cq_ = *(const LAS u32x4*)(lds + 65536 + tl_ * 128 + 16 * g); const float cs_ = *(const LAS float*)(lds + 81920 + (tl_ * 8 + g) * 4); \
            int ia[16]; \
            _Pragma("unroll") for (int rg = 0; rg < 4; ++rg) { const int c4 = (int)cq_[rg]; \
                _Pragma("unroll") for (int j = 0; j < 4; ++j) { const unsigned W0 = VV[4 * rg][j], W1 = VV[4 * rg + 1][j], W2 = VV[4 * rg + 2][j], W3 = VV[4 * rg + 3][j]; \
                    const unsigned lo01 = __builtin_amdgcn_perm(W1, W0, 0x05010400u), hi01 = __builtin_amdgcn_perm(W1, W0, 0x07030602u), lo23 = __builtin_amdgcn_perm(W3, W2, 0x05010400u), hi23 = __builtin_amdgcn_perm(W3, W2, 0x07030602u); \
                    ia[4 * j + 0] = rg == 0 ? dot4_first((int)__builtin_amdgcn_perm(lo23, lo01, 0x05040100u), c4) : __builtin_amdgcn_sdot4((int)__builtin_amdgcn_perm(lo23, lo01, 0x05040100u), c4, ia[4 * j + 0], false); \
                    ia[4 * j + 1] = rg == 0 ? dot4_first((int)__builtin_amdgcn_perm(lo23, lo01, 0x07060302u), c4) : __builtin_amdgcn_sdot4((int)__builtin_amdgcn_perm(lo23, lo01, 0x07060302u), c4, ia[4 * j + 1], false); \
                    ia[4 * j + 2] = rg == 0 ? dot4_first((int)__builtin_amdgcn_perm(hi23, hi01, 0x05040100u), c4) : __builtin_amdgcn_sdot4((int)__builtin_amdgcn_perm(hi23, hi01, 0x05040100u), c4, ia[4 * j + 2], false); \
                    ia[4 * j + 3] = rg == 0 ? dot4_first((int)__builtin_amdgcn_perm(hi23, hi01, 0x07060302u), c4) : __builtin_amdgcn_sdot4((int)__builtin_amdgcn_perm(hi23, hi01, 0x07060302u), c4, ia[4 * j + 3], false); } } \
            int r4[8], r2[4], r1x, r1y; \
            _Pragma("unroll") for (int j = 0; j < 4; ++j) { r4[2 * j] = iswapsum32(ia[2 * j], ia[2 * j + 8]); r4[2 * j + 1] = iswapsum32(ia[2 * j + 1], ia[2 * j + 9]); } \
            _Pragma("unroll") for (int j = 0; j < 2; ++j) { r2[2 * j] = iswapsum16(r4[2 * j], r4[2 * j + 4]); r2[2 * j + 1] = iswapsum16(r4[2 * j + 1], r4[2 * j + 5]); } \
            { const bool up = (lane & 8) != 0; const int sx = up ? r2[0] : r2[2], sy = up ? r2[1] : r2[3], kx = up ? r2[2] : r2[0], ky = up ? r2[3] : r2[1]; r1x = kx + ixor8(sx); r1y = ky + ixor8(sy); } \
            f32x2 q1; q1.x = (float)r1x * cs_; q1.y = (float)r1y * cs_; \
            if (!DRY) *(unsigned*)(PO + (size_t)t_ * DM + 128 * s + 16 * m + 2 * g) = cvtpk(q1.x, q1.y); } while (0)
        u32x4 vvA[16];
        for (int tt = 0; tt < 8; ++tt) { PV_ISSUE(vvA, tt); PV_REDUCE(vvA, tt); }
        __syncthreads();
        const int nxt = bc[par];
        if (nxt >= 0) {
#pragma unroll
            for (int i = 0; i < 4; ++i) pre[i] = *(const u32x4*)(IDX16 + (size_t)(nxt & 127) * 128 * 128 + 8 * (tid + 512 * i));
#pragma unroll
            for (int i = 0; i < 2; ++i) prc[i] = *(const u32x4*)(CQ + (size_t)(nxt & 127) * 128 * 128 + 16 * (tid + 512 * i));
            prs = *(const u32x2*)(CSC + (size_t)(nxt & 127) * 128 * 8 + 2 * tid); }
        for (int tt = 8; tt < 16; ++tt) { PV_ISSUE(vvA, tt); PV_REDUCE(vvA, tt); }
#undef PV_ISSUE
#undef PV_REDUCE
        __syncthreads();
        item = nxt; par ^= 1;
    }
}
#else
template <bool DRY> __device__ __forceinline__ void peer_v_phase8(ArgsP a, LAS unsigned char* lds, const int tidx, const int qoff = 0) {
    const int w = __builtin_amdgcn_readfirstlane(tidx >> 6); const int myx = (int)(xb_xcc_id() & 7u); int probe = 0;
    unsigned* heads = (unsigned*)(a->ws + WS_CTL) + Q_V + qoff; volatile LAS int* bc = (volatile LAS int*)(lds + 98304);
    const unsigned char* V8 = (const unsigned char*)(a->ws + WS_V8); const int* IDX = (const int*)(a->ws + WS_IDX); const float* COEF = (const float*)(a->ws + WS_COEF); bf16* PO = (bf16*)(a->ws + WS_PO);
    if (tidx == 0) bc[0] = peer_pop_t0(heads, myx, probe, 256u);
    __syncthreads();
    int item = bc[0], par = 1;
    u32x4 pre[8], prc[8];
    if (item >= 0) {
#pragma unroll
        for (int i = 0; i < 8; ++i) { pre[i] = *(const u32x4*)(IDX + (size_t)(item & 127) * 128 * 128 + 4 * (tidx + 512 * i)); prc[i] = *(const u32x4*)(COEF + (size_t)(item & 127) * 128 * 128 + 4 * (tidx + 512 * i)); } }
    while (item >= 0) {
        const int tid = opaque(tidx), lane = tid & 63, m = lane & 7, g = lane >> 3;
        const int s = item >> 7, tile = item & 127, tok0 = tile * 128;
#pragma unroll
        for (int i = 0; i < 8; ++i) { const int q = tid + 512 * i; *(LAS u32x2*)(lds + 8 * q) = (u32x2){pre[i].x | (pre[i].y << 16), pre[i].z | (pre[i].w << 16)}; *(LAS u32x4*)(lds + 32768 + 16 * q) = prc[i]; }
        __syncthreads();
        if (tid == 0) bc[par] = peer_pop_t0(heads, myx, probe, 256u);
        const unsigned char* vb = V8 + (size_t)s * 16384 * 128 + 16 * m;
#define PV_ISSUE(VV, X1, TT) do { const int tl_ = 16 * w + (TT); \
            const u32x4 idA_ = *(const LAS u32x4*)(lds + (tl_ * 128 + 16 * g) * 2), idB_ = *(const LAS u32x4*)(lds + (tl_ * 128 + 16 * g) * 2 + 16); \
            const unsigned idw_[8] = {idA_.x, idA_.y, idA_.z, idA_.w, idB_.x, idB_.y, idB_.z, idB_.w}; \
            _Pragma("unroll") for (int r = 0; r < 16; ++r) { const unsigned id = (r & 1) ? (idw_[r >> 1] >> 16) : (idw_[r >> 1] & 0xffffu); VV[r] = *(const u32x4*)(vb + (size_t)id * 128); } \
            X1 = (f32x2){0.f, 0.f}; } while (0)
#define PV_REDUCE(VV, X1, TT) do { const int tl_ = 16 * w + (TT), t_ = tok0 + tl_; f32x4 cfv[4]; \
            _Pragma("unroll") for (int i = 0; i < 4; ++i) cfv[i] = *(const LAS f32x4*)(lds + 32768 + (tl_ * 128 + 16 * g + 4 * i) * 4); \
            f32x2 acc[8]; \
            _Pragma("unroll") for (int j = 0; j < 8; ++j) acc[j] = (f32x2){0.f, 0.f}; \
            _Pragma("unroll") for (int r = 0; r < 16; ++r) { const float cf = cfv[r >> 2][r & 3]; const f32x2 c2 = {cf, cf}; \
                acc[0] += c2 * fp8lo(VV[r].x); acc[1] += c2 * fp8hi(VV[r].x); acc[2] += c2 * fp8lo(VV[r].y); acc[3] += c2 * fp8hi(VV[r].y); \
                acc[4] += c2 * fp8lo(VV[r].z); acc[5] += c2 * fp8hi(VV[r].z); acc[6] += c2 * fp8lo(VV[r].w); acc[7] += c2 * fp8hi(VV[r].w); } \
            f32x2 q4[4], q2[2], q1; \
            _Pragma("unroll") for (int j = 0; j < 4; ++j) q4[j] = (f32x2){swapsum32(acc[j].x, acc[j + 4].x), swapsum32(acc[j].y, acc[j + 4].y)}; \
            _Pragma("unroll") for (int j = 0; j < 2; ++j) q2[j] = (f32x2){swapsum16(q4[j].x, q4[j + 2].x), swapsum16(q4[j].y, q4[j + 2].y)}; \
            { const bool up = (lane & 8) != 0; const f32x2 snd = up ? q2[0] : q2[1], kp = up ? q2[1] : q2[0]; q1 = kp + (f32x2){xor8f(snd.x), xor8f(snd.y)}; } \
            if (!DRY) *(unsigned*)(PO + (size_t)t_ * DM + 128 * s + 16 * m + 2 * g) = cvtpk(q1.x + X1.x, q1.y + X1.y); } while (0)
        u32x4 vvA[16], vvB[16]; f32x2 xA, xB;
        for (int tt = 0; tt < 8; ++tt) { PV_ISSUE(vvA, xA, tt); PV_REDUCE(vvA, xA, tt); }
        __syncthreads();
        const int nxt = bc[par];
        if (nxt >= 0) {
#pragma unroll
            for (int i = 0; i < 8; ++i) { pre[i] = *(const u32x4*)(IDX + (size_t)(nxt & 127) * 128 * 128 + 4 * (tid + 512 * i)); prc[i] = *(const u32x4*)(COEF + (size_t)(nxt & 127) * 128 * 128 + 4 * (tid + 512 * i)); } }
        for (int tt = 8; tt < 16; ++tt) { PV_ISSUE(vvA, xA, tt); PV_REDUCE(vvA, xA, tt); }
        (void)vvB; (void)xB;
#undef PV_ISSUE
#undef PV_REDUCE
        __syncthreads();
        item = nxt; par ^= 1;
    }
}
#endif
#if SELFCHECK
constexpr size_t WS_YDBG = 464 * MiB;
constexpr size_t WS_XSAVE = 500 * MiB;
__device__ __forceinline__ float bfr(float v) { return bf2f(f2bf(v)); }
__device__ __forceinline__ void chk_report(ArgsP a, int k, float err) { if (!(err == err)) err = 1e30f; atomicMax((int*)(a->ws + WS_MISC + MISC_CHK) + k, __float_as_int(err)); }
__device__ const int CHK_ROWS[8] = {0, 1, 255, 256, 7777, 12345, 16128, 16383};
__device__ const int CHK_TOK[8] = {0, 1, 63, 127, 128, 129, 8191, 16383};
__device__ __forceinline__ float geluf(float x) { return 0.5f * x * (1.f + erff(x * 0.70710678118654752f)); }
__device__ __forceinline__ void chk1(ArgsP a, const int tidx) {
    const int gt = blockIdx.x * NTHR + tidx, NGT = gridDim.x * NTHR;
    const bf16 *Z = (const bf16*)(a->ws + WS_Z), *XBC = (const bf16*)(a->ws + WS_XBC), *Q = (const bf16*)(a->ws + WS_Q), *K = (const bf16*)(a->ws + WS_K), *V = (const bf16*)(a->ws + WS_V); const float* DTF = (const float*)(a->ws + WS_DTF);
    for (int it = gt; it < 8 * 5664; it += NGT) { const int t = CHK_ROWS[it / 5664], j = it % 5664; const float* xr = a->x + (size_t)t * DM;
        float ss = 0.f; for (int k = 0; k < DM; ++k) ss += xr[k] * xr[k]; const float rstd = 1.f / sqrtf(ss / DM + EPS);
        float ref = 0.f; for (int k = 0; k < DM; ++k) ref += bfr(xr[k] * rstd * a->ln1_w[k]) * bfr(a->w_in[(size_t)k * 5664 + j]);
        float got;
        if (j < 1024) got = bf2f(Z[(size_t)t * 1024 + j]); else if (j < 2560) got = bf2f(XBC[(size_t)t * 1536 + j - 1024]); else if (j < 2576) got = DTF[(size_t)t * 32 + j - 2560];
        else if (j < 3600) got = bf2f(Q[(size_t)t * 1024 + j - 2576]) / QSCALE; else if (j < 4624) got = bf2f(K[(size_t)t * 1024 + j - 3600]); else if (j < 5648) got = bf2f(V[(size_t)t * 1024 + j - 4624]);
        else got = DTF[(size_t)t * 32 + 16 + j - 5648];
        chk_report(a, 1, fabsf(got - ref)); }
}
__device__ __forceinline__ void chk2(ArgsP a, const int tidx) {
    const int gt = blockIdx.x * NTHR + tidx, NGT = gridDim.x * NTHR;
    const bf16 *XBC = (const bf16*)(a->ws + WS_XBC), *XS = (const bf16*)(a->ws + WS_XS), *BC = (const bf16*)(a->ws + WS_BC); const float *DTF = (const float*)(a->ws + WS_DTF), *DT = (const float*)(a->ws + WS_DT), *ACUM = (const float*)(a->ws + WS_ACUM);
    for (int it = gt; it < 64 * 1536; it += NGT) { const int si = it / 1536, ch = it % 1536; const int t = si < 8 ? si : (si < 16 ? 60 + (si - 8) : (int)(((unsigned)si * 2654435761u) % M));
        float acc = a->conv_b[ch]; for (int j = 0; j < 4; ++j) { const int tt = t - 3 + j; if (tt >= 0) acc += a->conv_w[j * 1536 + ch] * bf2f(XBC[(size_t)tt * 1536 + ch]); }
        const float ref = siluf(acc); const float got = ch < 1024 ? bf2f(XS[(size_t)t * 1024 + ch]) : bf2f(BC[(size_t)t * 512 + ch - 1024]);
        chk_report(a, 2, fabsf(got - ref));
        if (ch < 16) { const int h = ch; const float A = -__expf(a->a_log[h]); float ac = 0.f, dtl = 0.f; for (int tt = (t / 64) * 64; tt <= t; ++tt) { dtl = softplusf(DTF[(size_t)tt * 32 + h] + a->dt_bias[h]); ac += dtl * A; }
            chk_report(a, 2, fabsf(DT[(size_t)t * 16 + h] - dtl) * 10.f); chk_report(a, 2, fabsf(ACUM[(size_t)t * 16 + h] - ac)); } }
}
__device__ __forceinline__ void chk3(ArgsP a, const int tidx) {
    const int gt = blockIdx.x * NTHR + tidx, NGT = gridDim.x * NTHR;
    const bf16 *XS = (const bf16*)(a->ws + WS_XS), *BC = (const bf16*)(a->ws + WS_BC), *SL = (const bf16*)(a->ws + WS_SLOC); const float *DT = (const float*)(a->ws + WS_DT), *ACUM = (const float*)(a->ws + WS_ACUM);
    for (int it = gt; it < 8192; it += NGT) { const unsigned hsh = (unsigned)it * 2654435761u; const int c = it < 2048 ? (it & 1) * 255 : (hsh >> 8) & 255, h = (hsh >> 16) & 15, p = (hsh >> 20) & 63, n = (hsh >> 26) & 63 | ((it & 1) << 6), g = h >> 3;
        const float al = ACUM[(size_t)(c * 64 + 63) * 16 + h]; float ref = 0.f;
        for (int sx = 0; sx < 64; ++sx) { const int t = c * 64 + sx; ref += bf2f(BC[(size_t)t * 512 + 128 * g + n]) * bfr(bf2f(XS[(size_t)t * 1024 + 64 * h + p]) * DT[(size_t)t * 16 + h] * __expf(al - ACUM[(size_t)t * 16 + h])); }
        const float got = bf2f(SL[((size_t)(c * 16 + h) * 64 + p) * 128 + n]);
        chk_report(a, 3, fabsf(got - ref) / fmaxf(fabsf(ref), 0.05f)); }
}
__device__ __forceinline__ void chk13(ArgsP a, const int tidx) {
    const int gt = blockIdx.x * NTHR + tidx, NGT = gridDim.x * NTHR;
    const bf16 *XS = (const bf16*)(a->ws + WS_XS), *BC = (const bf16*)(a->ws + WS_BC), *SL = (const bf16*)(a->ws + WS_SLOC); const float *DT = (const float*)(a->ws + WS_DT), *ACUM = (const float*)(a->ws + WS_ACUM);
    for (int it = gt; it < 4096; it += NGT) { const unsigned hsh = (unsigned)it * 2654435761u; const int h = (hsh >> 16) & 15, p = (hsh >> 20) & 63, n = (hsh >> 26) & 63 | ((it & 1) << 6), g = h >> 3;
        float st = 0.f, num = 0.f, den = 1e-12f;
        for (int c = 0; c < NCHUNK; ++c) { const float got = bf2f(SL[((size_t)(c * 16 + h) * 64 + p) * 128 + n]); num += (got - st) * (got - st); den += st * st;
            const float al = ACUM[(size_t)(c * 64 + 63) * 16 + h]; float sl = 0.f;
            for (int sx = 0; sx < 64; ++sx) { const int t = c * 64 + sx; sl += bf2f(BC[(size_t)t * 512 + 128 * g + n]) * bf2f(XS[(size_t)t * 1024 + 64 * h + p]) * DT[(size_t)t * 16 + h] * __expf(al - ACUM[(size_t)t * 16 + h]); }
            st = st * __expf(al) + sl; }
        chk_report(a, 13, sqrtf(num / den)); }
}
__device__ __forceinline__ void chk4(ArgsP a, const int tidx) {
    const int lane = tidx & 63, gw = blockIdx.x * NWAVES + (tidx >> 6);
    const bf16 *XS = (const bf16*)(a->ws + WS_XS), *BC = (const bf16*)(a->ws + WS_BC); const float *DT = (const float*)(a->ws + WS_DT); const float* Y = (const float*)(a->ws + WS_YDBG);
    if (gw >= 32) return;
    const int h = (gw * 5 + 3) & 15, p = (gw * 23 + 7) & 63, g = h >> 3; const float A = -__expf(a->a_log[h]);
    float s0 = 0.f, s1 = 0.f, emax = 0.f, emax0 = 0.f, num = 0.f, den = 1e-12f;
    for (int t = 0; t < 8192; ++t) { const float dt = DT[(size_t)t * 16 + h], x = bf2f(XS[(size_t)t * 1024 + 64 * h + p]), dA = __expf(dt * A);
        const float b0 = bf2f(BC[(size_t)t * 512 + 128 * g + lane]), b1 = bf2f(BC[(size_t)t * 512 + 128 * g + 64 + lane]), c0 = bf2f(BC[(size_t)t * 512 + 256 + 128 * g + lane]), c1 = bf2f(BC[(size_t)t * 512 + 256 + 128 * g + 64 + lane]);
        s0 = s0 * dA + dt * b0 * x; s1 = s1 * dA + dt * b1 * x;
        const float y = wave_sum(c0 * s0 + c1 * s1); const float got = Y[(size_t)t * 1024 + 64 * h + p];
        float e = fabsf(got - y) / fmaxf(fabsf(y), 0.25f); if (!(got == got)) e = 1e30f; if (t < 64) emax0 = fmaxf(emax0, e); else { num += (got - y) * (got - y); den += y * y; } }
    emax = sqrtf(num / den);
    if (lane == 0) { chk_report(a, 12, emax0); chk_report(a, 4, emax); }
}
__device__ __forceinline__ void chk567(ArgsP a, const int tidx) {
    const int lane = tidx & 63, gw = blockIdx.x * NWAVES + (tidx >> 6);
    const bf16 *XS = (const bf16*)(a->ws + WS_XS), *Zb = (const bf16*)(a->ws + WS_Z), *MIX = (const bf16*)(a->ws + WS_MIX); const float* Y = (const float*)(a->ws + WS_YDBG);
    if (gw >= 64 && gw < 128) { const int si = gw - 64, g = si & 1, t = (si >> 1) < 4 ? (si >> 1) * 63 : (int)(((unsigned)si * 2654435761u) % 8192);
        float v[8]; float ss = 0.f;
#pragma unroll
        for (int i = 0; i < 8; ++i) { const int ch = 512 * g + lane + 64 * i; const float y = (Y[(size_t)t * 1024 + ch] + a->d_skip[ch >> 6] * bf2f(XS[(size_t)t * 1024 + ch])) * siluf(bf2f(Zb[(size_t)t * 1024 + ch])); v[i] = y; ss += y * y; }
        const float rstd = 1.f / sqrtf(wave_sum(ss) / 512.f + EPS); float e = 0.f;
#pragma unroll
        for (int i = 0; i < 8; ++i) { const int ch = 512 * g + lane + 64 * i; const float rf = v[i] * rstd * a->ssd_norm_w[ch]; e = fmaxf(e, fabsf(bf2f(MIX[(size_t)t * DM + ch]) - rf) / fmaxf(1.f, fabsf(rf))); }
        chk_report(a, 5, e); }
    if (gw >= 128 && gw < 144 && lane == 0) { const int h = gw - 128; const float* DTF = (const float*)(a->ws + WS_DTF); const float* CL = (const float*)(a->ws + WS_CUMF) + (size_t)h * M; double c = 0.0; float e = 0.f;
        for (int t = 0; t < M; ++t) { c += (double)logsigmoidf(DTF[(size_t)t * 32 + 16 + h] + a->fox_f_bias[h]); const float ref = (float)(c * 1.4426950408889634); e = fmaxf(e, fabsf(CL[t] - ref) / (1.f + 1e-4f * fabsf(ref))); }
        chk_report(a, 6, e); }
    if (gw >= 160 && gw < 224) { const int si = gw - 160, h = (si * 7 + 1) & 15; const int t = si < 8 ? CHK_TOK[si] : (int)(((unsigned)si * 2654435761u) % M);
        const bf16 *Q = (const bf16*)(a->ws + WS_Q), *K = (const bf16*)(a->ws + WS_K), *V = (const bf16*)(a->ws + WS_V); const float* CL = (const float*)(a->ws + WS_CUMF) + (size_t)h * M;
        const float q = bf2f(Q[(size_t)t * 1024 + 64 * h + lane]); float m = -1e30f, l = 0.f, o = 0.f;
        for (int j = 0; j <= t; ++j) { const float s = wave_sum(q * bf2f(K[(size_t)j * 1024 + 64 * h + lane])) + (CL[t] - CL[j]); const float mn = fmaxf(m, s), al = exp2f(m - mn), p = exp2f(s - mn);
            l = l * al + p; o = o * al + p * bf2f(V[(size_t)j * 1024 + 64 * h + lane]); m = mn; }
        const float e = fabsf(bf2f(MIX[(size_t)t * DM + 1024 + 64 * h + lane]) - o / l);
        chk_report(a, 7, wave_max(e)); }
}
__device__ __forceinline__ void chk8(ArgsP a, const int tidx) {
    const int gt = blockIdx.x * NTHR + tidx, NGT = gridDim.x * NTHR; const bf16* MIX = (const bf16*)(a->ws + WS_MIX); const bf16* HN = (const bf16*)(a->ws + WS_HN); float* XSV = (float*)(a->ws + WS_XSAVE);
    for (int it = gt; it < 8 * DM; it += NGT) { const int r = it / DM, t = CHK_ROWS[r], c = it % DM; float ref = a->x[(size_t)t * DM + c];
        for (int k = 0; k < DM; ++k) ref += bf2f(MIX[(size_t)t * DM + k]) * bfr(a->w_out[(size_t)k * DM + c]);
        const float got = bf2f(((const bf16*)(a->ws + WS_X1B))[(size_t)t * DM + c]); XSV[it] = got; chk_report(a, 8, fabsf(got - ref)); chk_report(a, 8, fabsf(bf2f(HN[(size_t)t * DM + c]) - got * a->ln2_w[c]) * 0.5f);
        if (c == 0) { float ss = 0.f; for (int k = 0; k < DM; ++k) { const float v = bf2f(((const bf16*)(a->ws + WS_X1B))[(size_t)t * DM + k]); ss += v * v; } const float sq = ((const float*)(a->ws + WS_MISC + MISC_SUMSQ))[t]; chk_report(a, 8, fabsf(sq - ss) / ss * 2.f); } }
}
__device__ __forceinline__ void chk910(ArgsP a, LAS unsigned char* lds, const int tidx) {
    const int gt = blockIdx.x * NTHR + tidx, NGT = gridDim.x * NTHR; const bf16* HN = (const bf16*)(a->ws + WS_HN); const bf16* QP = (const bf16*)(a->ws + WS_QP);
    for (int it = gt; it < 8 * DM; it += NGT) { const int r = it / DM, t = CHK_ROWS[r], c = it % DM; float ref = 0.f;
        for (int k = 0; k < DM; ++k) ref += bf2f(HN[(size_t)t * DM + k]) * bfr(a->peer_wq[(size_t)k * DM + c]);
        chk_report(a, 9, fabsf(bf2f(QP[(size_t)t * DM + c]) - ref)); }
    const int lane = tidx & 63, wv = tidx >> 6, gw = blockIdx.x * NWAVES + wv;
    if (gw < 64) { const int t = CHK_ROWS[gw >> 3], hd = gw & 7; LAS float* S = (LAS float*)lds + wv * 256;
        for (int half = 0; half < 2; ++half) for (int n = lane; n < 128; n += 64) { const float* kr = (half ? a->peer_k2 : a->peer_k1) + ((size_t)hd * 128 + n) * 128; float s = 0.f;
            for (int d = 0; d < 128; ++d) s += bf2f(QP[(size_t)t * DM + 256 * hd + 128 * half + d]) * bfr(kr[d]); S[128 * half + n] = s; }
        asm volatile("s_waitcnt lgkmcnt(0)" ::: "memory");
        float lo = -1e30f, hi = 1e30f; { float mx = -1e30f, mn = 1e30f; for (int i = lane; i < 128; i += 64) { mx = fmaxf(mx, S[i]); mn = fminf(mn, S[i]); } float mx2 = -1e30f, mn2 = 1e30f; for (int i = lane; i < 128; i += 64) { mx2 = fmaxf(mx2, S[128 + i]); mn2 = fminf(mn2, S[128 + i]); }
            hi = wave_max(mx) + wave_max(mx2) + 1.f; lo = -wave_max(-mn) - wave_max(-mn2) - 1.f; }
        for (int itn = 0; itn < 40; ++itn) { const float mid = 0.5f * (lo + hi); int cnt = 0; for (int i = lane; i < 16384; i += 64) cnt += (S[i >> 7] + S[128 + (i & 127)] >= mid) ? 1 : 0; cnt = (int)wave_sum((float)cnt); if (cnt >= 16) lo = mid; else hi = mid; }
        const float thr = lo; float mxs = -1e30f; for (int i = lane; i < 16384; i += 64) { const float s = S[i >> 7] + S[128 + (i & 127)]; if (s >= thr) mxs = fmaxf(mxs, s); } mxs = wave_max(mxs);
        const float rstd = 1.f / sqrtf(((const float*)(a->ws + WS_MISC + MISC_SUMSQ))[t] / DM + EPS);
        float den = 0.f; for (int i = lane; i < 16384; i += 64) { const float s = S[i >> 7] + S[128 + (i & 127)]; if (s >= thr) den += __expf((s - mxs) * rstd); } den = wave_sum(den);
        float e = 0.f; if (lane < 16) { const int id = ((const int*)(a->ws + WS_IDX))[(size_t)t * 128 + 16 * hd + lane]; const float g = ((const float*)(a->ws + WS_GW))[(size_t)t * 128 + 16 * hd + lane];
            if (id < 0 || id >= 16384) e = 10.f; else { const float s = S[id >> 7] + S[128 + (id & 127)]; if (s < thr - 2e-3f) e = 5.f; e = fmaxf(e, fabsf(g - __expf((s - mxs) * rstd) / den)); }
            for (int k2 = 0; k2 < 16; ++k2) { const int id2 = __shfl(id, k2); if (k2 != lane && id2 == id) e = 7.f; } }
        chk_report(a, 10, wave_max(e)); }
}
__device__ __forceinline__ void chk11(ArgsP a, const int tidx) {
    const int lane = tidx & 63, gw = blockIdx.x * NWAVES + (tidx >> 6); if (gw >= 8) return;
    const int t = CHK_ROWS[gw]; const bf16* HN = (const bf16*)(a->ws + WS_HN); const float* XSV = (const float*)(a->ws + WS_XSAVE) + gw * DM;
    const float rstd2 = 1.f / sqrtf(((const float*)(a->ws + WS_MISC + MISC_SUMSQ))[t] / DM + EPS);
    float acc[32];
#pragma unroll
    for (int i = 0; i < 32; ++i) acc[i] = 0.f;
    for (int k = 0; k < 128; ++k) { const int id = ((const int*)(a->ws + WS_IDX))[(size_t)t * 128 + k]; const float g = ((const float*)(a->ws + WS_GW))[(size_t)t * 128 + k];
        float s = 0.f;
#pragma unroll
        for (int i = 0; i < 32; ++i) { const int d = lane + 64 * i; s += bfr(a->peer_u[(size_t)id * DM + d]) * bf2f(HN[(size_t)t * DM + d]); }
        const float cf = g * geluf(wave_sum(s) * rstd2);
#pragma unroll
        for (int i = 0; i < 32; ++i) acc[i] += cf * bfr(a->peer_v[(size_t)id * DM + lane + 64 * i]); }
    float ss = 0.f;
#pragma unroll
    for (int i = 0; i < 32; ++i) { acc[i] += XSV[lane + 64 * i]; ss += acc[i] * acc[i]; }
    const float rstd = 1.f / sqrtf(wave_sum(ss) / DM + EPS); float e = 0.f;
#pragma unroll
    for (int i = 0; i < 32; ++i) e = fmaxf(e, fabsf(a->out[(size_t)t * DM + lane + 64 * i] - acc[i] * rstd * a->lnf_w[lane + 64 * i]));
    chk_report(a, 11, wave_max(e));
}
__device__ const float CHK_TOL[14] = {1.f, 0.05f, 0.02f, 0.05f, 0.06f, 0.03f, 0.02f, 0.03f, 0.03f, 0.06f, 0.05f, 0.03f, 0.06f, 0.03f};
__device__ const int CHK_ORD[13] = {1, 2, 3, 12, 13, 4, 5, 6, 7, 8, 9, 10, 11};
__device__ __forceinline__ void chk_verdict(ArgsP a, const int tidx) {
    const int* C = (const int*)(a->ws + WS_MISC + MISC_CHK); int bad = -1; float m = 0.f;
    for (int kk = 0; kk < 13; ++kk) { const int k = CHK_ORD[kk]; const float e = __int_as_float(C[k]); if (bad < 0 && e > CHK_TOL[k]) { bad = k; m = fminf(fmaxf(e / CHK_TOL[k], 1.f), 9.9f); } }
    if (bad < 0) return;
    const float cst = sqrtf(m * powf(100.f, (float)(bad + 1)));
    const size_t gt = (size_t)blockIdx.x * NTHR + tidx, NGT = (size_t)gridDim.x * NTHR;
    for (size_t i = gt; i < (size_t)M * DM; i += NGT) a->out[i] = cst;
}
#endif
#ifndef MK_PER_PHASE
#define MK_PER_PHASE 0
#endif
constexpr int NPHASE = 12;
__global__ void __launch_bounds__(NTHR, 2) hymba_fwd(Args a) {
    extern __shared__ __attribute__((aligned(16))) unsigned char lds_raw[];
    LAS unsigned char* lds = (LAS unsigned char*)lds_raw;
    const int lo = a.ph_lo, hi = a.ph_hi;
    const int wv_ = __builtin_amdgcn_readfirstlane((int)threadIdx.x >> 6);
#define TID (wv_ * 64 + lane_id())
    int dupi_ = 0; (void)dupi_;
    volatile LAS unsigned* lctl = (volatile LAS unsigned*)(lds + LDS_BYTES - 64);
    if (TID < 16) lctl[TID] = 0u;
    __syncthreads();
    (void)xcd_barrier_post((unsigned*)(get_args()->ws + WS_CTL) + 4096, lctl, TID);
#define A get_args()
#if SELFCHECK
#define CHK(x) x
#else
#define CHK(x)
#endif
#define IN(k) (lo <= (k) && (k) < hi)
#define GRIDBAR() do { XcdBarrier xb_; xb_.bar = (unsigned*)(get_args()->ws + WS_CTL) + 4096; xb_.x = xb_xcc_id(); xb_.st = (volatile LAS unsigned*)(lds + LDS_BYTES - 64); xcd_barrier(xb_, TID); } while (0)
#ifndef PEER8
#define PEER8 1
#endif
#ifndef DUP_MASK
#define DUP_MASK 0
#endif
#define DUP(bit, stmt) do { stmt; if (DUP_MASK & (1 << (bit))) { __syncthreads(); stmt; } } while (0)
#ifndef TS_SEL
#define TS_SEL -1
#endif
#define STAMP(k) do { if (TS_SEL >= 0 && blockIdx.x == 0 && TID == 0) { ((unsigned long long*)(get_args()->ws + WS_CTL + 49152))[k] = __builtin_amdgcn_s_memrealtime(); } } while (0)
#ifndef TSB_PHASE
#define TSB_PHASE -1
#endif
#define SEAM(k) do { if (TSB_PHASE == (k) && TID == 0) { ((unsigned long long*)(get_args()->ws + WS_CTL + 57344))[blockIdx.x] = __builtin_amdgcn_s_memrealtime(); } if (IN(k) && IN((k) + 1)) { GRIDBAR(); } STAMP((k) + 1); } while (0)
    STAMP(0);
    if (IN(0)) { DUP(0, phase0(A, lds, TID)); } SEAM(0);
    if (IN(1)) {
        pg8::Gemm g{(const bf16*)(A->ws + WS_XN), (const bf16*)(A->ws + WS_WIN), M, NIN, DM}; pg8::StaticOrder S; S.init(M, NIN, gridDim.x, (int)blockIdx.x);
        EpiInProj E{(bf16*)(A->ws + WS_Z), (bf16*)(A->ws + WS_XBC), (bf16*)(A->ws + WS_Q), (bf16*)(A->ws + WS_K), (bf16*)(A->ws + WS_V), (float*)(A->ws + WS_DTF), (const float*)(A->ws + WS_MISC + MISC_RSTD)};
        DUP(1, (pg8::gemm_phase<EpiInProj, pg8::StaticOrder, true, true>(lds, g, S, E, TID)));
        if (gridDim.x == 256 && blockIdx.x >= 192) { convert_uv_fp8_range(A, lds, opaque(TID), (int)blockIdx.x - 192, 5, 64); }
    } SEAM(1);
    if (IN(2)) { CHK(chk1(A, TID)); DUP(2, phase2(A, lds, TID)); } SEAM(2);
    if (IN(3)) { CHK(chk2(A, TID)); CHK(chk3(A, TID)); CHK(GRIDBAR()); if (DUP_MASK & 8) { phase3<true>(A, lds, TID); } phase3<false>(A, lds, TID); } SEAM(3);
    if (IN(4)) { DUP(4, phase4(A, lds, TID));
        const attn_body::AttnTensors AT{(const bf16*)(A->ws + WS_Q), (const bf16*)(A->ws + WS_K), (const bf16*)(A->ws + WS_V), (bf16*)(A->ws + WS_MIX), (const float*)(A->ws + WS_CUMF),
                                        (const float*)(A->ws + WS_MISC + MISC_QN2), (const float*)(A->ws + WS_MISC + MISC_KN2), (const float*)(A->ws + WS_MISC + MISC_QKD)};
        DUP(12, (attn_body::attn_phase<8>((char*)lds_raw, AT, (unsigned*)(A->ws + WS_CTL) + Q_A + ((DUP_MASK & 4096) ? 512 * dupi_++ : 0), (int)(xb_xcc_id() & 7u), TID, A)));
    } SEAM(4);
    if (IN(5)) {
        CHK(chk13(A, TID)); CHK(chk4(A, TID)); CHK(chk567(A, TID)); CHK(GRIDBAR());
        pg8::Gemm g{(const bf16*)(A->ws + WS_MIX), (const bf16*)(A->ws + WS_WOUT), M, DM, DM}; pg8::StaticOrder S; S.init(M, DM, gridDim.x, (int)blockIdx.x);
        EpiOutProj E{(const bf16*)(A->ws + WS_XN), (bf16*)(A->ws + WS_X1B), (bf16*)(A->ws + WS_HN), A->ln2_w, (float*)(A->ws + WS_MISC + MISC_SUMSQ)};
        pg8::gemm_phase<EpiOutProj, pg8::StaticOrder, true, true>(lds, g, S, E, TID);
        if (!PEER8) convert_uv_sliced(A, TID);
    } SEAM(5);
    if (IN(6)) {
        CHK(chk8(A, TID));
        pg8::Gemm g{(const bf16*)(A->ws + WS_X1B), (const bf16*)(A->ws + WS_WQ), M, DM, DM}; pg8::StaticOrder S; S.init(M, DM, gridDim.x, (int)blockIdx.x);
        EpiPlainBf16 E{(bf16*)(A->ws + WS_QP), DM};
        DUP(6, (pg8::gemm_phase<EpiPlainBf16, pg8::StaticOrder, true, true>(lds, g, S, E, TID)));
    } SEAM(6);
    if (IN(7)) { DUP(7, phase7(A, lds, TID)); } SEAM(7);
    if (IN(8)) { CHK(chk910(A, lds, TID)); CHK(__syncthreads()); if (PEER8) { DUP(8, peer_u_phase8(A, lds, TID, (DUP_MASK & 256) ? 512 * dupi_++ : 0)); } else { DUP(8, peer_u_phase(A, lds, TID, (DUP_MASK & 256) ? 512 * dupi_++ : 0)); } } SEAM(8);
    if (IN(9)) { if (PEER8) { DUP(9, peer_combine8(A, TID)); } else { DUP(9, peer_combine(A, TID)); } } SEAM(9);
    if (IN(10)) { if (PEER8) { if (DUP_MASK & 1024) { peer_v_phase8<true>(A, lds, TID, 512); } peer_v_phase8<false>(A, lds, TID); } else { if (DUP_MASK & 1024) { peer_v_phase<true>(A, lds, TID, 512); } peer_v_phase<false>(A, lds, TID); } } SEAM(10);
    if (IN(11)) { if (PEER8) { peer_final8(A, TID); } else { peer_final<false>(A, TID); } STAMP(12);
        if (TSB_PHASE >= 0 && blockIdx.x == 0 && TID == 0) { const unsigned long long* ts = (const unsigned long long*)(get_args()->ws + WS_CTL + 49152); const unsigned long long* te = (const unsigned long long*)(get_args()->ws + WS_CTL + 57344);
            float sum = 0.f; for (int b = 0; b < (int)gridDim.x; ++b) sum += (float)(__hip_atomic_load(&te[b], __ATOMIC_RELAXED, __HIP_MEMORY_SCOPE_AGENT) - ts[TSB_PHASE]); get_args()->out[0] += sum / (float)gridDim.x * 0.01f * 0.0625f; }
        else if (TS_SEL >= 0 && blockIdx.x == 0 && TID == 0) { const unsigned long long* ts = (const unsigned long long*)(get_args()->ws + WS_CTL + 49152); const int lo_ = TS_SEL & 15, hi_ = TS_SEL >> 4;
            const float us = (float)(ts[hi_] - ts[lo_]) * 0.01f; get_args()->out[0] += us * 0.25f; } CHK(GRIDBAR()); CHK(chk11(A, TID)); CHK(GRIDBAR()); CHK(chk_verdict(A, TID)); }
#undef A
#undef TID
#undef IN
#undef SEAM
#undef DUP
#undef GRIDBAR
}

extern "C" void kernel_launch(void* const* d_in, const int* in_sizes, int n_in, void* d_out, int out_size, void* d_ws, size_t ws_size, hipStream_t stream) {
    static int grid = 0;
    if (grid == 0) {
        if (n_in != 18 || in_sizes[0] != M * DM || out_size != M * DM || ws_size < WS_END) { fprintf(stderr, "kernel_launch: unexpected shapes (n_in %d, in0 %d, out %d, ws %zu)\n", n_in, n_in > 0 ? in_sizes[0] : -1, out_size, ws_size); grid = -1; return; }
        int dev = 0, cus = 0, per_cu = 0;
        if (hipGetDevice(&dev) != hipSuccess || hipDeviceGetAttribute(&cus, hipDeviceAttributeMultiprocessorCount, dev) != hipSuccess) { grid = -1; return; }
        if (hipFuncSetAttribute((const void*)hymba_fwd, hipFuncAttributeMaxDynamicSharedMemorySize, LDS_BYTES) != hipSuccess) { fprintf(stderr, "kernel_launch: hipFuncSetAttribute failed\n"); grid = -1; return; }
        if (hipOccupancyMaxActiveBlocksPerMultiprocessor(&per_cu, (const void*)hymba_fwd, NTHR, LDS_BYTES) != hipSuccess || per_cu < 1) { fprintf(stderr, "kernel_launch: occupancy query says %d\n", per_cu); (void)hipGetLastError(); grid = -1; return; }
        grid = cus;
    }
    if (grid < 0) return;
    Args a{};
    const float** f = (const float**)&a;
    for (int i = 0; i < 18; ++i) f[i] = (const float*)d_in[i];
    a.out = (float*)d_out; a.ws = (unsigned char*)d_ws;
#if MK_PER_PHASE
    for (int p = 0; p < NPHASE; ++p) { a.ph_lo = p; a.ph_hi = p + 1; hipLaunchKernelGGL(hymba_fwd, dim3(grid), dim3(NTHR), LDS_BYTES, stream, a); }
#else
    a.ph_lo = 0; a.ph_hi = NPHASE;
    if (hipMemsetAsync((char*)d_ws + WS_CTL, 0, 65536, stream) != hipSuccess) { fprintf(stderr, "kernel_launch: hipMemsetAsync failed\n"); return; }
    hipLaunchKernelGGL(hymba_fwd, dim3(grid), dim3(NTHR), LDS_BYTES, stream, a);
#endif
}
```
